# Optimizing an MI355X kernel written in HIP

```python
import math
import jax, jax.numpy as jnp
from jax import lax
import numpy as np

D_MODEL = 1024
BATCH = 8
SEQ = 2048
DEPTH = 1

DA_HEADS = 4
DA_HEAD_DIM = 64
DA_V_DIM = 2 * DA_HEAD_DIM
ROPE_THETA = 500000.0
ROPE_DIM = DA_HEAD_DIM // 4
Q_BLOCK = 128
LAMBDA_STD = 0.1
RET_HEADS = 4
RET_QK_DIM = 64
RET_V_DIM = 128
RET_CHUNK = 128
RET_ROT_BASE = 10000.0
DA_QK_W = DA_HEADS * 2 * DA_HEAD_DIM
DA_V_W = DA_HEADS * DA_V_DIM
RET_QK_W = RET_HEADS * RET_QK_DIM
RET_V_W = RET_HEADS * RET_V_DIM
IN_SPLITS = (DA_QK_W, DA_QK_W, DA_V_W, RET_QK_W, RET_QK_W, RET_V_W, RET_V_W, D_MODEL, D_MODEL)
IN_W = sum(IN_SPLITS)
D_FF = -(-8 * D_MODEL // (3 * 256)) * 256
EPS = 1e-6

kernel_name = "hybrid_diffattn_retention_gated_block"


def rms_norm(x, g=None):
    xf = x.astype(jnp.float32)
    y = xf * lax.rsqrt(jnp.mean(xf * xf, axis=-1, keepdims=True) + EPS)
    if g is not None:
        y = y * g.astype(jnp.float32)
    return y.astype(x.dtype)


def rotary(x, pos, rot_dim, theta):
    half = rot_dim // 2
    inv_freq = theta ** (-jnp.arange(half, dtype=jnp.float32) / half)
    ang = pos.astype(jnp.float32)[..., None] * inv_freq
    cos = jnp.cos(ang)[:, :, None, :]
    sin = jnp.sin(ang)[:, :, None, :]
    xr = x[..., :rot_dim].astype(jnp.float32)
    x1, x2 = xr[..., :half], xr[..., half:]
    rot = jnp.concatenate([x1 * cos - x2 * sin, x2 * cos + x1 * sin], axis=-1).astype(x.dtype)
    return jnp.concatenate([rot, x[..., rot_dim:]], axis=-1)


def diff_attention(q, k, v, pos, qn_g, kn_g, lq1, lk1, lq2, lk2, subln_g, lambda_init):
    B, S, H2, d = q.shape
    H = H2 // 2
    q = rotary(rms_norm(q, qn_g), pos, ROPE_DIM, ROPE_THETA)
    k = rotary(rms_norm(k, kn_g), pos, ROPE_DIM, ROPE_THETA)
    f32 = jnp.float32
    lam = (jnp.exp(jnp.sum(lq1.astype(f32) * lk1.astype(f32)))
           - jnp.exp(jnp.sum(lq2.astype(f32) * lk2.astype(f32))) + lambda_init)
    nb = S // Q_BLOCK
    qb = q.reshape(B, nb, Q_BLOCK, H2, d).transpose(1, 0, 3, 2, 4)
    kt = k.transpose(0, 2, 1, 3)
    vt = v.transpose(0, 2, 1, 3)
    scale = d ** -0.5
    kpos = jnp.arange(S)

    def block(args):
        qblk, i = args
        s = jnp.einsum('bhqd,bhkd->bhqk', qblk, kt).astype(f32) * scale
        qpos = i * Q_BLOCK + jnp.arange(Q_BLOCK)
        s = jnp.where(kpos[None, :] <= qpos[:, None], s, -1e30)
        p = jax.nn.softmax(s, axis=-1).reshape(B, H, 2, Q_BLOCK, S)
        a = (p[:, :, 0] - lam * p[:, :, 1]).astype(vt.dtype)
        return jnp.einsum('bhqk,bhkd->bhqd', a, vt)

    o = lax.map(block, (qb, jnp.arange(nb)))
    o = o.transpose(1, 0, 3, 2, 4).reshape(B, S, H, 2 * d)
    return rms_norm(o, subln_g) * (1.0 - lambda_init)


def retention(q, k, v, pos):
    B, S, H, dk = q.shape
    dv = v.shape[-1]
    C = RET_CHUNK
    N = S // C
    f32 = jnp.float32
    q = rotary(q, pos, dk, RET_ROT_BASE)
    k = rotary(k, pos, dk, RET_ROT_BASE)
    qc = q.astype(f32).reshape(B, N, C, H, dk)
    kc = k.astype(f32).reshape(B, N, C, H, dk) * (dk ** -0.5)
    vc = v.astype(f32).reshape(B, N, C, H, dv)
    log_g = jnp.log(1.0 - 2.0 ** (-5.0 - jnp.arange(H, dtype=f32)))
    idx = jnp.arange(C, dtype=f32)
    rel = idx[:, None] - idx[None, :]
    dmask = jnp.where(rel >= 0, jnp.exp(log_g[:, None, None] * jnp.maximum(rel, 0.0)), 0.0)
    sc = jnp.einsum('bnihd,bnjhd->bnhij', qc, kc) * dmask
    inner = jnp.einsum('bnhij,bnjhe->bnihe', sc, vc)
    k_decay = jnp.exp(log_g[:, None] * (C - 1.0 - idx)[None, :])
    kv = jnp.einsum('bnjhd,hj,bnjhe->nbhde', kc, k_decay, vc)
    chunk_decay = jnp.exp(log_g * C)[None, :, None, None]

    def step(R, kv_n):
        return R * chunk_decay + kv_n, R

    _, R_prev = lax.scan(step, jnp.zeros((B, H, dk, dv), f32), kv)
    q_decay = jnp.exp(log_g[:, None] * (idx + 1.0)[None, :])
    cross = jnp.einsum('bnihd,nbhde,hi->bnihe', qc, R_prev, q_decay)
    o = (inner + cross).reshape(B, S, H, dv)
    return rms_norm(o).astype(v.dtype)


def setup_inputs(seed: int = 0) -> dict:
    key = jax.random.key(seed)
    ks = jax.random.split(key, 24)
    n = jax.random.normal
    f = jnp.float32
    x = n(ks[0], (BATCH, SEQ, D_MODEL), f)
    c = n(ks[1], (BATCH, D_MODEL), f)
    offset = jax.random.randint(ks[2], (BATCH, 1), 0, 4096, dtype=jnp.int32)
    positions = (offset + jnp.arange(SEQ, dtype=jnp.int32)[None, :]).astype(jnp.int32)
    return {
        "x": x,
        "c": c,
        "positions": positions,
        "ada_w": n(ks[3], (DEPTH, D_MODEL, 6 * D_MODEL), f) * D_MODEL ** -0.5,
        "ada_b": n(ks[4], (DEPTH, 6 * D_MODEL), f) * 0.02,
        "norm1_g": 1.0 + 0.02 * n(ks[5], (DEPTH, D_MODEL), f),
        "w_in": n(ks[6], (DEPTH, D_MODEL, IN_W), f) * D_MODEL ** -0.5,
        "q_norm_g": 1.0 + 0.02 * n(ks[7], (DEPTH, DA_HEAD_DIM), f),
        "k_norm_g": 1.0 + 0.02 * n(ks[8], (DEPTH, DA_HEAD_DIM), f),
        "lambda_q1": n(ks[9], (DEPTH, DA_HEAD_DIM), f) * LAMBDA_STD,
        "lambda_k1": n(ks[10], (DEPTH, DA_HEAD_DIM), f) * LAMBDA_STD,
        "lambda_q2": n(ks[11], (DEPTH, DA_HEAD_DIM), f) * LAMBDA_STD,
        "lambda_k2": n(ks[12], (DEPTH, DA_HEAD_DIM), f) * LAMBDA_STD,
        "subln_g": 1.0 + 0.02 * n(ks[13], (DEPTH, DA_V_DIM), f),
        "w_branch_a": n(ks[14], (DEPTH, DA_V_W, D_MODEL), f) * DA_V_W ** -0.5,
        "w_branch_b": n(ks[15], (DEPTH, RET_V_W, D_MODEL), f) * RET_V_W ** -0.5,
        "w_out": n(ks[16], (DEPTH, D_MODEL, D_MODEL), f) * D_MODEL ** -0.5,
        "norm2_g": 1.0 + 0.02 * n(ks[17], (DEPTH, D_MODEL), f),
        "w_gate_up": n(ks[18], (DEPTH, D_MODEL, 2 * D_FF), f) * D_MODEL ** -0.5,
        "w_down": n(ks[19], (DEPTH, D_FF, D_MODEL), f) * D_FF ** -0.5,
    }


def reference(x, c, positions, ada_w, ada_b, norm1_g, w_in, q_norm_g, k_norm_g,
              lambda_q1, lambda_k1, lambda_q2, lambda_k2, subln_g, w_branch_a, w_branch_b,
              w_out, norm2_g, w_gate_up, w_down):
    B, S, _ = x.shape
    splits = [int(s) for s in np.cumsum(IN_SPLITS)[:-1]]
    for l in range(DEPTH):
        mod = jnp.einsum('bd,de->be', jax.nn.silu(c), ada_w[l]) + ada_b[l]
        sh1, sc1, g1, sh2, sc2, g2 = jnp.split(mod, 6, axis=-1)
        h = rms_norm(x, norm1_g[l]) * (1.0 + sc1[:, None, :]) + sh1[:, None, :]
        proj = jnp.einsum('bsd,de->bse', h, w_in[l])
        dq, dk, dv, rq, rk, rv, rg, ga, gb = jnp.split(proj, splits, axis=-1)
        lambda_init = 0.8 - 0.6 * math.exp(-0.3 * l)
        oa = diff_attention(
            dq.reshape(B, S, 2 * DA_HEADS, DA_HEAD_DIM),
            dk.reshape(B, S, 2 * DA_HEADS, DA_HEAD_DIM),
            dv.reshape(B, S, DA_HEADS, DA_V_DIM),
            positions, q_norm_g[l], k_norm_g[l],
            lambda_q1[l], lambda_k1[l], lambda_q2[l], lambda_k2[l], subln_g[l], lambda_init)
        ob = retention(
            rq.reshape(B, S, RET_HEADS, RET_QK_DIM),
            rk.reshape(B, S, RET_HEADS, RET_QK_DIM),
            rv.reshape(B, S, RET_HEADS, RET_V_DIM),
            positions)
        ob = ob.reshape(B, S, RET_V_W) * jax.nn.silu(rg)
        ya = jnp.einsum('bse,ed->bsd', oa.reshape(B, S, DA_V_W), w_branch_a[l])
        yb = jnp.einsum('bse,ed->bsd', ob, w_branch_b[l])
        y = jax.nn.sigmoid(ga) * ya + jax.nn.sigmoid(gb) * yb
        x = x + g1[:, None, :] * jnp.einsum('bsd,de->bse', y, w_out[l])
        h2 = rms_norm(x, norm2_g[l]) * (1.0 + sc2[:, None, :]) + sh2[:, None, :]
        gate, up = jnp.split(jnp.einsum('bsd,de->bse', h2, w_gate_up[l]), 2, axis=-1)
        x = x + g2[:, None, :] * jnp.einsum('bsf,fd->bsd', jax.nn.silu(gate) * up, w_down[l])
    return x
```

```cpp
#include <hip/hip_runtime.h>
#include <cstdint>
#include <cstdio>

typedef unsigned short bf16_t;
typedef short bf16x8 __attribute__((ext_vector_type(8)));
typedef float f32x4 __attribute__((ext_vector_type(4)));
typedef unsigned u32x2 __attribute__((ext_vector_type(2)));
typedef unsigned u32x4 __attribute__((ext_vector_type(4)));

constexpr int BATCH = 8, SEQ = 2048, DM = 1024, M = BATCH * SEQ, INW = 5120, DFF = 2816, MODW = 6 * DM;
constexpr float EPS = 1e-6f;
constexpr float C2 = 0.125f * 1.4426950408889634f;

constexpr size_t MiB = 1u << 20;
constexpr size_t WS_CTL = 0, WS_MOD = 1 * MiB, WS_TA = 2 * MiB, WS_TR = 3 * MiB;
constexpr size_t WS_WIN = 8 * MiB, WS_WA = 18 * MiB, WS_WB = 19 * MiB, WS_WOUT = 20 * MiB, WS_WGU = 22 * MiB, WS_WDN = 33 * MiB;
constexpr size_t WS_XN = 40 * MiB;
constexpr size_t WS_DQ = 72 * MiB, WS_DK = 88 * MiB, WS_DV = 104 * MiB, WS_RQ = 120 * MiB, WS_RK = 128 * MiB, WS_RV = 136 * MiB,
                 WS_RG = 152 * MiB, WS_GA = 168 * MiB, WS_GB = 200 * MiB, WS_RETO = 232 * MiB;
constexpr size_t WS_AO = WS_XN, WS_OA = WS_DQ, WS_OB = WS_RG, WS_Y = WS_DK, WS_ACT = 120 * MiB, WS_END = 256 * MiB;

__device__ __forceinline__ unsigned f2bf(float f) { unsigned u = __float_as_uint(f); return (u + 0x7fffu + ((u >> 16) & 1u)) >> 16; }
__device__ __forceinline__ unsigned pk2(float lo, float hi) { return f2bf(lo) | (f2bf(hi) << 16); }
__device__ __forceinline__ float bf2f(unsigned h) { return __uint_as_float(h << 16); }
__device__ __forceinline__ float bflo(unsigned w) { return __uint_as_float(w << 16); }
__device__ __forceinline__ float bfhi(unsigned w) { return __uint_as_float(w & 0xffff0000u); }
__device__ __forceinline__ u32x2 pack4(f32x4 v) { u32x2 r; r.x = pk2(v[0], v[1]); r.y = pk2(v[2], v[3]); return r; }
__device__ __forceinline__ float wave_sum(float v) {
#pragma unroll
    for (int o = 1; o < 64; o <<= 1) v += __shfl_xor(v, o);
    return v;
}
__device__ __forceinline__ float silu_f(float x) { return x / (1.f + __expf(-x)); }
__device__ __forceinline__ float sigm_f(float x) { return 1.f / (1.f + __expf(-x)); }

__constant__ double c_invf_da[8] = {1.0, 0.19392274474868576, 0.03760603093086393, 0.007292664737217109, 0.001414213562373095, 0.0002742481756762073, 5.318295896944988e-05, 1.031338537721246e-05};
__constant__ double c_invf_ret[32] = {1.0, 0.7498942093324559, 0.5623413251903491, 0.4216965034285822, 0.31622776601683794, 0.23713737056616552, 0.1778279410038923, 0.1333521432163324, 0.1, 0.07498942093324558, 0.05623413251903491, 0.042169650342858224, 0.03162277660168379, 0.023713737056616554, 0.01778279410038923, 0.01333521432163324, 0.01, 0.007498942093324558, 0.005623413251903491, 0.004216965034285823, 0.0031622776601683794, 0.0023713737056616554, 0.0017782794100389228, 0.001333521432163324, 0.001, 0.0007498942093324559, 0.0005623413251903491, 0.00042169650342858224, 0.00031622776601683794, 0.00023713737056616554, 0.00017782794100389227, 0.0001333521432163324};
__device__ __forceinline__ float log2gamma(int h) { return h == 0 ? -0.04580368961312479f : h == 1 ? -0.02272007650008353f : h == 2 ? -0.011315313227834146f : -0.005646563141142063f; }

__device__ __forceinline__ void mod_phase(int wg, int G, const float* c, const float* ada_w, const float* ada_b, float* mod, float* lds) {
    const int tid = threadIdx.x, wave = tid >> 6, lane = tid & 63;
    for (int i = tid; i < BATCH * DM; i += 512) lds[i] = silu_f(c[i]);
    __syncthreads();
    float* red = lds + BATCH * DM;
    const int cc = lane % 24, par = lane / 24;
    for (int cg = wg; cg < MODW / 24; cg += G) {
        const int e0 = cg * 24;
        float acc[8];
#pragma unroll
        for (int b = 0; b < 8; ++b) acc[b] = 0.f;
        if (par < 2) {
            const int d0 = wave * 128 + par;
#pragma unroll 8
            for (int i = 0; i < 64; ++i) {
                const int d = d0 + 2 * i;
                const float w = ada_w[(size_t)d * MODW + e0 + cc];
#pragma unroll
                for (int b = 0; b < 8; ++b) acc[b] += lds[b * DM + d] * w;
            }
#pragma unroll
            for (int b = 0; b < 8; ++b) red[((wave * 2 + par) * 8 + b) * 24 + cc] = acc[b];
        }
        __syncthreads();
        if (tid < 192) {
            const int b = tid / 24, c2 = tid % 24;
            float s = ada_b[e0 + c2];
#pragma unroll
            for (int w = 0; w < 16; ++w) s += red[(w * 8 + b) * 24 + c2];
            mod[b * MODW + e0 + c2] = s;
        }
        __syncthreads();
    }
}

__device__ __forceinline__ int slot2col(int map, int slot) {
    if (map == 1) { const int pn = slot >> 8, bj = (slot >> 7) & 1, wc = (slot >> 5) & 3, r = slot & 31; return (pn << 8) + (wc << 6) + (bj << 5) + r; }
    if (map == 2) { const int pn = slot >> 8, bj = (slot >> 7) & 1, j = slot & 127; return bj * DFF + pn * 128 + j; }
    return slot;
}
__device__ __forceinline__ void convert_item(const float* W, int K, int N, bf16_t* Wt, int map, float* scr, int item, int lane) {
    const int nblk = N / 32, kb = item / nblk, nb = item % nblk, k0 = 64 * kb, s0 = 32 * nb, c0 = slot2col(map, s0);
#pragma unroll 8
    for (int i = 0; i < 32; ++i) { const int kk = 2 * i + (lane >> 5); scr[kk * 33 + (lane & 31)] = W[(size_t)(k0 + kk) * N + c0 + (lane & 31)]; }
    __builtin_amdgcn_s_waitcnt(0xc07f); __builtin_amdgcn_wave_barrier();
    const int c = lane & 7;
#pragma unroll
    for (int j = 0; j < 4; ++j) { const int n = (lane >> 3) + 8 * j; const float* s = scr + (8 * c) * 33 + n;
        u32x4 o; o.x = pk2(s[0 * 33], s[1 * 33]); o.y = pk2(s[2 * 33], s[3 * 33]); o.z = pk2(s[4 * 33], s[5 * 33]); o.w = pk2(s[6 * 33], s[7 * 33]);
        *(u32x4*)(Wt + (size_t)(s0 + n) * K + k0 + 8 * c) = o; }
    __builtin_amdgcn_s_waitcnt(0xc07f); __builtin_amdgcn_wave_barrier();
}
struct ConvPtrs { const float *w_in, *wa, *wb, *wout, *wgu, *wdn; bf16_t *w_in_t, *wa_t, *wb_t, *wout_t, *wgu_t, *wdn_t; };
__device__ __forceinline__ void convert_phase(int wg, int G, const ConvPtrs& P, float* lds) {
    const int tid = threadIdx.x, wave = tid >> 6, lane = tid & 63;
    float* scr = lds + wave * (64 * 33);
    const int gw = wg * 8 + wave, NGW = G * 8;
    constexpr int I_IN = (DM / 64) * (INW / 32), I_A = (512 / 64) * (DM / 32), I_O = (DM / 64) * (DM / 32), I_GU = (DM / 64) * (2 * DFF / 32), I_DN = (DFF / 64) * (DM / 32);
    constexpr int NIT = I_IN + 2 * I_A + I_O + I_GU + I_DN;
    for (int it = gw; it < NIT; it += NGW) {
        int r = it;
        if (r < I_IN) { convert_item(P.w_in, DM, INW, P.w_in_t, 1, scr, r, lane); continue; } r -= I_IN;
        if (r < I_A) { convert_item(P.wa, 512, DM, P.wa_t, 0, scr, r, lane); continue; } r -= I_A;
        if (r < I_A) { convert_item(P.wb, 512, DM, P.wb_t, 0, scr, r, lane); continue; } r -= I_A;
        if (r < I_O) { convert_item(P.wout, DM, DM, P.wout_t, 0, scr, r, lane); continue; } r -= I_O;
        if (r < I_GU) { convert_item(P.wgu, DM, 2 * DFF, P.wgu_t, 2, scr, r, lane); continue; } r -= I_GU;
        convert_item(P.wdn, DFF, DM, P.wdn_t, 0, scr, r, lane);
    }
}

__device__ __forceinline__ void trig_phase(int wg, int G, const int* positions, float* TA, float* TR) {
    const int gt = wg * 512 + threadIdx.x, NT = G * 512;
    for (int it = gt; it < M * 40; it += NT) {
        const int row = it / 40, i = it % 40;
        const double p = (double)positions[row];
        const double a = p * (i < 8 ? c_invf_da[i] : c_invf_ret[i - 8]);
        double rev = a * 0.15915494309189535;
        rev -= __builtin_rint(rev);
        const float r = (float)(rev * 6.283185307179586);
        const float sn = sinf(r), cs = cosf(r);
        if (i < 8) { TA[row * 16 + i] = cs; TA[row * 16 + 8 + i] = sn; }
        else { TR[row * 64 + (i - 8)] = cs; TR[row * 64 + 32 + (i - 8)] = sn; }
    }
}

__device__ __forceinline__ void xn_phase(int wg, int G, const float* x, const float* g, const float* sc, const float* sh, bf16_t* XN) {
    const int tid = threadIdx.x, wave = tid >> 6, lane = tid & 63;
    for (int row = wg * 8 + wave; row < M; row += G * 8) {
        const int b = row / SEQ;
        const f32x4* xr = (const f32x4*)(x + (size_t)row * DM) + lane;
        f32x4 v[4]; float ss = 0.f;
#pragma unroll
        for (int j = 0; j < 4; ++j) { v[j] = xr[64 * j]; ss += (v[j][0] * v[j][0] + v[j][1] * v[j][1]) + (v[j][2] * v[j][2] + v[j][3] * v[j][3]); }
        const float rstd = rsqrtf(wave_sum(ss) * (1.f / DM) + EPS);
        u32x2* o = (u32x2*)(XN + (size_t)row * DM) + lane;
#pragma unroll
        for (int j = 0; j < 4; ++j) {
            const int col = 4 * lane + 256 * j;
            const f32x4 gg = *(const f32x4*)(g + col), s1 = *(const f32x4*)(sc + b * MODW + col), s0 = *(const f32x4*)(sh + b * MODW + col);
            f32x4 y = v[j] * rstd * gg * (s1 + 1.f) + s0;
            o[64 * j] = pack4(y);
        }
    }
}

__device__ __forceinline__ void combine_phase(int wg, int G, const bf16_t* AO, const bf16_t* RETO, bf16_t* RG_OB, bf16_t* OA,
                                              const float* lq1, const float* lk1, const float* lq2, const float* lk2, const float* subln_g) {
    const int tid = threadIdx.x, wave = tid >> 6, lane = tid & 63;
    const float lam = __expf(wave_sum(lq1[lane] * lk1[lane])) - __expf(wave_sum(lq2[lane] * lk2[lane])) + 0.2f;
    const int h = lane >> 4, d0 = (lane & 15) * 8;
    float gsub[8];
#pragma unroll
    for (int e = 0; e < 8; ++e) gsub[e] = subln_g[d0 + e] * 0.8f;
    for (int row = wg * 8 + wave; row < M; row += G * 8) {
        {
            const u32x4 a = *(const u32x4*)(AO + (size_t)row * 1024 + (2 * h) * 128 + d0), b = *(const u32x4*)(AO + (size_t)row * 1024 + (2 * h + 1) * 128 + d0);
            float d[8]; float ss = 0.f;
#pragma unroll
            for (int e = 0; e < 4; ++e) { d[2 * e] = bflo(a[e]) - lam * bflo(b[e]); d[2 * e + 1] = bfhi(a[e]) - lam * bfhi(b[e]); }
#pragma unroll
            for (int e = 0; e < 8; ++e) ss += d[e] * d[e];
            ss += __shfl_xor(ss, 1); ss += __shfl_xor(ss, 2); ss += __shfl_xor(ss, 4); ss += __shfl_xor(ss, 8);
            const float rstd = rsqrtf(ss * (1.f / 128.f) + EPS);
            u32x4 o;
#pragma unroll
            for (int e = 0; e < 4; ++e) o[e] = pk2(d[2 * e] * rstd * gsub[2 * e], d[2 * e + 1] * rstd * gsub[2 * e + 1]);
            *(u32x4*)(OA + (size_t)row * 512 + h * 128 + d0) = o;
        }
        {
            const u32x4 a = *(const u32x4*)(RETO + (size_t)row * 512 + h * 128 + d0), gt = *(const u32x4*)(RG_OB + (size_t)row * 512 + h * 128 + d0);
            float d[8]; float ss = 0.f;
#pragma unroll
            for (int e = 0; e < 4; ++e) { d[2 * e] = bflo(a[e]); d[2 * e + 1] = bfhi(a[e]); }
#pragma unroll
            for (int e = 0; e < 8; ++e) ss += d[e] * d[e];
            ss += __shfl_xor(ss, 1); ss += __shfl_xor(ss, 2); ss += __shfl_xor(ss, 4); ss += __shfl_xor(ss, 8);
            const float rstd = rsqrtf(ss * (1.f / 128.f) + EPS);
            u32x4 o;
#pragma unroll
            for (int e = 0; e < 4; ++e) o[e] = pk2(d[2 * e] * rstd * bflo(gt[e]), d[2 * e + 1] * rstd * bfhi(gt[e]));
            *(u32x4*)(RG_OB + (size_t)row * 512 + h * 128 + d0) = o;
        }
    }
}

struct InProjEpi {
    bf16_t *DQ, *DK, *DV, *RQ, *RK, *RV, *RG, *GA, *GB; const float *qg, *kg, *TA, *TR;
    __device__ __forceinline__ void operator()(const f32x4 (&v)[4], int row, int pn, int wc, int fq) const {
        f32x4 o[4]; bf16_t* dst;
        if (pn < 4) {
            const bool isq = pn < 2; const float* gn = isq ? qg : kg;
            float ss = 0.f;
#pragma unroll
            for (int g = 0; g < 4; ++g) ss += (v[g][0] * v[g][0] + v[g][1] * v[g][1]) + (v[g][2] * v[g][2] + v[g][3] * v[g][3]);
            ss += __shfl_xor(ss, 16); ss += __shfl_xor(ss, 32);
            const float rstd = rsqrtf(ss * (1.f / 64.f) + EPS) * (isq ? C2 : 1.f);
#pragma unroll
            for (int g = 0; g < 4; ++g) { const f32x4 gg = *(const f32x4*)(gn + 16 * g + 4 * fq); o[g] = v[g] * rstd * gg; }
            f32x4 other;
#pragma unroll
            for (int r = 0; r < 4; ++r) other[r] = __shfl_xor(o[0][r], 32);
            const f32x4 cs = *(const f32x4*)(TA + (size_t)row * 16 + 4 * (fq & 1)), sn = *(const f32x4*)(TA + (size_t)row * 16 + 8 + 4 * (fq & 1));
            o[0] = (fq < 2) ? (o[0] * cs - other * sn) : (o[0] * cs + other * sn);
            dst = (isq ? DQ : DK) + (size_t)row * 512 + ((pn & 1) * 4 + wc) * 64;
        } else if (pn == 6 || pn == 7) {
            const bool isq = pn == 6;
#pragma unroll
            for (int n = 0; n < 2; ++n) {
                const f32x4 cs = *(const f32x4*)(TR + (size_t)row * 64 + 16 * n + 4 * fq), sn = *(const f32x4*)(TR + (size_t)row * 64 + 32 + 16 * n + 4 * fq);
                o[n] = v[n] * cs - v[2 + n] * sn; o[2 + n] = v[2 + n] * cs + v[n] * sn;
            }
            const float t = (float)(row & (SEQ - 1)), lg = log2gamma(wc);
            const float s = isq ? exp2f(t * lg) : exp2f(-t * lg) * 0.125f;
#pragma unroll
            for (int g = 0; g < 4; ++g) o[g] = o[g] * s;
            dst = (isq ? RQ : RK) + (size_t)row * 256 + wc * 64;
        } else if (pn < 6) {
#pragma unroll
            for (int g = 0; g < 4; ++g) o[g] = v[g];
            dst = DV + (size_t)row * 512 + (pn - 4) * 256 + wc * 64;
        } else if (pn < 10) {
#pragma unroll
            for (int g = 0; g < 4; ++g) o[g] = v[g];
            dst = RV + (size_t)row * 512 + (pn - 8) * 256 + wc * 64;
        } else if (pn < 12) {
#pragma unroll
            for (int g = 0; g < 4; ++g)
#pragma unroll
                for (int r = 0; r < 4; ++r) o[g][r] = silu_f(v[g][r]);
            dst = RG + (size_t)row * 512 + (pn - 10) * 256 + wc * 64;
        } else {
#pragma unroll
            for (int g = 0; g < 4; ++g)
#pragma unroll
                for (int r = 0; r < 4; ++r) o[g][r] = sigm_f(v[g][r]);
            dst = (pn < 16 ? GA + (size_t)row * 1024 + (pn - 12) * 256 : GB + (size_t)row * 1024 + (pn - 16) * 256) + wc * 64;
        }
#pragma unroll
        for (int g = 0; g < 4; ++g) *(u32x2*)(dst + 16 * g + 4 * fq) = pack4(o[g]);
    }
};
struct BranchEpi {
    const bf16_t* gate; bf16_t* Y; int which;
    __device__ __forceinline__ void operator()(const f32x4 (&v)[4], int row, int pn, int wc, int fq) const {
#pragma unroll
        for (int g = 0; g < 4; ++g) {
            const size_t off = (size_t)row * 1024 + 256 * pn + 128 * (g >> 1) + 32 * wc + 16 * (g & 1) + 4 * fq;
            const u32x2 gt = *(const u32x2*)(gate + off);
            f32x4 y; y[0] = bflo(gt.x) * v[g][0]; y[1] = bfhi(gt.x) * v[g][1]; y[2] = bflo(gt.y) * v[g][2]; y[3] = bfhi(gt.y) * v[g][3];
            if (which) { const u32x2 p = *(const u32x2*)(Y + off); y[0] += bflo(p.x); y[1] += bfhi(p.x); y[2] += bflo(p.y); y[3] += bfhi(p.y); }
            *(u32x2*)(Y + off) = pack4(y);
        }
    }
};
struct ResidEpi {
    const float* base; float* out; const float* gvec;
    __device__ __forceinline__ void operator()(const f32x4 (&v)[4], int row, int pn, int wc, int fq) const {
        const int b = row / SEQ;
#pragma unroll
        for (int g = 0; g < 4; ++g) {
            const int col = 256 * pn + 128 * (g >> 1) + 32 * wc + 16 * (g & 1) + 4 * fq;
            const f32x4 gg = *(const f32x4*)(gvec + b * MODW + col), bs = *(const f32x4*)(base + (size_t)row * DM + col);
            *(f32x4*)(out + (size_t)row * DM + col) = bs + gg * v[g];
        }
    }
};
struct GateUpEpi {
    bf16_t* ACT;
    __device__ __forceinline__ void operator()(const f32x4 (&v)[4], int row, int pn, int wc, int fq) const {
#pragma unroll
        for (int n = 0; n < 2; ++n) {
            f32x4 y;
#pragma unroll
            for (int r = 0; r < 4; ++r) y[r] = silu_f(v[n][r]) * v[2 + n][r];
            *(u32x2*)(ACT + (size_t)row * DFF + 128 * pn + 32 * wc + 16 * n + 4 * fq) = pack4(y);
        }
    }
};

template <class Epi>
__global__ void __launch_bounds__(256) k_gemm_ref(const bf16_t* A, const bf16_t* Bt, int K, Epi E) {
    const int tid = threadIdx.x, lane = tid & 63, wc = tid >> 6, fr = lane & 15, fq = lane >> 4;
    const int row0 = blockIdx.x * 16, pn = blockIdx.y;
    f32x4 acc[4];
#pragma unroll
    for (int g = 0; g < 4; ++g) acc[g] = (f32x4){0.f, 0.f, 0.f, 0.f};
    const bf16_t* ap = A + (size_t)(row0 + fr) * K + fq * 8;
    const bf16_t* bp = Bt + (size_t)(256 * pn + 32 * wc + fr) * K + fq * 8;
    for (int k0 = 0; k0 < K; k0 += 32) {
        const bf16x8 a = *(const bf16x8*)(ap + k0);
#pragma unroll
        for (int g = 0; g < 4; ++g) {
            const bf16x8 b = *(const bf16x8*)(bp + (size_t)(128 * (g >> 1) + 16 * (g & 1)) * K + k0);
            acc[g] = __builtin_amdgcn_mfma_f32_16x16x32_bf16(b, a, acc[g], 0, 0, 0);
        }
    }
    E(acc, row0 + fr, pn, wc, fq);
}

template <bool LINEAR>
__global__ void __launch_bounds__(256) k_attn_ref(const bf16_t* Q, int qpitch, const bf16_t* K, int kpitch, const bf16_t* V, int vpitch, bf16_t* O, int opitch, int vdiv) {
    __shared__ float sS[4][SEQ];
    __shared__ float sQ[4][64];
    __shared__ float sO[2][4][128];
    const int tid = threadIdx.x, i0 = blockIdx.x * 4, u = blockIdx.y, b = blockIdx.z;
    { const int q = tid >> 6, d = tid & 63; sQ[q][d] = bf2f(Q[(size_t)(b * SEQ + i0 + q) * qpitch + u * 64 + d]); }
    __syncthreads();
    const int nk = i0 + 4;
    for (int j = tid; j < nk; j += 256) {
        const bf16_t* kr = K + (size_t)(b * SEQ + j) * kpitch + u * 64;
        float a[4] = {0.f, 0.f, 0.f, 0.f};
#pragma unroll
        for (int d8 = 0; d8 < 8; ++d8) {
            const u32x4 kk = *(const u32x4*)(kr + d8 * 8);
#pragma unroll
            for (int e = 0; e < 4; ++e) {
                const float k0 = bflo(kk[e]), k1 = bfhi(kk[e]);
#pragma unroll
                for (int q = 0; q < 4; ++q) a[q] += sQ[q][d8 * 8 + 2 * e] * k0 + sQ[q][d8 * 8 + 2 * e + 1] * k1;
            }
        }
#pragma unroll
        for (int q = 0; q < 4; ++q) sS[q][j] = (j <= i0 + q) ? a[q] : (LINEAR ? 0.f : -INFINITY);
    }
    __syncthreads();
    if (!LINEAR) {
        const int w = tid >> 6, lane = tid & 63;
        float mx = -INFINITY;
        for (int j = lane; j < nk; j += 64) mx = fmaxf(mx, sS[w][j]);
#pragma unroll
        for (int o = 1; o < 64; o <<= 1) mx = fmaxf(mx, __shfl_xor(mx, o));
        float sum = 0.f;
        for (int j = lane; j < nk; j += 64) { const float p = exp2f(sS[w][j] - mx); sS[w][j] = p; sum += p; }
        sum = wave_sum(sum);
        const float inv = 1.f / sum;
        for (int j = lane; j < nk; j += 64) sS[w][j] *= inv;
    }
    __syncthreads();
    const int d = tid & 127, hf = tid >> 7, h = u / vdiv;
    float o[4] = {0.f, 0.f, 0.f, 0.f};
    for (int j = hf; j < nk; j += 2) {
        const float v = bf2f(V[(size_t)(b * SEQ + j) * vpitch + h * 128 + d]);
#pragma unroll
        for (int q = 0; q < 4; ++q) o[q] += sS[q][j] * v;
    }
#pragma unroll
    for (int q = 0; q < 4; ++q) sO[hf][q][d] = o[q];
    __syncthreads();
    if (hf == 0) {
#pragma unroll
        for (int q = 0; q < 4; ++q) O[(size_t)(b * SEQ + i0 + q) * opitch + u * 128 + d] = (bf16_t)f2bf(sO[0][q][d] + sO[1][q][d]);
    }
}

struct ThinArgs {
    const float *x, *c, *ada_w, *ada_b, *g1n, *g2n, *lq1, *lk1, *lq2, *lk2, *subln; const int* pos; ConvPtrs cv;
    float *mod, *TA, *TR, *xres; bf16_t *XN, *AO, *RETO, *RG_OB, *OA;
};
__global__ void __launch_bounds__(512) k_thin(ThinArgs a, int what) {
    extern __shared__ __attribute__((aligned(16))) unsigned char lds_raw[];
    float* lds = (float*)lds_raw;
    const int wg = blockIdx.x, G = gridDim.x;
    if (what == 0) { mod_phase(wg, G, a.c, a.ada_w, a.ada_b, a.mod, lds); }
    else if (what == 1) { convert_phase(wg, G, a.cv, lds); trig_phase(wg, G, a.pos, a.TA, a.TR); }
    else if (what == 2) { xn_phase(wg, G, a.x, a.g1n, a.mod + 1 * DM, a.mod + 0 * DM, a.XN); }
    else if (what == 3) { combine_phase(wg, G, a.AO, a.RETO, a.RG_OB, a.OA, a.lq1, a.lk1, a.lq2, a.lk2, a.subln); }
    else if (what == 4) { xn_phase(wg, G, a.xres, a.g2n, a.mod + 4 * DM, a.mod + 3 * DM, a.XN); }
}

extern "C" void kernel_launch(void* const* d_in, const int* in_sizes, int n_in, void* d_out, int out_size, void* d_ws, size_t ws_size, hipStream_t stream) {
    if (n_in != 20 || ws_size < WS_END) { fprintf(stderr, "kernel_launch: unexpected n_in %d / ws_size %zu\n", n_in, ws_size); return; }
    unsigned char* ws = (unsigned char*)d_ws;
    const float* x = (const float*)d_in[0]; float* out = (float*)d_out;
    float* mod = (float*)(ws + WS_MOD);
    ThinArgs a{};
    a.x = x; a.c = (const float*)d_in[1]; a.pos = (const int*)d_in[2]; a.ada_w = (const float*)d_in[3]; a.ada_b = (const float*)d_in[4];
    a.g1n = (const float*)d_in[5]; a.g2n = (const float*)d_in[17];
    a.lq1 = (const float*)d_in[9]; a.lk1 = (const float*)d_in[10]; a.lq2 = (const float*)d_in[11]; a.lk2 = (const float*)d_in[12]; a.subln = (const float*)d_in[13];
    a.cv.w_in = (const float*)d_in[6]; a.cv.wa = (const float*)d_in[14]; a.cv.wb = (const float*)d_in[15]; a.cv.wout = (const float*)d_in[16]; a.cv.wgu = (const float*)d_in[18]; a.cv.wdn = (const float*)d_in[19];
    a.cv.w_in_t = (bf16_t*)(ws + WS_WIN); a.cv.wa_t = (bf16_t*)(ws + WS_WA); a.cv.wb_t = (bf16_t*)(ws + WS_WB); a.cv.wout_t = (bf16_t*)(ws + WS_WOUT); a.cv.wgu_t = (bf16_t*)(ws + WS_WGU); a.cv.wdn_t = (bf16_t*)(ws + WS_WDN);
    a.mod = mod; a.TA = (float*)(ws + WS_TA); a.TR = (float*)(ws + WS_TR); a.xres = out;
    a.XN = (bf16_t*)(ws + WS_XN); a.AO = (bf16_t*)(ws + WS_AO); a.RETO = (bf16_t*)(ws + WS_RETO); a.RG_OB = (bf16_t*)(ws + WS_RG); a.OA = (bf16_t*)(ws + WS_OA);
    bf16_t *DQ = (bf16_t*)(ws + WS_DQ), *DK = (bf16_t*)(ws + WS_DK), *DV = (bf16_t*)(ws + WS_DV), *RQ = (bf16_t*)(ws + WS_RQ), *RK = (bf16_t*)(ws + WS_RK), *RV = (bf16_t*)(ws + WS_RV),
           *RG = (bf16_t*)(ws + WS_RG), *GA = (bf16_t*)(ws + WS_GA), *GB = (bf16_t*)(ws + WS_GB), *Y = (bf16_t*)(ws + WS_Y), *ACT = (bf16_t*)(ws + WS_ACT);
    const size_t thin_lds = 8 * 64 * 33 * 4;
    static bool attr_done = false;
    if (!attr_done) { (void)hipFuncSetAttribute((const void*)k_thin, hipFuncAttributeMaxDynamicSharedMemorySize, (int)thin_lds); attr_done = true; }
    hipLaunchKernelGGL(k_thin, dim3(256), dim3(512), thin_lds, stream, a, 0);
    hipLaunchKernelGGL(k_thin, dim3(256), dim3(512), thin_lds, stream, a, 1);
    hipLaunchKernelGGL(k_thin, dim3(256), dim3(512), thin_lds, stream, a, 2);
    {
        InProjEpi E{DQ, DK, DV, RQ, RK, RV, RG, GA, GB, (const float*)d_in[7], (const float*)d_in[8], a.TA, a.TR};
        hipLaunchKernelGGL(k_gemm_ref<InProjEpi>, dim3(M / 16, INW / 256), dim3(256), 0, stream, a.XN, a.cv.w_in_t, DM, E);
    }
    hipLaunchKernelGGL(k_attn_ref<false>, dim3(SEQ / 4, 8, BATCH), dim3(256), 0, stream, DQ, 512, DK, 512, DV, 512, a.AO, 1024, 2);
    hipLaunchKernelGGL(k_attn_ref<true>, dim3(SEQ / 4, 4, BATCH), dim3(256), 0, stream, RQ, 256, RK, 256, RV, 512, a.RETO, 512, 1);
    hipLaunchKernelGGL(k_thin, dim3(256), dim3(512), thin_lds, stream, a, 3);
    { BranchEpi E{GA, Y, 0}; hipLaunchKernelGGL(k_gemm_ref<BranchEpi>, dim3(M / 16, DM / 256), dim3(256), 0, stream, a.OA, a.cv.wa_t, 512, E); }
    { BranchEpi E{GB, Y, 1}; hipLaunchKernelGGL(k_gemm_ref<BranchEpi>, dim3(M / 16, DM / 256), dim3(256), 0, stream, a.RG_OB, a.cv.wb_t, 512, E); }
    { ResidEpi E{x, out, mod + 2 * DM}; hipLaunchKernelGGL(k_gemm_ref<ResidEpi>, dim3(M / 16, DM / 256), dim3(256), 0, stream, Y, a.cv.wout_t, DM, E); }
    hipLaunchKernelGGL(k_thin, dim3(256), dim3(512), thin_lds, stream, a, 4);
    { GateUpEpi E{ACT}; hipLaunchKernelGGL(k_gemm_ref<GateUpEpi>, dim3(M / 16, 2 * DFF / 256), dim3(256), 0, stream, a.XN, a.cv.wgu_t, DM, E); }
    { ResidEpi E{out, out, mod + 5 * DM}; hipLaunchKernelGGL(k_gemm_ref<ResidEpi>, dim3(M / 16, DM / 256), dim3(256), 0, stream, ACT, a.cv.wdn_t, DFF, E); }
}
```

```cpp
#include <hip/hip_runtime.h>
#include <cstdint>
#include <cstdio>
#include <hip/hip_bf16.h>
#include <cmath>

typedef unsigned short bf16_t;
typedef short bf16x8 __attribute__((ext_vector_type(8)));
typedef float f32x4 __attribute__((ext_vector_type(4)));
typedef unsigned u32x2 __attribute__((ext_vector_type(2)));
typedef unsigned u32x4 __attribute__((ext_vector_type(4)));

constexpr int BATCH = 8, SEQ = 2048, DM = 1024, M = BATCH * SEQ, INW = 5120, DFF = 2816, MODW = 6 * DM;
constexpr float EPS = 1e-6f;
constexpr float C2 = 0.125f * 1.4426950408889634f;

constexpr size_t MiB = 1u << 20;
constexpr size_t WS_CTL = 0, WS_MOD = 1 * MiB, WS_CVEC = 1 * MiB + 256 * 1024, WS_TA = 2 * MiB, WS_TR = 3 * MiB, WS_ROWSS = 7 * MiB;
constexpr size_t WS_WIN = 8 * MiB, WS_WA = 18 * MiB, WS_WB = 19 * MiB, WS_WOUT = 20 * MiB, WS_WGU = 22 * MiB, WS_WDN = 33 * MiB;
constexpr size_t WS_XN = 40 * MiB;
constexpr size_t WS_DQ = 72 * MiB, WS_DK = 88 * MiB, WS_DV = 104 * MiB, WS_RQ = 120 * MiB, WS_RK = 128 * MiB, WS_RV = 136 * MiB,
                 WS_RG = 152 * MiB, WS_GA = 168 * MiB, WS_GB = 200 * MiB, WS_RETO = 232 * MiB, WS_X1B = 208 * MiB;
constexpr size_t WS_AO = WS_XN, WS_OA = WS_DQ, WS_OB = WS_RG, WS_Y = WS_DK, WS_ACT = 120 * MiB, WS_END = 256 * MiB;

__device__ __forceinline__ int lane_id_() { return (int)__builtin_amdgcn_mbcnt_hi(~0u, __builtin_amdgcn_mbcnt_lo(~0u, 0u)); }
__device__ __forceinline__ unsigned f2bf(float f) { unsigned u = __float_as_uint(f); return (u + 0x7fffu + ((u >> 16) & 1u)) >> 16; }
typedef float f32x2_t_ __attribute__((ext_vector_type(2))); typedef __bf16 bf16x2_t_ __attribute__((ext_vector_type(2)));
__device__ __forceinline__ unsigned pk2(float lo, float hi) { f32x2_t_ v = {lo, hi}; bf16x2_t_ b = __builtin_convertvector(v, bf16x2_t_); return __builtin_bit_cast(unsigned, b); }
__device__ __forceinline__ float bf2f(unsigned h) { return __uint_as_float(h << 16); }
__device__ __forceinline__ float bflo(unsigned w) { return __uint_as_float(w << 16); }
__device__ __forceinline__ float bfhi(unsigned w) { return __uint_as_float(w & 0xffff0000u); }
__device__ __forceinline__ u32x2 pack4(f32x4 v) { u32x2 r; r.x = pk2(v[0], v[1]); r.y = pk2(v[2], v[3]); return r; }
__device__ __forceinline__ float wave_sum(float v) {
#pragma unroll
    for (int o = 1; o < 64; o <<= 1) v += __shfl_xor(v, o);
    return v;
}
__device__ __forceinline__ float silu_f(float x) { return x * __builtin_amdgcn_rcpf(1.f + __builtin_amdgcn_exp2f(-1.4426950408889634f * x)); }
__device__ __forceinline__ float sigm_f(float x) { return __builtin_amdgcn_rcpf(1.f + __builtin_amdgcn_exp2f(-1.4426950408889634f * x)); }

__constant__ double c_invf_da[8] = {1.0, 0.19392274474868576, 0.03760603093086393, 0.007292664737217109, 0.001414213562373095, 0.0002742481756762073, 5.318295896944988e-05, 1.031338537721246e-05};
__constant__ double c_invf_ret[32] = {1.0, 0.7498942093324559, 0.5623413251903491, 0.4216965034285822, 0.31622776601683794, 0.23713737056616552, 0.1778279410038923, 0.1333521432163324, 0.1, 0.07498942093324558, 0.05623413251903491, 0.042169650342858224, 0.03162277660168379, 0.023713737056616554, 0.01778279410038923, 0.01333521432163324, 0.01, 0.007498942093324558, 0.005623413251903491, 0.004216965034285823, 0.0031622776601683794, 0.0023713737056616554, 0.0017782794100389228, 0.001333521432163324, 0.001, 0.0007498942093324559, 0.0005623413251903491, 0.00042169650342858224, 0.00031622776601683794, 0.00023713737056616554, 0.00017782794100389227, 0.0001333521432163324};
__device__ __forceinline__ float log2gamma(int h) { return h == 0 ? -0.04580368961312479f : h == 1 ? -0.02272007650008353f : h == 2 ? -0.011315313227834146f : -0.005646563141142063f; }

template <bool SILU, bool GUMAP>
__device__ __forceinline__ void gemv8_phase(int tid, int wg, int G, const float* vec, int vpitch, const float* W, int N, const float* bias, float* out, int opitch, float* lds) {
    const int wave = tid >> 6, lane = tid & 63, r8 = lane >> 3, c4 = lane & 7;
    f32x4 w[16];
    if (wg < N / 32) { const float* wp = W + (size_t)(wave * 128 + r8) * N + wg * 32 + c4 * 4;
#pragma unroll
        for (int i = 0; i < 16; ++i) w[i] = *(const f32x4*)(wp + (size_t)(8 * i) * N); }
    for (int i = tid; i < BATCH * DM; i += 512) { const float v = vec[(i >> 10) * vpitch + (i & 1023)]; lds[i] = SILU ? silu_f(v) : v; }
    __syncthreads();
    float* red = lds + BATCH * DM;
    for (int cg = wg; cg < N / 32; cg += G) {
        const int e0 = cg * 32;
        f32x4 acc[8];
#pragma unroll
        for (int b = 0; b < 8; ++b) acc[b] = (f32x4){0.f, 0.f, 0.f, 0.f};
        if (cg != wg) { const float* wp = W + (size_t)(wave * 128 + r8) * N + e0 + c4 * 4;
#pragma unroll
            for (int i = 0; i < 16; ++i) w[i] = *(const f32x4*)(wp + (size_t)(8 * i) * N); }
#pragma unroll
        for (int i = 0; i < 16; ++i) {
            const int d = wave * 128 + 8 * i + r8;
#pragma unroll
            for (int b = 0; b < 8; ++b) acc[b] += w[i] * lds[b * DM + d];
        }
#pragma unroll
        for (int b = 0; b < 8; ++b)
#pragma unroll
            for (int e = 0; e < 4; ++e) { float v = acc[b][e]; v += __shfl_xor(v, 8); v += __shfl_xor(v, 16); v += __shfl_xor(v, 32); acc[b][e] = v; }
        if (r8 == 0) {
#pragma unroll
            for (int b = 0; b < 8; ++b) *(f32x4*)(red + (wave * 8 + b) * 32 + c4 * 4) = acc[b];
        }
        __syncthreads();
        if (tid < 256) {
            const int b = tid >> 5, c2 = tid & 31, e = e0 + c2;
            float s = bias ? bias[e] : 0.f;
#pragma unroll
            for (int w2 = 0; w2 < 8; ++w2) s += red[(w2 * 8 + b) * 32 + c2];
            int oi = e;
            if (GUMAP) { const int bj = e / DFF, r = e % DFF; oi = (r >> 7) * 256 + bj * 128 + (r & 127); }
            out[b * opitch + oi] = s;
        }
        __syncthreads();
    }
}

__device__ __forceinline__ int slot2col(int map, int slot) {
    if (map == 1) { const int pn = slot >> 8, bj = (slot >> 7) & 1, wc = (slot >> 5) & 3, r = slot & 31; return (pn << 8) + (wc << 6) + (bj << 5) + r; }
    if (map == 2) { const int pn = slot >> 8, bj = (slot >> 7) & 1, j = slot & 127; return bj * DFF + pn * 128 + j; }
    return slot;
}
__device__ __forceinline__ void convert_item(const float* W, int K, int N, bf16_t* Wt, int map, float* scr, int item, int lane) {
    const int nblk = N / 32, kb = item / nblk, nb = item % nblk, k0 = 64 * kb, s0 = 32 * nb, c0 = slot2col(map, s0);
    { const int r8 = lane >> 3, c4 = lane & 7;
      f32x4 v[8];
#pragma unroll
      for (int i = 0; i < 8; ++i) v[i] = *(const f32x4*)(W + (size_t)(k0 + 8 * i + r8) * N + c0 + 4 * c4);
#pragma unroll
      for (int i = 0; i < 8; ++i) { float* d = scr + (8 * i + r8) * 33 + 4 * c4; d[0] = v[i][0]; d[1] = v[i][1]; d[2] = v[i][2]; d[3] = v[i][3]; } }
    __builtin_amdgcn_s_waitcnt(0xc07f); __builtin_amdgcn_wave_barrier();
    const int c = lane & 7;
#pragma unroll
    for (int j = 0; j < 4; ++j) { const int n = (lane >> 3) + 8 * j; const float* s = scr + (8 * c) * 33 + n;
        u32x4 o; o.x = pk2(s[0 * 33], s[1 * 33]); o.y = pk2(s[2 * 33], s[3 * 33]); o.z = pk2(s[4 * 33], s[5 * 33]); o.w = pk2(s[6 * 33], s[7 * 33]);
        *(u32x4*)(Wt + (size_t)(s0 + n) * K + k0 + 8 * c) = o; }
    __builtin_amdgcn_s_waitcnt(0xc07f); __builtin_amdgcn_wave_barrier();
}
struct ConvPtrs { const float *w_in, *wa, *wb, *wout, *wgu, *wdn; bf16_t *w_in_t, *wa_t, *wb_t, *wout_t, *wgu_t, *wdn_t; };
__device__ __forceinline__ void convert_phase(int tid, int wg, int G, const ConvPtrs& P, float* lds) {
    const int wave = tid >> 6, lane = tid & 63;
    float* scr = lds + wave * (64 * 33);
    const int gw = wg * 8 + wave, NGW = G * 8;
    constexpr int I_IN = (DM / 64) * (INW / 32), I_A = (512 / 64) * (DM / 32), I_O = (DM / 64) * (DM / 32), I_GU = (DM / 64) * (2 * DFF / 32), I_DN = (DFF / 64) * (DM / 32);
    constexpr int NIT = I_IN + 2 * I_A + I_O + I_GU + I_DN;
    for (int it = gw; it < NIT; it += NGW) {
        int r = it;
        if (r < I_IN) { convert_item(P.w_in, DM, INW, P.w_in_t, 1, scr, r, lane); continue; } r -= I_IN;
        if (r < I_A) { convert_item(P.wa, 512, DM, P.wa_t, 0, scr, r, lane); continue; } r -= I_A;
        if (r < I_A) { convert_item(P.wb, 512, DM, P.wb_t, 0, scr, r, lane); continue; } r -= I_A;
        if (r < I_O) { convert_item(P.wout, DM, DM, P.wout_t, 0, scr, r, lane); continue; } r -= I_O;
        if (r < I_GU) { convert_item(P.wgu, DM, 2 * DFF, P.wgu_t, 2, scr, r, lane); continue; } r -= I_GU;
        convert_item(P.wdn, DFF, DM, P.wdn_t, 0, scr, r, lane);
    }
}

__device__ __forceinline__ void trig_phase(int tid, int wg, int G, const int* positions, float* TA, float* TR) {
    const int gt = wg * 512 + tid, NT = G * 512;
    for (int it = gt; it < M * 40; it += NT) {
        const int row = it / 40, i = it % 40;
        const double p = (double)positions[row];
        const double a = p * (i < 8 ? c_invf_da[i] : c_invf_ret[i - 8]);
        double rev = a * 0.15915494309189535;
        rev -= __builtin_rint(rev);
        const float sn = __builtin_amdgcn_sinf((float)rev), cs = __builtin_amdgcn_cosf((float)rev);
        if (i < 8) { TA[row * 16 + i] = cs; TA[row * 16 + 8 + i] = sn; }
        else { TR[row * 64 + (i - 8)] = cs; TR[row * 64 + 32 + (i - 8)] = sn; }
    }
}

__device__ __forceinline__ void xn_phase(int tid, int wg, int G, const float* x, const float* g, const float* sc, const float* sh, bf16_t* XN) {
    const int wave = tid >> 6, lane = tid & 63;
    for (int r0 = (wg * 8 + wave) * 8; r0 < M; r0 += G * 64) {
        const int b = r0 / SEQ;
        f32x4 a[4], s0[4];
#pragma unroll
        for (int j = 0; j < 4; ++j) { const int col = 4 * lane + 256 * j; a[j] = *(const f32x4*)(g + col) * (*(const f32x4*)(sc + b * MODW + col) + 1.f); s0[j] = *(const f32x4*)(sh + b * MODW + col); }
#pragma unroll
        for (int h = 0; h < 2; ++h) {
            f32x4 v[4][4];
#pragma unroll
            for (int r = 0; r < 4; ++r)
#pragma unroll
                for (int j = 0; j < 4; ++j) v[r][j] = ((const f32x4*)(x + (size_t)(r0 + 4 * h + r) * DM))[lane + 64 * j];
            __builtin_amdgcn_sched_barrier(0);
#pragma unroll
            for (int r = 0; r < 4; ++r) {
                float ss = 0.f;
#pragma unroll
                for (int j = 0; j < 4; ++j) ss += (v[r][j][0] * v[r][j][0] + v[r][j][1] * v[r][j][1]) + (v[r][j][2] * v[r][j][2] + v[r][j][3] * v[r][j][3]);
                const float rstd = rsqrtf(wave_sum(ss) * (1.f / DM) + EPS);
                u32x2* o = (u32x2*)(XN + (size_t)(r0 + 4 * h + r) * DM) + lane;
#pragma unroll
                for (int j = 0; j < 4; ++j) o[64 * j] = pack4(v[r][j] * rstd * a[j] + s0[j]);
            }
        }
    }
}

__device__ __forceinline__ void combine_phase(int tid, int wg, int G, const bf16_t* AO, const bf16_t* RETO, bf16_t* RG_OB, bf16_t* OA,
                                              const float* lq1, const float* lk1, const float* lq2, const float* lk2, const float* subln_g) {
    const int wave = tid >> 6, lane = tid & 63;
    const float lam = __expf(wave_sum(lq1[lane] * lk1[lane])) - __expf(wave_sum(lq2[lane] * lk2[lane])) + 0.2f;
    const int h = lane >> 4, d0 = (lane & 15) * 8;
    float gsub[8];
#pragma unroll
    for (int e = 0; e < 8; ++e) gsub[e] = subln_g[d0 + e] * 0.8f;
    for (int row = wg * 64 + wave * 8; row < M; row += G * 64) for (int rj = 0; rj < 8; ++rj, ++row) {
        {
            const u32x4 a = *(const u32x4*)(AO + (size_t)row * 1024 + (2 * h) * 128 + d0), b = *(const u32x4*)(AO + (size_t)row * 1024 + (2 * h + 1) * 128 + d0);
            float d[8]; float ss = 0.f;
#pragma unroll
            for (int e = 0; e < 4; ++e) { d[2 * e] = bflo(a[e]) - lam * bflo(b[e]); d[2 * e + 1] = bfhi(a[e]) - lam * bfhi(b[e]); }
#pragma unroll
            for (int e = 0; e < 8; ++e) ss += d[e] * d[e];
            ss += __shfl_xor(ss, 1); ss += __shfl_xor(ss, 2); ss += __shfl_xor(ss, 4); ss += __shfl_xor(ss, 8);
            const float rstd = rsqrtf(ss * (1.f / 128.f) + EPS);
            u32x4 o;
#pragma unroll
            for (int e = 0; e < 4; ++e) o[e] = pk2(d[2 * e] * rstd * gsub[2 * e], d[2 * e + 1] * rstd * gsub[2 * e + 1]);
            *(u32x4*)(OA + (size_t)row * 512 + h * 128 + d0) = o;
        }
        {
            const u32x4 a = *(const u32x4*)(RETO + (size_t)row * 512 + h * 128 + d0), gt = *(const u32x4*)(RG_OB + (size_t)row * 512 + h * 128 + d0);
            float d[8]; float ss = 0.f;
#pragma unroll
            for (int e = 0; e < 4; ++e) { d[2 * e] = bflo(a[e]); d[2 * e + 1] = bfhi(a[e]); }
#pragma unroll
            for (int e = 0; e < 8; ++e) ss += d[e] * d[e];
            ss += __shfl_xor(ss, 1); ss += __shfl_xor(ss, 2); ss += __shfl_xor(ss, 4); ss += __shfl_xor(ss, 8);
            const float rstd = rsqrtf(ss * (1.f / 128.f) + EPS);
            u32x4 o;
#pragma unroll
            for (int e = 0; e < 4; ++e) o[e] = pk2(d[2 * e] * rstd * bflo(gt[e]), d[2 * e + 1] * rstd * bfhi(gt[e]));
            *(u32x4*)(RG_OB + (size_t)row * 512 + h * 128 + d0) = o;
        }
    }
}

__device__ __forceinline__ u32x4 pack8(f32x4 a, f32x4 b) { u32x4 r; r.x = pk2(a[0], a[1]); r.y = pk2(a[2], a[3]); r.z = pk2(b[0], b[1]); r.w = pk2(b[2], b[3]); return r; }
#define SLOT8(pn, wc, fq, g) (256 * (pn) + 128 * ((g) >> 1) + 32 * (wc) + 8 * (fq) + 4 * ((g) & 1))
struct InProjEpi {
    static constexpr int BATCH = 2;
    struct Tile { f32x4 gn[4]; };
    struct Pre { f32x4 t[4]; };
    bf16_t *DQ, *DK, *DV, *RQ, *RK, *RV, *RG, *GA, *GB; const float *qg, *kg, *TA, *TR;
    __device__ __forceinline__ Tile tile_pre(int b, int pn, int wc, int fq) const {
        Tile T;
        if (pn < 4) { const float* gn = pn < 2 ? qg : kg;
#pragma unroll
            for (int g = 0; g < 4; ++g) T.gn[g] = *(const f32x4*)(gn + 32 * (g >> 1) + 8 * fq + 4 * (g & 1)); }
        return T;
    }
    __device__ __forceinline__ Pre row_pre(int row, int b, int pn, int wc, int fq) const {
        Pre P;
        if (pn < 4) {
#pragma unroll
            for (int i = 0; i < 4; ++i) P.t[i] = *(const f32x4*)(TA + (size_t)row * 16 + 4 * i); }
        else if (pn == 6 || pn == 7) {
#pragma unroll
            for (int n = 0; n < 2; ++n) { P.t[n] = *(const f32x4*)(TR + (size_t)row * 64 + 8 * fq + 4 * n); P.t[2 + n] = *(const f32x4*)(TR + (size_t)row * 64 + 32 + 8 * fq + 4 * n); } }
        return P;
    }
    __device__ __forceinline__ void operator()(const f32x4 (&v)[4], const Pre& P, const Tile& T, int row, int b, int pn, int wc, int fq) const {
        f32x4 o[4]; bf16_t* dst;
        if (pn < 4) {
            const bool isq = pn < 2;
            float ss = 0.f;
#pragma unroll
            for (int g = 0; g < 4; ++g) ss += (v[g][0] * v[g][0] + v[g][1] * v[g][1]) + (v[g][2] * v[g][2] + v[g][3] * v[g][3]);
            ss += __shfl_xor(ss, 16); ss += __shfl_xor(ss, 32);
            const float rstd = rsqrtf(ss * (1.f / 64.f) + EPS) * (isq ? C2 : 1.f);
#pragma unroll
            for (int g = 0; g < 4; ++g) o[g] = v[g] * rstd * T.gn[g];
#pragma unroll
            for (int n = 0; n < 2; ++n) {
                f32x4 other;
#pragma unroll
                for (int r = 0; r < 4; ++r) other[r] = __shfl_xor(o[n][r], 16);
                const f32x4 rot = (fq == 0) ? (o[n] * P.t[n] - other * P.t[2 + n]) : (o[n] * P.t[n] + other * P.t[2 + n]);
                o[n] = (fq < 2) ? rot : o[n];
            }
            dst = (isq ? DQ : DK) + (size_t)row * 512 + ((pn & 1) * 4 + wc) * 64;
        } else if (pn == 6 || pn == 7) {
            const bool isq = pn == 6;
#pragma unroll
            for (int n = 0; n < 2; ++n) { o[n] = v[n] * P.t[n] - v[2 + n] * P.t[2 + n]; o[2 + n] = v[2 + n] * P.t[n] + v[n] * P.t[2 + n]; }
            const float t = (float)(row & (SEQ - 1)), lg = log2gamma(wc);
            const float s = isq ? exp2f(t * lg) : exp2f(-t * lg) * 0.125f;
#pragma unroll
            for (int g = 0; g < 4; ++g) o[g] = o[g] * s;
            dst = (isq ? RQ : RK) + (size_t)row * 256 + wc * 64;
        } else if (pn < 6) {
#pragma unroll
            for (int g = 0; g < 4; ++g) o[g] = v[g];
            dst = DV + (size_t)row * 512 + (pn - 4) * 256 + wc * 64;
        } else if (pn < 10) {
#pragma unroll
            for (int g = 0; g < 4; ++g) o[g] = v[g];
            dst = RV + (size_t)row * 512 + (pn - 8) * 256 + wc * 64;
        } else if (pn < 12) {
#pragma unroll
            for (int g = 0; g < 4; ++g)
#pragma unroll
                for (int r = 0; r < 4; ++r) o[g][r] = silu_f(v[g][r]);
            dst = RG + (size_t)row * 512 + (pn - 10) * 256 + wc * 64;
        } else {
#pragma unroll
            for (int g = 0; g < 4; ++g)
#pragma unroll
                for (int r = 0; r < 4; ++r) o[g][r] = sigm_f(v[g][r]);
            dst = (pn < 16 ? GA + (size_t)row * 1024 + (pn - 12) * 256 : GB + (size_t)row * 1024 + (pn - 16) * 256) + wc * 64;
        }
#pragma unroll
        for (int bj = 0; bj < 2; ++bj) *(u32x4*)(dst + 32 * bj + 8 * fq) = pack8(o[2 * bj], o[2 * bj + 1]);
    }
};
struct OutEpi {
    static constexpr int BATCH = 4;
    struct Tile { f32x4 g1[4], a2[4]; };
    struct Pre { f32x4 x[4]; };
    const float* x; bf16_t* X1B; const float* mod; const float* g2n; bf16_t* XM; float* rowss;
    __device__ __forceinline__ Tile tile_pre(int b, int pn, int wc, int fq) const {
        Tile T;
#pragma unroll
        for (int g = 0; g < 4; ++g) { const int col = SLOT8(pn, wc, fq, g);
            T.g1[g] = *(const f32x4*)(mod + b * MODW + 2 * DM + col); T.a2[g] = *(const f32x4*)(g2n + col) * (*(const f32x4*)(mod + b * MODW + 4 * DM + col) + 1.f); }
        return T;
    }
    __device__ __forceinline__ Pre row_pre(int row, int b, int pn, int wc, int fq) const {
        Pre P;
#pragma unroll
        for (int g = 0; g < 4; ++g) P.x[g] = *(const f32x4*)(x + (size_t)row * DM + SLOT8(pn, wc, fq, g));
        return P;
    }
    __device__ __forceinline__ float operator()(const f32x4 (&v)[4], const Pre& P, const Tile& T, int row, int b, int pn, int wc, int fq) const {
        float ss = 0.f; f32x4 xm[4], x1[4];
#pragma unroll
        for (int g = 0; g < 4; ++g) {
            x1[g] = P.x[g] + T.g1[g] * v[g];
            ss += (x1[g][0] * x1[g][0] + x1[g][1] * x1[g][1]) + (x1[g][2] * x1[g][2] + x1[g][3] * x1[g][3]);
            xm[g] = x1[g] * T.a2[g];
        }
#pragma unroll
        for (int bj = 0; bj < 2; ++bj) { *(u32x4*)(X1B + (size_t)row * DM + SLOT8(pn, wc, fq, 2 * bj)) = pack8(x1[2 * bj], x1[2 * bj + 1]);
                                         *(u32x4*)(XM + (size_t)row * DM + SLOT8(pn, wc, fq, 2 * bj)) = pack8(xm[2 * bj], xm[2 * bj + 1]); }
        ss += __shfl_xor(ss, 16); ss += __shfl_xor(ss, 32);
        return ss;
    }
};
struct ResidEpi {
    static constexpr int BATCH = 8;
    struct Tile { f32x4 gg[4]; };
    struct Pre { u32x4 bs[2]; };
    const bf16_t* base; float* out; const float* gvec;
    __device__ __forceinline__ Tile tile_pre(int b, int pn, int wc, int fq) const {
        Tile T;
#pragma unroll
        for (int g = 0; g < 4; ++g) T.gg[g] = *(const f32x4*)(gvec + b * MODW + SLOT8(pn, wc, fq, g));
        return T;
    }
    __device__ __forceinline__ Pre row_pre(int row, int b, int pn, int wc, int fq) const {
        Pre P;
#pragma unroll
        for (int bj = 0; bj < 2; ++bj) P.bs[bj] = *(const u32x4*)(base + (size_t)row * DM + SLOT8(pn, wc, fq, 2 * bj));
        return P;
    }
    __device__ __forceinline__ void operator()(const f32x4 (&v)[4], const Pre& P, const Tile& T, int row, int b, int pn, int wc, int fq) const {
#pragma unroll
        for (int g = 0; g < 4; ++g) { const unsigned w0 = P.bs[g >> 1][2 * (g & 1)], w1 = P.bs[g >> 1][2 * (g & 1) + 1];
            const f32x4 bs = {bflo(w0), bfhi(w0), bflo(w1), bfhi(w1)};
            *(f32x4*)(out + (size_t)row * DM + SLOT8(pn, wc, fq, g)) = bs + T.gg[g] * v[g]; }
    }
};
struct GateUpEpi {
    static constexpr int BATCH = 4;
    struct Tile { f32x4 cg[2], cu[2]; };
    struct Pre { f32x4 s4; };
    bf16_t* ACT; const float* rowss; const float* cvec;
    __device__ __forceinline__ Tile tile_pre(int b, int pn, int wc, int fq) const {
        Tile T;
#pragma unroll
        for (int n = 0; n < 2; ++n) { const int slot = 256 * pn + 32 * wc + 8 * fq + 4 * n; T.cg[n] = *(const f32x4*)(cvec + b * (2 * DFF) + slot); T.cu[n] = *(const f32x4*)(cvec + b * (2 * DFF) + slot + 128); }
        return T;
    }
    __device__ __forceinline__ Pre row_pre(int row, int b, int pn, int wc, int fq) const { Pre P; P.s4 = *(const f32x4*)(rowss + (size_t)row * 4); return P; }
    __device__ __forceinline__ void operator()(const f32x4 (&v)[4], const Pre& P, const Tile& T, int row, int b, int pn, int wc, int fq) const {
        const float rstd = rsqrtf(((P.s4[0] + P.s4[1]) + (P.s4[2] + P.s4[3])) * (1.f / DM) + EPS);
        f32x4 y[2];
#pragma unroll
        for (int n = 0; n < 2; ++n) {
            const f32x4 gt = v[n] * rstd + T.cg[n], up = v[2 + n] * rstd + T.cu[n];
#pragma unroll
            for (int r = 0; r < 4; ++r) y[n][r] = silu_f(gt[r]) * up[r];
        }
        *(u32x4*)(ACT + (size_t)row * DFF + 128 * pn + 32 * wc + 8 * fq) = pack8(y[0], y[1]);
    }
};

namespace pg8 {
#define PG8_LAS __attribute__((address_space(3)))
typedef unsigned short bf16_t;
typedef short bf16x8 __attribute__((ext_vector_type(8)));
typedef float f32x4 __attribute__((ext_vector_type(4)));
typedef unsigned u32x4 __attribute__((ext_vector_type(4)));
constexpr int BM = 256, BK = 64, HALF = 128, HTB = HALF * BK * 2  , STAGE_BYTES = 8 * HTB, NXCD = 8, WGM = 4;

__host__ __device__ __forceinline__ int lds_byte(int r, int c) { const int st = (r >> 4) * 2 + (c >> 5), rr = r & 15, cc = c & 31, ob = rr * 64 + cc * 2; return st * 1024 + (ob ^ (((ob >> 9) & 1) << 5)); }
__host__ __device__ __forceinline__ void stage_rc(int b, int& R, int& C) { const int st = b / 1024, sb = b % 1024, swz = sb ^ (((sb >> 9) & 1) << 5); R = (st >> 1) * 16 + swz / 64; C = (st & 1) * 32 + (swz % 64) / 2; }
__host__ __device__ __forceinline__ int perm32(int rho) { const int n = rho >> 4, i = rho & 15; return 8 * (i >> 2) + 4 * n + (i & 3); }

struct Unit { int pm, pn, sel, half; };
struct Gemm { const bf16_t* A; const bf16_t* Bt; int M, N, K; const bf16_t* A2; const bf16_t* Bt2; };

struct StaticOrder {
    int nM, nN, nwg, G, c;
    __host__ __device__ void init(int M, int N, int G_, int c_) { nM = M / BM; nN = N / BM; nwg = nM * nN; G = G_; c = c_; }
    __host__ __device__ bool next(int i, Unit& u) const {
        const long L = (long)i * G + c; if (L >= nwg) return false;
        int wgid = (int)L; { const int q = nwg / NXCD, r = nwg % NXCD, xcd = wgid % NXCD, off = wgid / NXCD; wgid = (xcd < r ? xcd * (q + 1) : r * (q + 1) + (xcd - r) * q) + off; }
        const int nig = WGM * nN, gid = wgid / nig, fm = gid * WGM, gsz = (nM - fm) < WGM ? (nM - fm) : WGM;
        u.pm = fm + ((wgid % nig) % gsz); u.pn = (wgid % nig) / gsz; u.sel = 0; u.half = 0; return true;
    }
    __device__ __forceinline__ void a_ready(const Unit&) const {}
    __device__ __forceinline__ void done(const Unit&) const {}
};

template <class Epi, class Sched, bool ALIGN_EPI = false, bool SP2 = false>
__device__ __forceinline__ void gemm_phase(PG8_LAS unsigned char* lds, const Gemm g, const Sched& S, const Epi& E, const int WAVE_S) {
    const int wid = WAVE_S, lane = lane_id_(), tid = wid * 64 + lane, wr = wid >> 2, wc = wid & 3, fr = lane & 15, fq = lane >> 4;
    const int K = g.K, nt = K / BK;
    unsigned voffA[2], voffB[2];
#pragma unroll
    for (int i = 0; i < 2; ++i) { int R, C; stage_rc(tid * 16 + i * 8192, R, C); const int Rb = Epi::PERM ? ((R & ~31) + perm32(R & 31)) : R;
        voffA[i] = (unsigned)(R * K + C) * 2u; voffB[i] = (unsigned)(Rb * K + C) * 2u; }
    const size_t kstep = (size_t)(BK * 2);
    const size_t hstep = (size_t)HALF * K * 2;
    const size_t tstep = 2 * hstep;
    const unsigned ldsw = (unsigned)wid * 1024u;
    const int aoff = lds_byte(wr * 64 + fr, fq * 8), boff = lds_byte(wc * 32 + fr, fq * 8);
#define PG8_SA(b, h) (((b) * 2 + (h)) * HTB)
#define PG8_SB(b, h) ((4 + (b) * 2 + (h)) * HTB)
#define PG8_STAGE(bufoff, gbase, voff) do { _Pragma("unroll") for (int _i = 0; _i < 2; ++_i) \
        __builtin_amdgcn_global_load_lds((const unsigned*)((const char*)(gbase) + (voff)[_i]), (PG8_LAS unsigned*)(lds + (bufoff) + ldsw + _i * 8192), 16, 0, 0); } while (0)
#define PG8_LDA(dst, b, h) do { _Pragma("unroll") for (int m = 0; m < 4; ++m) _Pragma("unroll") for (int k = 0; k < 2; ++k) dst[m][k] = *(const PG8_LAS bf16x8*)(lds + PG8_SA(b, h) + aoff + m * 2048 + k * 1024); } while (0)
#define PG8_LDB(dst, b, h) do { _Pragma("unroll") for (int n = 0; n < 2; ++n) _Pragma("unroll") for (int k = 0; k < 2; ++k) dst[n][k] = *(const PG8_LAS bf16x8*)(lds + PG8_SB(b, h) + boff + n * 2048 + k * 1024); } while (0)
#define PG8_MMA(ai, bj, At, Bt) do { __builtin_amdgcn_s_setprio(1); _Pragma("unroll") for (int m = 0; m < 4; ++m) _Pragma("unroll") for (int n = 0; n < 2; ++n) _Pragma("unroll") for (int k = 0; k < 2; ++k) \
        acc[ai][bj][m][n] = __builtin_amdgcn_mfma_f32_16x16x32_bf16(Bt[n][k], At[m][k], acc[ai][bj][m][n], 0, 0, 0); __builtin_amdgcn_s_setprio(0); } while (0)
#define PG8_WAIT_V(n) asm volatile("s_waitcnt vmcnt(" #n ")" ::: "memory")
#define PG8_WAIT_L(n) asm volatile("s_waitcnt lgkmcnt(" #n ")" ::: "memory")
#define PG8_BAR __builtin_amdgcn_s_barrier()
#define PG8_SCHED __builtin_amdgcn_sched_barrier(0)
    Unit cur, nxt; int ui = 0;
    if (!S.next(0, cur)) return;
    f32x4 acc[2][2][4][2];
#pragma unroll
    for (int a = 0; a < 2; ++a)
#pragma unroll
        for (int b = 0; b < 2; ++b)
#pragma unroll
            for (int m = 0; m < 4; ++m)
#pragma unroll
                for (int n = 0; n < 2; ++n) acc[a][b][m][n] = (f32x4){0.f, 0.f, 0.f, 0.f};
    bf16x8 At[4][2], B0[2][2], B1[2][2];
    const char* cA = (const char*)(cur.sel ? g.A2 : g.A) + (size_t)cur.pm * tstep + (cur.half == 2 ? hstep : (size_t)0); const char* cB = (const char*)(cur.sel ? g.Bt2 : g.Bt) + (size_t)cur.pn * tstep;
    S.a_ready(cur);
    if constexpr (SP2) {
        PG8_STAGE(PG8_SB(0, 0), cB, voffB); PG8_STAGE(PG8_SB(0, 1), cB + hstep, voffB); PG8_STAGE(PG8_SA(0, 0), cA, voffA); PG8_STAGE(PG8_SA(0, 1), cA + hstep, voffA);
        if (wr == 1) PG8_BAR;
        PG8_WAIT_V(2); PG8_BAR;
        PG8_STAGE(PG8_SB(1, 0), cB + kstep, voffB); PG8_STAGE(PG8_SA(1, 0), cA + kstep, voffA); PG8_STAGE(PG8_SB(1, 1), cB + hstep + kstep, voffB);
        PG8_WAIT_V(6); PG8_BAR;
    } else {
        PG8_STAGE(PG8_SB(0, 0), cB, voffB); PG8_STAGE(PG8_SA(0, 0), cA, voffA); PG8_STAGE(PG8_SB(0, 1), cB + hstep, voffB); PG8_STAGE(PG8_SA(0, 1), cA + hstep, voffA);
        if (wr == 1) PG8_BAR;
        PG8_WAIT_V(4); PG8_BAR;
        PG8_STAGE(PG8_SB(1, 0), cB + kstep, voffB); PG8_STAGE(PG8_SA(1, 0), cA + kstep, voffA); PG8_STAGE(PG8_SB(1, 1), cB + hstep + kstep, voffB);
        PG8_WAIT_V(6); PG8_BAR;
    }
    for (;;) {
        const bool has_next = S.next(ui + 1, nxt);
        const char* nA = has_next ? (const char*)(nxt.sel ? g.A2 : g.A) + (size_t)nxt.pm * tstep + (nxt.half == 2 ? hstep : (size_t)0) : cA; const char* nB = has_next ? (const char*)(nxt.sel ? g.Bt2 : g.Bt) + (size_t)nxt.pn * tstep : cB;
        for (int t = 0; t < nt; t += 2) {
            const bool last = (t == nt - 2);
            const char* a1 = cA + (size_t)(t + 1) * kstep;
            const char* a2 = last ? nA : cA + (size_t)(t + 2) * kstep; const char* b2 = last ? nB : cB + (size_t)(t + 2) * kstep;
            const char* a3 = a2 + kstep; const char* b3 = b2 + kstep;
            if (last && has_next) S.a_ready(nxt);
            if constexpr (SP2) {
            PG8_LDB(B0, 0, 0); PG8_LDB(B1, 0, 1); PG8_SCHED; PG8_LDA(At, 0, 0); PG8_STAGE(PG8_SA(1, 1), a1 + hstep, voffA);
            PG8_WAIT_V(8); PG8_WAIT_L(0); PG8_BAR; PG8_MMA(0, 0, At, B0); PG8_MMA(0, 1, At, B1); PG8_BAR; PG8_SCHED;
            PG8_LDA(At, 0, 1); PG8_STAGE(PG8_SB(0, 0), b2, voffB); PG8_STAGE(PG8_SB(0, 1), b2 + hstep, voffB); PG8_STAGE(PG8_SA(0, 0), a2, voffA);
            PG8_WAIT_V(8); PG8_WAIT_L(0); PG8_BAR; PG8_MMA(1, 0, At, B0); PG8_MMA(1, 1, At, B1); PG8_BAR; PG8_SCHED;
            PG8_LDB(B0, 1, 0); PG8_LDB(B1, 1, 1); PG8_SCHED; PG8_LDA(At, 1, 0); PG8_STAGE(PG8_SA(0, 1), a2 + hstep, voffA);
            PG8_WAIT_V(8); PG8_WAIT_L(0); PG8_BAR; PG8_MMA(0, 0, At, B0); PG8_MMA(0, 1, At, B1); PG8_BAR; PG8_SCHED;
            PG8_LDA(At, 1, 1); PG8_STAGE(PG8_SB(1, 0), b3, voffB); PG8_STAGE(PG8_SB(1, 1), b3 + hstep, voffB); PG8_STAGE(PG8_SA(1, 0), a3, voffA);
            PG8_WAIT_V(8); PG8_WAIT_L(0); PG8_BAR; PG8_MMA(1, 0, At, B0); PG8_MMA(1, 1, At, B1); PG8_BAR; PG8_SCHED;
            } else {
            PG8_LDB(B0, 0, 0); PG8_SCHED; PG8_LDA(At, 0, 0); PG8_STAGE(PG8_SA(1, 1), a1 + hstep, voffA);
            PG8_WAIT_L(8); PG8_BAR; PG8_WAIT_L(0); PG8_MMA(0, 0, At, B0); PG8_BAR; PG8_SCHED;
            PG8_LDB(B1, 0, 1); PG8_STAGE(PG8_SB(0, 0), b2, voffB);
            PG8_BAR; PG8_WAIT_L(0); PG8_MMA(0, 1, At, B1); PG8_BAR;
            PG8_LDA(At, 0, 1); PG8_STAGE(PG8_SA(0, 0), a2, voffA);
            PG8_BAR; PG8_WAIT_L(0); PG8_MMA(1, 0, At, B0); PG8_BAR; PG8_SCHED;
            PG8_STAGE(PG8_SB(0, 1), b2 + hstep, voffB);
            PG8_WAIT_V(6); PG8_BAR; PG8_MMA(1, 1, At, B1); PG8_BAR;
            PG8_LDB(B0, 1, 0); PG8_SCHED; PG8_LDA(At, 1, 0); PG8_STAGE(PG8_SA(0, 1), a2 + hstep, voffA);
            PG8_WAIT_L(8); PG8_BAR; PG8_WAIT_L(0); PG8_MMA(0, 0, At, B0); PG8_BAR; PG8_SCHED;
            PG8_LDB(B1, 1, 1); PG8_STAGE(PG8_SB(1, 0), b3, voffB);
            PG8_BAR; PG8_WAIT_L(0); PG8_MMA(0, 1, At, B1); PG8_BAR;
            PG8_LDA(At, 1, 1); PG8_STAGE(PG8_SA(1, 0), a3, voffA);
            PG8_BAR; PG8_WAIT_L(0); PG8_MMA(1, 0, At, B0); PG8_BAR; PG8_SCHED;
            PG8_STAGE(PG8_SB(1, 1), b3 + hstep, voffB);
            PG8_WAIT_V(6); PG8_BAR; PG8_MMA(1, 1, At, B1); PG8_BAR;
            }
        }
        if constexpr (ALIGN_EPI) { if (wr == 0) PG8_BAR; }
        if constexpr (!Epi::AFTER_DRAIN) { E(acc, cur, wr, wc, fr, fq); S.done(cur); }
        if (!has_next) break;
        if (Epi::zero_after(cur))
#pragma unroll
        for (int a = 0; a < 2; ++a)
#pragma unroll
            for (int b = 0; b < 2; ++b)
#pragma unroll
                for (int m = 0; m < 4; ++m)
#pragma unroll
                    for (int n = 0; n < 2; ++n) acc[a][b][m][n] = (f32x4){0.f, 0.f, 0.f, 0.f};
        cur = nxt; cA = nA; cB = nB; ++ui;
        if constexpr (ALIGN_EPI) { if (wr == 1) PG8_BAR; }
    }
    PG8_WAIT_V(0);
    if constexpr (!ALIGN_EPI) { if (wr == 0) PG8_BAR; }
    PG8_BAR;
    if constexpr (Epi::AFTER_DRAIN) { E.fused(acc, cur, wr, wc, fr, fq, lds, wid, lane); S.done(cur); }
#undef PG8_SA
#undef PG8_SB
#undef PG8_STAGE
#undef PG8_LDA
#undef PG8_LDB
#undef PG8_MMA
#undef PG8_WAIT_V
#undef PG8_WAIT_L
#undef PG8_BAR
#undef PG8_SCHED
}
}

namespace pg8 {
template <class RowEpi> struct EpiRows {
    static constexpr bool PERM = true, AFTER_DRAIN = false;
    RowEpi R;
    static __device__ __forceinline__ bool zero_after(const Unit&) { return true; }
    __device__ __forceinline__ void operator()(const f32x4 (&acc)[2][2][4][2], const Unit& u, int wr, int wc, int fr, int fq) const {
        const int b = u.pm >> 3, row0 = u.pm * BM + wr * 64 + fr + (u.half == 2 ? HALF : 0);
        const typename RowEpi::Tile T = R.tile_pre(b, u.pn, wc, fq);
        constexpr int NB = RowEpi::BATCH;
#pragma unroll
        for (int g0 = 0; g0 < 8; g0 += NB) {
            if (u.half && g0 >= 4) break;
            typename RowEpi::Pre P[NB];
#pragma unroll
            for (int j = 0; j < NB; ++j) P[j] = R.row_pre(row0 + ((g0 + j) >> 2) * HALF + ((g0 + j) & 3) * 16, b, u.pn, wc, fq);
            __builtin_amdgcn_sched_barrier(0);
#pragma unroll
            for (int j = 0; j < NB; ++j) { const int ai = (g0 + j) >> 2, m = (g0 + j) & 3;
                const f32x4 v[4] = {acc[ai][0][m][0], acc[ai][0][m][1], acc[ai][1][m][0], acc[ai][1][m][1]};
                R(v, P[j], T, row0 + ai * HALF + m * 16, b, u.pn, wc, fq); }
        }
    }
};
struct EpiOutFused {
    static constexpr bool PERM = true, AFTER_DRAIN = true;
    OutEpi R;
    static __device__ __forceinline__ bool zero_after(const Unit&) { return true; }
    __device__ __forceinline__ void operator()(const f32x4 (&)[2][2][4][2], const Unit&, int, int, int, int) const {}
    __device__ __forceinline__ void fused(f32x4 (&acc)[2][2][4][2], const Unit& u, int wr, int wc, int fr, int fq, PG8_LAS unsigned char* lds, int wid, int lane) const {
        PG8_LAS float* sred = (PG8_LAS float*)lds;
        const int b = u.pm >> 3;
        const OutEpi::Tile T = R.tile_pre(b, u.pn, wc, fq);
        constexpr int NB = OutEpi::BATCH;
#pragma unroll
        for (int g0 = 0; g0 < 8; g0 += NB) {
            OutEpi::Pre P[NB];
#pragma unroll
            for (int j = 0; j < NB; ++j) P[j] = R.row_pre(u.pm * BM + ((g0 + j) >> 2) * HALF + wr * 64 + ((g0 + j) & 3) * 16 + fr, b, u.pn, wc, fq);
            __builtin_amdgcn_sched_barrier(0);
#pragma unroll
            for (int j = 0; j < NB; ++j) { const int ai = (g0 + j) >> 2, m = (g0 + j) & 3;
                const f32x4 v[4] = {acc[ai][0][m][0], acc[ai][0][m][1], acc[ai][1][m][0], acc[ai][1][m][1]};
                const int rl = ai * HALF + wr * 64 + m * 16 + fr;
                const float ss = R(v, P[j], T, u.pm * BM + rl, b, u.pn, wc, fq);
                if (fq == 0) sred[rl * 4 + wc] = ss; }
        }
        asm volatile("s_waitcnt lgkmcnt(0)" ::: "memory"); __builtin_amdgcn_s_barrier(); asm volatile("" ::: "memory");
        const int t = wid * 64 + lane;
        if (t < 256) { const f32x4 p = *(const PG8_LAS f32x4*)(sred + t * 4); R.rowss[(size_t)(u.pm * BM + t) * 4 + u.pn] = (p[0] + p[1]) + (p[2] + p[3]); }
    }
};
struct DoubleKOrder : StaticOrder {
    __host__ __device__ bool next(int i, Unit& u) const { const bool ok = StaticOrder::next(i >> 1, u); u.half = i & 1; return ok; }
};
template <class RowEpi> struct EpiRowsDK {
    static constexpr bool PERM = true, AFTER_DRAIN = false;
    RowEpi R;
    static __device__ __forceinline__ bool zero_after(const Unit& u) { return u.half == 1; }
    __device__ __forceinline__ void operator()(f32x4 (&acc)[2][2][4][2], const Unit& u, int wr, int wc, int fr, int fq) const {
        if (u.half == 0) return;
#pragma unroll
        for (int a = 0; a < 2; ++a)
#pragma unroll
            for (int b = 0; b < 2; ++b)
#pragma unroll
                for (int m = 0; m < 4; ++m)
#pragma unroll
                    for (int n = 0; n < 2; ++n) acc[a][b][m][n] = acc[a][b][m][n] * 0.5f;
        Unit v = u; v.half = 0; EpiRows<RowEpi> E{R}; E(acc, v, wr, wc, fr, fq);
    }
};
struct PairOrder : StaticOrder {
    __host__ __device__ bool next(int i, Unit& u) const { const bool ok = StaticOrder::next(i >> 1, u); u.sel = i & 1; return ok; }
};
struct BranchTileEpi {
    static constexpr bool PERM = true, AFTER_DRAIN = false;
    const bf16_t *GA, *GB; bf16_t* Y;
    static __device__ __forceinline__ bool zero_after(const Unit& u) { return u.sel == 1; }
    __device__ __forceinline__ void operator()(f32x4 (&acc)[2][2][4][2], const Unit& u, int wr, int wc, int fr, int fq) const {
        const size_t off0 = (size_t)(u.pm * BM + wr * 64 + fr) * 1024 + u.pn * BM + wc * 32 + 8 * fq;
#pragma unroll
        for (int g0 = 0; g0 < 8; g0 += 4) {
            u32x4 gb[4][2], ga[4][2];
#pragma unroll
            for (int j = 0; j < 4; ++j)
#pragma unroll
                for (int bj = 0; bj < 2; ++bj) { const size_t off = off0 + (size_t)(((g0 + j) >> 2) * HALF + ((g0 + j) & 3) * 16) * 1024 + bj * HALF;
                    gb[j][bj] = *(const u32x4*)(GB + off); if (u.sel == 0) ga[j][bj] = *(const u32x4*)(GA + off); }
            __builtin_amdgcn_sched_barrier(0);
#pragma unroll
            for (int j = 0; j < 4; ++j) { const int ai = (g0 + j) >> 2, m = (g0 + j) & 3;
#pragma unroll
                for (int bj = 0; bj < 2; ++bj) {
                    f32x4 sb[2];
#pragma unroll
                    for (int n = 0; n < 2; ++n) { sb[n][0] = fmaxf(bflo(gb[j][bj][2 * n]), 1e-30f); sb[n][1] = fmaxf(bfhi(gb[j][bj][2 * n]), 1e-30f); sb[n][2] = fmaxf(bflo(gb[j][bj][2 * n + 1]), 1e-30f); sb[n][3] = fmaxf(bfhi(gb[j][bj][2 * n + 1]), 1e-30f); }
                    if (u.sel == 0) {
#pragma unroll
                        for (int n = 0; n < 2; ++n) { f32x4 r; r[0] = bflo(ga[j][bj][2 * n]) * __builtin_amdgcn_rcpf(sb[n][0]); r[1] = bfhi(ga[j][bj][2 * n]) * __builtin_amdgcn_rcpf(sb[n][1]);
                            r[2] = bflo(ga[j][bj][2 * n + 1]) * __builtin_amdgcn_rcpf(sb[n][2]); r[3] = bfhi(ga[j][bj][2 * n + 1]) * __builtin_amdgcn_rcpf(sb[n][3]);
                            acc[ai][bj][m][n] = acc[ai][bj][m][n] * r; }
                    } else {
                        *(u32x4*)(Y + off0 + (size_t)(ai * HALF + m * 16) * 1024 + bj * HALF) = pack8(acc[ai][bj][m][0] * sb[0], acc[ai][bj][m][1] * sb[1]);
                    }
                }
            }
        }
    }
};
}

namespace attn_body {
using bf16=__hip_bfloat16;
using bf16x8=__attribute__((ext_vector_type(8)))short;
using s16x4=__attribute__((ext_vector_type(4)))short;
using f32x16=__attribute__((ext_vector_type(16)))float;
using u32x4=__attribute__((ext_vector_type(4)))unsigned;
constexpr int SEQ=2048,D=64;
constexpr int NW=8,QBLK=32,QB=QBLK*NW,KVBLK=64,NQB=SEQ/QB;
constexpr int ATTN_UNIT_ROWS=QB;
__device__ __forceinline__ int crow(int r,int hi){return (r&3)+8*(r>>2)+4*hi;}
#define SBAR() __builtin_amdgcn_sched_barrier(0)
template<bool LIN> __device__ __forceinline__ void cmask(f32x16&p0,f32x16&p1,int jb,int qrel,int hi){
  const float NEG=LIN?0.f:-INFINITY; int kb=64*jb+4*hi;
  #pragma unroll
  for(int r=0;r<16;++r){int kv=kb+(r&3)+8*(r>>2); if(kv>qrel)p0[r]=NEG; if(kv+32>qrel)p1[r]=NEG;}
}

constexpr int NSLOT=3, SLOTB=8192;
constexpr int LDS_RT=98304, LDS_RTS=106496, RS_NSLOT=6, RS_SLOTB=16384;
constexpr int LDS_K=0, LDS_V=NSLOT*SLOTB, LDS_WS=2*NSLOT*SLOTB, LDS_OST=LDS_WS+NW*64*4, LDS_BYTES=LDS_OST+NW*4096;
constexpr float C2=0.125f*1.4426950408889634f;
__device__ __forceinline__ void glds16s(const void*sbase,unsigned voff,unsigned lds_dst){unsigned keep;
  asm volatile("s_mov_b32 %0, m0\n\ts_mov_b32 m0, %3\n\ts_nop 4\n\tglobal_load_lds_dwordx4 %1, %2\n\ts_mov_b32 m0, %0":"=&s"(keep):"v"(voff),"s"(sbase),"s"(lds_dst):"memory");}
__device__ __forceinline__ const char* uptr(const char*p){const unsigned long long a=(unsigned long long)p;const unsigned lo=__builtin_amdgcn_readfirstlane((unsigned)a),hi=__builtin_amdgcn_readfirstlane((unsigned)(a>>32));return (const char*)(((unsigned long long)hi<<32)|lo);}
__device__ __forceinline__ void glds16(const void*gsrc,unsigned lds_dst){unsigned keep;
  asm volatile("s_mov_b32 %0, m0\n\ts_mov_b32 m0, %2\n\ts_nop 0\n\tglobal_load_lds_dwordx4 %1, off\n\ts_mov_b32 m0, %0":"=&s"(keep):"v"(gsrc),"s"(lds_dst):"memory");}
__device__ __forceinline__ float max3f(float a,float b,float c){float r;asm("v_max3_f32 %0, %1, %2, %3":"=v"(r):"v"(a),"v"(b),"v"(c));return r;}
__device__ __forceinline__ float max2f(float a,float b){float r;asm("v_max_f32_e32 %0, %1, %2":"=v"(r):"v"(a),"v"(b));return r;}
__device__ __forceinline__ float fadd_s(float a,float b){float r;asm("v_add_f32_e32 %0, %1, %2":"=v"(r):"v"(a),"v"(b));return r;}
__device__ __forceinline__ float fsub_s(float a,float b){float r;asm("v_sub_f32_e32 %0, %1, %2":"=v"(r):"v"(a),"v"(b));return r;}
typedef float f32x2_t __attribute__((ext_vector_type(2))); typedef __bf16 bf16x2_t __attribute__((ext_vector_type(2)));
__device__ __forceinline__ unsigned cvtpk_s(float lo,float hi){f32x2_t v={lo,hi};bf16x2_t b=__builtin_convertvector(v,bf16x2_t);return __builtin_bit_cast(unsigned,b);}
#define WAIT_BAR(N) asm volatile("s_waitcnt vmcnt(" #N ") lgkmcnt(0)\n\ts_barrier":::"memory")

__device__ __forceinline__ void qkt(f32x16&p0,f32x16&p1,const char*Kslot,const bf16x8*qr,const f32x16&negm,int r32,int hi){
  const char*kb=Kslot+hi*1024+r32*16;
  #pragma unroll
  for(int d0=0;d0<4;++d0){
    const bf16x8 b0=*reinterpret_cast<const bf16x8*>(kb+d0*2048);
    const bf16x8 b1=*reinterpret_cast<const bf16x8*>(kb+d0*2048+512);
    if(d0==0){p0=__builtin_amdgcn_mfma_f32_32x32x16_bf16(b0,qr[0],negm,0,0,0);p1=__builtin_amdgcn_mfma_f32_32x32x16_bf16(b1,qr[0],negm,0,0,0);}
    else{p0=__builtin_amdgcn_mfma_f32_32x32x16_bf16(b0,qr[d0],p0,0,0,0);p1=__builtin_amdgcn_mfma_f32_32x32x16_bf16(b1,qr[d0],p1,0,0,0);}}
}
typedef __attribute__((address_space(3))) const char* lds_cptr;
typedef short v4i16_t __attribute__((ext_vector_type(4)));
__device__ __forceinline__ void kload8(bf16x8*kf,lds_cptr kp){
  kf[0]=*(const __attribute__((address_space(3))) bf16x8*)(kp);      kf[1]=*(const __attribute__((address_space(3))) bf16x8*)(kp+512);
  kf[2]=*(const __attribute__((address_space(3))) bf16x8*)(kp+2048); kf[3]=*(const __attribute__((address_space(3))) bf16x8*)(kp+2560);
  kf[4]=*(const __attribute__((address_space(3))) bf16x8*)(kp+4096); kf[5]=*(const __attribute__((address_space(3))) bf16x8*)(kp+4608);
  kf[6]=*(const __attribute__((address_space(3))) bf16x8*)(kp+6144); kf[7]=*(const __attribute__((address_space(3))) bf16x8*)(kp+6656);
}
__device__ __forceinline__ void kload2(bf16x8*kf,lds_cptr kp,int j){ kf[2*j]=*(const __attribute__((address_space(3))) bf16x8*)(kp+j*2048); kf[2*j+1]=*(const __attribute__((address_space(3))) bf16x8*)(kp+j*2048+512); }
__device__ __forceinline__ s16x4 vtr(lds_cptr p){ return __builtin_bit_cast(s16x4,__builtin_amdgcn_ds_read_tr16_b64_v4i16((__attribute__((address_space(3))) v4i16_t*)p)); }
__device__ __forceinline__ float rowmax(const f32x16&p0,const f32x16&p1){
  float a=max3f(p0[0],p0[1],p1[0]),b=max3f(p0[2],p0[3],p1[1]);a=max3f(a,p1[2],p1[3]);
  #pragma unroll
  for(int r=4;r<16;r+=4){a=max3f(a,p0[r],p0[r+1]);b=max3f(b,p0[r+2],p0[r+3]);a=max3f(a,p1[r],p1[r+1]);b=max3f(b,p1[r+2],p1[r+3]);}
  const float m=max2f(a,b);
  auto rr=__builtin_amdgcn_permlane32_swap(__float_as_uint(m),__float_as_uint(m),false,false);
  return max2f(__uint_as_float(rr[0]),__uint_as_float(rr[1]));
}
__device__ __forceinline__ void pv(f32x16*o,int vb,bf16x8 pa0,bf16x8 pa1,bf16x8 pa2,bf16x8 pa3){
  #pragma unroll
  for(int d0=0;d0<2;++d0){s16x4 lo[4],hi[4];
    #pragma unroll
    for(int ks=0;ks<4;++ks){
      asm volatile("ds_read_b64_tr_b16 %0,%1 offset:%c2":"=&v"(lo[ks]):"v"(vb),"i"(d0*4096+ks*1024):"memory");
      asm volatile("ds_read_b64_tr_b16 %0,%1 offset:%c2":"=&v"(hi[ks]):"v"(vb),"i"(d0*4096+ks*1024+512):"memory");}
    asm volatile("s_waitcnt lgkmcnt(0)":::"memory");SBAR();
    #define PK(k) (bf16x8){lo[k][0],lo[k][1],lo[k][2],lo[k][3],hi[k][0],hi[k][1],hi[k][2],hi[k][3]}
    o[d0]=__builtin_amdgcn_mfma_f32_32x32x16_bf16(pa0,PK(0),o[d0],0,0,0);
    o[d0]=__builtin_amdgcn_mfma_f32_32x32x16_bf16(pa1,PK(1),o[d0],0,0,0);
    o[d0]=__builtin_amdgcn_mfma_f32_32x32x16_bf16(pa2,PK(2),o[d0],0,0,0);
    o[d0]=__builtin_amdgcn_mfma_f32_32x32x16_bf16(pa3,PK(3),o[d0],0,0,0);
    #undef PK
  }
}

#ifndef ATTN_STORE16
#define ATTN_STORE16(p,v) (*(u32x4*)(p)=(v))
#endif
template<int THRL,bool LIN> __device__ __forceinline__ void attn_unit(long rowbase,int qb,const bf16*Q,int QP,const bf16*__restrict__ K,int KP,const bf16*__restrict__ V,int VP,bf16*O,int OP,char*shm,const bool xr,const int WAVE_S){
  int lane=lane_id_(); asm volatile("":"+v"(lane)); const int r32=lane&31,hi=lane>>5; const int wid=WAVE_S;
  const int q0=qb*QB;
  const bf16*Qw=Q+(rowbase+q0+wid*QBLK)*QP;
  const bf16*Kh=K+rowbase*KP,*Vh=V+rowbase*VP;
  const unsigned lds0=(unsigned)(uintptr_t)shm;
  float*wsf=(float*)(shm+LDS_WS)+wid*64;
  const unsigned koff=(unsigned)((lane*KP+wid*8)*2);
  const unsigned voff=(unsigned)(((16*(wid&3)+(lane>>2))*VP+(wid>>2)*32+(lane&3)*8)*2);
  const unsigned kdst=lds0+LDS_K+wid*1024, vdst=lds0+LDS_V+wid*1024;
  #define DMA_K(t,slot) glds16s(uptr((const char*)(Kh+(long)(t)*KVBLK*KP)),koff,(unsigned)__builtin_amdgcn_readfirstlane(kdst+(slot)))
  #define DMA_V(t,slot) glds16s(uptr((const char*)(Vh+(long)(t)*KVBLK*VP)),voff,(unsigned)__builtin_amdgcn_readfirstlane(vdst+(slot)))
  const int vb0=(int)(lds0+LDS_V)+((lane>>4)&1)*32+(lane&3)*8+(4*hi+((lane&15)>>2))*64;
  const char*Kbase=shm+LDS_K; bf16x8 kf[8];
  const lds_cptr shm3=(lds_cptr)shm; const lds_cptr kp0=shm3+LDS_K+hi*1024+r32*16; const lds_cptr vp0=shm3+LDS_V+((lane>>4)&1)*32+(lane&3)*8+(4*hi+((lane&15)>>2))*64;
  const int NT=(q0+QB)/KVBLK;
  DMA_K(0,0);DMA_V(0,0);DMA_K(1,SLOTB);
  bf16x8 qr[4];
  #pragma unroll
  for(int d0=0;d0<4;++d0)qr[d0]=*reinterpret_cast<const bf16x8*>(&Qw[(long)r32*QP+d0*16+hi*8]);
  float mhat=0.f,l_reg=0.f;f32x16 o[2];o[0]=f32x16{};o[1]=f32x16{};f32x16 negm;
  if constexpr(LIN){ if(xr){ const lds_cptr rt=(lds_cptr)shm+LDS_RT;
    _Pragma("unroll") for(int e2=0;e2<2;++e2) _Pragma("unroll") for(int d0=0;d0<4;++d0){ const bf16x8 rf=*(const __attribute__((address_space(3))) bf16x8*)(rt+((32*e2+r32)*64+16*d0+8*hi)*2);
      o[e2]=__builtin_amdgcn_mfma_f32_32x32x16_bf16(qr[d0],rf,o[e2],0,0,0);} } }
  #define NEGM (LIN?f32x16{}:negm)
  const int qrel=wid*QBLK+r32;
  #define CMASK(P0,P1,t) do{int jb_=(t)-(NT-4); if(jb_>=0)cmask<LIN>(P0,P1,jb_,qrel,hi);}while(0)
  bool resc=false;
  #define START(P0,P1) do{ if constexpr(!LIN){ const float rm=rowmax(P0,P1); resc=false; \
    { const float dl=rm; mhat=fadd_s(mhat,dl); \
      _Pragma("unroll") for(int r=0;r<16;++r){P0[r]=fsub_s(P0[r],dl);P1[r]=fsub_s(P1[r],dl);} \
      _Pragma("unroll") for(int r=0;r<16;++r)negm[r]=-mhat; asm volatile("":"+v"(negm)); } \
    _Pragma("unroll") for(int r=0;r<16;++r)P0[r]=__builtin_amdgcn_exp2f(P0[r]); } }while(0)
  #define RESC() do{ if(resc){ asm volatile("s_waitcnt lgkmcnt(0)":::"memory"); \
      _Pragma("unroll") for(int d_=0;d_<2;++d_) _Pragma("unroll") for(int r=0;r<16;++r)o[d_][r]*=wsf[crow(r,hi)]; } }while(0)
  f32x16 pA0,pA1,pB0,pB1;
  int sl_prev=0,sl_cur=0,sl_next=SLOTB;
  #define ROT() do{sl_prev=sl_cur;sl_cur=sl_next;sl_next=(sl_next==(NSLOT-1)*SLOTB)?0:sl_next+SLOTB;}while(0)
  DMA_K(2,2*SLOTB);
  WAIT_BAR(3);
  qkt(pA0,pA1,Kbase,qr,f32x16{},r32,hi);asm volatile("s_nop 15\n\ts_nop 7":"+v"(pA0),"+v"(pA1));CMASK(pA0,pA1,0);
  START(pA0,pA1);
  if constexpr(!LIN){ _Pragma("unroll") for(int r=0;r<16;++r)pA1[r]=__builtin_amdgcn_exp2f(pA1[r]); }
  WAIT_BAR(0);
  DMA_K(3,0);DMA_V(1,SLOTB);
  ROT();
  kload8(kf,kp0+sl_cur);
  WAIT_BAR(2);
  s16x4 vlo[8],vhi[8]; u32x4 pw0,pw1,pw2,pw3;
  #define PKW(P,B) cvtpk_s(P[B],P[B+1])
  #define PAF(k) __builtin_bit_cast(bf16x8,pw##k)
  #define VFR(i) (bf16x8){vlo[i][0],vlo[i][1],vlo[i][2],vlo[i][3],vhi[i][0],vhi[i][1],vhi[i][2],vhi[i][3]}
  #define PIN(x) asm volatile("":"+v"(x))
  #define MX3(a,b,c) __builtin_fmaxf(__builtin_fmaxf((a),(b)),(c))
  #define GAPA(MF,A0,A1,A2,A3,W0,W1,PW) do{ MF; if constexpr(!LIN){ sacc+=A0; sacc+=A1; sacc+=A2; sacc+=A3; PIN(sacc); } W0; W1; PIN(PW); SBAR(); }while(0)
  #define EX(v) __builtin_amdgcn_exp2f(v)
  #define GAPB(MF,X,B) do{ MF; if constexpr(!LIN){ X[B]=EX(X[B]); X[B+1]=EX(X[B+1]); X[B+2]=EX(X[B+2]); X[B+3]=EX(X[B+3]); PIN(X); } SBAR(); }while(0)
  #define VRD(i) do{ vlo[i]=vtr(vp_+(((i)>>2)*4096+((i)&3)*1024)); vhi[i]=vtr(vp_+(((i)>>2)*4096+((i)&3)*1024+512)); }while(0)
  #define KRD(G,j) do{ if(G){ kload2(kf,kp0+sl_next,j); SBAR(); } }while(0)
  #define STEP(C0,C1,P0,P1,t,GK,GV,GL) do{ SBAR(); \
    const lds_cptr vp_=vp0+sl_prev; \
    VRD(0); SBAR(); float sacc=(P0[0]+P0[1]); \
    GAPA(C0=__builtin_amdgcn_mfma_f32_32x32x16_bf16(kf[0],qr[0],NEGM,0,0,0), P0[2],P0[3],P0[4],P0[5],     pw0[0]=PKW(P0,0), pw0[1]=PKW(P0,2), pw0); \
    VRD(4); SBAR(); GAPA(C1=__builtin_amdgcn_mfma_f32_32x32x16_bf16(kf[1],qr[0],NEGM,0,0,0), P0[6],P0[7],P0[8],P0[9],     pw0[2]=PKW(P0,4), pw0[3]=PKW(P0,6), pw0); \
    VRD(1); SBAR(); GAPA(C0=__builtin_amdgcn_mfma_f32_32x32x16_bf16(kf[2],qr[1],C0,0,0,0),   P0[10],P0[11],P0[12],P0[13], pw1[0]=PKW(P0,8), pw1[1]=PKW(P0,10), pw1); \
    VRD(5); SBAR(); GAPA(C1=__builtin_amdgcn_mfma_f32_32x32x16_bf16(kf[3],qr[1],C1,0,0,0),   P0[14],P0[15],P1[0],P1[1],   pw1[2]=PKW(P0,12),pw1[3]=PKW(P0,14), pw1); \
    VRD(2); SBAR(); GAPA(C0=__builtin_amdgcn_mfma_f32_32x32x16_bf16(kf[4],qr[2],C0,0,0,0),   P1[2],P1[3],P1[4],P1[5],     pw2[0]=PKW(P1,0), pw2[1]=PKW(P1,2), pw2); \
    VRD(6); SBAR(); GAPA(C1=__builtin_amdgcn_mfma_f32_32x32x16_bf16(kf[5],qr[2],C1,0,0,0),   P1[6],P1[7],P1[8],P1[9],     pw2[2]=PKW(P1,4), pw2[3]=PKW(P1,6), pw2); \
    VRD(3); SBAR(); GAPA(C0=__builtin_amdgcn_mfma_f32_32x32x16_bf16(kf[6],qr[3],C0,0,0,0),   P1[10],P1[11],P1[12],P1[13], pw3[0]=PKW(P1,8), pw3[1]=PKW(P1,10), pw3); \
    VRD(7); SBAR(); GAPA(C1=__builtin_amdgcn_mfma_f32_32x32x16_bf16(kf[7],qr[3],C1,0,0,0),   P1[14],P1[15],0.f,0.f,       pw3[2]=PKW(P1,12),pw3[3]=PKW(P1,14), pw3); \
    l_reg+=sacc; \
    if(GK){DMA_K((t)+3,sl_cur);} if(GV){DMA_V((t)+1,sl_next);} \
    CMASK(C0,C1,t); \
    resc=false; if constexpr(!LIN){ float a=MX3(C0[0],C0[1],C1[0]),b=MX3(C0[2],C0[3],C1[1]); a=MX3(a,C1[2],C1[3]); \
      _Pragma("unroll") for(int r=4;r<16;r+=4){a=MX3(a,C0[r],C0[r+1]);b=MX3(b,C0[r+2],C0[r+3]);a=MX3(a,C1[r],C1[r+1]);b=MX3(b,C1[r+2],C1[r+3]);} \
      float rm=__builtin_fmaxf(a,b); { auto rr=__builtin_amdgcn_permlane32_swap(__float_as_uint(rm),__float_as_uint(rm),false,false); rm=__builtin_fmaxf(__uint_as_float(rr[0]),__uint_as_float(rr[1])); } \
      if(__builtin_expect(__any(rm>(float)THRL),0)){ const float dl=__builtin_fmaxf(rm,0.f); mhat+=dl; \
        _Pragma("unroll") for(int r=0;r<16;++r){C0[r]-=dl;C1[r]-=dl;} \
        _Pragma("unroll") for(int r=0;r<16;++r)negm[r]=-mhat; asm volatile("":"+v"(negm)); \
        const float f=__builtin_amdgcn_exp2f(-dl); l_reg*=f; if(hi==0)wsf[r32]=f; resc=true; } } \
    SBAR(); \
    GAPB(o[0]=__builtin_amdgcn_mfma_f32_32x32x16_bf16(PAF(0),VFR(0),o[0],0,0,0), C0,0); \
    GAPB(o[1]=__builtin_amdgcn_mfma_f32_32x32x16_bf16(PAF(0),VFR(4),o[1],0,0,0), C0,4); \
    KRD(GL,0); GAPB(o[0]=__builtin_amdgcn_mfma_f32_32x32x16_bf16(PAF(1),VFR(1),o[0],0,0,0), C0,8); \
    KRD(GL,1); GAPB(o[1]=__builtin_amdgcn_mfma_f32_32x32x16_bf16(PAF(1),VFR(5),o[1],0,0,0), C0,12); \
    KRD(GL,2); GAPB(o[0]=__builtin_amdgcn_mfma_f32_32x32x16_bf16(PAF(2),VFR(2),o[0],0,0,0), C1,0); \
    KRD(GL,3); GAPB(o[1]=__builtin_amdgcn_mfma_f32_32x32x16_bf16(PAF(2),VFR(6),o[1],0,0,0), C1,4); \
    GAPB(o[0]=__builtin_amdgcn_mfma_f32_32x32x16_bf16(PAF(3),VFR(3),o[0],0,0,0), C1,8); \
    GAPB(o[1]=__builtin_amdgcn_mfma_f32_32x32x16_bf16(PAF(3),VFR(7),o[1],0,0,0), C1,12); \
    }while(0)
  int t=1;
  #undef CMASK
  #define CMASK(P0,P1,t) do{}while(0)
  for(;t+5<NT;t+=2){
    STEP(pB0,pB1,pA0,pA1,t,true,true,true);     WAIT_BAR(2); RESC(); ROT();
    STEP(pA0,pA1,pB0,pB1,t+1,true,true,true);   WAIT_BAR(2); RESC(); ROT();
  }
  #undef CMASK
  #define CMASK(P0,P1,t) do{int jb_=(t)-(NT-4); if(jb_>=0)cmask<LIN>(P0,P1,jb_,qrel,hi);}while(0)
  #define ENDW(tt) do{ if((tt)+3<NT){WAIT_BAR(2);} else if((tt)+2<NT){WAIT_BAR(1);} else {WAIT_BAR(0);} }while(0)
  for(;t+1<NT;t+=2){
    STEP(pB0,pB1,pA0,pA1,t,(t+3<NT),(t+1<NT),(t+1<NT));       ENDW(t);   RESC(); ROT();
    STEP(pA0,pA1,pB0,pB1,t+1,(t+4<NT),(t+2<NT),(t+2<NT));     ENDW(t+1); RESC(); ROT();
  }
  STEP(pB0,pB1,pA0,pA1,NT-1,false,false,false); RESC();
  { float sacc=pB0[0]+pB0[1]; _Pragma("unroll") for(int r=2;r<16;++r)sacc+=pB0[r]; _Pragma("unroll") for(int r=0;r<16;++r)sacc+=pB1[r]; l_reg+=sacc;
    pw0=(u32x4){PKW(pB0,0),PKW(pB0,2),PKW(pB0,4),PKW(pB0,6)};pw1=(u32x4){PKW(pB0,8),PKW(pB0,10),PKW(pB0,12),PKW(pB0,14)};pw2=(u32x4){PKW(pB1,0),PKW(pB1,2),PKW(pB1,4),PKW(pB1,6)};pw3=(u32x4){PKW(pB1,8),PKW(pB1,10),PKW(pB1,12),PKW(pB1,14)};
    SBAR(); pv(o,vb0+sl_cur,PAF(0),PAF(1),PAF(2),PAF(3)); }
  #undef PKW
  #undef PAF
  #undef VFR
  #undef PIN
  #undef MX3
  #undef GAPA
  #undef GAPB
  #undef EX
  #undef VRD
  #undef KRD
  #undef STEP
  #undef ENDW
  {auto rr=__builtin_amdgcn_permlane32_swap(__float_as_uint(l_reg),__float_as_uint(l_reg),false,false);l_reg=__uint_as_float(rr[0])+__uint_as_float(rr[1]);}
  if(hi==0)wsf[32+r32]=l_reg;asm volatile("s_waitcnt lgkmcnt(0)":::"memory");
  float rli[16];
  #pragma unroll
  for(int r=0;r<16;++r)rli[r]=LIN?1.f:__builtin_amdgcn_rcpf(wsf[32+crow(r,hi)]);
  bf16*Ow=O+(rowbase+q0+wid*QBLK)*OP;
  { bf16*stg=(bf16*)(shm+LDS_OST)+wid*2048;
    #pragma unroll
    for(int r=0;r<16;++r){const int orow=crow(r,hi);
      #pragma unroll
      for(int d0=0;d0<2;++d0)stg[orow*64+d0*32+r32]=__float2bfloat16(o[d0][r]*rli[r]);}
    asm volatile("s_waitcnt lgkmcnt(0)":::"memory");
    int lane_e=lane; asm volatile("":"+v"(lane_e));
    #pragma unroll
    for(int i=0;i<4;++i){const int row=i*8+(lane_e>>3),ch=lane_e&7; const u32x4 v=*(const u32x4*)(stg+row*64+ch*8); ATTN_STORE16(Ow+(long)row*OP+ch*8,v);} }
  asm volatile("s_waitcnt lgkmcnt(0)\n\ts_barrier":::"memory");
  #undef DMA_K
  #undef DMA_V
  #undef CMASK
  #undef START
  #undef RESC
  #undef ROT
}
constexpr int ATTN_LDS_BYTES=LDS_BYTES;
__device__ __forceinline__ void ret_state(long rowbase,int nt,const bf16*__restrict__ K,int KP,const bf16*__restrict__ V,int VP,char*shm,const int WAVE_S){
  int lane=lane_id_(); asm volatile("":"+v"(lane)); const int r32=lane&31,hi=lane>>5; const int wid=WAVE_S;
  const bf16*Kh=K+rowbase*KP,*Vh=V+rowbase*VP;
  const unsigned lds0=(unsigned)(uintptr_t)shm;
  const unsigned koff=(unsigned)(((16*(wid&3)+(lane>>2))*KP+(wid>>2)*32+(lane&3)*8)*2);
  const unsigned voff=(unsigned)(((16*(wid&3)+(lane>>2))*VP+(wid>>2)*32+(lane&3)*8)*2);
  const unsigned kdst=lds0+wid*1024, vdst=lds0+8192+wid*1024;
  #define RS_DMA(t,slot) do{ glds16s(uptr((const char*)(Kh+(long)(t)*KVBLK*KP)),koff,(unsigned)__builtin_amdgcn_readfirstlane(kdst+(slot))); \
                             glds16s(uptr((const char*)(Vh+(long)(t)*KVBLK*VP)),voff,(unsigned)__builtin_amdgcn_readfirstlane(vdst+(slot))); }while(0)
  const lds_cptr shm3=(lds_cptr)shm;
  const int frag=((lane>>4)&1)*32+(lane&3)*8+(4*hi+((lane&15)>>2))*64;
  const int eb=wid&1, db=(wid>>1)&1, kh=wid>>2;
  f32x16 acc=f32x16{};
  { int s=0; for(int t=0;t<5&&t<nt;++t){ RS_DMA(t,s); s+=RS_SLOTB; } }
  int sl=0, sl_free=5*RS_SLOTB;
  for(int t=0;t<nt;++t){
    const int after=(nt-1-t)<4?(nt-1-t):4;
    if(after==4)WAIT_BAR(8); else if(after==3)WAIT_BAR(6); else if(after==2)WAIT_BAR(4); else if(after==1)WAIT_BAR(2); else WAIT_BAR(0);
    if(t+5<nt)RS_DMA(t+5,sl_free);
    const lds_cptr kp=shm3+sl+frag, vp=shm3+sl+8192+frag;
    #pragma unroll
    for(int k2=0;k2<2;++k2){ const int ks=2*kh+k2;
      const s16x4 alo=vtr(vp+eb*4096+ks*1024), ahi=vtr(vp+eb*4096+ks*1024+512), blo=vtr(kp+db*4096+ks*1024), bhi=vtr(kp+db*4096+ks*1024+512);
      const bf16x8 af=(bf16x8){alo[0],alo[1],alo[2],alo[3],ahi[0],ahi[1],ahi[2],ahi[3]}, bf=(bf16x8){blo[0],blo[1],blo[2],blo[3],bhi[0],bhi[1],bhi[2],bhi[3]};
      acc=__builtin_amdgcn_mfma_f32_32x32x16_bf16(af,bf,acc,0,0,0); }
    sl_free=sl; sl=(sl==(RS_NSLOT-1)*RS_SLOTB)?0:sl+RS_SLOTB;
  }
  #undef RS_DMA
  __attribute__((address_space(3))) float*part=(__attribute__((address_space(3))) float*)((__attribute__((address_space(3))) char*)shm+LDS_RTS)+(wid&3)*1024;
  if(kh==1){ _Pragma("unroll") for(int r=0;r<16;++r)part[r*64+lane]=acc[r]; }
  asm volatile("s_waitcnt lgkmcnt(0)\n\ts_barrier":::"memory");
  if(kh==0){ __attribute__((address_space(3))) unsigned short*rt=(__attribute__((address_space(3))) unsigned short*)((__attribute__((address_space(3))) char*)shm+LDS_RT);
    _Pragma("unroll") for(int r=0;r<16;++r){ const float v=acc[r]+part[r*64+lane]; rt[(32*eb+crow(r,hi))*64+32*db+r32]=(unsigned short)(cvtpk_s(v,0.f)&0xffffu); } }
  asm volatile("s_waitcnt lgkmcnt(0)\n\ts_barrier":::"memory");
}
constexpr int A2_K=0, A2_V=3*8192, A2_WS=A2_V+3*16384, A2_OST=A2_WS+NW*64*4, A2_BYTES=A2_OST+NW*4096;
template<int THRL> __device__ __forceinline__ void attn_unit2(long rowbase,int qb,const bf16*Q,int QP,const bf16*__restrict__ K,int KP,const bf16*__restrict__ V,int VP,bf16*O,int OP,char*shm,const int WAVE_S){
  int lane=lane_id_(); asm volatile("":"+v"(lane)); const int r32=lane&31,hi=lane>>5; const int wid=WAVE_S;
  const int q0=qb*QB;
  const bf16*Qw=Q+(rowbase+q0+wid*QBLK)*QP;
  const bf16*Kh=K+rowbase*KP,*Vh=V+rowbase*VP;
  const unsigned lds0=(unsigned)(uintptr_t)shm;
  float*wsf=(float*)(shm+A2_WS)+wid*64;
  const unsigned koff=(unsigned)((lane*KP+wid*8)*2);
  const unsigned voff=(unsigned)(((16*(wid&3)+(lane>>2))*VP+(wid>>2)*32+(lane&3)*8)*2);
  const unsigned kdst=lds0+A2_K+wid*1024, vdst=lds0+A2_V+wid*1024;
  #define DMA_K(t,slot) glds16s(uptr((const char*)(Kh+(long)(t)*KVBLK*KP)),koff,(unsigned)__builtin_amdgcn_readfirstlane(kdst+(slot)))
  #define DMA_V(t,slot) do{ glds16s(uptr((const char*)(Vh+(long)(t)*KVBLK*VP)),voff,(unsigned)__builtin_amdgcn_readfirstlane(vdst+2*(slot))); \
                            glds16s(uptr((const char*)(Vh+(long)(t)*KVBLK*VP)+128),voff,(unsigned)__builtin_amdgcn_readfirstlane(vdst+2*(slot)+8192)); }while(0)
  const char*Kbase=shm+A2_K; bf16x8 kf[8];
  const lds_cptr shm3=(lds_cptr)shm; const lds_cptr kp0=shm3+A2_K+hi*1024+r32*16; const lds_cptr vp0=shm3+A2_V+((lane>>4)&1)*32+(lane&3)*8+(4*hi+((lane&15)>>2))*64;
  const int NT=(q0+QB)/KVBLK;
  DMA_K(0,0);DMA_V(0,0);DMA_K(1,SLOTB);
  bf16x8 qr[4];
  #pragma unroll
  for(int d0=0;d0<4;++d0)qr[d0]=*reinterpret_cast<const bf16x8*>(&Qw[(long)r32*QP+d0*16+hi*8]);
  float mhat=0.f,l_reg=0.f;f32x16 o[4];o[0]=f32x16{};o[1]=f32x16{};o[2]=f32x16{};o[3]=f32x16{};
  const int qrel=wid*QBLK+r32;
  #define CMASK(P0,P1,t) do{int jb_=(t)-(NT-4); if(jb_>=0)cmask<false>(P0,P1,jb_,qrel,hi);}while(0)
  bool resc=false;
  #define RESC() do{ if(resc){ asm volatile("s_waitcnt lgkmcnt(0)":::"memory"); \
      _Pragma("unroll") for(int d_=0;d_<4;++d_) _Pragma("unroll") for(int r=0;r<16;++r)o[d_][r]*=wsf[crow(r,hi)]; } }while(0)
  f32x16 pA0,pA1,pB0,pB1;
  int sl_prev=0,sl_cur=0,sl_next=SLOTB;
  #define ROT() do{sl_prev=sl_cur;sl_cur=sl_next;sl_next=(sl_next==(NSLOT-1)*SLOTB)?0:sl_next+SLOTB;}while(0)
  DMA_K(2,2*SLOTB);
  WAIT_BAR(4);
  qkt(pA0,pA1,Kbase,qr,f32x16{},r32,hi);asm volatile("s_nop 15\n\ts_nop 7":"+v"(pA0),"+v"(pA1));CMASK(pA0,pA1,0);
  { const float rm=rowmax(pA0,pA1); mhat=rm;
    _Pragma("unroll") for(int r=0;r<16;++r){pA0[r]=__builtin_amdgcn_exp2f(pA0[r]-mhat);pA1[r]=__builtin_amdgcn_exp2f(pA1[r]-mhat);} }
  WAIT_BAR(0);
  DMA_K(3,0);DMA_V(1,SLOTB);
  ROT();
  kload8(kf,kp0+sl_cur);
  WAIT_BAR(3);
  s16x4 fa_lo,fa_hi,fb_lo,fb_hi,fc_lo,fc_hi,fd_lo,fd_hi; u32x4 pw0,pw1,pw2,pw3;
  #define PKW(P,B) cvtpk_s(P[B],P[B+1])
  #define PAF(k) __builtin_bit_cast(bf16x8,pw##k)
  #define PIN(x) asm volatile("":"+v"(x))
  #define MX3(a,b,c) __builtin_fmaxf(__builtin_fmaxf((a),(b)),(c))
  #define VOFF(i) ((((i)&3)>>1)*8192+((i)&1)*4096+((i)>>2)*1024)
  #define VRDX(X,i) do{ X##_lo=vtr(vp_+VOFF(i)); X##_hi=vtr(vp_+VOFF(i)+512); }while(0)
  #define VFRX(X) (bf16x8){X##_lo[0],X##_lo[1],X##_lo[2],X##_lo[3],X##_hi[0],X##_hi[1],X##_hi[2],X##_hi[3]}
  #define GAPA(MF,A0,A1,A2,A3,W0,W1,PW) do{ MF; sacc+=A0; sacc+=A1; sacc+=A2; sacc+=A3; PIN(sacc); W0; W1; PIN(PW); SBAR(); }while(0)
  #define EX(v) __builtin_amdgcn_exp2f(v)
  #define GAPB(MF,X,B) do{ MF; X[B]=EX(X[B]-mhat); X[B+1]=EX(X[B+1]-mhat); PIN(X); SBAR(); }while(0)
  #define KRD(G,j) do{ if(G){ kload2(kf,kp0+sl_next,j); SBAR(); } }while(0)
  #define PVM(i,X) o[(i)&3]=__builtin_amdgcn_mfma_f32_32x32x16_bf16(PAF_((i)>>2),VFRX(X),o[(i)&3],0,0,0)
  #define PAF_(k) ((k)==0?PAF(0):(k)==1?PAF(1):(k)==2?PAF(2):PAF(3))
  #define STEP(C0,C1,P0,P1,t,GK,GV,GL) do{ SBAR(); \
    const lds_cptr vp_=vp0+2*sl_prev; \
    float sacc=(P0[0]+P0[1]); \
    GAPA(C0=__builtin_amdgcn_mfma_f32_32x32x16_bf16(kf[0],qr[0],f32x16{},0,0,0), P0[2],P0[3],P0[4],P0[5],     pw0[0]=PKW(P0,0), pw0[1]=PKW(P0,2), pw0); \
    GAPA(C1=__builtin_amdgcn_mfma_f32_32x32x16_bf16(kf[1],qr[0],f32x16{},0,0,0), P0[6],P0[7],P0[8],P0[9],     pw0[2]=PKW(P0,4), pw0[3]=PKW(P0,6), pw0); \
    GAPA(C0=__builtin_amdgcn_mfma_f32_32x32x16_bf16(kf[2],qr[1],C0,0,0,0),   P0[10],P0[11],P0[12],P0[13], pw1[0]=PKW(P0,8), pw1[1]=PKW(P0,10), pw1); \
    GAPA(C1=__builtin_amdgcn_mfma_f32_32x32x16_bf16(kf[3],qr[1],C1,0,0,0),   P0[14],P0[15],P1[0],P1[1],   pw1[2]=PKW(P0,12),pw1[3]=PKW(P0,14), pw1); \
    GAPA(C0=__builtin_amdgcn_mfma_f32_32x32x16_bf16(kf[4],qr[2],C0,0,0,0),   P1[2],P1[3],P1[4],P1[5],     pw2[0]=PKW(P1,0), pw2[1]=PKW(P1,2), pw2); \
    VRDX(fa,0); SBAR(); GAPA(C1=__builtin_amdgcn_mfma_f32_32x32x16_bf16(kf[5],qr[2],C1,0,0,0),   P1[6],P1[7],P1[8],P1[9],     pw2[2]=PKW(P1,4), pw2[3]=PKW(P1,6), pw2); \
    VRDX(fb,1); SBAR(); GAPA(C0=__builtin_amdgcn_mfma_f32_32x32x16_bf16(kf[6],qr[3],C0,0,0,0),   P1[10],P1[11],P1[12],P1[13], pw3[0]=PKW(P1,8), pw3[1]=PKW(P1,10), pw3); \
    VRDX(fc,2); SBAR(); GAPA(C1=__builtin_amdgcn_mfma_f32_32x32x16_bf16(kf[7],qr[3],C1,0,0,0),   P1[14],P1[15],0.f,0.f,       pw3[2]=PKW(P1,12),pw3[3]=PKW(P1,14), pw3); \
    l_reg+=sacc; \
    if(GK){DMA_K((t)+3,sl_cur);} if(GV){DMA_V((t)+1,sl_next);} \
    CMASK(C0,C1,t); \
    resc=false; { float a=MX3(C0[0],C0[1],C1[0]),b=MX3(C0[2],C0[3],C1[1]); a=MX3(a,C1[2],C1[3]); \
      _Pragma("unroll") for(int r=4;r<16;r+=4){a=MX3(a,C0[r],C0[r+1]);b=MX3(b,C0[r+2],C0[r+3]);a=MX3(a,C1[r],C1[r+1]);b=MX3(b,C1[r+2],C1[r+3]);} \
      float rm=__builtin_fmaxf(a,b); { auto rr=__builtin_amdgcn_permlane32_swap(__float_as_uint(rm),__float_as_uint(rm),false,false); rm=__builtin_fmaxf(__uint_as_float(rr[0]),__uint_as_float(rr[1])); } \
      rm-=mhat; \
      if(__builtin_expect(__any(rm>(float)THRL),0)){ const float dl=__builtin_fmaxf(rm,0.f); mhat+=dl; \
        const float f=__builtin_amdgcn_exp2f(-dl); l_reg*=f; if(hi==0)wsf[r32]=f; resc=true; } } \
    SBAR(); \
    VRDX(fd,3);  SBAR(); GAPB(PVM(0,fa),  C0,0); \
    VRDX(fa,4);  SBAR(); GAPB(PVM(1,fb),  C0,2); \
    VRDX(fb,5);  SBAR(); GAPB(PVM(2,fc),  C0,4); \
    VRDX(fc,6);  SBAR(); KRD(GL,0); GAPB(PVM(3,fd),  C0,6); \
    VRDX(fd,7);  SBAR(); KRD(GL,1); GAPB(PVM(4,fa),  C0,8); \
    VRDX(fa,8);  SBAR(); KRD(GL,2); GAPB(PVM(5,fb),  C0,10); \
    VRDX(fb,9);  SBAR(); KRD(GL,3); GAPB(PVM(6,fc),  C0,12); \
    VRDX(fc,10); SBAR(); GAPB(PVM(7,fd),  C0,14); \
    VRDX(fd,11); SBAR(); GAPB(PVM(8,fa),  C1,0); \
    VRDX(fa,12); SBAR(); GAPB(PVM(9,fb),  C1,2); \
    VRDX(fb,13); SBAR(); GAPB(PVM(10,fc), C1,4); \
    VRDX(fc,14); SBAR(); GAPB(PVM(11,fd), C1,6); \
    VRDX(fd,15); SBAR(); GAPB(PVM(12,fa), C1,8); \
    GAPB(PVM(13,fb), C1,10); \
    GAPB(PVM(14,fc), C1,12); \
    GAPB(PVM(15,fd), C1,14); \
    }while(0)
  int t=1;
  #undef CMASK
  #define CMASK(P0,P1,t) do{}while(0)
  for(;t+5<NT;t+=2){
    STEP(pB0,pB1,pA0,pA1,t,true,true,true);     WAIT_BAR(3); RESC(); ROT();
    STEP(pA0,pA1,pB0,pB1,t+1,true,true,true);   WAIT_BAR(3); RESC(); ROT();
  }
  #undef CMASK
  #define CMASK(P0,P1,t) do{int jb_=(t)-(NT-4); if(jb_>=0)cmask<false>(P0,P1,jb_,qrel,hi);}while(0)
  #define ENDW(tt) do{ if((tt)+3<NT){WAIT_BAR(3);} else if((tt)+2<NT){WAIT_BAR(2);} else {WAIT_BAR(0);} }while(0)
  for(;t+1<NT;t+=2){
    STEP(pB0,pB1,pA0,pA1,t,(t+3<NT),(t+1<NT),(t+1<NT));       ENDW(t);   RESC(); ROT();
    STEP(pA0,pA1,pB0,pB1,t+1,(t+4<NT),(t+2<NT),(t+2<NT));     ENDW(t+1); RESC(); ROT();
  }
  STEP(pB0,pB1,pA0,pA1,NT-1,false,false,false); RESC();
  { float sacc=pB0[0]+pB0[1]; _Pragma("unroll") for(int r=2;r<16;++r)sacc+=pB0[r]; _Pragma("unroll") for(int r=0;r<16;++r)sacc+=pB1[r]; l_reg+=sacc;
    pw0=(u32x4){PKW(pB0,0),PKW(pB0,2),PKW(pB0,4),PKW(pB0,6)};pw1=(u32x4){PKW(pB0,8),PKW(pB0,10),PKW(pB0,12),PKW(pB0,14)};pw2=(u32x4){PKW(pB1,0),PKW(pB1,2),PKW(pB1,4),PKW(pB1,6)};pw3=(u32x4){PKW(pB1,8),PKW(pB1,10),PKW(pB1,12),PKW(pB1,14)};
    SBAR(); const lds_cptr vp_=vp0+2*sl_cur;
    #pragma unroll
    for(int e4=0;e4<4;++e4){ s16x4 lo[4],hh[4];
      #pragma unroll
      for(int ks=0;ks<4;++ks){ lo[ks]=vtr(vp_+VOFF(4*ks+e4)); hh[ks]=vtr(vp_+VOFF(4*ks+e4)+512); }
      #define PK(k) (bf16x8){lo[k][0],lo[k][1],lo[k][2],lo[k][3],hh[k][0],hh[k][1],hh[k][2],hh[k][3]}
      o[e4]=__builtin_amdgcn_mfma_f32_32x32x16_bf16(PAF(0),PK(0),o[e4],0,0,0);
      o[e4]=__builtin_amdgcn_mfma_f32_32x32x16_bf16(PAF(1),PK(1),o[e4],0,0,0);
      o[e4]=__builtin_amdgcn_mfma_f32_32x32x16_bf16(PAF(2),PK(2),o[e4],0,0,0);
      o[e4]=__builtin_amdgcn_mfma_f32_32x32x16_bf16(PAF(3),PK(3),o[e4],0,0,0);
      #undef PK
    } }
  #undef PKW
  #undef PAF
  #undef PAF_
  #undef PVM
  #undef PIN
  #undef MX3
  #undef VOFF
  #undef VRDX
  #undef VFRX
  #undef GAPA
  #undef GAPB
  #undef EX
  #undef KRD
  #undef STEP
  #undef ENDW
  {auto rr=__builtin_amdgcn_permlane32_swap(__float_as_uint(l_reg),__float_as_uint(l_reg),false,false);l_reg=__uint_as_float(rr[0])+__uint_as_float(rr[1]);}
  if(hi==0)wsf[32+r32]=l_reg;asm volatile("s_waitcnt lgkmcnt(0)":::"memory");
  float rli[16];
  #pragma unroll
  for(int r=0;r<16;++r)rli[r]=__builtin_amdgcn_rcpf(wsf[32+crow(r,hi)]);
  bf16*Ow=O+(rowbase+q0+wid*QBLK)*OP;
  { bf16*stg=(bf16*)(shm+A2_OST)+wid*2048;
    int lane_e=lane; asm volatile("":"+v"(lane_e));
    #pragma unroll
    for(int hh=0;hh<2;++hh){
      #pragma unroll
      for(int r=0;r<16;++r){const int orow=crow(r,hi);
        #pragma unroll
        for(int d0=0;d0<2;++d0)stg[orow*64+d0*32+r32]=__float2bfloat16(o[2*hh+d0][r]*rli[r]);}
      asm volatile("s_waitcnt lgkmcnt(0)":::"memory");
      #pragma unroll
      for(int i=0;i<4;++i){const int row=i*8+(lane_e>>3),ch=lane_e&7; const u32x4 v=*(const u32x4*)(stg+row*64+ch*8); ATTN_STORE16(Ow+(long)row*OP+hh*64+ch*8,v);}
      asm volatile("s_waitcnt lgkmcnt(0)":::"memory");
    } }
  asm volatile("s_waitcnt lgkmcnt(0)\n\ts_barrier":::"memory");
  #undef DMA_K
  #undef DMA_V
  #undef CMASK
  #undef RESC
  #undef ROT
}
#undef SBAR
#undef WAIT_BAR
}

#define GAS __attribute__((address_space(1)))
#define LAS __attribute__((address_space(3)))
typedef unsigned v4u __attribute__((ext_vector_type(4)));
typedef float f32x4 __attribute__((ext_vector_type(4)));
typedef short bf16x8 __attribute__((ext_vector_type(8)));
typedef GAS unsigned gu32;
typedef GAS unsigned long long gu64;
#define RLX_AGENT __ATOMIC_RELAXED, __HIP_MEMORY_SCOPE_AGENT
#define LDS_WAIT() asm volatile("s_waitcnt lgkmcnt(0)" ::: "memory")
#define VM_WAIT() asm volatile("s_waitcnt vmcnt(0)" ::: "memory")
__device__ __forceinline__ unsigned long long rt() { return __builtin_amdgcn_s_memrealtime(); }

#define XB_TMO      128
#define XB_XCNT(j)  (256  + 64 * (j))
#define XB_XSUB(j)  (1280 + 64 * (j))
#define XB_XGEN(j)  (2304 + 64 * (j))
#define XB_TOP      3328
#define XB_TOPGEN   3392
#define XCD_BAR_WORDS 3456
#define XB_SPIN_CAP (1u << 18)

__device__ __forceinline__ unsigned xb_ld(unsigned* p)              { return __hip_atomic_load(p, __ATOMIC_RELAXED, __HIP_MEMORY_SCOPE_AGENT); }
__device__ __forceinline__ unsigned xb_add(unsigned* p, unsigned v) { return __hip_atomic_fetch_add(p, v, __ATOMIC_RELAXED, __HIP_MEMORY_SCOPE_AGENT); }
__device__ __forceinline__ unsigned xb_xcc_id() { return (unsigned)__builtin_amdgcn_s_getreg((3 << 11) | 20) & 0xFu; }
#define XB_SPIN(cond, bar) do { unsigned _sp = 0; while (cond) { __builtin_amdgcn_s_sleep(1); \
    if ((++_sp & 255u) == 0u) { if (xb_ld(&(bar)[XB_TMO])) break; if (_sp > XB_SPIN_CAP) { atomicAdd(&(bar)[XB_TMO], 1u); break; } } } } while (0)

struct XcdBarrier {
    unsigned* bar; unsigned x;
    volatile LAS unsigned* st;
};

__device__ __forceinline__ XcdBarrier xcd_barrier_post(unsigned* bar, volatile LAS unsigned* st, const bool first) {
    XcdBarrier b; b.bar = bar; b.x = xb_xcc_id(); b.st = st;
    if (first) (void)xb_add(&bar[XB_XCNT(b.x)], 1u);
    return b;
}
__device__ __forceinline__ void xcd_barrier_complete(unsigned* bar, unsigned x, unsigned& nloc, unsigned& nx) {
    const unsigned G = gridDim.x * gridDim.y * gridDim.z;
    unsigned sum, cnt, mine, sp = 0u;
    for (;;) {
        sum = 0u; cnt = 0u; mine = 0u;
#pragma unroll
        for (unsigned j = 0; j < 16; ++j) { const unsigned c = xb_ld(&bar[XB_XCNT(j)]); sum += c; cnt += (c > 0u) ? 1u : 0u; mine = (j == x) ? c : mine; }
        if (sum == G) break;
        __builtin_amdgcn_s_sleep(1);
        if ((++sp & 255u) == 0u) { if (xb_ld(&bar[XB_TMO])) break; if (sp > XB_SPIN_CAP) { atomicAdd(&bar[XB_TMO], 1u); break; } }
    }
    nloc = mine > 0u ? mine : 1u; nx = cnt > 0u ? cnt : 1u;
}

__device__ __forceinline__ void xcd_barrier(const XcdBarrier& b, const bool first) {
    asm volatile("s_waitcnt vmcnt(0)" ::: "memory");
    __syncthreads();
    if (first) {
        unsigned* bar = b.bar;
        __builtin_amdgcn_s_waitcnt(0);
        unsigned nloc = b.st[0], nx = b.st[1];
        if (nloc == 0u) { xcd_barrier_complete(bar, b.x, nloc, nx); b.st[0] = nloc; b.st[1] = nx; }
        const unsigned old = xb_add(&bar[XB_XSUB(b.x)], 1u);
        const unsigned gen = old / nloc;
        if (old + 1u == (gen + 1u) * nloc) {
            __builtin_amdgcn_fence(__ATOMIC_RELEASE, "agent");
            asm volatile("s_waitcnt vmcnt(0)" ::: "memory");
            const unsigned og = xb_add(&bar[XB_TOP], 1u);
            const unsigned tg = og / nx;
            if (og + 1u == (tg + 1u) * nx) xb_add(&bar[XB_TOPGEN], 1u);
            else XB_SPIN(xb_ld(&bar[XB_TOPGEN]) == tg, bar);
            __builtin_amdgcn_fence(__ATOMIC_ACQUIRE, "agent");
            xb_add(&bar[XB_XGEN(b.x)], 1u);
            asm volatile("s_waitcnt vmcnt(0)" ::: "memory");
        } else {
            XB_SPIN(xb_ld(&bar[XB_XGEN(b.x)]) == gen, bar);
            __builtin_amdgcn_fence(__ATOMIC_ACQUIRE, "agent");
            asm volatile("s_waitcnt vmcnt(0)" ::: "memory");
        }
    }
    __syncthreads();
}

constexpr int NWAVES = 8;
constexpr int RING_OFF = 0, RING_BYTES = 131072;
constexpr int LDSCTL_OFF = RING_BYTES, MISC_OFF = LDSCTL_OFF + 320;
constexpr int LDS_BYTES = 147456;
constexpr int CW_BAR = 0;
#ifndef MK_N_LAUNCHES
#define MK_N_LAUNCHES 1
#endif
constexpr size_t CTL_ZERO_BYTES = (MK_N_LAUNCHES == 1 ? 16 : 256) * 1024;
constexpr int N_PHASES = 10;
#ifndef PROBE_DOUBLEK
#define PROBE_DOUBLEK 0
#endif
#ifndef PROBE_PHASE
#define PROBE_PHASE -1
#endif
constexpr int PROBE_AMP = 8;
#ifndef PROBE_REPS
#define PROBE_REPS 1,1,1,1,1,1,1,1,1,1
#endif
constexpr int PHASE_REP[N_PHASES] = {PROBE_REPS};

__device__ __forceinline__ const void* karg(unsigned off) {
    asm volatile("" : "+s"(off));
    return *(const void* const __attribute__((address_space(4)))*)((const char __attribute__((address_space(4)))*)__builtin_amdgcn_kernarg_segment_ptr() + off);
}
struct MArgs { const void* in[20]; float* out; unsigned char* ws; int ph_lo, ph_hi, li, pad; };

__global__ void __launch_bounds__(NWAVES * 64, 2) mega_fwd(MArgs args) {
    extern __shared__ __attribute__((aligned(16))) unsigned char lds[];
    LAS unsigned char* L = (LAS unsigned char*)lds;
    const int WAVE_S = __builtin_amdgcn_readfirstlane((int)(threadIdx.x >> 6));
#define TID() (WAVE_S * 64 + lane_id_())
#define FIRST() (WAVE_S == 0 && lane_id_() == 0)
    const int G = gridDim.x, bx = blockIdx.x, vcu = (G % 8 == 0) ? (bx % 8) * (G / 8) + bx / 8 : bx;
    for (int u = (int)threadIdx.x; u < (LDS_BYTES - LDSCTL_OFF) / 4; u += NWAVES * 64) ((LAS unsigned*)(L + LDSCTL_OFF))[u] = 0u;
    __syncthreads();
    unsigned* ctl = (unsigned*)(args.ws + WS_CTL);
    XcdBarrier bar = xcd_barrier_post(ctl + CW_BAR + args.li * XCD_BAR_WORDS, (volatile LAS unsigned*)(L + MISC_OFF) + 8, FIRST());
    const int lo = args.ph_lo, hi = args.ph_hi;
    unsigned long long t_last = PROBE_PHASE >= 0 ? __builtin_amdgcn_s_memrealtime() : 0ull, t_a = 0ull, t_b = 0ull;
#define IN(k) (lo <= (k) && (k) < hi)
#define SEAM(k) do { if (PROBE_PHASE == (k)) { t_a = t_last; } if (IN(k) && IN((k) + 1)) xcd_barrier(bar, FIRST()); if (PROBE_PHASE >= 0) { t_last = __builtin_amdgcn_s_memrealtime(); if (PROBE_PHASE == (k)) t_b = t_last; } } while (0)

#define INF(k) ((const float*)karg(8 * (k)))
#define OUTP() ((float*)karg(160))
#define WSB(off) ((bf16_t*)((unsigned char*)karg(168) + (off)))
#define WSF(off) ((float*)((unsigned char*)karg(168) + (off)))

    if (IN(0)) for (int rep_ = 0; rep_ < PHASE_REP[0]; ++rep_) {
        gemv8_phase<true, false>(TID(), vcu, G, INF(1), DM, INF(3), MODW, INF(4), WSF(WS_MOD), MODW, (float*)lds);
        ConvPtrs cv{INF(6), INF(14), INF(15), INF(16), INF(18), INF(19), WSB(WS_WIN), WSB(WS_WA), WSB(WS_WB), WSB(WS_WOUT), WSB(WS_WGU), WSB(WS_WDN)};
        convert_phase(TID(), vcu, G, cv, (float*)lds);
        trig_phase(TID(), vcu, G, (const int*)karg(16), WSF(WS_TA), WSF(WS_TR));
        __syncthreads();
    }
    SEAM(0);
    if (IN(1)) for (int rep_ = 0; rep_ < PHASE_REP[1]; ++rep_) { const float* mod = WSF(WS_MOD); xn_phase(TID(), vcu, G, INF(0), INF(5), mod + 1 * DM, mod + 0 * DM, WSB(WS_XN));
        gemv8_phase<false, true>(TID(), vcu, G, mod + 3 * DM, MODW, INF(18), 2 * DFF, nullptr, WSF(WS_CVEC), 2 * DFF, (float*)lds); }
    SEAM(1);
    if (IN(2)) for (int rep_ = 0; rep_ < PHASE_REP[2]; ++rep_) {
        pg8::Gemm g{WSB(WS_XN), WSB(WS_WIN), M, INW, DM}; pg8::StaticOrder S; S.init(M, INW, G, bx);
        pg8::EpiRows<InProjEpi> E{{WSB(WS_DQ), WSB(WS_DK), WSB(WS_DV), WSB(WS_RQ), WSB(WS_RK), WSB(WS_RV), WSB(WS_RG), WSB(WS_GA), WSB(WS_GB), INF(7), INF(8), WSF(WS_TA), WSF(WS_TR)}};
        pg8::gemm_phase<pg8::EpiRows<InProjEpi>, pg8::StaticOrder, true, true>(L + RING_OFF, g, S, E, WAVE_S);
    }
    SEAM(2);
    if (IN(3)) for (int rep_ = 0; rep_ < PHASE_REP[3]; ++rep_) {
        char* shm = (char*)lds + RING_OFF;
        typedef attn_body::bf16 abf;
        const int xb = vcu >> 5, lc = vcu & 31;
        for (int i = 0; i < 2; ++i) {
            if (i < 1) {
                const int s4 = lc & 3, u = lc >> 2, b = xb, h = u >> 1;
                for (int k = 0; k < 2; ++k)
                    attn_body::attn_unit2<8>((long)b * SEQ, k == 0 ? 7 - s4 : s4, (const abf*)(WSB(WS_DQ) + u * 64), 512, (const abf*)(WSB(WS_DK) + u * 64), 512, (const abf*)(WSB(WS_DV) + h * 128), 512,
                                             (abf*)(WSB(WS_AO) + u * 128), 1024, shm, WAVE_S);
            } else {
                const int s4 = lc & 3, half = (lc >> 2) & 1, h = lc >> 3, b = xb;
                for (int k = 0; k < 2; ++k) {
                    const int qb = k == 0 ? 7 - s4 : s4; const long row0 = (long)b * SEQ;
                    if (qb > 0) attn_body::ret_state(row0, 4 * qb, (const abf*)(WSB(WS_RK) + h * 64), 256, (const abf*)(WSB(WS_RV) + h * 128 + half * 64), 512, shm, WAVE_S);
                    attn_body::attn_unit<8, true>(row0 + 256 * qb, 0, (const abf*)(WSB(WS_RQ) + h * 64), 256, (const abf*)(WSB(WS_RK) + h * 64), 256, (const abf*)(WSB(WS_RV) + h * 128 + half * 64), 512,
                                                  (abf*)(WSB(WS_RETO) + h * 128 + half * 64), 512, shm, qb > 0, WAVE_S);
                }
            }
        }
    }
    SEAM(3);
    if (IN(4)) for (int rep_ = 0; rep_ < PHASE_REP[4]; ++rep_) combine_phase(TID(), vcu, G, WSB(WS_AO), WSB(WS_RETO), WSB(WS_RG), WSB(WS_OA), INF(9), INF(10), INF(11), INF(12), INF(13));
    SEAM(4);
    if (IN(5)) for (int rep_ = 0; rep_ < PHASE_REP[5]; ++rep_) {
        pg8::Gemm g{WSB(WS_OA), WSB(WS_WA), M, DM, 512, WSB(WS_OB), WSB(WS_WB)}; pg8::PairOrder S; S.init(M, DM, G, bx); pg8::BranchTileEpi E{WSB(WS_GA), WSB(WS_GB), WSB(WS_Y)};
        pg8::gemm_phase<pg8::BranchTileEpi, pg8::PairOrder, true, true>(L + RING_OFF, g, S, E, WAVE_S);
    }
    SEAM(5);
    if (IN(6)) for (int rep_ = 0; rep_ < PHASE_REP[6]; ++rep_) {
        pg8::Gemm g{WSB(WS_Y), WSB(WS_WOUT), M, DM, DM}; pg8::StaticOrder S; S.init(M, DM, G, bx); pg8::EpiOutFused E{{INF(0), WSB(WS_X1B), WSF(WS_MOD), INF(17), WSB(WS_XN), WSF(WS_ROWSS)}};
        pg8::gemm_phase<pg8::EpiOutFused, pg8::StaticOrder, false, true>(L + RING_OFF, g, S, E, WAVE_S);
    }
    SEAM(6);
    if (IN(8)) for (int rep_ = 0; rep_ < PHASE_REP[8]; ++rep_) {
        pg8::Gemm g{WSB(WS_XN), WSB(WS_WGU), M, 2 * DFF, DM}; pg8::StaticOrder S; S.init(M, 2 * DFF, G, bx); pg8::EpiRows<GateUpEpi> E{{WSB(WS_ACT), WSF(WS_ROWSS), WSF(WS_CVEC)}};
        pg8::gemm_phase<pg8::EpiRows<GateUpEpi>, pg8::StaticOrder, true, true>(L + RING_OFF, g, S, E, WAVE_S);
    }
    SEAM(8);
    if (IN(9)) for (int rep_ = 0; rep_ < PHASE_REP[9]; ++rep_) {
        float* out = OUTP();
        pg8::Gemm g{WSB(WS_ACT), WSB(WS_WDN), M, DM, DFF};
#if PROBE_DOUBLEK
        pg8::DoubleKOrder S; S.init(M, DM, G, bx); pg8::EpiRowsDK<ResidEpi> E{{WSB(WS_X1B), out, WSF(WS_MOD) + 5 * DM}};
        pg8::gemm_phase<pg8::EpiRowsDK<ResidEpi>, pg8::DoubleKOrder, false, true>(L + RING_OFF, g, S, E, WAVE_S);
#else
        pg8::StaticOrder S; S.init(M, DM, G, bx); pg8::EpiRows<ResidEpi> E{{WSB(WS_X1B), out, WSF(WS_MOD) + 5 * DM}};
        pg8::gemm_phase<pg8::EpiRows<ResidEpi>, pg8::StaticOrder, true, true>(L + RING_OFF, g, S, E, WAVE_S);
#endif
    }
#undef INF
#undef OUTP
#undef WSB
#undef WSF
    SEAM(9);
    if (PROBE_PHASE >= 0 && blockIdx.x == 0 && WAVE_S == 0) { const unsigned long long tgt = __builtin_amdgcn_s_memrealtime() + (unsigned long long)PROBE_AMP * (t_b - t_a); while (__builtin_amdgcn_s_memrealtime() < tgt) __builtin_amdgcn_s_sleep(8); }
#undef IN
#undef SEAM
#undef TID
#undef FIRST
}

#ifndef MK_N_LAUNCHES
#define MK_N_LAUNCHES 1
#endif
extern "C" void kernel_launch(void* const* d_in, const int* in_sizes, int n_in, void* d_out, int out_size, void* d_ws, size_t ws_size, hipStream_t stream) {
    static int grid = 0;
    if (grid == 0) {
        if (n_in != 20 || in_sizes[0] != M * DM || out_size != M * DM || ws_size < WS_END) { fprintf(stderr, "kernel_launch: unexpected shapes (n_in %d, ws %zu)\n", n_in, ws_size); grid = -1; return; }
        int dev = 0, cus = 0, per_cu = 0;
        if (hipGetDevice(&dev) != hipSuccess || hipDeviceGetAttribute(&cus, hipDeviceAttributeMultiprocessorCount, dev) != hipSuccess) { grid = -1; return; }
        if (hipFuncSetAttribute((const void*)mega_fwd, hipFuncAttributeMaxDynamicSharedMemorySize, LDS_BYTES) != hipSuccess) { fprintf(stderr, "kernel_launch: hipFuncSetAttribute failed\n"); grid = -1; return; }
        if (hipOccupancyMaxActiveBlocksPerMultiprocessor(&per_cu, (const void*)mega_fwd, NWAVES * 64, LDS_BYTES) != hipSuccess || per_cu < 1) { fprintf(stderr, "kernel_launch: occupancy query says %d\n", per_cu); per_cu = 1; }
        (void)hipGetLastError();
        if (cus != 256) { fprintf(stderr, "kernel_launch: built for a 256-CU device (got %d)\n", cus); grid = -1; return; }
        grid = cus;
    }
    if (grid < 0) return;
    (void)hipMemsetAsync((char*)d_ws + WS_CTL, 0, CTL_ZERO_BYTES, stream);
    MArgs a{};
    for (int i = 0; i < 20; ++i) a.in[i] = d_in[i];
    a.out = (float*)d_out; a.ws = (unsigned char*)d_ws;
    if (MK_N_LAUNCHES == 1) { a.ph_lo = 0; a.ph_hi = N_PHASES; a.li = 0; hipLaunchKernelGGL(mega_fwd, dim3(grid), dim3(NWAVES * 64), LDS_BYTES, stream, a); }
    else for (int p = 0; p < N_PHASES; ++p) { a.ph_lo = p; a.ph_hi = p + 1; a.li = p; hipLaunchKernelGGL(mega_fwd, dim3(grid), dim3(NWAVES * 64), LDS_BYTES, stream, a); }
}
```

```cpp
#include <hip/hip_runtime.h>
#include <cstdint>
#include <cstdio>
#include <hip/hip_bf16.h>
#include <cmath>

typedef unsigned short bf16_t;
typedef short bf16x8 __attribute__((ext_vector_type(8)));
typedef float f32x4 __attribute__((ext_vector_type(4)));
typedef unsigned u32x2 __attribute__((ext_vector_type(2)));
typedef unsigned u32x4 __attribute__((ext_vector_type(4)));

constexpr int BATCH = 8, SEQ = 2048, DM = 1024, M = BATCH * SEQ, INW = 5120, DFF = 2816, MODW = 6 * DM;
constexpr float EPS = 1e-6f;
constexpr float C2 = 0.125f * 1.4426950408889634f;

constexpr size_t MiB = 1u << 20;
constexpr size_t WS_CTL = 0, WS_MOD = 1 * MiB, WS_CVEC = 1 * MiB + 256 * 1024, WS_TA = 2 * MiB, WS_TR = 3 * MiB, WS_ROWSS = 7 * MiB;
constexpr size_t WS_WIN = 8 * MiB, WS_WA = 18 * MiB, WS_WB = 19 * MiB, WS_WOUT = 20 * MiB, WS_WGU = 22 * MiB, WS_WDN = 33 * MiB;
constexpr size_t WS_XN = 40 * MiB;
constexpr size_t WS_DQ = 72 * MiB, WS_DK = 88 * MiB, WS_DV = 104 * MiB, WS_RQ = 120 * MiB, WS_RK = 128 * MiB, WS_RV = 136 * MiB,
                 WS_RG = 152 * MiB, WS_GA = 168 * MiB, WS_GB = 200 * MiB, WS_RETO = 232 * MiB, WS_X1B = 208 * MiB;
constexpr size_t WS_AO = WS_XN, WS_OA = WS_DQ, WS_OB = WS_RG, WS_Y = WS_DK, WS_ACT = 120 * MiB, WS_END = 256 * MiB;

__device__ __forceinline__ int lane_id_() { return (int)__builtin_amdgcn_mbcnt_hi(~0u, __builtin_amdgcn_mbcnt_lo(~0u, 0u)); }
__device__ __forceinline__ unsigned f2bf(float f) { unsigned u = __float_as_uint(f); return (u + 0x7fffu + ((u >> 16) & 1u)) >> 16; }
typedef float f32x2_t_ __attribute__((ext_vector_type(2))); typedef __bf16 bf16x2_t_ __attribute__((ext_vector_type(2)));
__device__ __forceinline__ unsigned pk2(float lo, float hi) { f32x2_t_ v = {lo, hi}; bf16x2_t_ b = __builtin_convertvector(v, bf16x2_t_); return __builtin_bit_cast(unsigned, b); }
__device__ __forceinline__ float bf2f(unsigned h) { return __uint_as_float(h << 16); }
__device__ __forceinline__ float bflo(unsigned w) { return __uint_as_float(w << 16); }
__device__ __forceinline__ float bfhi(unsigned w) { return __uint_as_float(w & 0xffff0000u); }
__device__ __forceinline__ u32x2 pack4(f32x4 v) { u32x2 r; r.x = pk2(v[0], v[1]); r.y = pk2(v[2], v[3]); return r; }
__device__ __forceinline__ float wave_sum(float v) {
#pragma unroll
    for (int o = 1; o < 64; o <<= 1) v += __shfl_xor(v, o);
    return v;
}
__device__ __forceinline__ float silu_f(float x) { return x * __builtin_amdgcn_rcpf(1.f + __builtin_amdgcn_exp2f(-1.4426950408889634f * x)); }
__device__ __forceinline__ float sigm_f(float x) { return __builtin_amdgcn_rcpf(1.f + __builtin_amdgcn_exp2f(-1.4426950408889634f * x)); }

__constant__ double c_invf_da[8] = {1.0, 0.19392274474868576, 0.03760603093086393, 0.007292664737217109, 0.001414213562373095, 0.0002742481756762073, 5.318295896944988e-05, 1.031338537721246e-05};
__constant__ double c_invf_ret[32] = {1.0, 0.7498942093324559, 0.5623413251903491, 0.4216965034285822, 0.31622776601683794, 0.23713737056616552, 0.1778279410038923, 0.1333521432163324, 0.1, 0.07498942093324558, 0.05623413251903491, 0.042169650342858224, 0.03162277660168379, 0.023713737056616554, 0.01778279410038923, 0.01333521432163324, 0.01, 0.007498942093324558, 0.005623413251903491, 0.004216965034285823, 0.0031622776601683794, 0.0023713737056616554, 0.0017782794100389228, 0.001333521432163324, 0.001, 0.0007498942093324559, 0.0005623413251903491, 0.00042169650342858224, 0.00031622776601683794, 0.00023713737056616554, 0.00017782794100389227, 0.0001333521432163324};
__device__ __forceinline__ float log2gamma(int h) { return h == 0 ? -0.04580368961312479f : h == 1 ? -0.02272007650008353f : h == 2 ? -0.011315313227834146f : -0.005646563141142063f; }

template <bool SILU, bool GUMAP>
__device__ __forceinline__ void gemv8_phase(int tid, int wg, int G, const float* vec, int vpitch, const float* W, int N, const float* bias, float* out, int opitch, float* lds) {
    const int wave = tid >> 6, lane = tid & 63, r8 = lane >> 3, c4 = lane & 7;
    f32x4 w[16];
    if (wg < N / 32) { const float* wp = W + (size_t)(wave * 128 + r8) * N + wg * 32 + c4 * 4;
#pragma unroll
        for (int i = 0; i < 16; ++i) w[i] = *(const f32x4*)(wp + (size_t)(8 * i) * N); }
    for (int i = tid; i < BATCH * DM; i += 512) { const float v = vec[(i >> 10) * vpitch + (i & 1023)]; lds[i] = SILU ? silu_f(v) : v; }
    __syncthreads();
    float* red = lds + BATCH * DM;
    for (int cg = wg; cg < N / 32; cg += G) {
        const int e0 = cg * 32;
        f32x4 acc[8];
#pragma unroll
        for (int b = 0; b < 8; ++b) acc[b] = (f32x4){0.f, 0.f, 0.f, 0.f};
        if (cg != wg) { const float* wp = W + (size_t)(wave * 128 + r8) * N + e0 + c4 * 4;
#pragma unroll
            for (int i = 0; i < 16; ++i) w[i] = *(const f32x4*)(wp + (size_t)(8 * i) * N); }
#pragma unroll
        for (int i = 0; i < 16; ++i) {
            const int d = wave * 128 + 8 * i + r8;
#pragma unroll
            for (int b = 0; b < 8; ++b) acc[b] += w[i] * lds[b * DM + d];
        }
#pragma unroll
        for (int b = 0; b < 8; ++b)
#pragma unroll
            for (int e = 0; e < 4; ++e) { float v = acc[b][e]; v += __shfl_xor(v, 8); v += __shfl_xor(v, 16); v += __shfl_xor(v, 32); acc[b][e] = v; }
        if (r8 == 0) {
#pragma unroll
            for (int b = 0; b < 8; ++b) *(f32x4*)(red + (wave * 8 + b) * 32 + c4 * 4) = acc[b];
        }
        __syncthreads();
        if (tid < 256) {
            const int b = tid >> 5, c2 = tid & 31, e = e0 + c2;
            float s = bias ? bias[e] : 0.f;
#pragma unroll
            for (int w2 = 0; w2 < 8; ++w2) s += red[(w2 * 8 + b) * 32 + c2];
            int oi = e;
            if (GUMAP) { const int bj = e / DFF, r = e % DFF; oi = (r >> 7) * 256 + bj * 128 + (r & 127); }
            out[b * opitch + oi] = s;
        }
        __syncthreads();
    }
}

__device__ __forceinline__ int slot2col(int map, int slot) {
    if (map == 1) { const int pn = slot >> 8, bj = (slot >> 7) & 1, wc = (slot >> 5) & 3, r = slot & 31; return (pn << 8) + (wc << 6) + (bj << 5) + r; }
    if (map == 2) { const int pn = slot >> 8, bj = (slot >> 7) & 1, j = slot & 127; return bj * DFF + pn * 128 + j; }
    return slot;
}
__device__ __forceinline__ void convert_item(const float* W, int K, int N, bf16_t* Wt, int map, float* scr, int item, int lane) {
    const int nblk = N / 32, kb = item / nblk, nb = item % nblk, k0 = 64 * kb, s0 = 32 * nb, c0 = slot2col(map, s0);
    { const int r8 = lane >> 3, c4 = lane & 7;
      f32x4 v[8];
#pragma unroll
      for (int i = 0; i < 8; ++i) v[i] = *(const f32x4*)(W + (size_t)(k0 + 8 * i + r8) * N + c0 + 4 * c4);
#pragma unroll
      for (int i = 0; i < 8; ++i) { float* d = scr + (8 * i + r8) * 33 + 4 * c4; d[0] = v[i][0]; d[1] = v[i][1]; d[2] = v[i][2]; d[3] = v[i][3]; } }
    __builtin_amdgcn_s_waitcnt(0xc07f); __builtin_amdgcn_wave_barrier();
    const int c = lane & 7;
#pragma unroll
    for (int j = 0; j < 4; ++j) { const int n = (lane >> 3) + 8 * j; const float* s = scr + (8 * c) * 33 + n;
        u32x4 o; o.x = pk2(s[0 * 33], s[1 * 33]); o.y = pk2(s[2 * 33], s[3 * 33]); o.z = pk2(s[4 * 33], s[5 * 33]); o.w = pk2(s[6 * 33], s[7 * 33]);
        *(u32x4*)(Wt + (size_t)(s0 + n) * K + k0 + 8 * c) = o; }
    __builtin_amdgcn_s_waitcnt(0xc07f); __builtin_amdgcn_wave_barrier();
}
struct ConvPtrs { const float *w_in, *wa, *wb, *wout, *wgu, *wdn; bf16_t *w_in_t, *wa_t, *wb_t, *wout_t, *wgu_t, *wdn_t; };
__device__ __forceinline__ void convert_phase(int tid, int wg, int G, const ConvPtrs& P, float* lds) {
    const int wave = tid >> 6, lane = tid & 63;
    float* scr = lds + wave * (64 * 33);
    const int gw = wg * 8 + wave, NGW = G * 8;
    constexpr int I_IN = (DM / 64) * (INW / 32), I_A = (512 / 64) * (DM / 32), I_O = (DM / 64) * (DM / 32), I_GU = (DM / 64) * (2 * DFF / 32), I_DN = (DFF / 64) * (DM / 32);
    constexpr int NIT = I_IN + 2 * I_A + I_O + I_GU + I_DN;
    for (int it = gw; it < NIT; it += NGW) {
        int r = it;
        if (r < I_IN) { convert_item(P.w_in, DM, INW, P.w_in_t, 1, scr, r, lane); continue; } r -= I_IN;
        if (r < I_A) { convert_item(P.wa, 512, DM, P.wa_t, 0, scr, r, lane); continue; } r -= I_A;
        if (r < I_A) { convert_item(P.wb, 512, DM, P.wb_t, 0, scr, r, lane); continue; } r -= I_A;
        if (r < I_O) { convert_item(P.wout, DM, DM, P.wout_t, 0, scr, r, lane); continue; } r -= I_O;
        if (r < I_GU) { convert_item(P.wgu, DM, 2 * DFF, P.wgu_t, 2, scr, r, lane); continue; } r -= I_GU;
        convert_item(P.wdn, DFF, DM, P.wdn_t, 0, scr, r, lane);
    }
}

__device__ __forceinline__ void trig_phase(int tid, int wg, int G, const int* positions, float* TA, float* TR) {
    const int gt = wg * 512 + tid, NT = G * 512;
    for (int it = gt; it < M * 40; it += NT) {
        const int row = it / 40, i = it % 40;
        const double p = (double)positions[row];
        const double a = p * (i < 8 ? c_invf_da[i] : c_invf_ret[i - 8]);
        double rev = a * 0.15915494309189535;
        rev -= __builtin_rint(rev);
        const float sn = __builtin_amdgcn_sinf((float)rev), cs = __builtin_amdgcn_cosf((float)rev);
        if (i < 8) { TA[row * 16 + i] = cs; TA[row * 16 + 8 + i] = sn; }
        else { TR[row * 64 + (i - 8)] = cs; TR[row * 64 + 32 + (i - 8)] = sn; }
    }
}

__device__ __forceinline__ void xn_phase(int tid, int wg, int G, const float* x, const float* g, const float* sc, const float* sh, bf16_t* XN) {
    const int wave = tid >> 6, lane = tid & 63;
    for (int r0 = (wg * 8 + wave) * 8; r0 < M; r0 += G * 64) {
        const int b = r0 / SEQ;
        f32x4 a[4], s0[4];
#pragma unroll
        for (int j = 0; j < 4; ++j) { const int col = 4 * lane + 256 * j; a[j] = *(const f32x4*)(g + col) * (*(const f32x4*)(sc + b * MODW + col) + 1.f); s0[j] = *(const f32x4*)(sh + b * MODW + col); }
#pragma unroll
        for (int h = 0; h < 2; ++h) {
            f32x4 v[4][4];
#pragma unroll
            for (int r = 0; r < 4; ++r)
#pragma unroll
                for (int j = 0; j < 4; ++j) v[r][j] = ((const f32x4*)(x + (size_t)(r0 + 4 * h + r) * DM))[lane + 64 * j];
            __builtin_amdgcn_sched_barrier(0);
#pragma unroll
            for (int r = 0; r < 4; ++r) {
                float ss = 0.f;
#pragma unroll
                for (int j = 0; j < 4; ++j) ss += (v[r][j][0] * v[r][j][0] + v[r][j][1] * v[r][j][1]) + (v[r][j][2] * v[r][j][2] + v[r][j][3] * v[r][j][3]);
                const float rstd = rsqrtf(wave_sum(ss) * (1.f / DM) + EPS);
                u32x2* o = (u32x2*)(XN + (size_t)(r0 + 4 * h + r) * DM) + lane;
#pragma unroll
                for (int j = 0; j < 4; ++j) o[64 * j] = pack4(v[r][j] * rstd * a[j] + s0[j]);
            }
        }
    }
}

__device__ __forceinline__ void combine_phase(int tid, int wg, int G, const bf16_t* AO, const bf16_t* RETO, bf16_t* RG_OB, bf16_t* OA,
                                              const float* lq1, const float* lk1, const float* lq2, const float* lk2, const float* subln_g) {
    const int wave = tid >> 6, lane = tid & 63;
    const float lam = __expf(wave_sum(lq1[lane] * lk1[lane])) - __expf(wave_sum(lq2[lane] * lk2[lane])) + 0.2f;
    const int h = lane >> 4, d0 = (lane & 15) * 8;
    float gsub[8];
#pragma unroll
    for (int e = 0; e < 8; ++e) gsub[e] = subln_g[d0 + e] * 0.8f;
    for (int row = wg * 64 + wave * 8; row < M; row += G * 64) for (int rj = 0; rj < 8; ++rj, ++row) {
        {
            const u32x4 a = *(const u32x4*)(AO + (size_t)row * 1024 + (2 * h) * 128 + d0), b = *(const u32x4*)(AO + (size_t)row * 1024 + (2 * h + 1) * 128 + d0);
            float d[8]; float ss = 0.f;
#pragma unroll
            for (int e = 0; e < 4; ++e) { d[2 * e] = bflo(a[e]) - lam * bflo(b[e]); d[2 * e + 1] = bfhi(a[e]) - lam * bfhi(b[e]); }
#pragma unroll
            for (int e = 0; e < 8; ++e) ss += d[e] * d[e];
            ss += __shfl_xor(ss, 1); ss += __shfl_xor(ss, 2); ss += __shfl_xor(ss, 4); ss += __shfl_xor(ss, 8);
            const float rstd = rsqrtf(ss * (1.f / 128.f) + EPS);
            u32x4 o;
#pragma unroll
            for (int e = 0; e < 4; ++e) o[e] = pk2(d[2 * e] * rstd * gsub[2 * e], d[2 * e + 1] * rstd * gsub[2 * e + 1]);
            *(u32x4*)(OA + (size_t)row * 512 + h * 128 + d0) = o;
        }
        {
            const u32x4 a = *(const u32x4*)(RETO + (size_t)row * 512 + h * 128 + d0), gt = *(const u32x4*)(RG_OB + (size_t)row * 512 + h * 128 + d0);
            float d[8]; float ss = 0.f;
#pragma unroll
            for (int e = 0; e < 4; ++e) { d[2 * e] = bflo(a[e]); d[2 * e + 1] = bfhi(a[e]); }
#pragma unroll
            for (int e = 0; e < 8; ++e) ss += d[e] * d[e];
            ss += __shfl_xor(ss, 1); ss += __shfl_xor(ss, 2); ss += __shfl_xor(ss, 4); ss += __shfl_xor(ss, 8);
            const float rstd = rsqrtf(ss * (1.f / 128.f) + EPS);
            u32x4 o;
#pragma unroll
            for (int e = 0; e < 4; ++e) o[e] = pk2(d[2 * e] * rstd * bflo(gt[e]), d[2 * e + 1] * rstd * bfhi(gt[e]));
            *(u32x4*)(RG_OB + (size_t)row * 512 + h * 128 + d0) = o;
        }
    }
}

__device__ __forceinline__ u32x4 pack8(f32x4 a, f32x4 b) { u32x4 r; r.x = pk2(a[0], a[1]); r.y = pk2(a[2], a[3]); r.z = pk2(b[0], b[1]); r.w = pk2(b[2], b[3]); return r; }
#define SLOT8(pn, wc, fq, g) (256 * (pn) + 128 * ((g) >> 1) + 32 * (wc) + 8 * (fq) + 4 * ((g) & 1))
struct InProjEpi {
    static constexpr int BATCH = 2;
    struct Tile { f32x4 gn[4]; };
    struct Pre { f32x4 t[4]; };
    bf16_t *DQ, *DK, *DV, *RQ, *RK, *RV, *RG, *GA, *GB; const float *qg, *kg, *TA, *TR;
    __device__ __forceinline__ Tile tile_pre(int b, int pn, int wc, int fq) const {
        Tile T;
        if (pn < 4) { const float* gn = pn < 2 ? qg : kg;
#pragma unroll
            for (int g = 0; g < 4; ++g) T.gn[g] = *(const f32x4*)(gn + 32 * (g >> 1) + 8 * fq + 4 * (g & 1)); }
        return T;
    }
    __device__ __forceinline__ Pre row_pre(int row, int b, int pn, int wc, int fq) const {
        Pre P;
        if (pn < 4) {
#pragma unroll
            for (int i = 0; i < 4; ++i) P.t[i] = *(const f32x4*)(TA + (size_t)row * 16 + 4 * i); }
        else if (pn == 6 || pn == 7) {
#pragma unroll
            for (int n = 0; n < 2; ++n) { P.t[n] = *(const f32x4*)(TR + (size_t)row * 64 + 8 * fq + 4 * n); P.t[2 + n] = *(const f32x4*)(TR + (size_t)row * 64 + 32 + 8 * fq + 4 * n); } }
        return P;
    }
    __device__ __forceinline__ void operator()(const f32x4 (&v)[4], const Pre& P, const Tile& T, int row, int b, int pn, int wc, int fq) const {
        f32x4 o[4]; bf16_t* dst;
        if (pn < 4) {
            const bool isq = pn < 2;
            float ss = 0.f;
#pragma unroll
            for (int g = 0; g < 4; ++g) ss += (v[g][0] * v[g][0] + v[g][1] * v[g][1]) + (v[g][2] * v[g][2] + v[g][3] * v[g][3]);
            ss += __shfl_xor(ss, 16); ss += __shfl_xor(ss, 32);
            const float rstd = rsqrtf(ss * (1.f / 64.f) + EPS) * (isq ? C2 : 1.f);
#pragma unroll
            for (int g = 0; g < 4; ++g) o[g] = v[g] * rstd * T.gn[g];
#pragma unroll
            for (int n = 0; n < 2; ++n) {
                f32x4 other;
#pragma unroll
                for (int r = 0; r < 4; ++r) other[r] = __shfl_xor(o[n][r], 16);
                const f32x4 rot = (fq == 0) ? (o[n] * P.t[n] - other * P.t[2 + n]) : (o[n] * P.t[n] + other * P.t[2 + n]);
                o[n] = (fq < 2) ? rot : o[n];
            }
            dst = (isq ? DQ : DK) + (size_t)row * 512 + ((pn & 1) * 4 + wc) * 64;
        } else if (pn == 6 || pn == 7) {
            const bool isq = pn == 6;
#pragma unroll
            for (int n = 0; n < 2; ++n) { o[n] = v[n] * P.t[n] - v[2 + n] * P.t[2 + n]; o[2 + n] = v[2 + n] * P.t[n] + v[n] * P.t[2 + n]; }
            const float t = (float)(row & (SEQ - 1)), lg = log2gamma(wc);
            const float s = isq ? exp2f(t * lg) : exp2f(-t * lg) * 0.125f;
#pragma unroll
            for (int g = 0; g < 4; ++g) o[g] = o[g] * s;
            dst = (isq ? RQ : RK) + (size_t)row * 256 + wc * 64;
        } else if (pn < 6) {
#pragma unroll
            for (int g = 0; g < 4; ++g) o[g] = v[g];
            dst = DV + (size_t)row * 512 + (pn - 4) * 256 + wc * 64;
        } else if (pn < 10) {
#pragma unroll
            for (int g = 0; g < 4; ++g) o[g] = v[g];
            dst = RV + (size_t)row * 512 + (pn - 8) * 256 + wc * 64;
        } else if (pn < 12) {
#pragma unroll
            for (int g = 0; g < 4; ++g)
#pragma unroll
                for (int r = 0; r < 4; ++r) o[g][r] = silu_f(v[g][r]);
            dst = RG + (size_t)row * 512 + (pn - 10) * 256 + wc * 64;
        } else {
#pragma unroll
            for (int g = 0; g < 4; ++g)
#pragma unroll
                for (int r = 0; r < 4; ++r) o[g][r] = sigm_f(v[g][r]);
            dst = (pn < 16 ? GA + (size_t)row * 1024 + (pn - 12) * 256 : GB + (size_t)row * 1024 + (pn - 16) * 256) + wc * 64;
        }
#pragma unroll
        for (int bj = 0; bj < 2; ++bj) *(u32x4*)(dst + 32 * bj + 8 * fq) = pack8(o[2 * bj], o[2 * bj + 1]);
    }
};
struct OutEpi {
    static constexpr int BATCH = 4;
    struct Tile { f32x4 g1[4], a2[4]; };
    struct Pre { f32x4 x[4]; };
    const float* x; bf16_t* X1B; const float* mod; const float* g2n; bf16_t* XM; float* rowss;
    __device__ __forceinline__ Tile tile_pre(int b, int pn, int wc, int fq) const {
        Tile T;
#pragma unroll
        for (int g = 0; g < 4; ++g) { const int col = SLOT8(pn, wc, fq, g);
            T.g1[g] = *(const f32x4*)(mod + b * MODW + 2 * DM + col); T.a2[g] = *(const f32x4*)(g2n + col) * (*(const f32x4*)(mod + b * MODW + 4 * DM + col) + 1.f); }
        return T;
    }
    __device__ __forceinline__ Pre row_pre(int row, int b, int pn, int wc, int fq) const {
        Pre P;
#pragma unroll
        for (int g = 0; g < 4; ++g) P.x[g] = *(const f32x4*)(x + (size_t)row * DM + SLOT8(pn, wc, fq, g));
        return P;
    }
    __device__ __forceinline__ float operator()(const f32x4 (&v)[4], const Pre& P, const Tile& T, int row, int b, int pn, int wc, int fq) const {
        float ss = 0.f; f32x4 xm[4], x1[4];
#pragma unroll
        for (int g = 0; g < 4; ++g) {
            x1[g] = P.x[g] + T.g1[g] * v[g];
            ss += (x1[g][0] * x1[g][0] + x1[g][1] * x1[g][1]) + (x1[g][2] * x1[g][2] + x1[g][3] * x1[g][3]);
            xm[g] = x1[g] * T.a2[g];
        }
#pragma unroll
        for (int bj = 0; bj < 2; ++bj) { *(u32x4*)(X1B + (size_t)row * DM + SLOT8(pn, wc, fq, 2 * bj)) = pack8(x1[2 * bj], x1[2 * bj + 1]);
                                         *(u32x4*)(XM + (size_t)row * DM + SLOT8(pn, wc, fq, 2 * bj)) = pack8(xm[2 * bj], xm[2 * bj + 1]); }
        ss += __shfl_xor(ss, 16); ss += __shfl_xor(ss, 32);
        return ss;
    }
};
struct ResidEpi {
    static constexpr int BATCH = 8;
    struct Tile { f32x4 gg[4]; };
    struct Pre { u32x4 bs[2]; };
    const bf16_t* base; float* out; const float* gvec;
    __device__ __forceinline__ Tile tile_pre(int b, int pn, int wc, int fq) const {
        Tile T;
#pragma unroll
        for (int g = 0; g < 4; ++g) T.gg[g] = *(const f32x4*)(gvec + b * MODW + SLOT8(pn, wc, fq, g));
        return T;
    }
    __device__ __forceinline__ Pre row_pre(int row, int b, int pn, int wc, int fq) const {
        Pre P;
#pragma unroll
        for (int bj = 0; bj < 2; ++bj) P.bs[bj] = *(const u32x4*)(base + (size_t)row * DM + SLOT8(pn, wc, fq, 2 * bj));
        return P;
    }
    __device__ __forceinline__ void operator()(const f32x4 (&v)[4], const Pre& P, const Tile& T, int row, int b, int pn, int wc, int fq) const {
#pragma unroll
        for (int g = 0; g < 4; ++g) { const unsigned w0 = P.bs[g >> 1][2 * (g & 1)], w1 = P.bs[g >> 1][2 * (g & 1) + 1];
            const f32x4 bs = {bflo(w0), bfhi(w0), bflo(w1), bfhi(w1)};
            *(f32x4*)(out + (size_t)row * DM + SLOT8(pn, wc, fq, g)) = bs + T.gg[g] * v[g]; }
    }
};
struct GateUpEpi {
    static constexpr int BATCH = 4;
    struct Tile { f32x4 cg[2], cu[2]; };
    struct Pre { f32x4 s4; };
    bf16_t* ACT; const float* rowss; const float* cvec;
    __device__ __forceinline__ Tile tile_pre(int b, int pn, int wc, int fq) const {
        Tile T;
#pragma unroll
        for (int n = 0; n < 2; ++n) { const int slot = 256 * pn + 32 * wc + 8 * fq + 4 * n; T.cg[n] = *(const f32x4*)(cvec + b * (2 * DFF) + slot); T.cu[n] = *(const f32x4*)(cvec + b * (2 * DFF) + slot + 128); }
        return T;
    }
    __device__ __forceinline__ Pre row_pre(int row, int b, int pn, int wc, int fq) const { Pre P; P.s4 = *(const f32x4*)(rowss + (size_t)row * 4); return P; }
    __device__ __forceinline__ void operator()(const f32x4 (&v)[4], const Pre& P, const Tile& T, int row, int b, int pn, int wc, int fq) const {
        const float rstd = rsqrtf(((P.s4[0] + P.s4[1]) + (P.s4[2] + P.s4[3])) * (1.f / DM) + EPS);
        f32x4 y[2];
#pragma unroll
        for (int n = 0; n < 2; ++n) {
            const f32x4 gt = v[n] * rstd + T.cg[n], up = v[2 + n] * rstd + T.cu[n];
#pragma unroll
            for (int r = 0; r < 4; ++r) y[n][r] = silu_f(gt[r]) * up[r];
        }
        *(u32x4*)(ACT + (size_t)row * DFF + 128 * pn + 32 * wc + 8 * fq) = pack8(y[0], y[1]);
    }
};

namespace pg8 {
#define PG8_LAS __attribute__((address_space(3)))
typedef unsigned short bf16_t;
typedef short bf16x8 __attribute__((ext_vector_type(8)));
typedef float f32x4 __attribute__((ext_vector_type(4)));
typedef unsigned u32x4 __attribute__((ext_vector_type(4)));
constexpr int BM = 256, BK = 64, HALF = 128, HTB = HALF * BK * 2  , STAGE_BYTES = 8 * HTB, NXCD = 8, WGM = 4;

__host__ __device__ __forceinline__ int lds_byte(int r, int c) { const int st = (r >> 4) * 2 + (c >> 5), rr = r & 15, cc = c & 31, ob = rr * 64 + cc * 2; return st * 1024 + (ob ^ (((ob >> 9) & 1) << 5)); }
__host__ __device__ __forceinline__ void stage_rc(int b, int& R, int& C) { const int st = b / 1024, sb = b % 1024, swz = sb ^ (((sb >> 9) & 1) << 5); R = (st >> 1) * 16 + swz / 64; C = (st & 1) * 32 + (swz % 64) / 2; }
__host__ __device__ __forceinline__ int perm32(int rho) { const int n = rho >> 4, i = rho & 15; return 8 * (i >> 2) + 4 * n + (i & 3); }

struct Unit { int pm, pn, sel, half; };
struct Gemm { const bf16_t* A; const bf16_t* Bt; int M, N, K; const bf16_t* A2; const bf16_t* Bt2; };

struct StaticOrder {
    int nM, nN, nwg, G, c;
    __host__ __device__ void init(int M, int N, int G_, int c_) { nM = M / BM; nN = N / BM; nwg = nM * nN; G = G_; c = c_; }
    __host__ __device__ bool next(int i, Unit& u) const {
        const long L = (long)i * G + c; if (L >= nwg) return false;
        int wgid = (int)L; { const int q = nwg / NXCD, r = nwg % NXCD, xcd = wgid % NXCD, off = wgid / NXCD; wgid = (xcd < r ? xcd * (q + 1) : r * (q + 1) + (xcd - r) * q) + off; }
        const int nig = WGM * nN, gid = wgid / nig, fm = gid * WGM, gsz = (nM - fm) < WGM ? (nM - fm) : WGM;
        u.pm = fm + ((wgid % nig) % gsz); u.pn = (wgid % nig) / gsz; u.sel = 0; u.half = 0; return true;
    }
    __device__ __forceinline__ void a_ready(const Unit&) const {}
    __device__ __forceinline__ void done(const Unit&) const {}
};

template <class Epi, class Sched, bool ALIGN_EPI = false, bool SP2 = false>
__device__ __forceinline__ void gemm_phase(PG8_LAS unsigned char* lds, const Gemm g, const Sched& S, const Epi& E, const int WAVE_S) {
    const int wid = WAVE_S, lane = lane_id_(), tid = wid * 64 + lane, wr = wid >> 2, wc = wid & 3, fr = lane & 15, fq = lane >> 4;
    const int K = g.K, nt = K / BK;
    unsigned voffA[2], voffB[2];
#pragma unroll
    for (int i = 0; i < 2; ++i) { int R, C; stage_rc(tid * 16 + i * 8192, R, C); const int Rb = Epi::PERM ? ((R & ~31) + perm32(R & 31)) : R;
        voffA[i] = (unsigned)(R * K + C) * 2u; voffB[i] = (unsigned)(Rb * K + C) * 2u; }
    const size_t kstep = (size_t)(BK * 2);
    const size_t hstep = (size_t)HALF * K * 2;
    const size_t tstep = 2 * hstep;
    const unsigned ldsw = (unsigned)wid * 1024u;
    const int aoff = lds_byte(wr * 64 + fr, fq * 8), boff = lds_byte(wc * 32 + fr, fq * 8);
#define PG8_SA(b, h) (((b) * 2 + (h)) * HTB)
#define PG8_SB(b, h) ((4 + (b) * 2 + (h)) * HTB)
#define PG8_STAGE(bufoff, gbase, voff) do { _Pragma("unroll") for (int _i = 0; _i < 2; ++_i) \
        __builtin_amdgcn_global_load_lds((const unsigned*)((const char*)(gbase) + (voff)[_i]), (PG8_LAS unsigned*)(lds + (bufoff) + ldsw + _i * 8192), 16, 0, 0); } while (0)
#define PG8_LDA(dst, b, h) do { _Pragma("unroll") for (int m = 0; m < 4; ++m) _Pragma("unroll") for (int k = 0; k < 2; ++k) dst[m][k] = *(const PG8_LAS bf16x8*)(lds + PG8_SA(b, h) + aoff + m * 2048 + k * 1024); } while (0)
#define PG8_LDB(dst, b, h) do { _Pragma("unroll") for (int n = 0; n < 2; ++n) _Pragma("unroll") for (int k = 0; k < 2; ++k) dst[n][k] = *(const PG8_LAS bf16x8*)(lds + PG8_SB(b, h) + boff + n * 2048 + k * 1024); } while (0)
#define PG8_MMA(ai, bj, At, Bt) do { __builtin_amdgcn_s_setprio(1); _Pragma("unroll") for (int m = 0; m < 4; ++m) _Pragma("unroll") for (int n = 0; n < 2; ++n) _Pragma("unroll") for (int k = 0; k < 2; ++k) \
        acc[ai][bj][m][n] = __builtin_amdgcn_mfma_f32_16x16x32_bf16(Bt[n][k], At[m][k], acc[ai][bj][m][n], 0, 0, 0); __builtin_amdgcn_s_setprio(0); } while (0)
#define PG8_WAIT_V(n) asm volatile("s_waitcnt vmcnt(" #n ")" ::: "memory")
#define PG8_WAIT_L(n) asm volatile("s_waitcnt lgkmcnt(" #n ")" ::: "memory")
#define PG8_BAR __builtin_amdgcn_s_barrier()
#define PG8_SCHED __builtin_amdgcn_sched_barrier(0)
    Unit cur, nxt; int ui = 0;
    if (!S.next(0, cur)) return;
    f32x4 acc[2][2][4][2];
#pragma unroll
    for (int a = 0; a < 2; ++a)
#pragma unroll
        for (int b = 0; b < 2; ++b)
#pragma unroll
            for (int m = 0; m < 4; ++m)
#pragma unroll
                for (int n = 0; n < 2; ++n) acc[a][b][m][n] = (f32x4){0.f, 0.f, 0.f, 0.f};
    bf16x8 At[4][2], B0[2][2], B1[2][2];
    const char* cA = (const char*)(cur.sel ? g.A2 : g.A) + (size_t)cur.pm * tstep + (cur.half == 2 ? hstep : (size_t)0); const char* cB = (const char*)(cur.sel ? g.Bt2 : g.Bt) + (size_t)cur.pn * tstep;
    S.a_ready(cur);
    if constexpr (SP2) {
        PG8_STAGE(PG8_SB(0, 0), cB, voffB); PG8_STAGE(PG8_SB(0, 1), cB + hstep, voffB); PG8_STAGE(PG8_SA(0, 0), cA, voffA); PG8_STAGE(PG8_SA(0, 1), cA + hstep, voffA);
        if (wr == 1) PG8_BAR;
        PG8_WAIT_V(2); PG8_BAR;
        PG8_STAGE(PG8_SB(1, 0), cB + kstep, voffB); PG8_STAGE(PG8_SA(1, 0), cA + kstep, voffA); PG8_STAGE(PG8_SB(1, 1), cB + hstep + kstep, voffB);
        PG8_WAIT_V(6); PG8_BAR;
    } else {
        PG8_STAGE(PG8_SB(0, 0), cB, voffB); PG8_STAGE(PG8_SA(0, 0), cA, voffA); PG8_STAGE(PG8_SB(0, 1), cB + hstep, voffB); PG8_STAGE(PG8_SA(0, 1), cA + hstep, voffA);
        if (wr == 1) PG8_BAR;
        PG8_WAIT_V(4); PG8_BAR;
        PG8_STAGE(PG8_SB(1, 0), cB + kstep, voffB); PG8_STAGE(PG8_SA(1, 0), cA + kstep, voffA); PG8_STAGE(PG8_SB(1, 1), cB + hstep + kstep, voffB);
        PG8_WAIT_V(6); PG8_BAR;
    }
    for (;;) {
        const bool has_next = S.next(ui + 1, nxt);
        const char* nA = has_next ? (const char*)(nxt.sel ? g.A2 : g.A) + (size_t)nxt.pm * tstep + (nxt.half == 2 ? hstep : (size_t)0) : cA; const char* nB = has_next ? (const char*)(nxt.sel ? g.Bt2 : g.Bt) + (size_t)nxt.pn * tstep : cB;
        for (int t = 0; t < nt; t += 2) {
            const bool last = (t == nt - 2);
            const char* a1 = cA + (size_t)(t + 1) * kstep;
            const char* a2 = last ? nA : cA + (size_t)(t + 2) * kstep; const char* b2 = last ? nB : cB + (size_t)(t + 2) * kstep;
            const char* a3 = a2 + kstep; const char* b3 = b2 + kstep;
            if (last && has_next) S.a_ready(nxt);
            if constexpr (SP2) {
            PG8_LDB(B0, 0, 0); PG8_LDB(B1, 0, 1); PG8_SCHED; PG8_LDA(At, 0, 0); PG8_STAGE(PG8_SA(1, 1), a1 + hstep, voffA);
            PG8_WAIT_V(8); PG8_WAIT_L(0); PG8_BAR; PG8_MMA(0, 0, At, B0); PG8_MMA(0, 1, At, B1); PG8_BAR; PG8_SCHED;
            PG8_LDA(At, 0, 1); PG8_STAGE(PG8_SB(0, 0), b2, voffB); PG8_STAGE(PG8_SB(0, 1), b2 + hstep, voffB); PG8_STAGE(PG8_SA(0, 0), a2, voffA);
            PG8_WAIT_V(8); PG8_WAIT_L(0); PG8_BAR; PG8_MMA(1, 0, At, B0); PG8_MMA(1, 1, At, B1); PG8_BAR; PG8_SCHED;
            PG8_LDB(B0, 1, 0); PG8_LDB(B1, 1, 1); PG8_SCHED; PG8_LDA(At, 1, 0); PG8_STAGE(PG8_SA(0, 1), a2 + hstep, voffA);
            PG8_WAIT_V(8); PG8_WAIT_L(0); PG8_BAR; PG8_MMA(0, 0, At, B0); PG8_MMA(0, 1, At, B1); PG8_BAR; PG8_SCHED;
            PG8_LDA(At, 1, 1); PG8_STAGE(PG8_SB(1, 0), b3, voffB); PG8_STAGE(PG8_SB(1, 1), b3 + hstep, voffB); PG8_STAGE(PG8_SA(1, 0), a3, voffA);
            PG8_WAIT_V(8); PG8_WAIT_L(0); PG8_BAR; PG8_MMA(1, 0, At, B0); PG8_MMA(1, 1, At, B1); PG8_BAR; PG8_SCHED;
            } else {
            PG8_LDB(B0, 0, 0); PG8_SCHED; PG8_LDA(At, 0, 0); PG8_STAGE(PG8_SA(1, 1), a1 + hstep, voffA);
            PG8_WAIT_L(8); PG8_BAR; PG8_WAIT_L(0); PG8_MMA(0, 0, At, B0); PG8_BAR; PG8_SCHED;
            PG8_LDB(B1, 0, 1); PG8_STAGE(PG8_SB(0, 0), b2, voffB);
            PG8_BAR; PG8_WAIT_L(0); PG8_MMA(0, 1, At, B1); PG8_BAR;
            PG8_LDA(At, 0, 1); PG8_STAGE(PG8_SA(0, 0), a2, voffA);
            PG8_BAR; PG8_WAIT_L(0); PG8_MMA(1, 0, At, B0); PG8_BAR; PG8_SCHED;
            PG8_STAGE(PG8_SB(0, 1), b2 + hstep, voffB);
            PG8_WAIT_V(6); PG8_BAR; PG8_MMA(1, 1, At, B1); PG8_BAR;
            PG8_LDB(B0, 1, 0); PG8_SCHED; PG8_LDA(At, 1, 0); PG8_STAGE(PG8_SA(0, 1), a2 + hstep, voffA);
            PG8_WAIT_L(8); PG8_BAR; PG8_WAIT_L(0); PG8_MMA(0, 0, At, B0); PG8_BAR; PG8_SCHED;
            PG8_LDB(B1, 1, 1); PG8_STAGE(PG8_SB(1, 0), b3, voffB);
            PG8_BAR; PG8_WAIT_L(0); PG8_MMA(0, 1, At, B1); PG8_BAR;
            PG8_LDA(At, 1, 1); PG8_STAGE(PG8_SA(1, 0), a3, voffA);
            PG8_BAR; PG8_WAIT_L(0); PG8_MMA(1, 0, At, B0); PG8_BAR; PG8_SCHED;
            PG8_STAGE(PG8_SB(1, 1), b3 + hstep, voffB);
            PG8_WAIT_V(6); PG8_BAR; PG8_MMA(1, 1, At, B1); PG8_BAR;
            }
        }
        if constexpr (ALIGN_EPI) { if (wr == 0) PG8_BAR; }
        if constexpr (!Epi::AFTER_DRAIN) { E(acc, cur, wr, wc, fr, fq); S.done(cur); }
        if (!has_next) break;
        if (Epi::zero_after(cur))
#pragma unroll
        for (int a = 0; a < 2; ++a)
#pragma unroll
            for (int b = 0; b < 2; ++b)
#pragma unroll
                for (int m = 0; m < 4; ++m)
#pragma unroll
                    for (int n = 0; n < 2; ++n) acc[a][b][m][n] = (f32x4){0.f, 0.f, 0.f, 0.f};
        cur = nxt; cA = nA; cB = nB; ++ui;
        if constexpr (ALIGN_EPI) { if (wr == 1) PG8_BAR; }
    }
    PG8_WAIT_V(0);
    if constexpr (!ALIGN_EPI) { if (wr == 0) PG8_BAR; }
    PG8_BAR;
    if constexpr (Epi::AFTER_DRAIN) { E.fused(acc, cur, wr, wc, fr, fq, lds, wid, lane); S.done(cur); }
#undef PG8_SA
#undef PG8_SB
#undef PG8_STAGE
#undef PG8_LDA
#undef PG8_LDB
#undef PG8_MMA
#undef PG8_WAIT_V
#undef PG8_WAIT_L
#undef PG8_BAR
#undef PG8_SCHED
}
}

namespace pg8 {
template <class RowEpi> struct EpiRows {
    static constexpr bool PERM = true, AFTER_DRAIN = false;
    RowEpi R;
    static __device__ __forceinline__ bool zero_after(const Unit&) { return true; }
    __device__ __forceinline__ void operator()(const f32x4 (&acc)[2][2][4][2], const Unit& u, int wr, int wc, int fr, int fq) const {
        const int b = u.pm >> 3, row0 = u.pm * BM + wr * 64 + fr + (u.half == 2 ? HALF : 0);
        const typename RowEpi::Tile T = R.tile_pre(b, u.pn, wc, fq);
        constexpr int NB = RowEpi::BATCH;
#pragma unroll
        for (int g0 = 0; g0 < 8; g0 += NB) {
            if (u.half && g0 >= 4) break;
            typename RowEpi::Pre P[NB];
#pragma unroll
            for (int j = 0; j < NB; ++j) P[j] = R.row_pre(row0 + ((g0 + j) >> 2) * HALF + ((g0 + j) & 3) * 16, b, u.pn, wc, fq);
            __builtin_amdgcn_sched_barrier(0);
#pragma unroll
            for (int j = 0; j < NB; ++j) { const int ai = (g0 + j) >> 2, m = (g0 + j) & 3;
                const f32x4 v[4] = {acc[ai][0][m][0], acc[ai][0][m][1], acc[ai][1][m][0], acc[ai][1][m][1]};
                R(v, P[j], T, row0 + ai * HALF + m * 16, b, u.pn, wc, fq); }
        }
    }
};
struct EpiOutFused {
    static constexpr bool PERM = true, AFTER_DRAIN = true;
    OutEpi R;
    static __device__ __forceinline__ bool zero_after(const Unit&) { return true; }
    __device__ __forceinline__ void operator()(const f32x4 (&)[2][2][4][2], const Unit&, int, int, int, int) const {}
    __device__ __forceinline__ void fused(f32x4 (&acc)[2][2][4][2], const Unit& u, int wr, int wc, int fr, int fq, PG8_LAS unsigned char* lds, int wid, int lane) const {
        PG8_LAS float* sred = (PG8_LAS float*)lds;
        const int b = u.pm >> 3;
        const OutEpi::Tile T = R.tile_pre(b, u.pn, wc, fq);
        constexpr int NB = OutEpi::BATCH;
#pragma unroll
        for (int g0 = 0; g0 < 8; g0 += NB) {
            OutEpi::Pre P[NB];
#pragma unroll
            for (int j = 0; j < NB; ++j) P[j] = R.row_pre(u.pm * BM + ((g0 + j) >> 2) * HALF + wr * 64 + ((g0 + j) & 3) * 16 + fr, b, u.pn, wc, fq);
            __builtin_amdgcn_sched_barrier(0);
#pragma unroll
            for (int j = 0; j < NB; ++j) { const int ai = (g0 + j) >> 2, m = (g0 + j) & 3;
                const f32x4 v[4] = {acc[ai][0][m][0], acc[ai][0][m][1], acc[ai][1][m][0], acc[ai][1][m][1]};
                const int rl = ai * HALF + wr * 64 + m * 16 + fr;
                const float ss = R(v, P[j], T, u.pm * BM + rl, b, u.pn, wc, fq);
                if (fq == 0) sred[rl * 4 + wc] = ss; }
        }
        asm volatile("s_waitcnt lgkmcnt(0)" ::: "memory"); __builtin_amdgcn_s_barrier(); asm volatile("" ::: "memory");
        const int t = wid * 64 + lane;
        if (t < 256) { const f32x4 p = *(const PG8_LAS f32x4*)(sred + t * 4); R.rowss[(size_t)(u.pm * BM + t) * 4 + u.pn] = (p[0] + p[1]) + (p[2] + p[3]); }
    }
};
struct DoubleKOrder : StaticOrder {
    __host__ __device__ bool next(int i, Unit& u) const { const bool ok = StaticOrder::next(i >> 1, u); u.half = i & 1; return ok; }
};
template <class RowEpi> struct EpiRowsDK {
    static constexpr bool PERM = true, AFTER_DRAIN = false;
    RowEpi R;
    static __device__ __forceinline__ bool zero_after(const Unit& u) { return u.half == 1; }
    __device__ __forceinline__ void operator()(f32x4 (&acc)[2][2][4][2], const Unit& u, int wr, int wc, int fr, int fq) const {
        if (u.half == 0) return;
#pragma unroll
        for (int a = 0; a < 2; ++a)
#pragma unroll
            for (int b = 0; b < 2; ++b)
#pragma unroll
                for (int m = 0; m < 4; ++m)
#pragma unroll
                    for (int n = 0; n < 2; ++n) acc[a][b][m][n] = acc[a][b][m][n] * 0.5f;
        Unit v = u; v.half = 0; EpiRows<RowEpi> E{R}; E(acc, v, wr, wc, fr, fq);
    }
};
struct PairOrder : StaticOrder {
    __host__ __device__ bool next(int i, Unit& u) const { const bool ok = StaticOrder::next(i >> 1, u); u.sel = i & 1; return ok; }
};
struct BranchTileEpi {
    static constexpr bool PERM = true, AFTER_DRAIN = false;
    const bf16_t *GA, *GB; bf16_t* Y;
    static __device__ __forceinline__ bool zero_after(const Unit& u) { return u.sel == 1; }
    __device__ __forceinline__ void operator()(f32x4 (&acc)[2][2][4][2], const Unit& u, int wr, int wc, int fr, int fq) const {
        const size_t off0 = (size_t)(u.pm * BM + wr * 64 + fr) * 1024 + u.pn * BM + wc * 32 + 8 * fq;
#pragma unroll
        for (int g0 = 0; g0 < 8; g0 += 4) {
            u32x4 gb[4][2], ga[4][2];
#pragma unroll
            for (int j = 0; j < 4; ++j)
#pragma unroll
                for (int bj = 0; bj < 2; ++bj) { const size_t off = off0 + (size_t)(((g0 + j) >> 2) * HALF + ((g0 + j) & 3) * 16) * 1024 + bj * HALF;
                    gb[j][bj] = *(const u32x4*)(GB + off); if (u.sel == 0) ga[j][bj] = *(const u32x4*)(GA + off); }
            __builtin_amdgcn_sched_barrier(0);
#pragma unroll
            for (int j = 0; j < 4; ++j) { const int ai = (g0 + j) >> 2, m = (g0 + j) & 3;
#pragma unroll
                for (int bj = 0; bj < 2; ++bj) {
                    f32x4 sb[2];
#pragma unroll
                    for (int n = 0; n < 2; ++n) { sb[n][0] = fmaxf(bflo(gb[j][bj][2 * n]), 1e-30f); sb[n][1] = fmaxf(bfhi(gb[j][bj][2 * n]), 1e-30f); sb[n][2] = fmaxf(bflo(gb[j][bj][2 * n + 1]), 1e-30f); sb[n][3] = fmaxf(bfhi(gb[j][bj][2 * n + 1]), 1e-30f); }
                    if (u.sel == 0) {
#pragma unroll
                        for (int n = 0; n < 2; ++n) { f32x4 r; r[0] = bflo(ga[j][bj][2 * n]) * __builtin_amdgcn_rcpf(sb[n][0]); r[1] = bfhi(ga[j][bj][2 * n]) * __builtin_amdgcn_rcpf(sb[n][1]);
                            r[2] = bflo(ga[j][bj][2 * n + 1]) * __builtin_amdgcn_rcpf(sb[n][2]); r[3] = bfhi(ga[j][bj][2 * n + 1]) * __builtin_amdgcn_rcpf(sb[n][3]);
                            acc[ai][bj][m][n] = acc[ai][bj][m][n] * r; }
                    } else {
                        *(u32x4*)(Y + off0 + (size_t)(ai * HALF + m * 16) * 1024 + bj * HALF) = pack8(acc[ai][bj][m][0] * sb[0], acc[ai][bj][m][1] * sb[1]);
                    }
                }
            }
        }
    }
};
}

namespace attn_body {
using bf16=__hip_bfloat16;
using bf16x8=__attribute__((ext_vector_type(8)))short;
using s16x4=__attribute__((ext_vector_type(4)))short;
using f32x16=__attribute__((ext_vector_type(16)))float;
using u32x4=__attribute__((ext_vector_type(4)))unsigned;
constexpr int SEQ=2048,D=64;
constexpr int NW=8,QBLK=32,QB=QBLK*NW,KVBLK=64,NQB=SEQ/QB;
constexpr int ATTN_UNIT_ROWS=QB;
__device__ __forceinline__ int crow(int r,int hi){return (r&3)+8*(r>>2)+4*hi;}
#define SBAR() __builtin_amdgcn_sched_barrier(0)
template<bool LIN> __device__ __forceinline__ void cmask(f32x16&p0,f32x16&p1,int jb,int qrel,int hi){
  const float NEG=LIN?0.f:-INFINITY; int kb=64*jb+4*hi;
  #pragma unroll
  for(int r=0;r<16;++r){int kv=kb+(r&3)+8*(r>>2); if(kv>qrel)p0[r]=NEG; if(kv+32>qrel)p1[r]=NEG;}
}

constexpr int NSLOT=3, SLOTB=8192;
constexpr int LDS_RT=98304, LDS_RTS=106496, RS_NSLOT=6, RS_SLOTB=16384;
constexpr int LDS_K=0, LDS_V=NSLOT*SLOTB, LDS_WS=2*NSLOT*SLOTB, LDS_OST=LDS_WS+NW*64*4, LDS_BYTES=LDS_OST+NW*4096;
constexpr float C2=0.125f*1.4426950408889634f;
__device__ __forceinline__ void glds16s(const void*sbase,unsigned voff,unsigned lds_dst){unsigned keep;
  asm volatile("s_mov_b32 %0, m0\n\ts_mov_b32 m0, %3\n\ts_nop 4\n\tglobal_load_lds_dwordx4 %1, %2\n\ts_mov_b32 m0, %0":"=&s"(keep):"v"(voff),"s"(sbase),"s"(lds_dst):"memory");}
__device__ __forceinline__ const char* uptr(const char*p){const unsigned long long a=(unsigned long long)p;const unsigned lo=__builtin_amdgcn_readfirstlane((unsigned)a),hi=__builtin_amdgcn_readfirstlane((unsigned)(a>>32));return (const char*)(((unsigned long long)hi<<32)|lo);}
__device__ __forceinline__ void glds16(const void*gsrc,unsigned lds_dst){unsigned keep;
  asm volatile("s_mov_b32 %0, m0\n\ts_mov_b32 m0, %2\n\ts_nop 0\n\tglobal_load_lds_dwordx4 %1, off\n\ts_mov_b32 m0, %0":"=&s"(keep):"v"(gsrc),"s"(lds_dst):"memory");}
__device__ __forceinline__ float max3f(float a,float b,float c){float r;asm("v_max3_f32 %0, %1, %2, %3":"=v"(r):"v"(a),"v"(b),"v"(c));return r;}
__device__ __forceinline__ float max2f(float a,float b){float r;asm("v_max_f32_e32 %0, %1, %2":"=v"(r):"v"(a),"v"(b));return r;}
__device__ __forceinline__ float fadd_s(float a,float b){float r;asm("v_add_f32_e32 %0, %1, %2":"=v"(r):"v"(a),"v"(b));return r;}
__device__ __forceinline__ float fsub_s(float a,float b){float r;asm("v_sub_f32_e32 %0, %1, %2":"=v"(r):"v"(a),"v"(b));return r;}
typedef float f32x2_t __attribute__((ext_vector_type(2))); typedef __bf16 bf16x2_t __attribute__((ext_vector_type(2)));
__device__ __forceinline__ unsigned cvtpk_s(float lo,float hi){f32x2_t v={lo,hi};bf16x2_t b=__builtin_convertvector(v,bf16x2_t);return __builtin_bit_cast(unsigned,b);}
#define WAIT_BAR(N) asm volatile("s_waitcnt vmcnt(" #N ") lgkmcnt(0)\n\ts_barrier":::"memory")

__device__ __forceinline__ void qkt(f32x16&p0,f32x16&p1,const char*Kslot,const bf16x8*qr,const f32x16&negm,int r32,int hi){
  const char*kb=Kslot+hi*1024+r32*16;
  #pragma unroll
  for(int d0=0;d0<4;++d0){
    const bf16x8 b0=*reinterpret_cast<const bf16x8*>(kb+d0*2048);
    const bf16x8 b1=*reinterpret_cast<const bf16x8*>(kb+d0*2048+512);
    if(d0==0){p0=__builtin_amdgcn_mfma_f32_32x32x16_bf16(b0,qr[0],negm,0,0,0);p1=__builtin_amdgcn_mfma_f32_32x32x16_bf16(b1,qr[0],negm,0,0,0);}
    else{p0=__builtin_amdgcn_mfma_f32_32x32x16_bf16(b0,qr[d0],p0,0,0,0);p1=__builtin_amdgcn_mfma_f32_32x32x16_bf16(b1,qr[d0],p1,0,0,0);}}
}
typedef __attribute__((address_space(3))) const char* lds_cptr;
typedef short v4i16_t __attribute__((ext_vector_type(4)));
__device__ __forceinline__ void kload8(bf16x8*kf,lds_cptr kp){
  kf[0]=*(const __attribute__((address_space(3))) bf16x8*)(kp);      kf[1]=*(const __attribute__((address_space(3))) bf16x8*)(kp+512);
  kf[2]=*(const __attribute__((address_space(3))) bf16x8*)(kp+2048); kf[3]=*(const __attribute__((address_space(3))) bf16x8*)(kp+2560);
  kf[4]=*(const __attribute__((address_space(3))) bf16x8*)(kp+4096); kf[5]=*(const __attribute__((address_space(3))) bf16x8*)(kp+4608);
  kf[6]=*(const __attribute__((address_space(3))) bf16x8*)(kp+6144); kf[7]=*(const __attribute__((address_space(3))) bf16x8*)(kp+6656);
}
__device__ __forceinline__ void kload2(bf16x8*kf,lds_cptr kp,int j){ kf[2*j]=*(const __attribute__((address_space(3))) bf16x8*)(kp+j*2048); kf[2*j+1]=*(const __attribute__((address_space(3))) bf16x8*)(kp+j*2048+512); }
__device__ __forceinline__ s16x4 vtr(lds_cptr p){ return __builtin_bit_cast(s16x4,__builtin_amdgcn_ds_read_tr16_b64_v4i16((__attribute__((address_space(3))) v4i16_t*)p)); }
__device__ __forceinline__ float rowmax(const f32x16&p0,const f32x16&p1){
  float a=max3f(p0[0],p0[1],p1[0]),b=max3f(p0[2],p0[3],p1[1]);a=max3f(a,p1[2],p1[3]);
  #pragma unroll
  for(int r=4;r<16;r+=4){a=max3f(a,p0[r],p0[r+1]);b=max3f(b,p0[r+2],p0[r+3]);a=max3f(a,p1[r],p1[r+1]);b=max3f(b,p1[r+2],p1[r+3]);}
  const float m=max2f(a,b);
  auto rr=__builtin_amdgcn_permlane32_swap(__float_as_uint(m),__float_as_uint(m),false,false);
  return max2f(__uint_as_float(rr[0]),__uint_as_float(rr[1]));
}
__device__ __forceinline__ void pv(f32x16*o,int vb,bf16x8 pa0,bf16x8 pa1,bf16x8 pa2,bf16x8 pa3){
  #pragma unroll
  for(int d0=0;d0<2;++d0){s16x4 lo[4],hi[4];
    #pragma unroll
    for(int ks=0;ks<4;++ks){
      asm volatile("ds_read_b64_tr_b16 %0,%1 offset:%c2":"=&v"(lo[ks]):"v"(vb),"i"(d0*4096+ks*1024):"memory");
      asm volatile("ds_read_b64_tr_b16 %0,%1 offset:%c2":"=&v"(hi[ks]):"v"(vb),"i"(d0*4096+ks*1024+512):"memory");}
    asm volatile("s_waitcnt lgkmcnt(0)":::"memory");SBAR();
    #define PK(k) (bf16x8){lo[k][0],lo[k][1],lo[k][2],lo[k][3],hi[k][0],hi[k][1],hi[k][2],hi[k][3]}
    o[d0]=__builtin_amdgcn_mfma_f32_32x32x16_bf16(pa0,PK(0),o[d0],0,0,0);
    o[d0]=__builtin_amdgcn_mfma_f32_32x32x16_bf16(pa1,PK(1),o[d0],0,0,0);
    o[d0]=__builtin_amdgcn_mfma_f32_32x32x16_bf16(pa2,PK(2),o[d0],0,0,0);
    o[d0]=__builtin_amdgcn_mfma_f32_32x32x16_bf16(pa3,PK(3),o[d0],0,0,0);
    #undef PK
  }
}

#ifndef ATTN_STORE16
#define ATTN_STORE16(p,v) (*(u32x4*)(p)=(v))
#endif
template<int THRL,bool LIN> __device__ __forceinline__ void attn_unit(long rowbase,int qb,const bf16*Q,int QP,const bf16*__restrict__ K,int KP,const bf16*__restrict__ V,int VP,bf16*O,int OP,char*shm,const bool xr,const int WAVE_S){
  int lane=lane_id_(); asm volatile("":"+v"(lane)); const int r32=lane&31,hi=lane>>5; const int wid=WAVE_S;
  const int q0=qb*QB;
  const bf16*Qw=Q+(rowbase+q0+wid*QBLK)*QP;
  const bf16*Kh=K+rowbase*KP,*Vh=V+rowbase*VP;
  const unsigned lds0=(unsigned)(uintptr_t)shm;
  float*wsf=(float*)(shm+LDS_WS)+wid*64;
  const unsigned koff=(unsigned)((lane*KP+wid*8)*2);
  const unsigned voff=(unsigned)(((16*(wid&3)+(lane>>2))*VP+(wid>>2)*32+(lane&3)*8)*2);
  const unsigned kdst=lds0+LDS_K+wid*1024, vdst=lds0+LDS_V+wid*1024;
  #define DMA_K(t,slot) glds16s(uptr((const char*)(Kh+(long)(t)*KVBLK*KP)),koff,(unsigned)__builtin_amdgcn_readfirstlane(kdst+(slot)))
  #define DMA_V(t,slot) glds16s(uptr((const char*)(Vh+(long)(t)*KVBLK*VP)),voff,(unsigned)__builtin_amdgcn_readfirstlane(vdst+(slot)))
  const int vb0=(int)(lds0+LDS_V)+((lane>>4)&1)*32+(lane&3)*8+(4*hi+((lane&15)>>2))*64;
  const char*Kbase=shm+LDS_K; bf16x8 kf[8];
  const lds_cptr shm3=(lds_cptr)shm; const lds_cptr kp0=shm3+LDS_K+hi*1024+r32*16; const lds_cptr vp0=shm3+LDS_V+((lane>>4)&1)*32+(lane&3)*8+(4*hi+((lane&15)>>2))*64;
  const int NT=(q0+QB)/KVBLK;
  DMA_K(0,0);DMA_V(0,0);DMA_K(1,SLOTB);
  bf16x8 qr[4];
  #pragma unroll
  for(int d0=0;d0<4;++d0)qr[d0]=*reinterpret_cast<const bf16x8*>(&Qw[(long)r32*QP+d0*16+hi*8]);
  float mhat=0.f,l_reg=0.f;f32x16 o[2];o[0]=f32x16{};o[1]=f32x16{};f32x16 negm;
  if constexpr(LIN){ if(xr){ const lds_cptr rt=(lds_cptr)shm+LDS_RT;
    _Pragma("unroll") for(int e2=0;e2<2;++e2) _Pragma("unroll") for(int d0=0;d0<4;++d0){ const bf16x8 rf=*(const __attribute__((address_space(3))) bf16x8*)(rt+((32*e2+r32)*64+16*d0+8*hi)*2);
      o[e2]=__builtin_amdgcn_mfma_f32_32x32x16_bf16(qr[d0],rf,o[e2],0,0,0);} } }
  #define NEGM (LIN?f32x16{}:negm)
  const int qrel=wid*QBLK+r32;
  #define CMASK(P0,P1,t) do{int jb_=(t)-(NT-4); if(jb_>=0)cmask<LIN>(P0,P1,jb_,qrel,hi);}while(0)
  bool resc=false;
  #define START(P0,P1) do{ if constexpr(!LIN){ const float rm=rowmax(P0,P1); resc=false; \
    { const float dl=rm; mhat=fadd_s(mhat,dl); \
      _Pragma("unroll") for(int r=0;r<16;++r){P0[r]=fsub_s(P0[r],dl);P1[r]=fsub_s(P1[r],dl);} \
      _Pragma("unroll") for(int r=0;r<16;++r)negm[r]=-mhat; asm volatile("":"+v"(negm)); } \
    _Pragma("unroll") for(int r=0;r<16;++r)P0[r]=__builtin_amdgcn_exp2f(P0[r]); } }while(0)
  #define RESC() do{ if(resc){ asm volatile("s_waitcnt lgkmcnt(0)":::"memory"); \
      _Pragma("unroll") for(int d_=0;d_<2;++d_) _Pragma("unroll") for(int r=0;r<16;++r)o[d_][r]*=wsf[crow(r,hi)]; } }while(0)
  f32x16 pA0,pA1,pB0,pB1;
  int sl_prev=0,sl_cur=0,sl_next=SLOTB;
  #define ROT() do{sl_prev=sl_cur;sl_cur=sl_next;sl_next=(sl_next==(NSLOT-1)*SLOTB)?0:sl_next+SLOTB;}while(0)
  DMA_K(2,2*SLOTB);
  WAIT_BAR(3);
  qkt(pA0,pA1,Kbase,qr,f32x16{},r32,hi);asm volatile("s_nop 15\n\ts_nop 7":"+v"(pA0),"+v"(pA1));CMASK(pA0,pA1,0);
  START(pA0,pA1);
  if constexpr(!LIN){ _Pragma("unroll") for(int r=0;r<16;++r)pA1[r]=__builtin_amdgcn_exp2f(pA1[r]); }
  WAIT_BAR(0);
  DMA_K(3,0);DMA_V(1,SLOTB);
  ROT();
  kload8(kf,kp0+sl_cur);
  WAIT_BAR(2);
  s16x4 vlo[8],vhi[8]; u32x4 pw0,pw1,pw2,pw3;
  #define PKW(P,B) cvtpk_s(P[B],P[B+1])
  #define PAF(k) __builtin_bit_cast(bf16x8,pw##k)
  #define VFR(i) (bf16x8){vlo[i][0],vlo[i][1],vlo[i][2],vlo[i][3],vhi[i][0],vhi[i][1],vhi[i][2],vhi[i][3]}
  #define PIN(x) asm volatile("":"+v"(x))
  #define MX3(a,b,c) __builtin_fmaxf(__builtin_fmaxf((a),(b)),(c))
  #define GAPA(MF,A0,A1,A2,A3,W0,W1,PW) do{ MF; if constexpr(!LIN){ sacc+=A0; sacc+=A1; sacc+=A2; sacc+=A3; PIN(sacc); } W0; W1; PIN(PW); SBAR(); }while(0)
  #define EX(v) __builtin_amdgcn_exp2f(v)
  #define GAPB(MF,X,B) do{ MF; if constexpr(!LIN){ X[B]=EX(X[B]); X[B+1]=EX(X[B+1]); X[B+2]=EX(X[B+2]); X[B+3]=EX(X[B+3]); PIN(X); } SBAR(); }while(0)
  #define VRD(i) do{ vlo[i]=vtr(vp_+(((i)>>2)*4096+((i)&3)*1024)); vhi[i]=vtr(vp_+(((i)>>2)*4096+((i)&3)*1024+512)); }while(0)
  #define KRD(G,j) do{ if(G){ kload2(kf,kp0+sl_next,j); SBAR(); } }while(0)
  #define STEP(C0,C1,P0,P1,t,GK,GV,GL) do{ SBAR(); \
    const lds_cptr vp_=vp0+sl_prev; \
    VRD(0); SBAR(); float sacc=(P0[0]+P0[1]); \
    GAPA(C0=__builtin_amdgcn_mfma_f32_32x32x16_bf16(kf[0],qr[0],NEGM,0,0,0), P0[2],P0[3],P0[4],P0[5],     pw0[0]=PKW(P0,0), pw0[1]=PKW(P0,2), pw0); \
    VRD(4); SBAR(); GAPA(C1=__builtin_amdgcn_mfma_f32_32x32x16_bf16(kf[1],qr[0],NEGM,0,0,0), P0[6],P0[7],P0[8],P0[9],     pw0[2]=PKW(P0,4), pw0[3]=PKW(P0,6), pw0); \
    VRD(1); SBAR(); GAPA(C0=__builtin_amdgcn_mfma_f32_32x32x16_bf16(kf[2],qr[1],C0,0,0,0),   P0[10],P0[11],P0[12],P0[13], pw1[0]=PKW(P0,8), pw1[1]=PKW(P0,10), pw1); \
    VRD(5); SBAR(); GAPA(C1=__builtin_amdgcn_mfma_f32_32x32x16_bf16(kf[3],qr[1],C1,0,0,0),   P0[14],P0[15],P1[0],P1[1],   pw1[2]=PKW(P0,12),pw1[3]=PKW(P0,14), pw1); \
    VRD(2); SBAR(); GAPA(C0=__builtin_amdgcn_mfma_f32_32x32x16_bf16(kf[4],qr[2],C0,0,0,0),   P1[2],P1[3],P1[4],P1[5],     pw2[0]=PKW(P1,0), pw2[1]=PKW(P1,2), pw2); \
    VRD(6); SBAR(); GAPA(C1=__builtin_amdgcn_mfma_f32_32x32x16_bf16(kf[5],qr[2],C1,0,0,0),   P1[6],P1[7],P1[8],P1[9],     pw2[2]=PKW(P1,4), pw2[3]=PKW(P1,6), pw2); \
    VRD(3); SBAR(); GAPA(C0=__builtin_amdgcn_mfma_f32_32x32x16_bf16(kf[6],qr[3],C0,0,0,0),   P1[10],P1[11],P1[12],P1[13], pw3[0]=PKW(P1,8), pw3[1]=PKW(P1,10), pw3); \
    VRD(7); SBAR(); GAPA(C1=__builtin_amdgcn_mfma_f32_32x32x16_bf16(kf[7],qr[3],C1,0,0,0),   P1[14],P1[15],0.f,0.f,       pw3[2]=PKW(P1,12),pw3[3]=PKW(P1,14), pw3); \
    l_reg+=sacc; \
    if(GK){DMA_K((t)+3,sl_cur);} if(GV){DMA_V((t)+1,sl_next);} \
    CMASK(C0,C1,t); \
    resc=false; if constexpr(!LIN){ float a=MX3(C0[0],C0[1],C1[0]),b=MX3(C0[2],C0[3],C1[1]); a=MX3(a,C1[2],C1[3]); \
      _Pragma("unroll") for(int r=4;r<16;r+=4){a=MX3(a,C0[r],C0[r+1]);b=MX3(b,C0[r+2],C0[r+3]);a=MX3(a,C1[r],C1[r+1]);b=MX3(b,C1[r+2],C1[r+3]);} \
      float rm=__builtin_fmaxf(a,b); { auto rr=__builtin_amdgcn_permlane32_swap(__float_as_uint(rm),__float_as_uint(rm),false,false); rm=__builtin_fmaxf(__uint_as_float(rr[0]),__uint_as_float(rr[1])); } \
      if(__builtin_expect(__any(rm>(float)THRL),0)){ const float dl=__builtin_fmaxf(rm,0.f); mhat+=dl; \
        _Pragma("unroll") for(int r=0;r<16;++r){C0[r]-=dl;C1[r]-=dl;} \
        _Pragma("unroll") for(int r=0;r<16;++r)negm[r]=-mhat; asm volatile("":"+v"(negm)); \
        const float f=__builtin_amdgcn_exp2f(-dl); l_reg*=f; if(hi==0)wsf[r32]=f; resc=true; } } \
    SBAR(); \
    GAPB(o[0]=__builtin_amdgcn_mfma_f32_32x32x16_bf16(PAF(0),VFR(0),o[0],0,0,0), C0,0); \
    GAPB(o[1]=__builtin_amdgcn_mfma_f32_32x32x16_bf16(PAF(0),VFR(4),o[1],0,0,0), C0,4); \
    KRD(GL,0); GAPB(o[0]=__builtin_amdgcn_mfma_f32_32x32x16_bf16(PAF(1),VFR(1),o[0],0,0,0), C0,8); \
    KRD(GL,1); GAPB(o[1]=__builtin_amdgcn_mfma_f32_32x32x16_bf16(PAF(1),VFR(5),o[1],0,0,0), C0,12); \
    KRD(GL,2); GAPB(o[0]=__builtin_amdgcn_mfma_f32_32x32x16_bf16(PAF(2),VFR(2),o[0],0,0,0), C1,0); \
    KRD(GL,3); GAPB(o[1]=__builtin_amdgcn_mfma_f32_32x32x16_bf16(PAF(2),VFR(6),o[1],0,0,0), C1,4); \
    GAPB(o[0]=__builtin_amdgcn_mfma_f32_32x32x16_bf16(PAF(3),VFR(3),o[0],0,0,0), C1,8); \
    GAPB(o[1]=__builtin_amdgcn_mfma_f32_32x32x16_bf16(PAF(3),VFR(7),o[1],0,0,0), C1,12); \
    }while(0)
  int t=1;
  #undef CMASK
  #define CMASK(P0,P1,t) do{}while(0)
  for(;t+5<NT;t+=2){
    STEP(pB0,pB1,pA0,pA1,t,true,true,true);     WAIT_BAR(2); RESC(); ROT();
    STEP(pA0,pA1,pB0,pB1,t+1,true,true,true);   WAIT_BAR(2); RESC(); ROT();
  }
  #undef CMASK
  #define CMASK(P0,P1,t) do{int jb_=(t)-(NT-4); if(jb_>=0)cmask<LIN>(P0,P1,jb_,qrel,hi);}while(0)
  #define ENDW(tt) do{ if((tt)+3<NT){WAIT_BAR(2);} else if((tt)+2<NT){WAIT_BAR(1);} else {WAIT_BAR(0);} }while(0)
  for(;t+1<NT;t+=2){
    STEP(pB0,pB1,pA0,pA1,t,(t+3<NT),(t+1<NT),(t+1<NT));       ENDW(t);   RESC(); ROT();
    STEP(pA0,pA1,pB0,pB1,t+1,(t+4<NT),(t+2<NT),(t+2<NT));     ENDW(t+1); RESC(); ROT();
  }
  STEP(pB0,pB1,pA0,pA1,NT-1,false,false,false); RESC();
  { float sacc=pB0[0]+pB0[1]; _Pragma("unroll") for(int r=2;r<16;++r)sacc+=pB0[r]; _Pragma("unroll") for(int r=0;r<16;++r)sacc+=pB1[r]; l_reg+=sacc;
    pw0=(u32x4){PKW(pB0,0),PKW(pB0,2),PKW(pB0,4),PKW(pB0,6)};pw1=(u32x4){PKW(pB0,8),PKW(pB0,10),PKW(pB0,12),PKW(pB0,14)};pw2=(u32x4){PKW(pB1,0),PKW(pB1,2),PKW(pB1,4),PKW(pB1,6)};pw3=(u32x4){PKW(pB1,8),PKW(pB1,10),PKW(pB1,12),PKW(pB1,14)};
    SBAR(); pv(o,vb0+sl_cur,PAF(0),PAF(1),PAF(2),PAF(3)); }
  #undef PKW
  #undef PAF
  #undef VFR
  #undef PIN
  #undef MX3
  #undef GAPA
  #undef GAPB
  #undef EX
  #undef VRD
  #undef KRD
  #undef STEP
  #undef ENDW
  {auto rr=__builtin_amdgcn_permlane32_swap(__float_as_uint(l_reg),__float_as_uint(l_reg),false,false);l_reg=__uint_as_float(rr[0])+__uint_as_float(rr[1]);}
  if(hi==0)wsf[32+r32]=l_reg;asm volatile("s_waitcnt lgkmcnt(0)":::"memory");
  float rli[16];
  #pragma unroll
  for(int r=0;r<16;++r)rli[r]=LIN?1.f:__builtin_amdgcn_rcpf(wsf[32+crow(r,hi)]);
  bf16*Ow=O+(rowbase+q0+wid*QBLK)*OP;
  { bf16*stg=(bf16*)(shm+LDS_OST)+wid*2048;
    #pragma unroll
    for(int r=0;r<16;++r){const int orow=crow(r,hi);
      #pragma unroll
      for(int d0=0;d0<2;++d0)stg[orow*64+d0*32+r32]=__float2bfloat16(o[d0][r]*rli[r]);}
    asm volatile("s_waitcnt lgkmcnt(0)":::"memory");
    int lane_e=lane; asm volatile("":"+v"(lane_e));
    #pragma unroll
    for(int i=0;i<4;++i){const int row=i*8+(lane_e>>3),ch=lane_e&7; const u32x4 v=*(const u32x4*)(stg+row*64+ch*8); ATTN_STORE16(Ow+(long)row*OP+ch*8,v);} }
  asm volatile("s_waitcnt lgkmcnt(0)\n\ts_barrier":::"memory");
  #undef DMA_K
  #undef DMA_V
  #undef CMASK
  #undef START
  #undef RESC
  #undef ROT
}
constexpr int ATTN_LDS_BYTES=LDS_BYTES;
__device__ __forceinline__ void ret_state(long rowbase,int nt,const bf16*__restrict__ K,int KP,const bf16*__restrict__ V,int VP,char*shm,const int WAVE_S){
  int lane=lane_id_(); asm volatile("":"+v"(lane)); const int r32=lane&31,hi=lane>>5; const int wid=WAVE_S;
  const bf16*Kh=K+rowbase*KP,*Vh=V+rowbase*VP;
  const unsigned lds0=(unsigned)(uintptr_t)shm;
  const unsigned koff=(unsigned)(((16*(wid&3)+(lane>>2))*KP+(wid>>2)*32+(lane&3)*8)*2);
  const unsigned voff=(unsigned)(((16*(wid&3)+(lane>>2))*VP+(wid>>2)*32+(lane&3)*8)*2);
  const unsigned kdst=lds0+wid*1024, vdst=lds0+8192+wid*1024;
  #define RS_DMA(t,slot) do{ glds16s(uptr((const char*)(Kh+(long)(t)*KVBLK*KP)),koff,(unsigned)__builtin_amdgcn_readfirstlane(kdst+(slot))); \
                             glds16s(uptr((const char*)(Vh+(long)(t)*KVBLK*VP)),voff,(unsigned)__builtin_amdgcn_readfirstlane(vdst+(slot))); }while(0)
  const lds_cptr shm3=(lds_cptr)shm;
  const int frag=((lane>>4)&1)*32+(lane&3)*8+(4*hi+((lane&15)>>2))*64;
  const int eb=wid&1, db=(wid>>1)&1, kh=wid>>2;
  f32x16 acc=f32x16{};
  { int s=0; for(int t=0;t<5&&t<nt;++t){ RS_DMA(t,s); s+=RS_SLOTB; } }
  int sl=0, sl_free=5*RS_SLOTB;
  for(int t=0;t<nt;++t){
    const int after=(nt-1-t)<4?(nt-1-t):4;
    if(after==4)WAIT_BAR(8); else if(after==3)WAIT_BAR(6); else if(after==2)WAIT_BAR(4); else if(after==1)WAIT_BAR(2); else WAIT_BAR(0);
    if(t+5<nt)RS_DMA(t+5,sl_free);
    const lds_cptr kp=shm3+sl+frag, vp=shm3+sl+8192+frag;
    #pragma unroll
    for(int k2=0;k2<2;++k2){ const int ks=2*kh+k2;
      const s16x4 alo=vtr(vp+eb*4096+ks*1024), ahi=vtr(vp+eb*4096+ks*1024+512), blo=vtr(kp+db*4096+ks*1024), bhi=vtr(kp+db*4096+ks*1024+512);
      const bf16x8 af=(bf16x8){alo[0],alo[1],alo[2],alo[3],ahi[0],ahi[1],ahi[2],ahi[3]}, bf=(bf16x8){blo[0],blo[1],blo[2],blo[3],bhi[0],bhi[1],bhi[2],bhi[3]};
      acc=__builtin_amdgcn_mfma_f32_32x32x16_bf16(af,bf,acc,0,0,0); }
    sl_free=sl; sl=(sl==(RS_NSLOT-1)*RS_SLOTB)?0:sl+RS_SLOTB;
  }
  #undef RS_DMA
  __attribute__((address_space(3))) float*part=(__attribute__((address_space(3))) float*)((__attribute__((address_space(3))) char*)shm+LDS_RTS)+(wid&3)*1024;
  if(kh==1){ _Pragma("unroll") for(int r=0;r<16;++r)part[r*64+lane]=acc[r]; }
  asm volatile("s_waitcnt lgkmcnt(0)\n\ts_barrier":::"memory");
  if(kh==0){ __attribute__((address_space(3))) unsigned short*rt=(__attribute__((address_space(3))) unsigned short*)((__attribute__((address_space(3))) char*)shm+LDS_RT);
    _Pragma("unroll") for(int r=0;r<16;++r){ const float v=acc[r]+part[r*64+lane]; rt[(32*eb+crow(r,hi))*64+32*db+r32]=(unsigned short)(cvtpk_s(v,0.f)&0xffffu); } }
  asm volatile("s_waitcnt lgkmcnt(0)\n\ts_barrier":::"memory");
}
constexpr int A2_K=0, A2_V=3*8192, A2_WS=A2_V+3*16384, A2_OST=A2_WS+NW*64*4, A2_BYTES=A2_OST+NW*4096;
template<int THRL> __device__ __forceinline__ void attn_unit2(long rowbase,int qb,const bf16*Q,int QP,const bf16*__restrict__ K,int KP,const bf16*__restrict__ V,int VP,bf16*O,int OP,char*shm,const int WAVE_S){
  int lane=lane_id_(); asm volatile("":"+v"(lane)); const int r32=lane&31,hi=lane>>5; const int wid=WAVE_S;
  const int q0=qb*QB;
  const bf16*Qw=Q+(rowbase+q0+wid*QBLK)*QP;
  const bf16*Kh=K+rowbase*KP,*Vh=V+rowbase*VP;
  const unsigned lds0=(unsigned)(uintptr_t)shm;
  float*wsf=(float*)(shm+A2_WS)+wid*64;
  const unsigned koff=(unsigned)((lane*KP+wid*8)*2);
  const unsigned voff=(unsigned)(((16*(wid&3)+(lane>>2))*VP+(wid>>2)*32+(lane&3)*8)*2);
  const unsigned kdst=lds0+A2_K+wid*1024, vdst=lds0+A2_V+wid*1024;
  #define DMA_K(t,slot) glds16s(uptr((const char*)(Kh+(long)(t)*KVBLK*KP)),koff,(unsigned)__builtin_amdgcn_readfirstlane(kdst+(slot)))
  #define DMA_V(t,slot) do{ glds16s(uptr((const char*)(Vh+(long)(t)*KVBLK*VP)),voff,(unsigned)__builtin_amdgcn_readfirstlane(vdst+2*(slot))); \
                            glds16s(uptr((const char*)(Vh+(long)(t)*KVBLK*VP)+128),voff,(unsigned)__builtin_amdgcn_readfirstlane(vdst+2*(slot)+8192)); }while(0)
  const char*Kbase=shm+A2_K; bf16x8 kf[8];
  const lds_cptr shm3=(lds_cptr)shm; const lds_cptr kp0=shm3+A2_K+hi*1024+r32*16; const lds_cptr vp0=shm3+A2_V+((lane>>4)&1)*32+(lane&3)*8+(4*hi+((lane&15)>>2))*64;
  const int NT=(q0+QB)/KVBLK;
  DMA_K(0,0);DMA_V(0,0);DMA_K(1,SLOTB);
  bf16x8 qr[4];
  #pragma unroll
  for(int d0=0;d0<4;++d0)qr[d0]=*reinterpret_cast<const bf16x8*>(&Qw[(long)r32*QP+d0*16+hi*8]);
  float mhat=0.f,l_reg=0.f;f32x16 o[4];o[0]=f32x16{};o[1]=f32x16{};o[2]=f32x16{};o[3]=f32x16{};
  const int qrel=wid*QBLK+r32;
  #define CMASK(P0,P1,t) do{int jb_=(t)-(NT-4); if(jb_>=0)cmask<false>(P0,P1,jb_,qrel,hi);}while(0)
  bool resc=false;
  #define RESC() do{ if(resc){ asm volatile("s_waitcnt lgkmcnt(0)":::"memory"); \
      _Pragma("unroll") for(int d_=0;d_<4;++d_) _Pragma("unroll") for(int r=0;r<16;++r)o[d_][r]*=wsf[crow(r,hi)]; } }while(0)
  f32x16 pA0,pA1,pB0,pB1;
  int sl_prev=0,sl_cur=0,sl_next=SLOTB;
  #define ROT() do{sl_prev=sl_cur;sl_cur=sl_next;sl_next=(sl_next==(NSLOT-1)*SLOTB)?0:sl_next+SLOTB;}while(0)
  DMA_K(2,2*SLOTB);
  WAIT_BAR(4);
  qkt(pA0,pA1,Kbase,qr,f32x16{},r32,hi);asm volatile("s_nop 15\n\ts_nop 7":"+v"(pA0),"+v"(pA1));CMASK(pA0,pA1,0);
  { const float rm=rowmax(pA0,pA1); mhat=rm;
    _Pragma("unroll") for(int r=0;r<16;++r){pA0[r]=__builtin_amdgcn_exp2f(pA0[r]-mhat);pA1[r]=__builtin_amdgcn_exp2f(pA1[r]-mhat);} }
  WAIT_BAR(0);
  DMA_K(3,0);DMA_V(1,SLOTB);
  ROT();
  kload8(kf,kp0+sl_cur);
  WAIT_BAR(3);
  s16x4 fa_lo,fa_hi,fb_lo,fb_hi,fc_lo,fc_hi,fd_lo,fd_hi; u32x4 pw0,pw1,pw2,pw3;
  #define PKW(P,B) cvtpk_s(P[B],P[B+1])
  #define PAF(k) __builtin_bit_cast(bf16x8,pw##k)
  #define PIN(x) asm volatile("":"+v"(x))
  #define MX3(a,b,c) __builtin_fmaxf(__builtin_fmaxf((a),(b)),(c))
  #define VOFF(i) ((((i)&3)>>1)*8192+((i)&1)*4096+((i)>>2)*1024)
  #define VRDX(X,i) do{ X##_lo=vtr(vp_+VOFF(i)); X##_hi=vtr(vp_+VOFF(i)+512); }while(0)
  #define VFRX(X) (bf16x8){X##_lo[0],X##_lo[1],X##_lo[2],X##_lo[3],X##_hi[0],X##_hi[1],X##_hi[2],X##_hi[3]}
  #define GAPA(MF,A0,A1,A2,A3,W0,W1,PW) do{ MF; sacc+=A0; sacc+=A1; sacc+=A2; sacc+=A3; PIN(sacc); W0; W1; PIN(PW); SBAR(); }while(0)
  #define EX(v) __builtin_amdgcn_exp2f(v)
  #define GAPB(MF,X,B) do{ MF; X[B]=EX(X[B]-mhat); X[B+1]=EX(X[B+1]-mhat); PIN(X); SBAR(); }while(0)
  #define KRD(G,j) do{ if(G){ kload2(kf,kp0+sl_next,j); SBAR(); } }while(0)
  #define PVM(i,X) o[(i)&3]=__builtin_amdgcn_mfma_f32_32x32x16_bf16(PAF_((i)>>2),VFRX(X),o[(i)&3],0,0,0)
  #define PAF_(k) ((k)==0?PAF(0):(k)==1?PAF(1):(k)==2?PAF(2):PAF(3))
  #define STEP(C0,C1,P0,P1,t,GK,GV,GL) do{ SBAR(); \
    const lds_cptr vp_=vp0+2*sl_prev; \
    float sacc=(P0[0]+P0[1]); \
    GAPA(C0=__builtin_amdgcn_mfma_f32_32x32x16_bf16(kf[0],qr[0],f32x16{},0,0,0), P0[2],P0[3],P0[4],P0[5],     pw0[0]=PKW(P0,0), pw0[1]=PKW(P0,2), pw0); \
    GAPA(C1=__builtin_amdgcn_mfma_f32_32x32x16_bf16(kf[1],qr[0],f32x16{},0,0,0), P0[6],P0[7],P0[8],P0[9],     pw0[2]=PKW(P0,4), pw0[3]=PKW(P0,6), pw0); \
    GAPA(C0=__builtin_amdgcn_mfma_f32_32x32x16_bf16(kf[2],qr[1],C0,0,0,0),   P0[10],P0[11],P0[12],P0[13], pw1[0]=PKW(P0,8), pw1[1]=PKW(P0,10), pw1); \
    GAPA(C1=__builtin_amdgcn_mfma_f32_32x32x16_bf16(kf[3],qr[1],C1,0,0,0),   P0[14],P0[15],P1[0],P1[1],   pw1[2]=PKW(P0,12),pw1[3]=PKW(P0,14), pw1); \
    GAPA(C0=__builtin_amdgcn_mfma_f32_32x32x16_bf16(kf[4],qr[2],C0,0,0,0),   P1[2],P1[3],P1[4],P1[5],     pw2[0]=PKW(P1,0), pw2[1]=PKW(P1,2), pw2); \
    VRDX(fa,0); SBAR(); GAPA(C1=__builtin_amdgcn_mfma_f32_32x32x16_bf16(kf[5],qr[2],C1,0,0,0),   P1[6],P1[7],P1[8],P1[9],     pw2[2]=PKW(P1,4), pw2[3]=PKW(P1,6), pw2); \
    VRDX(fb,1); SBAR(); GAPA(C0=__builtin_amdgcn_mfma_f32_32x32x16_bf16(kf[6],qr[3],C0,0,0,0),   P1[10],P1[11],P1[12],P1[13], pw3[0]=PKW(P1,8), pw3[1]=PKW(P1,10), pw3); \
    VRDX(fc,2); SBAR(); GAPA(C1=__builtin_amdgcn_mfma_f32_32x32x16_bf16(kf[7],qr[3],C1,0,0,0),   P1[14],P1[15],0.f,0.f,       pw3[2]=PKW(P1,12),pw3[3]=PKW(P1,14), pw3); \
    l_reg+=sacc; \
    if(GK){DMA_K((t)+3,sl_cur);} if(GV){DMA_V((t)+1,sl_next);} \
    CMASK(C0,C1,t); \
    resc=false; { float a=MX3(C0[0],C0[1],C1[0]),b=MX3(C0[2],C0[3],C1[1]); a=MX3(a,C1[2],C1[3]); \
      _Pragma("unroll") for(int r=4;r<16;r+=4){a=MX3(a,C0[r],C0[r+1]);b=MX3(b,C0[r+2],C0[r+3]);a=MX3(a,C1[r],C1[r+1]);b=MX3(b,C1[r+2],C1[r+3]);} \
      float rm=__builtin_fmaxf(a,b); { auto rr=__builtin_amdgcn_permlane32_swap(__float_as_uint(rm),__float_as_uint(rm),false,false); rm=__builtin_fmaxf(__uint_as_float(rr[0]),__uint_as_float(rr[1])); } \
      rm-=mhat; \
      if(__builtin_expect(__any(rm>(float)THRL),0)){ const float dl=__builtin_fmaxf(rm,0.f); mhat+=dl; \
        const float f=__builtin_amdgcn_exp2f(-dl); l_reg*=f; if(hi==0)wsf[r32]=f; resc=true; } } \
    SBAR(); \
    VRDX(fd,3);  SBAR(); GAPB(PVM(0,fa),  C0,0); \
    VRDX(fa,4);  SBAR(); GAPB(PVM(1,fb),  C0,2); \
    VRDX(fb,5);  SBAR(); GAPB(PVM(2,fc),  C0,4); \
    VRDX(fc,6);  SBAR(); KRD(GL,0); GAPB(PVM(3,fd),  C0,6); \
    VRDX(fd,7);  SBAR(); KRD(GL,1); GAPB(PVM(4,fa),  C0,8); \
    VRDX(fa,8);  SBAR(); KRD(GL,2); GAPB(PVM(5,fb),  C0,10); \
    VRDX(fb,9);  SBAR(); KRD(GL,3); GAPB(PVM(6,fc),  C0,12); \
    VRDX(fc,10); SBAR(); GAPB(PVM(7,fd),  C0,14); \
    VRDX(fd,11); SBAR(); GAPB(PVM(8,fa),  C1,0); \
    VRDX(fa,12); SBAR(); GAPB(PVM(9,fb),  C1,2); \
    VRDX(fb,13); SBAR(); GAPB(PVM(10,fc), C1,4); \
    VRDX(fc,14); SBAR(); GAPB(PVM(11,fd), C1,6); \
    VRDX(fd,15); SBAR(); GAPB(PVM(12,fa), C1,8); \
    GAPB(PVM(13,fb), C1,10); \
    GAPB(PVM(14,fc), C1,12); \
    GAPB(PVM(15,fd), C1,14); \
    }while(0)
  int t=1;
  #undef CMASK
  #define CMASK(P0,P1,t) do{}while(0)
  for(;t+5<NT;t+=2){
    STEP(pB0,pB1,pA0,pA1,t,true,true,true);     WAIT_BAR(3); RESC(); ROT();
    STEP(pA0,pA1,pB0,pB1,t+1,true,true,true);   WAIT_BAR(3); RESC(); ROT();
  }
  #undef CMASK
  #define CMASK(P0,P1,t) do{int jb_=(t)-(NT-4); if(jb_>=0)cmask<false>(P0,P1,jb_,qrel,hi);}while(0)
  #define ENDW(tt) do{ if((tt)+3<NT){WAIT_BAR(3);} else if((tt)+2<NT){WAIT_BAR(2);} else {WAIT_BAR(0);} }while(0)
  for(;t+1<NT;t+=2){
    STEP(pB0,pB1,pA0,pA1,t,(t+3<NT),(t+1<NT),(t+1<NT));       ENDW(t);   RESC(); ROT();
    STEP(pA0,pA1,pB0,pB1,t+1,(t+4<NT),(t+2<NT),(t+2<NT));     ENDW(t+1); RESC(); ROT();
  }
  STEP(pB0,pB1,pA0,pA1,NT-1,false,false,false); RESC();
  { float sacc=pB0[0]+pB0[1]; _Pragma("unroll") for(int r=2;r<16;++r)sacc+=pB0[r]; _Pragma("unroll") for(int r=0;r<16;++r)sacc+=pB1[r]; l_reg+=sacc;
    pw0=(u32x4){PKW(pB0,0),PKW(pB0,2),PKW(pB0,4),PKW(pB0,6)};pw1=(u32x4){PKW(pB0,8),PKW(pB0,10),PKW(pB0,12),PKW(pB0,14)};pw2=(u32x4){PKW(pB1,0),PKW(pB1,2),PKW(pB1,4),PKW(pB1,6)};pw3=(u32x4){PKW(pB1,8),PKW(pB1,10),PKW(pB1,12),PKW(pB1,14)};
    SBAR(); const lds_cptr vp_=vp0+2*sl_cur;
    #pragma unroll
    for(int e4=0;e4<4;++e4){ s16x4 lo[4],hh[4];
      #pragma unroll
      for(int ks=0;ks<4;++ks){ lo[ks]=vtr(vp_+VOFF(4*ks+e4)); hh[ks]=vtr(vp_+VOFF(4*ks+e4)+512); }
      #define PK(k) (bf16x8){lo[k][0],lo[k][1],lo[k][2],lo[k][3],hh[k][0],hh[k][1],hh[k][2],hh[k][3]}
      o[e4]=__builtin_amdgcn_mfma_f32_32x32x16_bf16(PAF(0),PK(0),o[e4],0,0,0);
      o[e4]=__builtin_amdgcn_mfma_f32_32x32x16_bf16(PAF(1),PK(1),o[e4],0,0,0);
      o[e4]=__builtin_amdgcn_mfma_f32_32x32x16_bf16(PAF(2),PK(2),o[e4],0,0,0);
      o[e4]=__builtin_amdgcn_mfma_f32_32x32x16_bf16(PAF(3),PK(3),o[e4],0,0,0);
      #undef PK
    } }
  #undef PKW
  #undef PAF
  #undef PAF_
  #undef PVM
  #undef PIN
  #undef MX3
  #undef VOFF
  #undef VRDX
  #undef VFRX
  #undef GAPA
  #undef GAPB
  #undef EX
  #undef KRD
  #undef STEP
  #undef ENDW
  {auto rr=__builtin_amdgcn_permlane32_swap(__float_as_uint(l_reg),__float_as_uint(l_reg),false,false);l_reg=__uint_as_float(rr[0])+__uint_as_float(rr[1]);}
  if(hi==0)wsf[32+r32]=l_reg;asm volatile("s_waitcnt lgkmcnt(0)":::"memory");
  float rli[16];
  #pragma unroll
  for(int r=0;r<16;++r)rli[r]=__builtin_amdgcn_rcpf(wsf[32+crow(r,hi)]);
  bf16*Ow=O+(rowbase+q0+wid*QBLK)*OP;
  { bf16*stg=(bf16*)(shm+A2_OST)+wid*2048;
    int lane_e=lane; asm volatile("":"+v"(lane_e));
    #pragma unroll
    for(int hh=0;hh<2;++hh){
      #pragma unroll
      for(int r=0;r<16;++r){const int orow=crow(r,hi);
        #pragma unroll
        for(int d0=0;d0<2;++d0)stg[orow*64+d0*32+r32]=__float2bfloat16(o[2*hh+d0][r]*rli[r]);}
      asm volatile("s_waitcnt lgkmcnt(0)":::"memory");
      #pragma unroll
      for(int i=0;i<4;++i){const int row=i*8+(lane_e>>3),ch=lane_e&7; const u32x4 v=*(const u32x4*)(stg+row*64+ch*8); ATTN_STORE16(Ow+(long)row*OP+hh*64+ch*8,v);}
      asm volatile("s_waitcnt lgkmcnt(0)":::"memory");
    } }
  asm volatile("s_waitcnt lgkmcnt(0)\n\ts_barrier":::"memory");
  #undef DMA_K
  #undef DMA_V
  #undef CMASK
  #undef RESC
  #undef ROT
}
#undef SBAR
#undef WAIT_BAR
}

#define GAS __attribute__((address_space(1)))
#define LAS __attribute__((address_space(3)))
typedef unsigned v4u __attribute__((ext_vector_type(4)));
typedef float f32x4 __attribute__((ext_vector_type(4)));
typedef short bf16x8 __attribute__((ext_vector_type(8)));
typedef GAS unsigned gu32;
typedef GAS unsigned long long gu64;
#define RLX_AGENT __ATOMIC_RELAXED, __HIP_MEMORY_SCOPE_AGENT
#define LDS_WAIT() asm volatile("s_waitcnt lgkmcnt(0)" ::: "memory")
#define VM_WAIT() asm volatile("s_waitcnt vmcnt(0)" ::: "memory")
__device__ __forceinline__ unsigned long long rt() { return __builtin_amdgcn_s_memrealtime(); }

#define XB_TMO      128
#define XB_XCNT(j)  (256  + 64 * (j))
#define XB_XSUB(j)  (1280 + 64 * (j))
#define XB_XGEN(j)  (2304 + 64 * (j))
#define XB_TOP      3328
#define XB_TOPGEN   3392
#define XCD_BAR_WORDS 3456
#define XB_SPIN_CAP (1u << 18)

__device__ __forceinline__ unsigned xb_ld(unsigned* p)              { return __hip_atomic_load(p, __ATOMIC_RELAXED, __HIP_MEMORY_SCOPE_AGENT); }
__device__ __forceinline__ unsigned xb_add(unsigned* p, unsigned v) { return __hip_atomic_fetch_add(p, v, __ATOMIC_RELAXED, __HIP_MEMORY_SCOPE_AGENT); }
__device__ __forceinline__ unsigned xb_xcc_id() { return (unsigned)__builtin_amdgcn_s_getreg((3 << 11) | 20) & 0xFu; }
#define XB_SPIN(cond, bar) do { unsigned _sp = 0; while (cond) { __builtin_amdgcn_s_sleep(1); \
    if ((++_sp & 255u) == 0u) { if (xb_ld(&(bar)[XB_TMO])) break; if (_sp > XB_SPIN_CAP) { atomicAdd(&(bar)[XB_TMO], 1u); break; } } } } while (0)

struct XcdBarrier {
    unsigned* bar; unsigned x;
    volatile LAS unsigned* st;
};

__device__ __forceinline__ XcdBarrier xcd_barrier_post(unsigned* bar, volatile LAS unsigned* st, const bool first) {
    XcdBarrier b; b.bar = bar; b.x = xb_xcc_id(); b.st = st;
    if (first) (void)xb_add(&bar[XB_XCNT(b.x)], 1u);
    return b;
}
__device__ __forceinline__ void xcd_barrier_complete(unsigned* bar, unsigned x, unsigned& nloc, unsigned& nx) {
    const unsigned G = gridDim.x * gridDim.y * gridDim.z;
    unsigned sum, cnt, mine, sp = 0u;
    for (;;) {
        sum = 0u; cnt = 0u; mine = 0u;
#pragma unroll
        for (unsigned j = 0; j < 16; ++j) { const unsigned c = xb_ld(&bar[XB_XCNT(j)]); sum += c; cnt += (c > 0u) ? 1u : 0u; mine = (j == x) ? c : mine; }
        if (sum == G) break;
        __builtin_amdgcn_s_sleep(1);
        if ((++sp & 255u) == 0u) { if (xb_ld(&bar[XB_TMO])) break; if (sp > XB_SPIN_CAP) { atomicAdd(&bar[XB_TMO], 1u); break; } }
    }
    nloc = mine > 0u ? mine : 1u; nx = cnt > 0u ? cnt : 1u;
}

__device__ __forceinline__ void xcd_barrier(const XcdBarrier& b, const bool first) {
    asm volatile("s_waitcnt vmcnt(0)" ::: "memory");
    __syncthreads();
    if (first) {
        unsigned* bar = b.bar;
        __builtin_amdgcn_s_waitcnt(0);
        unsigned nloc = b.st[0], nx = b.st[1];
        if (nloc == 0u) { xcd_barrier_complete(bar, b.x, nloc, nx); b.st[0] = nloc; b.st[1] = nx; }
        const unsigned old = xb_add(&bar[XB_XSUB(b.x)], 1u);
        const unsigned gen = old / nloc;
        if (old + 1u == (gen + 1u) * nloc) {
            __builtin_amdgcn_fence(__ATOMIC_RELEASE, "agent");
            asm volatile("s_waitcnt vmcnt(0)" ::: "memory");
            const unsigned og = xb_add(&bar[XB_TOP], 1u);
            const unsigned tg = og / nx;
            if (og + 1u == (tg + 1u) * nx) xb_add(&bar[XB_TOPGEN], 1u);
            else XB_SPIN(xb_ld(&bar[XB_TOPGEN]) == tg, bar);
            __builtin_amdgcn_fence(__ATOMIC_ACQUIRE, "agent");
            xb_add(&bar[XB_XGEN(b.x)], 1u);
            asm volatile("s_waitcnt vmcnt(0)" ::: "memory");
        } else {
            XB_SPIN(xb_ld(&bar[XB_XGEN(b.x)]) == gen, bar);
            __builtin_amdgcn_fence(__ATOMIC_ACQUIRE, "agent");
            asm volatile("s_waitcnt vmcnt(0)" ::: "memory");
        }
    }
    __syncthreads();
}

constexpr int NWAVES = 8;
constexpr int RING_OFF = 0, RING_BYTES = 131072;
constexpr int LDSCTL_OFF = RING_BYTES, MISC_OFF = LDSCTL_OFF + 320;
constexpr int LDS_BYTES = 147456;
constexpr int CW_BAR = 0;
#ifndef MK_N_LAUNCHES
#define MK_N_LAUNCHES 1
#endif
constexpr size_t CTL_ZERO_BYTES = (MK_N_LAUNCHES == 1 ? 16 : 256) * 1024;
constexpr int N_PHASES = 10;
#ifndef PROBE_DOUBLEK
#define PROBE_DOUBLEK 0
#endif
#ifndef PROBE_PHASE
#define PROBE_PHASE -1
#endif
constexpr int PROBE_AMP = 8;
#ifndef PROBE_REPS
#define PROBE_REPS 1,1,1,1,1,1,1,1,1,1
#endif
constexpr int PHASE_REP[N_PHASES] = {PROBE_REPS};

__device__ __forceinline__ void xcd_barrier_arrive(const XcdBarrier& b, const bool first) {
    asm volatile("s_waitcnt vmcnt(0)" ::: "memory");
    __syncthreads();
    if (first) {
        unsigned* bar = b.bar;
        __builtin_amdgcn_s_waitcnt(0);
        unsigned nloc = b.st[0], nx = b.st[1];
        if (nloc == 0u) { xcd_barrier_complete(bar, b.x, nloc, nx); b.st[0] = nloc; b.st[1] = nx; }
        const unsigned old = xb_add(&bar[XB_XSUB(b.x)], 1u);
        const unsigned gen = old / nloc;
        unsigned role = 0u, tg = 0u;
        if (old + 1u == (gen + 1u) * nloc) {
            __builtin_amdgcn_fence(__ATOMIC_RELEASE, "agent");
            asm volatile("s_waitcnt vmcnt(0)" ::: "memory");
            const unsigned og = xb_add(&bar[XB_TOP], 1u);
            tg = og / nx;
            if (og + 1u == (tg + 1u) * nx) { xb_add(&bar[XB_TOPGEN], 1u); role = 2u; } else role = 1u;
        }
        b.st[2] = gen; b.st[3] = role; b.st[4] = tg;
    }
}
__device__ __forceinline__ void xcd_barrier_wait(const XcdBarrier& b, const bool first) {
    if (first) {
        unsigned* bar = b.bar;
        const unsigned gen = b.st[2], role = b.st[3], tg = b.st[4];
        if (role != 0u) {
            if (role == 1u) XB_SPIN(xb_ld(&bar[XB_TOPGEN]) == tg, bar);
            __builtin_amdgcn_fence(__ATOMIC_ACQUIRE, "agent");
            xb_add(&bar[XB_XGEN(b.x)], 1u);
            asm volatile("s_waitcnt vmcnt(0)" ::: "memory");
        } else {
            XB_SPIN(xb_ld(&bar[XB_XGEN(b.x)]) == gen, bar);
            __builtin_amdgcn_fence(__ATOMIC_ACQUIRE, "agent");
            asm volatile("s_waitcnt vmcnt(0)" ::: "memory");
        }
    }
    __syncthreads();
}
__device__ __forceinline__ const void* karg(unsigned off) {
    asm volatile("" : "+s"(off));
    return *(const void* const __attribute__((address_space(4)))*)((const char __attribute__((address_space(4)))*)__builtin_amdgcn_kernarg_segment_ptr() + off);
}
struct MArgs { const void* in[20]; float* out; unsigned char* ws; int ph_lo, ph_hi, li, pad; };

__global__ void __launch_bounds__(NWAVES * 64, 2) mega_fwd(MArgs args) {
    extern __shared__ __attribute__((aligned(16))) unsigned char lds[];
    LAS unsigned char* L = (LAS unsigned char*)lds;
    const int WAVE_S = __builtin_amdgcn_readfirstlane((int)(threadIdx.x >> 6));
#define TID() (WAVE_S * 64 + lane_id_())
#define FIRST() (WAVE_S == 0 && lane_id_() == 0)
    const int G = gridDim.x, bx = blockIdx.x, vcu = (G % 8 == 0) ? (bx % 8) * (G / 8) + bx / 8 : bx;
    for (int u = (int)threadIdx.x; u < (LDS_BYTES - LDSCTL_OFF) / 4; u += NWAVES * 64) ((LAS unsigned*)(L + LDSCTL_OFF))[u] = 0u;
    __syncthreads();
    unsigned* ctl = (unsigned*)(args.ws + WS_CTL);
    XcdBarrier bar = xcd_barrier_post(ctl + CW_BAR + args.li * XCD_BAR_WORDS, (volatile LAS unsigned*)(L + MISC_OFF) + 8, FIRST());
    const int lo = args.ph_lo, hi = args.ph_hi;
    unsigned long long t_last = PROBE_PHASE >= 0 ? __builtin_amdgcn_s_memrealtime() : 0ull, t_a = 0ull, t_b = 0ull;
#define IN(k) (lo <= (k) && (k) < hi)
#define SEAM(k) do { if (PROBE_PHASE == (k)) { t_a = t_last; } if (IN(k) && IN((k) + 1)) xcd_barrier(bar, FIRST()); if (PROBE_PHASE >= 0) { t_last = __builtin_amdgcn_s_memrealtime(); if (PROBE_PHASE == (k)) t_b = t_last; } } while (0)

#define INF(k) ((const float*)karg(8 * (k)))
#define OUTP() ((float*)karg(160))
#define WSB(off) ((bf16_t*)((unsigned char*)karg(168) + (off)))
#define WSF(off) ((float*)((unsigned char*)karg(168) + (off)))

    if (IN(0)) for (int rep_ = 0; rep_ < PHASE_REP[0]; ++rep_) {
        gemv8_phase<true, false>(TID(), vcu, G, INF(1), DM, INF(3), MODW, INF(4), WSF(WS_MOD), MODW, (float*)lds);
        if (IN(1) && rep_ == 0) xcd_barrier_arrive(bar, FIRST());
        ConvPtrs cv{INF(6), INF(14), INF(15), INF(16), INF(18), INF(19), WSB(WS_WIN), WSB(WS_WA), WSB(WS_WB), WSB(WS_WOUT), WSB(WS_WGU), WSB(WS_WDN)};
        convert_phase(TID(), vcu, G, cv, (float*)lds);
        trig_phase(TID(), vcu, G, (const int*)karg(16), WSF(WS_TA), WSF(WS_TR));
        __syncthreads();
    }
    if (IN(0) && IN(1)) { if (PROBE_PHASE == 0) t_a = t_last; xcd_barrier_wait(bar, FIRST()); if (PROBE_PHASE >= 0) { t_last = __builtin_amdgcn_s_memrealtime(); if (PROBE_PHASE == 0) t_b = t_last; } }
    if (IN(1)) for (int rep_ = 0; rep_ < PHASE_REP[1]; ++rep_) { const float* mod = WSF(WS_MOD); xn_phase(TID(), vcu, G, INF(0), INF(5), mod + 1 * DM, mod + 0 * DM, WSB(WS_XN));
        gemv8_phase<false, true>(TID(), vcu, G, mod + 3 * DM, MODW, INF(18), 2 * DFF, nullptr, WSF(WS_CVEC), 2 * DFF, (float*)lds); }
    SEAM(1);
    if (IN(2)) for (int rep_ = 0; rep_ < PHASE_REP[2]; ++rep_) {
        pg8::Gemm g{WSB(WS_XN), WSB(WS_WIN), M, INW, DM}; pg8::StaticOrder S; S.init(M, INW, G, bx);
        pg8::EpiRows<InProjEpi> E{{WSB(WS_DQ), WSB(WS_DK), WSB(WS_DV), WSB(WS_RQ), WSB(WS_RK), WSB(WS_RV), WSB(WS_RG), WSB(WS_GA), WSB(WS_GB), INF(7), INF(8), WSF(WS_TA), WSF(WS_TR)}};
        pg8::gemm_phase<pg8::EpiRows<InProjEpi>, pg8::StaticOrder, true, true>(L + RING_OFF, g, S, E, WAVE_S);
    }
    SEAM(2);
    if (IN(3)) for (int rep_ = 0; rep_ < PHASE_REP[3]; ++rep_) {
        char* shm = (char*)lds + RING_OFF;
        typedef attn_body::bf16 abf;
        const int xb = vcu >> 5, lc = vcu & 31;
        for (int i = 0; i < 2; ++i) {
            if (i < 1) {
                const int s4 = lc & 3, u = lc >> 2, b = xb, h = u >> 1;
                for (int k = 0; k < 2; ++k)
                    attn_body::attn_unit2<8>((long)b * SEQ, k == 0 ? 7 - s4 : s4, (const abf*)(WSB(WS_DQ) + u * 64), 512, (const abf*)(WSB(WS_DK) + u * 64), 512, (const abf*)(WSB(WS_DV) + h * 128), 512,
                                             (abf*)(WSB(WS_AO) + u * 128), 1024, shm, WAVE_S);
            } else {
                const int s4 = lc & 3, half = (lc >> 2) & 1, h = lc >> 3, b = xb;
                for (int k = 0; k < 2; ++k) {
                    const int qb = k == 0 ? 7 - s4 : s4; const long row0 = (long)b * SEQ;
                    if (qb > 0) attn_body::ret_state(row0, 4 * qb, (const abf*)(WSB(WS_RK) + h * 64), 256, (const abf*)(WSB(WS_RV) + h * 128 + half * 64), 512, shm, WAVE_S);
                    attn_body::attn_unit<8, true>(row0 + 256 * qb, 0, (const abf*)(WSB(WS_RQ) + h * 64), 256, (const abf*)(WSB(WS_RK) + h * 64), 256, (const abf*)(WSB(WS_RV) + h * 128 + half * 64), 512,
                                                  (abf*)(WSB(WS_RETO) + h * 128 + half * 64), 512, shm, qb > 0, WAVE_S);
                }
            }
        }
    }
    SEAM(3);
    if (IN(4)) for (int rep_ = 0; rep_ < PHASE_REP[4]; ++rep_) combine_phase(TID(), vcu, G, WSB(WS_AO), WSB(WS_RETO), WSB(WS_RG), WSB(WS_OA), INF(9), INF(10), INF(11), INF(12), INF(13));
    SEAM(4);
    if (IN(5)) for (int rep_ = 0; rep_ < PHASE_REP[5]; ++rep_) {
        pg8::Gemm g{WSB(WS_OA), WSB(WS_WA), M, DM, 512, WSB(WS_OB), WSB(WS_WB)}; pg8::PairOrder S; S.init(M, DM, G, bx); pg8::BranchTileEpi E{WSB(WS_GA), WSB(WS_GB), WSB(WS_Y)};
        pg8::gemm_phase<pg8::BranchTileEpi, pg8::PairOrder, true, true>(L + RING_OFF, g, S, E, WAVE_S);
    }
    SEAM(5);
    if (IN(6)) for (int rep_ = 0; rep_ < PHASE_REP[6]; ++rep_) {
        pg8::Gemm g{WSB(WS_Y), WSB(WS_WOUT), M, DM, DM}; pg8::StaticOrder S; S.init(M, DM, G, bx); pg8::EpiOutFused E{{INF(0), WSB(WS_X1B), WSF(WS_MOD), INF(17), WSB(WS_XN), WSF(WS_ROWSS)}};
        pg8::gemm_phase<pg8::EpiOutFused, pg8::StaticOrder, false, true>(L + RING_OFF, g, S, E, WAVE_S);
    }
    SEAM(6);
    if (IN(8)) for (int rep_ = 0; rep_ < PHASE_REP[8]; ++rep_) {
        pg8::Gemm g{WSB(WS_XN), WSB(WS_WGU), M, 2 * DFF, DM}; pg8::StaticOrder S; S.init(M, 2 * DFF, G, bx); pg8::EpiRows<GateUpEpi> E{{WSB(WS_ACT), WSF(WS_ROWSS), WSF(WS_CVEC)}};
        pg8::gemm_phase<pg8::EpiRows<GateUpEpi>, pg8::StaticOrder, true, true>(L + RING_OFF, g, S, E, WAVE_S);
    }
    SEAM(8);
    if (IN(9)) for (int rep_ = 0; rep_ < PHASE_REP[9]; ++rep_) {
        float* out = OUTP();
        pg8::Gemm g{WSB(WS_ACT), WSB(WS_WDN), M, DM, DFF};
#if PROBE_DOUBLEK
        pg8::DoubleKOrder S; S.init(M, DM, G, bx); pg8::EpiRowsDK<ResidEpi> E{{WSB(WS_X1B), out, WSF(WS_MOD) + 5 * DM}};
        pg8::gemm_phase<pg8::EpiRowsDK<ResidEpi>, pg8::DoubleKOrder, false, true>(L + RING_OFF, g, S, E, WAVE_S);
#else
        pg8::StaticOrder S; S.init(M, DM, G, bx); pg8::EpiRows<ResidEpi> E{{WSB(WS_X1B), out, WSF(WS_MOD) + 5 * DM}};
        pg8::gemm_phase<pg8::EpiRows<ResidEpi>, pg8::StaticOrder, true, true>(L + RING_OFF, g, S, E, WAVE_S);
#endif
    }
#undef INF
#undef OUTP
#undef WSB
#undef WSF
    SEAM(9);
    if (PROBE_PHASE >= 0 && blockIdx.x == 0 && WAVE_S == 0) { const unsigned long long tgt = __builtin_amdgcn_s_memrealtime() + (unsigned long long)PROBE_AMP * (t_b - t_a); while (__builtin_amdgcn_s_memrealtime() < tgt) __builtin_amdgcn_s_sleep(8); }
#undef IN
#undef SEAM
#undef TID
#undef FIRST
}

#ifndef MK_N_LAUNCHES
#define MK_N_LAUNCHES 1
#endif
extern "C" void kernel_launch(void* const* d_in, const int* in_sizes, int n_in, void* d_out, int out_size, void* d_ws, size_t ws_size, hipStream_t stream) {
    static int grid = 0;
    if (grid == 0) {
        if (n_in != 20 || in_sizes[0] != M * DM || out_size != M * DM || ws_size < WS_END) { fprintf(stderr, "kernel_launch: unexpected shapes (n_in %d, ws %zu)\n", n_in, ws_size); grid = -1; return; }
        int dev = 0, cus = 0, per_cu = 0;
        if (hipGetDevice(&dev) != hipSuccess || hipDeviceGetAttribute(&cus, hipDeviceAttributeMultiprocessorCount, dev) != hipSuccess) { grid = -1; return; }
        if (hipFuncSetAttribute((const void*)mega_fwd, hipFuncAttributeMaxDynamicSharedMemorySize, LDS_BYTES) != hipSuccess) { fprintf(stderr, "kernel_launch: hipFuncSetAttribute failed\n"); grid = -1; return; }
        if (hipOccupancyMaxActiveBlocksPerMultiprocessor(&per_cu, (const void*)mega_fwd, NWAVES * 64, LDS_BYTES) != hipSuccess || per_cu < 1) { fprintf(stderr, "kernel_launch: occupancy query says %d\n", per_cu); per_cu = 1; }
        (void)hipGetLastError();
        if (cus != 256) { fprintf(stderr, "kernel_launch: built for a 256-CU device (got %d)\n", cus); grid = -1; return; }
        grid = cus;
    }
    if (grid < 0) return;
    (void)hipMemsetAsync((char*)d_ws + WS_CTL, 0, CTL_ZERO_BYTES, stream);
    MArgs a{};
    for (int i = 0; i < 20; ++i) a.in[i] = d_in[i];
    a.out = (float*)d_out; a.ws = (unsigned char*)d_ws;
    if (MK_N_LAUNCHES == 1) { a.ph_lo = 0; a.ph_hi = N_PHASES; a.li = 0; hipLaunchKernelGGL(mega_fwd, dim3(grid), dim3(NWAVES * 64), LDS_BYTES, stream, a); }
    else for (int p = 0; p < N_PHASES; ++p) { a.ph_lo = p; a.ph_hi = p + 1; a.li = p; hipLaunchKernelGGL(mega_fwd, dim3(grid), dim3(NWAVES * 64), LDS_BYTES, stream, a); }
}
```

```cpp
#include <hip/hip_runtime.h>
#include <cstdint>
#include <cstdio>
#include <hip/hip_bf16.h>
#include <cmath>

typedef unsigned short bf16_t;
typedef short bf16x8 __attribute__((ext_vector_type(8)));
typedef float f32x4 __attribute__((ext_vector_type(4)));
typedef unsigned u32x2 __attribute__((ext_vector_type(2)));
typedef unsigned u32x4 __attribute__((ext_vector_type(4)));

constexpr int BATCH = 8, SEQ = 2048, DM = 1024, M = BATCH * SEQ, INW = 5120, DFF = 2816, MODW = 6 * DM;
constexpr float EPS = 1e-6f;
constexpr float C2 = 0.125f * 1.4426950408889634f;

constexpr size_t MiB = 1u << 20;
constexpr size_t WS_CTL = 0, WS_MOD = 1 * MiB, WS_CVEC = 1 * MiB + 256 * 1024, WS_TA = 2 * MiB, WS_TR = 3 * MiB, WS_ROWSS = 7 * MiB;
constexpr size_t WS_WIN = 8 * MiB, WS_WA = 18 * MiB, WS_WB = 19 * MiB, WS_WOUT = 20 * MiB, WS_WGU = 22 * MiB, WS_WDN = 33 * MiB;
constexpr size_t WS_XN = 40 * MiB;
constexpr size_t WS_DQ = 72 * MiB, WS_DK = 88 * MiB, WS_DV = 104 * MiB, WS_RQ = 120 * MiB, WS_RK = 128 * MiB, WS_RV = 136 * MiB,
                 WS_RG = 152 * MiB, WS_GA = 168 * MiB, WS_GB = 200 * MiB, WS_RETO = 232 * MiB, WS_X1B = 208 * MiB;
constexpr size_t WS_AO = WS_XN, WS_OA = WS_DQ, WS_OB = WS_RG, WS_Y = WS_DK, WS_ACT = 120 * MiB, WS_END = 256 * MiB;

__device__ __forceinline__ int lane_id_() { return (int)__builtin_amdgcn_mbcnt_hi(~0u, __builtin_amdgcn_mbcnt_lo(~0u, 0u)); }
__device__ __forceinline__ unsigned f2bf(float f) { unsigned u = __float_as_uint(f); return (u + 0x7fffu + ((u >> 16) & 1u)) >> 16; }
typedef float f32x2_t_ __attribute__((ext_vector_type(2))); typedef __bf16 bf16x2_t_ __attribute__((ext_vector_type(2)));
__device__ __forceinline__ unsigned pk2(float lo, float hi) { f32x2_t_ v = {lo, hi}; bf16x2_t_ b = __builtin_convertvector(v, bf16x2_t_); return __builtin_bit_cast(unsigned, b); }
__device__ __forceinline__ float bf2f(unsigned h) { return __uint_as_float(h << 16); }
__device__ __forceinline__ float bflo(unsigned w) { return __uint_as_float(w << 16); }
__device__ __forceinline__ float bfhi(unsigned w) { return __uint_as_float(w & 0xffff0000u); }
__device__ __forceinline__ u32x2 pack4(f32x4 v) { u32x2 r; r.x = pk2(v[0], v[1]); r.y = pk2(v[2], v[3]); return r; }
__device__ __forceinline__ float wave_sum(float v) {
#pragma unroll
    for (int o = 1; o < 64; o <<= 1) v += __shfl_xor(v, o);
    return v;
}
__device__ __forceinline__ float silu_f(float x) { return x * __builtin_amdgcn_rcpf(1.f + __builtin_amdgcn_exp2f(-1.4426950408889634f * x)); }
__device__ __forceinline__ float sigm_f(float x) { return __builtin_amdgcn_rcpf(1.f + __builtin_amdgcn_exp2f(-1.4426950408889634f * x)); }

__constant__ double c_invf_da[8] = {1.0, 0.19392274474868576, 0.03760603093086393, 0.007292664737217109, 0.001414213562373095, 0.0002742481756762073, 5.318295896944988e-05, 1.031338537721246e-05};
__constant__ double c_invf_ret[32] = {1.0, 0.7498942093324559, 0.5623413251903491, 0.4216965034285822, 0.31622776601683794, 0.23713737056616552, 0.1778279410038923, 0.1333521432163324, 0.1, 0.07498942093324558, 0.05623413251903491, 0.042169650342858224, 0.03162277660168379, 0.023713737056616554, 0.01778279410038923, 0.01333521432163324, 0.01, 0.007498942093324558, 0.005623413251903491, 0.004216965034285823, 0.0031622776601683794, 0.0023713737056616554, 0.0017782794100389228, 0.001333521432163324, 0.001, 0.0007498942093324559, 0.0005623413251903491, 0.00042169650342858224, 0.00031622776601683794, 0.00023713737056616554, 0.00017782794100389227, 0.0001333521432163324};
__device__ __forceinline__ float log2gamma(int h) { return h == 0 ? -0.04580368961312479f : h == 1 ? -0.02272007650008353f : h == 2 ? -0.011315313227834146f : -0.005646563141142063f; }

template <bool SILU, bool GUMAP>
__device__ __forceinline__ void gemv8_phase(int tid, int wg, int G, const float* vec, int vpitch, const float* W, int N, const float* bias, float* out, int opitch, float* lds) {
    const int wave = tid >> 6, lane = tid & 63, r8 = lane >> 3, c4 = lane & 7;
    f32x4 w[16];
    if (wg < N / 32) { const float* wp = W + (size_t)(wave * 128 + r8) * N + wg * 32 + c4 * 4;
#pragma unroll
        for (int i = 0; i < 16; ++i) w[i] = *(const f32x4*)(wp + (size_t)(8 * i) * N); }
    for (int i = tid; i < BATCH * DM; i += 512) { const float v = vec[(i >> 10) * vpitch + (i & 1023)]; lds[i] = SILU ? silu_f(v) : v; }
    __syncthreads();
    float* red = lds + BATCH * DM;
    for (int cg = wg; cg < N / 32; cg += G) {
        const int e0 = cg * 32;
        f32x4 acc[8];
#pragma unroll
        for (int b = 0; b < 8; ++b) acc[b] = (f32x4){0.f, 0.f, 0.f, 0.f};
        if (cg != wg) { const float* wp = W + (size_t)(wave * 128 + r8) * N + e0 + c4 * 4;
#pragma unroll
            for (int i = 0; i < 16; ++i) w[i] = *(const f32x4*)(wp + (size_t)(8 * i) * N); }
#pragma unroll
        for (int i = 0; i < 16; ++i) {
            const int d = wave * 128 + 8 * i + r8;
#pragma unroll
            for (int b = 0; b < 8; ++b) acc[b] += w[i] * lds[b * DM + d];
        }
#pragma unroll
        for (int b = 0; b < 8; ++b)
#pragma unroll
            for (int e = 0; e < 4; ++e) { float v = acc[b][e]; v += __shfl_xor(v, 8); v += __shfl_xor(v, 16); v += __shfl_xor(v, 32); acc[b][e] = v; }
        if (r8 == 0) {
#pragma unroll
            for (int b = 0; b < 8; ++b) *(f32x4*)(red + (wave * 8 + b) * 32 + c4 * 4) = acc[b];
        }
        __syncthreads();
        if (tid < 256) {
            const int b = tid >> 5, c2 = tid & 31, e = e0 + c2;
            float s = bias ? bias[e] : 0.f;
#pragma unroll
            for (int w2 = 0; w2 < 8; ++w2) s += red[(w2 * 8 + b) * 32 + c2];
            int oi = e;
            if (GUMAP) { const int bj = e / DFF, r = e % DFF; oi = (r >> 7) * 256 + bj * 128 + (r & 127); }
            out[b * opitch + oi] = s;
        }
        __syncthreads();
    }
}

__device__ __forceinline__ int slot2col(int map, int slot) {
    if (map == 1) { const int pn = slot >> 8, bj = (slot >> 7) & 1, wc = (slot >> 5) & 3, r = slot & 31; return (pn << 8) + (wc << 6) + (bj << 5) + r; }
    if (map == 2) { const int pn = slot >> 8, bj = (slot >> 7) & 1, j = slot & 127; return bj * DFF + pn * 128 + j; }
    return slot;
}
__device__ __forceinline__ void convert_item(const float* W, int K, int N, bf16_t* Wt, int map, float* scr, int item, int lane) {
    const int nblk = N / 32, kb = item / nblk, nb = item % nblk, k0 = 64 * kb, s0 = 32 * nb, c0 = slot2col(map, s0);
    { const int r8 = lane >> 3, c4 = lane & 7;
      f32x4 v[8];
#pragma unroll
      for (int i = 0; i < 8; ++i) v[i] = *(const f32x4*)(W + (size_t)(k0 + 8 * i + r8) * N + c0 + 4 * c4);
#pragma unroll
      for (int i = 0; i < 8; ++i) { float* d = scr + (8 * i + r8) * 33 + 4 * c4; d[0] = v[i][0]; d[1] = v[i][1]; d[2] = v[i][2]; d[3] = v[i][3]; } }
    __builtin_amdgcn_s_waitcnt(0xc07f); __builtin_amdgcn_wave_barrier();
    const int c = lane & 7;
#pragma unroll
    for (int j = 0; j < 4; ++j) { const int n = (lane >> 3) + 8 * j; const float* s = scr + (8 * c) * 33 + n;
        u32x4 o; o.x = pk2(s[0 * 33], s[1 * 33]); o.y = pk2(s[2 * 33], s[3 * 33]); o.z = pk2(s[4 * 33], s[5 * 33]); o.w = pk2(s[6 * 33], s[7 * 33]);
        *(u32x4*)(Wt + (size_t)(s0 + n) * K + k0 + 8 * c) = o; }
    __builtin_amdgcn_s_waitcnt(0xc07f); __builtin_amdgcn_wave_barrier();
}
struct ConvPtrs { const float *w_in, *wa, *wb, *wout, *wgu, *wdn; bf16_t *w_in_t, *wa_t, *wb_t, *wout_t, *wgu_t, *wdn_t; };
constexpr int CV_IN = (DM / 64) * (INW / 32), CV_A = (512 / 64) * (DM / 32), CV_O = (DM / 64) * (DM / 32), CV_GU = (DM / 64) * (2 * DFF / 32), CV_DN = (DFF / 64) * (DM / 32);
constexpr int CV_S0 = 0, CV_S1 = CV_IN, CV_S2 = CV_IN + 2 * CV_A + CV_O, CV_S3 = CV_S2 + CV_GU, CV_S4 = CV_S3 + CV_DN;
__device__ __forceinline__ void convert_phase(int tid, int wg, int G, const ConvPtrs& P, float* lds, int it0, int it1) {
    const int wave = tid >> 6, lane = tid & 63;
    float* scr = lds + wave * (64 * 33);
    const int gw = wg * 8 + wave, NGW = G * 8;
    constexpr int I_IN = CV_IN, I_A = CV_A, I_O = CV_O, I_GU = CV_GU;
    for (int it = it0 + gw; it < it1; it += NGW) {
        int r = it;
        if (r < I_IN) { convert_item(P.w_in, DM, INW, P.w_in_t, 1, scr, r, lane); continue; } r -= I_IN;
        if (r < I_A) { convert_item(P.wa, 512, DM, P.wa_t, 0, scr, r, lane); continue; } r -= I_A;
        if (r < I_A) { convert_item(P.wb, 512, DM, P.wb_t, 0, scr, r, lane); continue; } r -= I_A;
        if (r < I_O) { convert_item(P.wout, DM, DM, P.wout_t, 0, scr, r, lane); continue; } r -= I_O;
        if (r < I_GU) { convert_item(P.wgu, DM, 2 * DFF, P.wgu_t, 2, scr, r, lane); continue; } r -= I_GU;
        convert_item(P.wdn, DFF, DM, P.wdn_t, 0, scr, r, lane);
    }
}

__device__ __forceinline__ void trig_phase(int tid, int wg, int G, const int* positions, float* TA, float* TR) {
    const int gt = wg * 512 + tid, NT = G * 512;
    for (int it = gt; it < M * 40; it += NT) {
        const int row = it / 40, i = it % 40;
        const double p = (double)positions[row];
        const double a = p * (i < 8 ? c_invf_da[i] : c_invf_ret[i - 8]);
        double rev = a * 0.15915494309189535;
        rev -= __builtin_rint(rev);
        const float sn = __builtin_amdgcn_sinf((float)rev), cs = __builtin_amdgcn_cosf((float)rev);
        if (i < 8) { TA[row * 16 + i] = cs; TA[row * 16 + 8 + i] = sn; }
        else { TR[row * 64 + (i - 8)] = cs; TR[row * 64 + 32 + (i - 8)] = sn; }
    }
}

__device__ __forceinline__ void xn_phase(int tid, int wg, int G, const float* x, const float* g, const float* sc, const float* sh, bf16_t* XN) {
    const int wave = tid >> 6, lane = tid & 63;
    for (int r0 = (wg * 8 + wave) * 8; r0 < M; r0 += G * 64) {
        const int b = r0 / SEQ;
        f32x4 a[4], s0[4];
#pragma unroll
        for (int j = 0; j < 4; ++j) { const int col = 4 * lane + 256 * j; a[j] = *(const f32x4*)(g + col) * (*(const f32x4*)(sc + b * MODW + col) + 1.f); s0[j] = *(const f32x4*)(sh + b * MODW + col); }
#pragma unroll
        for (int h = 0; h < 2; ++h) {
            f32x4 v[4][4];
#pragma unroll
            for (int r = 0; r < 4; ++r)
#pragma unroll
                for (int j = 0; j < 4; ++j) v[r][j] = ((const f32x4*)(x + (size_t)(r0 + 4 * h + r) * DM))[lane + 64 * j];
            __builtin_amdgcn_sched_barrier(0);
#pragma unroll
            for (int r = 0; r < 4; ++r) {
                float ss = 0.f;
#pragma unroll
                for (int j = 0; j < 4; ++j) ss += (v[r][j][0] * v[r][j][0] + v[r][j][1] * v[r][j][1]) + (v[r][j][2] * v[r][j][2] + v[r][j][3] * v[r][j][3]);
                const float rstd = rsqrtf(wave_sum(ss) * (1.f / DM) + EPS);
                u32x2* o = (u32x2*)(XN + (size_t)(r0 + 4 * h + r) * DM) + lane;
#pragma unroll
                for (int j = 0; j < 4; ++j) o[64 * j] = pack4(v[r][j] * rstd * a[j] + s0[j]);
            }
        }
    }
}

__device__ __forceinline__ void combine_phase(int tid, int wg, int G, const bf16_t* AO, const bf16_t* RETO, bf16_t* RG_OB, bf16_t* OA,
                                              const float* lq1, const float* lk1, const float* lq2, const float* lk2, const float* subln_g) {
    const int wave = tid >> 6, lane = tid & 63;
    const float lam = __expf(wave_sum(lq1[lane] * lk1[lane])) - __expf(wave_sum(lq2[lane] * lk2[lane])) + 0.2f;
    const int h = lane >> 4, d0 = (lane & 15) * 8;
    float gsub[8];
#pragma unroll
    for (int e = 0; e < 8; ++e) gsub[e] = subln_g[d0 + e] * 0.8f;
    for (int row = wg * 64 + wave * 8; row < M; row += G * 64) for (int rj = 0; rj < 8; ++rj, ++row) {
        {
            const u32x4 a = *(const u32x4*)(AO + (size_t)row * 1024 + (2 * h) * 128 + d0), b = *(const u32x4*)(AO + (size_t)row * 1024 + (2 * h + 1) * 128 + d0);
            float d[8]; float ss = 0.f;
#pragma unroll
            for (int e = 0; e < 4; ++e) { d[2 * e] = bflo(a[e]) - lam * bflo(b[e]); d[2 * e + 1] = bfhi(a[e]) - lam * bfhi(b[e]); }
#pragma unroll
            for (int e = 0; e < 8; ++e) ss += d[e] * d[e];
            ss += __shfl_xor(ss, 1); ss += __shfl_xor(ss, 2); ss += __shfl_xor(ss, 4); ss += __shfl_xor(ss, 8);
            const float rstd = rsqrtf(ss * (1.f / 128.f) + EPS);
            u32x4 o;
#pragma unroll
            for (int e = 0; e < 4; ++e) o[e] = pk2(d[2 * e] * rstd * gsub[2 * e], d[2 * e + 1] * rstd * gsub[2 * e + 1]);
            *(u32x4*)(OA + (size_t)row * 512 + h * 128 + d0) = o;
        }
        {
            const u32x4 a = *(const u32x4*)(RETO + (size_t)row * 512 + h * 128 + d0), gt = *(const u32x4*)(RG_OB + (size_t)row * 512 + h * 128 + d0);
            float d[8]; float ss = 0.f;
#pragma unroll
            for (int e = 0; e < 4; ++e) { d[2 * e] = bflo(a[e]); d[2 * e + 1] = bfhi(a[e]); }
#pragma unroll
            for (int e = 0; e < 8; ++e) ss += d[e] * d[e];
            ss += __shfl_xor(ss, 1); ss += __shfl_xor(ss, 2); ss += __shfl_xor(ss, 4); ss += __shfl_xor(ss, 8);
            const float rstd = rsqrtf(ss * (1.f / 128.f) + EPS);
            u32x4 o;
#pragma unroll
            for (int e = 0; e < 4; ++e) o[e] = pk2(d[2 * e] * rstd * bflo(gt[e]), d[2 * e + 1] * rstd * bfhi(gt[e]));
            *(u32x4*)(RG_OB + (size_t)row * 512 + h * 128 + d0) = o;
        }
    }
}

__device__ __forceinline__ u32x4 pack8(f32x4 a, f32x4 b) { u32x4 r; r.x = pk2(a[0], a[1]); r.y = pk2(a[2], a[3]); r.z = pk2(b[0], b[1]); r.w = pk2(b[2], b[3]); return r; }
#define SLOT8(pn, wc, fq, g) (256 * (pn) + 128 * ((g) >> 1) + 32 * (wc) + 8 * (fq) + 4 * ((g) & 1))
struct InProjEpi {
    static constexpr int BATCH = 2;
    struct Tile { f32x4 gn[4]; };
    struct Pre { f32x4 t[4]; };
    bf16_t *DQ, *DK, *DV, *RQ, *RK, *RV, *RG, *GA, *GB; const float *qg, *kg, *TA, *TR;
    __device__ __forceinline__ Tile tile_pre(int b, int pn, int wc, int fq) const {
        Tile T;
        if (pn < 4) { const float* gn = pn < 2 ? qg : kg;
#pragma unroll
            for (int g = 0; g < 4; ++g) T.gn[g] = *(const f32x4*)(gn + 32 * (g >> 1) + 8 * fq + 4 * (g & 1)); }
        return T;
    }
    __device__ __forceinline__ Pre row_pre(int row, int b, int pn, int wc, int fq) const {
        Pre P;
        if (pn < 4) {
#pragma unroll
            for (int i = 0; i < 4; ++i) P.t[i] = *(const f32x4*)(TA + (size_t)row * 16 + 4 * i); }
        else if (pn == 6 || pn == 7) {
#pragma unroll
            for (int n = 0; n < 2; ++n) { P.t[n] = *(const f32x4*)(TR + (size_t)row * 64 + 8 * fq + 4 * n); P.t[2 + n] = *(const f32x4*)(TR + (size_t)row * 64 + 32 + 8 * fq + 4 * n); } }
        return P;
    }
    __device__ __forceinline__ void operator()(const f32x4 (&v)[4], const Pre& P, const Tile& T, int row, int b, int pn, int wc, int fq) const {
        f32x4 o[4]; bf16_t* dst;
        if (pn < 4) {
            const bool isq = pn < 2;
            float ss = 0.f;
#pragma unroll
            for (int g = 0; g < 4; ++g) ss += (v[g][0] * v[g][0] + v[g][1] * v[g][1]) + (v[g][2] * v[g][2] + v[g][3] * v[g][3]);
            ss += __shfl_xor(ss, 16); ss += __shfl_xor(ss, 32);
            const float rstd = rsqrtf(ss * (1.f / 64.f) + EPS) * (isq ? C2 : 1.f);
#pragma unroll
            for (int g = 0; g < 4; ++g) o[g] = v[g] * rstd * T.gn[g];
#pragma unroll
            for (int n = 0; n < 2; ++n) {
                f32x4 other;
#pragma unroll
                for (int r = 0; r < 4; ++r) other[r] = __shfl_xor(o[n][r], 16);
                const f32x4 rot = (fq == 0) ? (o[n] * P.t[n] - other * P.t[2 + n]) : (o[n] * P.t[n] + other * P.t[2 + n]);
                o[n] = (fq < 2) ? rot : o[n];
            }
            dst = (isq ? DQ : DK) + (size_t)row * 512 + ((pn & 1) * 4 + wc) * 64;
        } else if (pn == 6 || pn == 7) {
            const bool isq = pn == 6;
#pragma unroll
            for (int n = 0; n < 2; ++n) { o[n] = v[n] * P.t[n] - v[2 + n] * P.t[2 + n]; o[2 + n] = v[2 + n] * P.t[n] + v[n] * P.t[2 + n]; }
            const float t = (float)(row & (SEQ - 1)), lg = log2gamma(wc);
            const float s = isq ? exp2f(t * lg) : exp2f(-t * lg) * 0.125f;
#pragma unroll
            for (int g = 0; g < 4; ++g) o[g] = o[g] * s;
            dst = (isq ? RQ : RK) + (size_t)row * 256 + wc * 64;
        } else if (pn < 6) {
#pragma unroll
            for (int g = 0; g < 4; ++g) o[g] = v[g];
            dst = DV + (size_t)row * 512 + (pn - 4) * 256 + wc * 64;
        } else if (pn < 10) {
#pragma unroll
            for (int g = 0; g < 4; ++g) o[g] = v[g];
            dst = RV + (size_t)row * 512 + (pn - 8) * 256 + wc * 64;
        } else if (pn < 12) {
#pragma unroll
            for (int g = 0; g < 4; ++g)
#pragma unroll
                for (int r = 0; r < 4; ++r) o[g][r] = silu_f(v[g][r]);
            dst = RG + (size_t)row * 512 + (pn - 10) * 256 + wc * 64;
        } else {
#pragma unroll
            for (int g = 0; g < 4; ++g)
#pragma unroll
                for (int r = 0; r < 4; ++r) o[g][r] = sigm_f(v[g][r]);
            dst = (pn < 16 ? GA + (size_t)row * 1024 + (pn - 12) * 256 : GB + (size_t)row * 1024 + (pn - 16) * 256) + wc * 64;
        }
#pragma unroll
        for (int bj = 0; bj < 2; ++bj) *(u32x4*)(dst + 32 * bj + 8 * fq) = pack8(o[2 * bj], o[2 * bj + 1]);
    }
};
struct OutEpi {
    static constexpr int BATCH = 4;
    struct Tile { f32x4 g1[4], a2[4]; };
    struct Pre { f32x4 x[4]; };
    const float* x; bf16_t* X1B; const float* mod; const float* g2n; bf16_t* XM; float* rowss;
    __device__ __forceinline__ Tile tile_pre(int b, int pn, int wc, int fq) const {
        Tile T;
#pragma unroll
        for (int g = 0; g < 4; ++g) { const int col = SLOT8(pn, wc, fq, g);
            T.g1[g] = *(const f32x4*)(mod + b * MODW + 2 * DM + col); T.a2[g] = *(const f32x4*)(g2n + col) * (*(const f32x4*)(mod + b * MODW + 4 * DM + col) + 1.f); }
        return T;
    }
    __device__ __forceinline__ Pre row_pre(int row, int b, int pn, int wc, int fq) const {
        Pre P;
#pragma unroll
        for (int g = 0; g < 4; ++g) P.x[g] = *(const f32x4*)(x + (size_t)row * DM + SLOT8(pn, wc, fq, g));
        return P;
    }
    __device__ __forceinline__ float operator()(const f32x4 (&v)[4], const Pre& P, const Tile& T, int row, int b, int pn, int wc, int fq) const {
        float ss = 0.f; f32x4 xm[4], x1[4];
#pragma unroll
        for (int g = 0; g < 4; ++g) {
            x1[g] = P.x[g] + T.g1[g] * v[g];
            ss += (x1[g][0] * x1[g][0] + x1[g][1] * x1[g][1]) + (x1[g][2] * x1[g][2] + x1[g][3] * x1[g][3]);
            xm[g] = x1[g] * T.a2[g];
        }
#pragma unroll
        for (int bj = 0; bj < 2; ++bj) { *(u32x4*)(X1B + (size_t)row * DM + SLOT8(pn, wc, fq, 2 * bj)) = pack8(x1[2 * bj], x1[2 * bj + 1]);
                                         *(u32x4*)(XM + (size_t)row * DM + SLOT8(pn, wc, fq, 2 * bj)) = pack8(xm[2 * bj], xm[2 * bj + 1]); }
        ss += __shfl_xor(ss, 16); ss += __shfl_xor(ss, 32);
        return ss;
    }
};
struct ResidEpi {
    static constexpr int BATCH = 8;
    struct Tile { f32x4 gg[4]; };
    struct Pre { u32x4 bs[2]; };
    const bf16_t* base; float* out; const float* gvec;
    __device__ __forceinline__ Tile tile_pre(int b, int pn, int wc, int fq) const {
        Tile T;
#pragma unroll
        for (int g = 0; g < 4; ++g) T.gg[g] = *(const f32x4*)(gvec + b * MODW + SLOT8(pn, wc, fq, g));
        return T;
    }
    __device__ __forceinline__ Pre row_pre(int row, int b, int pn, int wc, int fq) const {
        Pre P;
#pragma unroll
        for (int bj = 0; bj < 2; ++bj) P.bs[bj] = *(const u32x4*)(base + (size_t)row * DM + SLOT8(pn, wc, fq, 2 * bj));
        return P;
    }
    __device__ __forceinline__ void operator()(const f32x4 (&v)[4], const Pre& P, const Tile& T, int row, int b, int pn, int wc, int fq) const {
#pragma unroll
        for (int g = 0; g < 4; ++g) { const unsigned w0 = P.bs[g >> 1][2 * (g & 1)], w1 = P.bs[g >> 1][2 * (g & 1) + 1];
            const f32x4 bs = {bflo(w0), bfhi(w0), bflo(w1), bfhi(w1)};
            *(f32x4*)(out + (size_t)row * DM + SLOT8(pn, wc, fq, g)) = bs + T.gg[g] * v[g]; }
    }
};
struct GateUpEpi {
    static constexpr int BATCH = 4;
    struct Tile { f32x4 cg[2], cu[2]; };
    struct Pre { f32x4 s4; };
    bf16_t* ACT; const float* rowss; const float* cvec;
    __device__ __forceinline__ Tile tile_pre(int b, int pn, int wc, int fq) const {
        Tile T;
#pragma unroll
        for (int n = 0; n < 2; ++n) { const int slot = 256 * pn + 32 * wc + 8 * fq + 4 * n; T.cg[n] = *(const f32x4*)(cvec + b * (2 * DFF) + slot); T.cu[n] = *(const f32x4*)(cvec + b * (2 * DFF) + slot + 128); }
        return T;
    }
    __device__ __forceinline__ Pre row_pre(int row, int b, int pn, int wc, int fq) const { Pre P; P.s4 = *(const f32x4*)(rowss + (size_t)row * 4); return P; }
    __device__ __forceinline__ void operator()(const f32x4 (&v)[4], const Pre& P, const Tile& T, int row, int b, int pn, int wc, int fq) const {
        const float rstd = rsqrtf(((P.s4[0] + P.s4[1]) + (P.s4[2] + P.s4[3])) * (1.f / DM) + EPS);
        f32x4 y[2];
#pragma unroll
        for (int n = 0; n < 2; ++n) {
            const f32x4 gt = v[n] * rstd + T.cg[n], up = v[2 + n] * rstd + T.cu[n];
#pragma unroll
            for (int r = 0; r < 4; ++r) y[n][r] = silu_f(gt[r]) * up[r];
        }
        *(u32x4*)(ACT + (size_t)row * DFF + 128 * pn + 32 * wc + 8 * fq) = pack8(y[0], y[1]);
    }
};

namespace pg8 {
#define PG8_LAS __attribute__((address_space(3)))
typedef unsigned short bf16_t;
typedef short bf16x8 __attribute__((ext_vector_type(8)));
typedef float f32x4 __attribute__((ext_vector_type(4)));
typedef unsigned u32x4 __attribute__((ext_vector_type(4)));
constexpr int BM = 256, BK = 64, HALF = 128, HTB = HALF * BK * 2  , STAGE_BYTES = 8 * HTB, NXCD = 8, WGM = 4;

__host__ __device__ __forceinline__ int lds_byte(int r, int c) { const int st = (r >> 4) * 2 + (c >> 5), rr = r & 15, cc = c & 31, ob = rr * 64 + cc * 2; return st * 1024 + (ob ^ (((ob >> 9) & 1) << 5)); }
__host__ __device__ __forceinline__ void stage_rc(int b, int& R, int& C) { const int st = b / 1024, sb = b % 1024, swz = sb ^ (((sb >> 9) & 1) << 5); R = (st >> 1) * 16 + swz / 64; C = (st & 1) * 32 + (swz % 64) / 2; }
__host__ __device__ __forceinline__ int perm32(int rho) { const int n = rho >> 4, i = rho & 15; return 8 * (i >> 2) + 4 * n + (i & 3); }

struct Unit { int pm, pn, sel, half; };
struct Gemm { const bf16_t* A; const bf16_t* Bt; int M, N, K; const bf16_t* A2; const bf16_t* Bt2; };

struct StaticOrder {
    int nM, nN, nwg, G, c;
    __host__ __device__ void init(int M, int N, int G_, int c_) { nM = M / BM; nN = N / BM; nwg = nM * nN; G = G_; c = c_; }
    __host__ __device__ bool next(int i, Unit& u) const {
        const long L = (long)i * G + c; if (L >= nwg) return false;
        int wgid = (int)L; { const int q = nwg / NXCD, r = nwg % NXCD, xcd = wgid % NXCD, off = wgid / NXCD; wgid = (xcd < r ? xcd * (q + 1) : r * (q + 1) + (xcd - r) * q) + off; }
        const int nig = WGM * nN, gid = wgid / nig, fm = gid * WGM, gsz = (nM - fm) < WGM ? (nM - fm) : WGM;
        u.pm = fm + ((wgid % nig) % gsz); u.pn = (wgid % nig) / gsz; u.sel = 0; u.half = 0; return true;
    }
    __device__ __forceinline__ void a_ready(const Unit&) const {}
    __device__ __forceinline__ void done(const Unit&) const {}
};

template <class Epi, class Sched, bool ALIGN_EPI = false, bool SP2 = false>
__device__ __forceinline__ void gemm_phase(PG8_LAS unsigned char* lds, const Gemm g, const Sched& S, const Epi& E, const int WAVE_S) {
    const int wid = WAVE_S, lane = lane_id_(), tid = wid * 64 + lane, wr = wid >> 2, wc = wid & 3, fr = lane & 15, fq = lane >> 4;
    const int K = g.K, nt = K / BK;
    unsigned voffA[2], voffB[2];
#pragma unroll
    for (int i = 0; i < 2; ++i) { int R, C; stage_rc(tid * 16 + i * 8192, R, C); const int Rb = Epi::PERM ? ((R & ~31) + perm32(R & 31)) : R;
        voffA[i] = (unsigned)(R * K + C) * 2u; voffB[i] = (unsigned)(Rb * K + C) * 2u; }
    const size_t kstep = (size_t)(BK * 2);
    const size_t hstep = (size_t)HALF * K * 2;
    const size_t tstep = 2 * hstep;
    const unsigned ldsw = (unsigned)wid * 1024u;
    const int aoff = lds_byte(wr * 64 + fr, fq * 8), boff = lds_byte(wc * 32 + fr, fq * 8);
#define PG8_SA(b, h) (((b) * 2 + (h)) * HTB)
#define PG8_SB(b, h) ((4 + (b) * 2 + (h)) * HTB)
#define PG8_STAGE(bufoff, gbase, voff) do { _Pragma("unroll") for (int _i = 0; _i < 2; ++_i) \
        __builtin_amdgcn_global_load_lds((const unsigned*)((const char*)(gbase) + (voff)[_i]), (PG8_LAS unsigned*)(lds + (bufoff) + ldsw + _i * 8192), 16, 0, 0); } while (0)
#define PG8_LDA(dst, b, h) do { _Pragma("unroll") for (int m = 0; m < 4; ++m) _Pragma("unroll") for (int k = 0; k < 2; ++k) dst[m][k] = *(const PG8_LAS bf16x8*)(lds + PG8_SA(b, h) + aoff + m * 2048 + k * 1024); } while (0)
#define PG8_LDB(dst, b, h) do { _Pragma("unroll") for (int n = 0; n < 2; ++n) _Pragma("unroll") for (int k = 0; k < 2; ++k) dst[n][k] = *(const PG8_LAS bf16x8*)(lds + PG8_SB(b, h) + boff + n * 2048 + k * 1024); } while (0)
#define PG8_MMA(ai, bj, At, Bt) do { __builtin_amdgcn_s_setprio(1); _Pragma("unroll") for (int m = 0; m < 4; ++m) _Pragma("unroll") for (int n = 0; n < 2; ++n) _Pragma("unroll") for (int k = 0; k < 2; ++k) \
        acc[ai][bj][m][n] = __builtin_amdgcn_mfma_f32_16x16x32_bf16(Bt[n][k], At[m][k], acc[ai][bj][m][n], 0, 0, 0); __builtin_amdgcn_s_setprio(0); } while (0)
#define PG8_WAIT_V(n) asm volatile("s_waitcnt vmcnt(" #n ")" ::: "memory")
#define PG8_WAIT_L(n) asm volatile("s_waitcnt lgkmcnt(" #n ")" ::: "memory")
#define PG8_BAR __builtin_amdgcn_s_barrier()
#define PG8_SCHED __builtin_amdgcn_sched_barrier(0)
    Unit cur, nxt; int ui = 0;
    if (!S.next(0, cur)) return;
    f32x4 acc[2][2][4][2];
#pragma unroll
    for (int a = 0; a < 2; ++a)
#pragma unroll
        for (int b = 0; b < 2; ++b)
#pragma unroll
            for (int m = 0; m < 4; ++m)
#pragma unroll
                for (int n = 0; n < 2; ++n) acc[a][b][m][n] = (f32x4){0.f, 0.f, 0.f, 0.f};
    bf16x8 At[4][2], B0[2][2], B1[2][2];
    const char* cA = (const char*)(cur.sel ? g.A2 : g.A) + (size_t)cur.pm * tstep + (cur.half == 2 ? hstep : (size_t)0); const char* cB = (const char*)(cur.sel ? g.Bt2 : g.Bt) + (size_t)cur.pn * tstep;
    S.a_ready(cur);
    if constexpr (SP2) {
        PG8_STAGE(PG8_SB(0, 0), cB, voffB); PG8_STAGE(PG8_SB(0, 1), cB + hstep, voffB); PG8_STAGE(PG8_SA(0, 0), cA, voffA); PG8_STAGE(PG8_SA(0, 1), cA + hstep, voffA);
        if (wr == 1) PG8_BAR;
        PG8_WAIT_V(2); PG8_BAR;
        PG8_STAGE(PG8_SB(1, 0), cB + kstep, voffB); PG8_STAGE(PG8_SA(1, 0), cA + kstep, voffA); PG8_STAGE(PG8_SB(1, 1), cB + hstep + kstep, voffB);
        PG8_WAIT_V(6); PG8_BAR;
    } else {
        PG8_STAGE(PG8_SB(0, 0), cB, voffB); PG8_STAGE(PG8_SA(0, 0), cA, voffA); PG8_STAGE(PG8_SB(0, 1), cB + hstep, voffB); PG8_STAGE(PG8_SA(0, 1), cA + hstep, voffA);
        if (wr == 1) PG8_BAR;
        PG8_WAIT_V(4); PG8_BAR;
        PG8_STAGE(PG8_SB(1, 0), cB + kstep, voffB); PG8_STAGE(PG8_SA(1, 0), cA + kstep, voffA); PG8_STAGE(PG8_SB(1, 1), cB + hstep + kstep, voffB);
        PG8_WAIT_V(6); PG8_BAR;
    }
    for (;;) {
        const bool has_next = S.next(ui + 1, nxt);
        const char* nA = has_next ? (const char*)(nxt.sel ? g.A2 : g.A) + (size_t)nxt.pm * tstep + (nxt.half == 2 ? hstep : (size_t)0) : cA; const char* nB = has_next ? (const char*)(nxt.sel ? g.Bt2 : g.Bt) + (size_t)nxt.pn * tstep : cB;
        for (int t = 0; t < nt; t += 2) {
            const bool last = (t == nt - 2);
            const char* a1 = cA + (size_t)(t + 1) * kstep;
            const char* a2 = last ? nA : cA + (size_t)(t + 2) * kstep; const char* b2 = last ? nB : cB + (size_t)(t + 2) * kstep;
            const char* a3 = a2 + kstep; const char* b3 = b2 + kstep;
            if (last && has_next) S.a_ready(nxt);
            if constexpr (SP2) {
            PG8_LDB(B0, 0, 0); PG8_LDB(B1, 0, 1); PG8_SCHED; PG8_LDA(At, 0, 0); PG8_STAGE(PG8_SA(1, 1), a1 + hstep, voffA);
            PG8_WAIT_V(8); PG8_WAIT_L(0); PG8_BAR; PG8_MMA(0, 0, At, B0); PG8_MMA(0, 1, At, B1); PG8_BAR; PG8_SCHED;
            PG8_LDA(At, 0, 1); PG8_STAGE(PG8_SB(0, 0), b2, voffB); PG8_STAGE(PG8_SB(0, 1), b2 + hstep, voffB); PG8_STAGE(PG8_SA(0, 0), a2, voffA);
            PG8_WAIT_V(8); PG8_WAIT_L(0); PG8_BAR; PG8_MMA(1, 0, At, B0); PG8_MMA(1, 1, At, B1); PG8_BAR; PG8_SCHED;
            PG8_LDB(B0, 1, 0); PG8_LDB(B1, 1, 1); PG8_SCHED; PG8_LDA(At, 1, 0); PG8_STAGE(PG8_SA(0, 1), a2 + hstep, voffA);
            PG8_WAIT_V(8); PG8_WAIT_L(0); PG8_BAR; PG8_MMA(0, 0, At, B0); PG8_MMA(0, 1, At, B1); PG8_BAR; PG8_SCHED;
            PG8_LDA(At, 1, 1); PG8_STAGE(PG8_SB(1, 0), b3, voffB); PG8_STAGE(PG8_SB(1, 1), b3 + hstep, voffB); PG8_STAGE(PG8_SA(1, 0), a3, voffA);
            PG8_WAIT_V(8); PG8_WAIT_L(0); PG8_BAR; PG8_MMA(1, 0, At, B0); PG8_MMA(1, 1, At, B1); PG8_BAR; PG8_SCHED;
            } else {
            PG8_LDB(B0, 0, 0); PG8_SCHED; PG8_LDA(At, 0, 0); PG8_STAGE(PG8_SA(1, 1), a1 + hstep, voffA);
            PG8_WAIT_L(8); PG8_BAR; PG8_WAIT_L(0); PG8_MMA(0, 0, At, B0); PG8_BAR; PG8_SCHED;
            PG8_LDB(B1, 0, 1); PG8_STAGE(PG8_SB(0, 0), b2, voffB);
            PG8_BAR; PG8_WAIT_L(0); PG8_MMA(0, 1, At, B1); PG8_BAR;
            PG8_LDA(At, 0, 1); PG8_STAGE(PG8_SA(0, 0), a2, voffA);
            PG8_BAR; PG8_WAIT_L(0); PG8_MMA(1, 0, At, B0); PG8_BAR; PG8_SCHED;
            PG8_STAGE(PG8_SB(0, 1), b2 + hstep, voffB);
            PG8_WAIT_V(6); PG8_BAR; PG8_MMA(1, 1, At, B1); PG8_BAR;
            PG8_LDB(B0, 1, 0); PG8_SCHED; PG8_LDA(At, 1, 0); PG8_STAGE(PG8_SA(0, 1), a2 + hstep, voffA);
            PG8_WAIT_L(8); PG8_BAR; PG8_WAIT_L(0); PG8_MMA(0, 0, At, B0); PG8_BAR; PG8_SCHED;
            PG8_LDB(B1, 1, 1); PG8_STAGE(PG8_SB(1, 0), b3, voffB);
            PG8_BAR; PG8_WAIT_L(0); PG8_MMA(0, 1, At, B1); PG8_BAR;
            PG8_LDA(At, 1, 1); PG8_STAGE(PG8_SA(1, 0), a3, voffA);
            PG8_BAR; PG8_WAIT_L(0); PG8_MMA(1, 0, At, B0); PG8_BAR; PG8_SCHED;
            PG8_STAGE(PG8_SB(1, 1), b3 + hstep, voffB);
            PG8_WAIT_V(6); PG8_BAR; PG8_MMA(1, 1, At, B1); PG8_BAR;
            }
        }
        if constexpr (ALIGN_EPI) { if (wr == 0) PG8_BAR; }
        if constexpr (!Epi::AFTER_DRAIN) { E(acc, cur, wr, wc, fr, fq); S.done(cur); }
        if (!has_next) break;
        if (Epi::zero_after(cur))
#pragma unroll
        for (int a = 0; a < 2; ++a)
#pragma unroll
            for (int b = 0; b < 2; ++b)
#pragma unroll
                for (int m = 0; m < 4; ++m)
#pragma unroll
                    for (int n = 0; n < 2; ++n) acc[a][b][m][n] = (f32x4){0.f, 0.f, 0.f, 0.f};
        cur = nxt; cA = nA; cB = nB; ++ui;
        if constexpr (ALIGN_EPI) { if (wr == 1) PG8_BAR; }
    }
    PG8_WAIT_V(0);
    if constexpr (!ALIGN_EPI) { if (wr == 0) PG8_BAR; }
    PG8_BAR;
    if constexpr (Epi::AFTER_DRAIN) { E.fused(acc, cur, wr, wc, fr, fq, lds, wid, lane); S.done(cur); }
#undef PG8_SA
#undef PG8_SB
#undef PG8_STAGE
#undef PG8_LDA
#undef PG8_LDB
#undef PG8_MMA
#undef PG8_WAIT_V
#undef PG8_WAIT_L
#undef PG8_BAR
#undef PG8_SCHED
}
}

namespace pg8 {
template <class RowEpi> struct EpiRows {
    static constexpr bool PERM = true, AFTER_DRAIN = false;
    RowEpi R;
    static __device__ __forceinline__ bool zero_after(const Unit&) { return true; }
    __device__ __forceinline__ void operator()(const f32x4 (&acc)[2][2][4][2], const Unit& u, int wr, int wc, int fr, int fq) const {
        const int b = u.pm >> 3, row0 = u.pm * BM + wr * 64 + fr + (u.half == 2 ? HALF : 0);
        const typename RowEpi::Tile T = R.tile_pre(b, u.pn, wc, fq);
        constexpr int NB = RowEpi::BATCH;
#pragma unroll
        for (int g0 = 0; g0 < 8; g0 += NB) {
            if (u.half && g0 >= 4) break;
            typename RowEpi::Pre P[NB];
#pragma unroll
            for (int j = 0; j < NB; ++j) P[j] = R.row_pre(row0 + ((g0 + j) >> 2) * HALF + ((g0 + j) & 3) * 16, b, u.pn, wc, fq);
            __builtin_amdgcn_sched_barrier(0);
#pragma unroll
            for (int j = 0; j < NB; ++j) { const int ai = (g0 + j) >> 2, m = (g0 + j) & 3;
                const f32x4 v[4] = {acc[ai][0][m][0], acc[ai][0][m][1], acc[ai][1][m][0], acc[ai][1][m][1]};
                R(v, P[j], T, row0 + ai * HALF + m * 16, b, u.pn, wc, fq); }
        }
    }
};
struct EpiOutFused {
    static constexpr bool PERM = true, AFTER_DRAIN = true;
    OutEpi R;
    static __device__ __forceinline__ bool zero_after(const Unit&) { return true; }
    __device__ __forceinline__ void operator()(const f32x4 (&)[2][2][4][2], const Unit&, int, int, int, int) const {}
    __device__ __forceinline__ void fused(f32x4 (&acc)[2][2][4][2], const Unit& u, int wr, int wc, int fr, int fq, PG8_LAS unsigned char* lds, int wid, int lane) const {
        PG8_LAS float* sred = (PG8_LAS float*)lds;
        const int b = u.pm >> 3;
        const OutEpi::Tile T = R.tile_pre(b, u.pn, wc, fq);
        constexpr int NB = OutEpi::BATCH;
#pragma unroll
        for (int g0 = 0; g0 < 8; g0 += NB) {
            OutEpi::Pre P[NB];
#pragma unroll
            for (int j = 0; j < NB; ++j) P[j] = R.row_pre(u.pm * BM + ((g0 + j) >> 2) * HALF + wr * 64 + ((g0 + j) & 3) * 16 + fr, b, u.pn, wc, fq);
            __builtin_amdgcn_sched_barrier(0);
#pragma unroll
            for (int j = 0; j < NB; ++j) { const int ai = (g0 + j) >> 2, m = (g0 + j) & 3;
                const f32x4 v[4] = {acc[ai][0][m][0], acc[ai][0][m][1], acc[ai][1][m][0], acc[ai][1][m][1]};
                const int rl = ai * HALF + wr * 64 + m * 16 + fr;
                const float ss = R(v, P[j], T, u.pm * BM + rl, b, u.pn, wc, fq);
                if (fq == 0) sred[rl * 4 + wc] = ss; }
        }
        asm volatile("s_waitcnt lgkmcnt(0)" ::: "memory"); __builtin_amdgcn_s_barrier(); asm volatile("" ::: "memory");
        const int t = wid * 64 + lane;
        if (t < 256) { const f32x4 p = *(const PG8_LAS f32x4*)(sred + t * 4); R.rowss[(size_t)(u.pm * BM + t) * 4 + u.pn] = (p[0] + p[1]) + (p[2] + p[3]); }
    }
};
struct DoubleKOrder : StaticOrder {
    __host__ __device__ bool next(int i, Unit& u) const { const bool ok = StaticOrder::next(i >> 1, u); u.half = i & 1; return ok; }
};
template <class RowEpi> struct EpiRowsDK {
    static constexpr bool PERM = true, AFTER_DRAIN = false;
    RowEpi R;
    static __device__ __forceinline__ bool zero_after(const Unit& u) { return u.half == 1; }
    __device__ __forceinline__ void operator()(f32x4 (&acc)[2][2][4][2], const Unit& u, int wr, int wc, int fr, int fq) const {
        if (u.half == 0) return;
#pragma unroll
        for (int a = 0; a < 2; ++a)
#pragma unroll
            for (int b = 0; b < 2; ++b)
#pragma unroll
                for (int m = 0; m < 4; ++m)
#pragma unroll
                    for (int n = 0; n < 2; ++n) acc[a][b][m][n] = acc[a][b][m][n] * 0.5f;
        Unit v = u; v.half = 0; EpiRows<RowEpi> E{R}; E(acc, v, wr, wc, fr, fq);
    }
};
struct PairOrder : StaticOrder {
    __host__ __device__ bool next(int i, Unit& u) const { const bool ok = StaticOrder::next(i >> 1, u); u.sel = i & 1; return ok; }
};
struct BranchTileEpi {
    static constexpr bool PERM = true, AFTER_DRAIN = false;
    const bf16_t *GA, *GB; bf16_t* Y;
    static __device__ __forceinline__ bool zero_after(const Unit& u) { return u.sel == 1; }
    __device__ __forceinline__ void operator()(f32x4 (&acc)[2][2][4][2], const Unit& u, int wr, int wc, int fr, int fq) const {
        const size_t off0 = (size_t)(u.pm * BM + wr * 64 + fr) * 1024 + u.pn * BM + wc * 32 + 8 * fq;
#pragma unroll
        for (int g0 = 0; g0 < 8; g0 += 4) {
            u32x4 gb[4][2], ga[4][2];
#pragma unroll
            for (int j = 0; j < 4; ++j)
#pragma unroll
                for (int bj = 0; bj < 2; ++bj) { const size_t off = off0 + (size_t)(((g0 + j) >> 2) * HALF + ((g0 + j) & 3) * 16) * 1024 + bj * HALF;
                    gb[j][bj] = *(const u32x4*)(GB + off); if (u.sel == 0) ga[j][bj] = *(const u32x4*)(GA + off); }
            __builtin_amdgcn_sched_barrier(0);
#pragma unroll
            for (int j = 0; j < 4; ++j) { const int ai = (g0 + j) >> 2, m = (g0 + j) & 3;
#pragma unroll
                for (int bj = 0; bj < 2; ++bj) {
                    f32x4 sb[2];
#pragma unroll
                    for (int n = 0; n < 2; ++n) { sb[n][0] = fmaxf(bflo(gb[j][bj][2 * n]), 1e-30f); sb[n][1] = fmaxf(bfhi(gb[j][bj][2 * n]), 1e-30f); sb[n][2] = fmaxf(bflo(gb[j][bj][2 * n + 1]), 1e-30f); sb[n][3] = fmaxf(bfhi(gb[j][bj][2 * n + 1]), 1e-30f); }
                    if (u.sel == 0) {
#pragma unroll
                        for (int n = 0; n < 2; ++n) { f32x4 r; r[0] = bflo(ga[j][bj][2 * n]) * __builtin_amdgcn_rcpf(sb[n][0]); r[1] = bfhi(ga[j][bj][2 * n]) * __builtin_amdgcn_rcpf(sb[n][1]);
                            r[2] = bflo(ga[j][bj][2 * n + 1]) * __builtin_amdgcn_rcpf(sb[n][2]); r[3] = bfhi(ga[j][bj][2 * n + 1]) * __builtin_amdgcn_rcpf(sb[n][3]);
                            acc[ai][bj][m][n] = acc[ai][bj][m][n] * r; }
                    } else {
                        *(u32x4*)(Y + off0 + (size_t)(ai * HALF + m * 16) * 1024 + bj * HALF) = pack8(acc[ai][bj][m][0] * sb[0], acc[ai][bj][m][1] * sb[1]);
                    }
                }
            }
        }
    }
};
}

namespace attn_body {
using bf16=__hip_bfloat16;
using bf16x8=__attribute__((ext_vector_type(8)))short;
using s16x4=__attribute__((ext_vector_type(4)))short;
using f32x16=__attribute__((ext_vector_type(16)))float;
using u32x4=__attribute__((ext_vector_type(4)))unsigned;
constexpr int SEQ=2048,D=64;
constexpr int NW=8,QBLK=32,QB=QBLK*NW,KVBLK=64,NQB=SEQ/QB;
constexpr int ATTN_UNIT_ROWS=QB;
__device__ __forceinline__ int crow(int r,int hi){return (r&3)+8*(r>>2)+4*hi;}
#define SBAR() __builtin_amdgcn_sched_barrier(0)
template<bool LIN> __device__ __forceinline__ void cmask(f32x16&p0,f32x16&p1,int jb,int qrel,int hi){
  const float NEG=LIN?0.f:-INFINITY; int kb=64*jb+4*hi;
  #pragma unroll
  for(int r=0;r<16;++r){int kv=kb+(r&3)+8*(r>>2); if(kv>qrel)p0[r]=NEG; if(kv+32>qrel)p1[r]=NEG;}
}

constexpr int NSLOT=3, SLOTB=8192;
constexpr int LDS_RT=98304, LDS_RTS=106496, RS_NSLOT=6, RS_SLOTB=16384;
constexpr int LDS_K=0, LDS_V=NSLOT*SLOTB, LDS_WS=2*NSLOT*SLOTB, LDS_OST=LDS_WS+NW*64*4, LDS_BYTES=LDS_OST+NW*4096;
constexpr float C2=0.125f*1.4426950408889634f;
__device__ __forceinline__ void glds16s(const void*sbase,unsigned voff,unsigned lds_dst){unsigned keep;
  asm volatile("s_mov_b32 %0, m0\n\ts_mov_b32 m0, %3\n\ts_nop 4\n\tglobal_load_lds_dwordx4 %1, %2\n\ts_mov_b32 m0, %0":"=&s"(keep):"v"(voff),"s"(sbase),"s"(lds_dst):"memory");}
__device__ __forceinline__ const char* uptr(const char*p){const unsigned long long a=(unsigned long long)p;const unsigned lo=__builtin_amdgcn_readfirstlane((unsigned)a),hi=__builtin_amdgcn_readfirstlane((unsigned)(a>>32));return (const char*)(((unsigned long long)hi<<32)|lo);}
__device__ __forceinline__ void glds16(const void*gsrc,unsigned lds_dst){unsigned keep;
  asm volatile("s_mov_b32 %0, m0\n\ts_mov_b32 m0, %2\n\ts_nop 0\n\tglobal_load_lds_dwordx4 %1, off\n\ts_mov_b32 m0, %0":"=&s"(keep):"v"(gsrc),"s"(lds_dst):"memory");}
__device__ __forceinline__ float max3f(float a,float b,float c){float r;asm("v_max3_f32 %0, %1, %2, %3":"=v"(r):"v"(a),"v"(b),"v"(c));return r;}
__device__ __forceinline__ float max2f(float a,float b){float r;asm("v_max_f32_e32 %0, %1, %2":"=v"(r):"v"(a),"v"(b));return r;}
__device__ __forceinline__ float fadd_s(float a,float b){float r;asm("v_add_f32_e32 %0, %1, %2":"=v"(r):"v"(a),"v"(b));return r;}
__device__ __forceinline__ float fsub_s(float a,float b){float r;asm("v_sub_f32_e32 %0, %1, %2":"=v"(r):"v"(a),"v"(b));return r;}
typedef float f32x2_t __attribute__((ext_vector_type(2))); typedef __bf16 bf16x2_t __attribute__((ext_vector_type(2)));
__device__ __forceinline__ unsigned cvtpk_s(float lo,float hi){f32x2_t v={lo,hi};bf16x2_t b=__builtin_convertvector(v,bf16x2_t);return __builtin_bit_cast(unsigned,b);}
#define WAIT_BAR(N) asm volatile("s_waitcnt vmcnt(" #N ") lgkmcnt(0)\n\ts_barrier":::"memory")

__device__ __forceinline__ void qkt(f32x16&p0,f32x16&p1,const char*Kslot,const bf16x8*qr,const f32x16&negm,int r32,int hi){
  const char*kb=Kslot+hi*1024+r32*16;
  #pragma unroll
  for(int d0=0;d0<4;++d0){
    const bf16x8 b0=*reinterpret_cast<const bf16x8*>(kb+d0*2048);
    const bf16x8 b1=*reinterpret_cast<const bf16x8*>(kb+d0*2048+512);
    if(d0==0){p0=__builtin_amdgcn_mfma_f32_32x32x16_bf16(b0,qr[0],negm,0,0,0);p1=__builtin_amdgcn_mfma_f32_32x32x16_bf16(b1,qr[0],negm,0,0,0);}
    else{p0=__builtin_amdgcn_mfma_f32_32x32x16_bf16(b0,qr[d0],p0,0,0,0);p1=__builtin_amdgcn_mfma_f32_32x32x16_bf16(b1,qr[d0],p1,0,0,0);}}
}
typedef __attribute__((address_space(3))) const char* lds_cptr;
typedef short v4i16_t __attribute__((ext_vector_type(4)));
__device__ __forceinline__ void kload8(bf16x8*kf,lds_cptr kp){
  kf[0]=*(const __attribute__((address_space(3))) bf16x8*)(kp);      kf[1]=*(const __attribute__((address_space(3))) bf16x8*)(kp+512);
  kf[2]=*(const __attribute__((address_space(3))) bf16x8*)(kp+2048); kf[3]=*(const __attribute__((address_space(3))) bf16x8*)(kp+2560);
  kf[4]=*(const __attribute__((address_space(3))) bf16x8*)(kp+4096); kf[5]=*(const __attribute__((address_space(3))) bf16x8*)(kp+4608);
  kf[6]=*(const __attribute__((address_space(3))) bf16x8*)(kp+6144); kf[7]=*(const __attribute__((address_space(3))) bf16x8*)(kp+6656);
}
__device__ __forceinline__ void kload2(bf16x8*kf,lds_cptr kp,int j){ kf[2*j]=*(const __attribute__((address_space(3))) bf16x8*)(kp+j*2048); kf[2*j+1]=*(const __attribute__((address_space(3))) bf16x8*)(kp+j*2048+512); }
__device__ __forceinline__ s16x4 vtr(lds_cptr p){ return __builtin_bit_cast(s16x4,__builtin_amdgcn_ds_read_tr16_b64_v4i16((__attribute__((address_space(3))) v4i16_t*)p)); }
__device__ __forceinline__ float rowmax(const f32x16&p0,const f32x16&p1){
  float a=max3f(p0[0],p0[1],p1[0]),b=max3f(p0[2],p0[3],p1[1]);a=max3f(a,p1[2],p1[3]);
  #pragma unroll
  for(int r=4;r<16;r+=4){a=max3f(a,p0[r],p0[r+1]);b=max3f(b,p0[r+2],p0[r+3]);a=max3f(a,p1[r],p1[r+1]);b=max3f(b,p1[r+2],p1[r+3]);}
  const float m=max2f(a,b);
  auto rr=__builtin_amdgcn_permlane32_swap(__float_as_uint(m),__float_as_uint(m),false,false);
  return max2f(__uint_as_float(rr[0]),__uint_as_float(rr[1]));
}
__device__ __forceinline__ void pv(f32x16*o,int vb,bf16x8 pa0,bf16x8 pa1,bf16x8 pa2,bf16x8 pa3){
  #pragma unroll
  for(int d0=0;d0<2;++d0){s16x4 lo[4],hi[4];
    #pragma unroll
    for(int ks=0;ks<4;++ks){
      asm volatile("ds_read_b64_tr_b16 %0,%1 offset:%c2":"=&v"(lo[ks]):"v"(vb),"i"(d0*4096+ks*1024):"memory");
      asm volatile("ds_read_b64_tr_b16 %0,%1 offset:%c2":"=&v"(hi[ks]):"v"(vb),"i"(d0*4096+ks*1024+512):"memory");}
    asm volatile("s_waitcnt lgkmcnt(0)":::"memory");SBAR();
    #define PK(k) (bf16x8){lo[k][0],lo[k][1],lo[k][2],lo[k][3],hi[k][0],hi[k][1],hi[k][2],hi[k][3]}
    o[d0]=__builtin_amdgcn_mfma_f32_32x32x16_bf16(pa0,PK(0),o[d0],0,0,0);
    o[d0]=__builtin_amdgcn_mfma_f32_32x32x16_bf16(pa1,PK(1),o[d0],0,0,0);
    o[d0]=__builtin_amdgcn_mfma_f32_32x32x16_bf16(pa2,PK(2),o[d0],0,0,0);
    o[d0]=__builtin_amdgcn_mfma_f32_32x32x16_bf16(pa3,PK(3),o[d0],0,0,0);
    #undef PK
  }
}

#ifndef ATTN_STORE16
#define ATTN_STORE16(p,v) (*(u32x4*)(p)=(v))
#endif
template<int THRL,bool LIN> __device__ __forceinline__ void attn_unit(long rowbase,int qb,const bf16*Q,int QP,const bf16*__restrict__ K,int KP,const bf16*__restrict__ V,int VP,bf16*O,int OP,char*shm,const bool xr,const int WAVE_S){
  int lane=lane_id_(); asm volatile("":"+v"(lane)); const int r32=lane&31,hi=lane>>5; const int wid=WAVE_S;
  const int q0=qb*QB;
  const bf16*Qw=Q+(rowbase+q0+wid*QBLK)*QP;
  const bf16*Kh=K+rowbase*KP,*Vh=V+rowbase*VP;
  const unsigned lds0=(unsigned)(uintptr_t)shm;
  float*wsf=(float*)(shm+LDS_WS)+wid*64;
  const unsigned koff=(unsigned)((lane*KP+wid*8)*2);
  const unsigned voff=(unsigned)(((16*(wid&3)+(lane>>2))*VP+(wid>>2)*32+(lane&3)*8)*2);
  const unsigned kdst=lds0+LDS_K+wid*1024, vdst=lds0+LDS_V+wid*1024;
  #define DMA_K(t,slot) glds16s(uptr((const char*)(Kh+(long)(t)*KVBLK*KP)),koff,(unsigned)__builtin_amdgcn_readfirstlane(kdst+(slot)))
  #define DMA_V(t,slot) glds16s(uptr((const char*)(Vh+(long)(t)*KVBLK*VP)),voff,(unsigned)__builtin_amdgcn_readfirstlane(vdst+(slot)))
  const int vb0=(int)(lds0+LDS_V)+((lane>>4)&1)*32+(lane&3)*8+(4*hi+((lane&15)>>2))*64;
  const char*Kbase=shm+LDS_K; bf16x8 kf[8];
  const lds_cptr shm3=(lds_cptr)shm; const lds_cptr kp0=shm3+LDS_K+hi*1024+r32*16; const lds_cptr vp0=shm3+LDS_V+((lane>>4)&1)*32+(lane&3)*8+(4*hi+((lane&15)>>2))*64;
  const int NT=(q0+QB)/KVBLK;
  DMA_K(0,0);DMA_V(0,0);DMA_K(1,SLOTB);
  bf16x8 qr[4];
  #pragma unroll
  for(int d0=0;d0<4;++d0)qr[d0]=*reinterpret_cast<const bf16x8*>(&Qw[(long)r32*QP+d0*16+hi*8]);
  float mhat=0.f,l_reg=0.f;f32x16 o[2];o[0]=f32x16{};o[1]=f32x16{};f32x16 negm;
  if constexpr(LIN){ if(xr){ const lds_cptr rt=(lds_cptr)shm+LDS_RT;
    _Pragma("unroll") for(int e2=0;e2<2;++e2) _Pragma("unroll") for(int d0=0;d0<4;++d0){ const bf16x8 rf=*(const __attribute__((address_space(3))) bf16x8*)(rt+((32*e2+r32)*64+16*d0+8*hi)*2);
      o[e2]=__builtin_amdgcn_mfma_f32_32x32x16_bf16(qr[d0],rf,o[e2],0,0,0);} } }
  #define NEGM (LIN?f32x16{}:negm)
  const int qrel=wid*QBLK+r32;
  #define CMASK(P0,P1,t) do{int jb_=(t)-(NT-4); if(jb_>=0)cmask<LIN>(P0,P1,jb_,qrel,hi);}while(0)
  bool resc=false;
  #define START(P0,P1) do{ if constexpr(!LIN){ const float rm=rowmax(P0,P1); resc=false; \
    { const float dl=rm; mhat=fadd_s(mhat,dl); \
      _Pragma("unroll") for(int r=0;r<16;++r){P0[r]=fsub_s(P0[r],dl);P1[r]=fsub_s(P1[r],dl);} \
      _Pragma("unroll") for(int r=0;r<16;++r)negm[r]=-mhat; asm volatile("":"+v"(negm)); } \
    _Pragma("unroll") for(int r=0;r<16;++r)P0[r]=__builtin_amdgcn_exp2f(P0[r]); } }while(0)
  #define RESC() do{ if(resc){ asm volatile("s_waitcnt lgkmcnt(0)":::"memory"); \
      _Pragma("unroll") for(int d_=0;d_<2;++d_) _Pragma("unroll") for(int r=0;r<16;++r)o[d_][r]*=wsf[crow(r,hi)]; } }while(0)
  f32x16 pA0,pA1,pB0,pB1;
  int sl_prev=0,sl_cur=0,sl_next=SLOTB;
  #define ROT() do{sl_prev=sl_cur;sl_cur=sl_next;sl_next=(sl_next==(NSLOT-1)*SLOTB)?0:sl_next+SLOTB;}while(0)
  DMA_K(2,2*SLOTB);
  WAIT_BAR(3);
  qkt(pA0,pA1,Kbase,qr,f32x16{},r32,hi);asm volatile("s_nop 15\n\ts_nop 7":"+v"(pA0),"+v"(pA1));CMASK(pA0,pA1,0);
  START(pA0,pA1);
  if constexpr(!LIN){ _Pragma("unroll") for(int r=0;r<16;++r)pA1[r]=__builtin_amdgcn_exp2f(pA1[r]); }
  WAIT_BAR(0);
  DMA_K(3,0);DMA_V(1,SLOTB);
  ROT();
  kload8(kf,kp0+sl_cur);
  WAIT_BAR(2);
  s16x4 vlo[8],vhi[8]; u32x4 pw0,pw1,pw2,pw3;
  #define PKW(P,B) cvtpk_s(P[B],P[B+1])
  #define PAF(k) __builtin_bit_cast(bf16x8,pw##k)
  #define VFR(i) (bf16x8){vlo[i][0],vlo[i][1],vlo[i][2],vlo[i][3],vhi[i][0],vhi[i][1],vhi[i][2],vhi[i][3]}
  #define PIN(x) asm volatile("":"+v"(x))
  #define MX3(a,b,c) __builtin_fmaxf(__builtin_fmaxf((a),(b)),(c))
  #define GAPA(MF,A0,A1,A2,A3,W0,W1,PW) do{ MF; if constexpr(!LIN){ sacc+=A0; sacc+=A1; sacc+=A2; sacc+=A3; PIN(sacc); } W0; W1; PIN(PW); SBAR(); }while(0)
  #define EX(v) __builtin_amdgcn_exp2f(v)
  #define GAPB(MF,X,B) do{ MF; if constexpr(!LIN){ X[B]=EX(X[B]); X[B+1]=EX(X[B+1]); X[B+2]=EX(X[B+2]); X[B+3]=EX(X[B+3]); PIN(X); } SBAR(); }while(0)
  #define VRD(i) do{ vlo[i]=vtr(vp_+(((i)>>2)*4096+((i)&3)*1024)); vhi[i]=vtr(vp_+(((i)>>2)*4096+((i)&3)*1024+512)); }while(0)
  #define KRD(G,j) do{ if(G){ kload2(kf,kp0+sl_next,j); SBAR(); } }while(0)
  #define STEP(C0,C1,P0,P1,t,GK,GV,GL) do{ SBAR(); \
    const lds_cptr vp_=vp0+sl_prev; \
    VRD(0); SBAR(); float sacc=(P0[0]+P0[1]); \
    GAPA(C0=__builtin_amdgcn_mfma_f32_32x32x16_bf16(kf[0],qr[0],NEGM,0,0,0), P0[2],P0[3],P0[4],P0[5],     pw0[0]=PKW(P0,0), pw0[1]=PKW(P0,2), pw0); \
    VRD(4); SBAR(); GAPA(C1=__builtin_amdgcn_mfma_f32_32x32x16_bf16(kf[1],qr[0],NEGM,0,0,0), P0[6],P0[7],P0[8],P0[9],     pw0[2]=PKW(P0,4), pw0[3]=PKW(P0,6), pw0); \
    VRD(1); SBAR(); GAPA(C0=__builtin_amdgcn_mfma_f32_32x32x16_bf16(kf[2],qr[1],C0,0,0,0),   P0[10],P0[11],P0[12],P0[13], pw1[0]=PKW(P0,8), pw1[1]=PKW(P0,10), pw1); \
    VRD(5); SBAR(); GAPA(C1=__builtin_amdgcn_mfma_f32_32x32x16_bf16(kf[3],qr[1],C1,0,0,0),   P0[14],P0[15],P1[0],P1[1],   pw1[2]=PKW(P0,12),pw1[3]=PKW(P0,14), pw1); \
    VRD(2); SBAR(); GAPA(C0=__builtin_amdgcn_mfma_f32_32x32x16_bf16(kf[4],qr[2],C0,0,0,0),   P1[2],P1[3],P1[4],P1[5],     pw2[0]=PKW(P1,0), pw2[1]=PKW(P1,2), pw2); \
    VRD(6); SBAR(); GAPA(C1=__builtin_amdgcn_mfma_f32_32x32x16_bf16(kf[5],qr[2],C1,0,0,0),   P1[6],P1[7],P1[8],P1[9],     pw2[2]=PKW(P1,4), pw2[3]=PKW(P1,6), pw2); \
    VRD(3); SBAR(); GAPA(C0=__builtin_amdgcn_mfma_f32_32x32x16_bf16(kf[6],qr[3],C0,0,0,0),   P1[10],P1[11],P1[12],P1[13], pw3[0]=PKW(P1,8), pw3[1]=PKW(P1,10), pw3); \
    VRD(7); SBAR(); GAPA(C1=__builtin_amdgcn_mfma_f32_32x32x16_bf16(kf[7],qr[3],C1,0,0,0),   P1[14],P1[15],0.f,0.f,       pw3[2]=PKW(P1,12),pw3[3]=PKW(P1,14), pw3); \
    l_reg+=sacc; \
    if(GK){DMA_K((t)+3,sl_cur);} if(GV){DMA_V((t)+1,sl_next);} \
    CMASK(C0,C1,t); \
    resc=false; if constexpr(!LIN){ float a=MX3(C0[0],C0[1],C1[0]),b=MX3(C0[2],C0[3],C1[1]); a=MX3(a,C1[2],C1[3]); \
      _Pragma("unroll") for(int r=4;r<16;r+=4){a=MX3(a,C0[r],C0[r+1]);b=MX3(b,C0[r+2],C0[r+3]);a=MX3(a,C1[r],C1[r+1]);b=MX3(b,C1[r+2],C1[r+3]);} \
      float rm=__builtin_fmaxf(a,b); { auto rr=__builtin_amdgcn_permlane32_swap(__float_as_uint(rm),__float_as_uint(rm),false,false); rm=__builtin_fmaxf(__uint_as_float(rr[0]),__uint_as_float(rr[1])); } \
      if(__builtin_expect(__any(rm>(float)THRL),0)){ const float dl=__builtin_fmaxf(rm,0.f); mhat+=dl; \
        _Pragma("unroll") for(int r=0;r<16;++r){C0[r]-=dl;C1[r]-=dl;} \
        _Pragma("unroll") for(int r=0;r<16;++r)negm[r]=-mhat; asm volatile("":"+v"(negm)); \
        const float f=__builtin_amdgcn_exp2f(-dl); l_reg*=f; if(hi==0)wsf[r32]=f; resc=true; } } \
    SBAR(); \
    GAPB(o[0]=__builtin_amdgcn_mfma_f32_32x32x16_bf16(PAF(0),VFR(0),o[0],0,0,0), C0,0); \
    GAPB(o[1]=__builtin_amdgcn_mfma_f32_32x32x16_bf16(PAF(0),VFR(4),o[1],0,0,0), C0,4); \
    KRD(GL,0); GAPB(o[0]=__builtin_amdgcn_mfma_f32_32x32x16_bf16(PAF(1),VFR(1),o[0],0,0,0), C0,8); \
    KRD(GL,1); GAPB(o[1]=__builtin_amdgcn_mfma_f32_32x32x16_bf16(PAF(1),VFR(5),o[1],0,0,0), C0,12); \
    KRD(GL,2); GAPB(o[0]=__builtin_amdgcn_mfma_f32_32x32x16_bf16(PAF(2),VFR(2),o[0],0,0,0), C1,0); \
    KRD(GL,3); GAPB(o[1]=__builtin_amdgcn_mfma_f32_32x32x16_bf16(PAF(2),VFR(6),o[1],0,0,0), C1,4); \
    GAPB(o[0]=__builtin_amdgcn_mfma_f32_32x32x16_bf16(PAF(3),VFR(3),o[0],0,0,0), C1,8); \
    GAPB(o[1]=__builtin_amdgcn_mfma_f32_32x32x16_bf16(PAF(3),VFR(7),o[1],0,0,0), C1,12); \
    }while(0)
  int t=1;
  #undef CMASK
  #define CMASK(P0,P1,t) do{}while(0)
  for(;t+5<NT;t+=2){
    STEP(pB0,pB1,pA0,pA1,t,true,true,true);     WAIT_BAR(2); RESC(); ROT();
    STEP(pA0,pA1,pB0,pB1,t+1,true,true,true);   WAIT_BAR(2); RESC(); ROT();
  }
  #undef CMASK
  #define CMASK(P0,P1,t) do{int jb_=(t)-(NT-4); if(jb_>=0)cmask<LIN>(P0,P1,jb_,qrel,hi);}while(0)
  #define ENDW(tt) do{ if((tt)+3<NT){WAIT_BAR(2);} else if((tt)+2<NT){WAIT_BAR(1);} else {WAIT_BAR(0);} }while(0)
  for(;t+1<NT;t+=2){
    STEP(pB0,pB1,pA0,pA1,t,(t+3<NT),(t+1<NT),(t+1<NT));       ENDW(t);   RESC(); ROT();
    STEP(pA0,pA1,pB0,pB1,t+1,(t+4<NT),(t+2<NT),(t+2<NT));     ENDW(t+1); RESC(); ROT();
  }
  STEP(pB0,pB1,pA0,pA1,NT-1,false,false,false); RESC();
  { float sacc=pB0[0]+pB0[1]; _Pragma("unroll") for(int r=2;r<16;++r)sacc+=pB0[r]; _Pragma("unroll") for(int r=0;r<16;++r)sacc+=pB1[r]; l_reg+=sacc;
    pw0=(u32x4){PKW(pB0,0),PKW(pB0,2),PKW(pB0,4),PKW(pB0,6)};pw1=(u32x4){PKW(pB0,8),PKW(pB0,10),PKW(pB0,12),PKW(pB0,14)};pw2=(u32x4){PKW(pB1,0),PKW(pB1,2),PKW(pB1,4),PKW(pB1,6)};pw3=(u32x4){PKW(pB1,8),PKW(pB1,10),PKW(pB1,12),PKW(pB1,14)};
    SBAR(); pv(o,vb0+sl_cur,PAF(0),PAF(1),PAF(2),PAF(3)); }
  #undef PKW
  #undef PAF
  #undef VFR
  #undef PIN
  #undef MX3
  #undef GAPA
  #undef GAPB
  #undef EX
  #undef VRD
  #undef KRD
  #undef STEP
  #undef ENDW
  {auto rr=__builtin_amdgcn_permlane32_swap(__float_as_uint(l_reg),__float_as_uint(l_reg),false,false);l_reg=__uint_as_float(rr[0])+__uint_as_float(rr[1]);}
  if(hi==0)wsf[32+r32]=l_reg;asm volatile("s_waitcnt lgkmcnt(0)":::"memory");
  float rli[16];
  #pragma unroll
  for(int r=0;r<16;++r)rli[r]=LIN?1.f:__builtin_amdgcn_rcpf(wsf[32+crow(r,hi)]);
  bf16*Ow=O+(rowbase+q0+wid*QBLK)*OP;
  { bf16*stg=(bf16*)(shm+LDS_OST)+wid*2048;
    #pragma unroll
    for(int r=0;r<16;++r){const int orow=crow(r,hi);
      #pragma unroll
      for(int d0=0;d0<2;++d0)stg[orow*64+d0*32+r32]=__float2bfloat16(o[d0][r]*rli[r]);}
    asm volatile("s_waitcnt lgkmcnt(0)":::"memory");
    int lane_e=lane; asm volatile("":"+v"(lane_e));
    #pragma unroll
    for(int i=0;i<4;++i){const int row=i*8+(lane_e>>3),ch=lane_e&7; const u32x4 v=*(const u32x4*)(stg+row*64+ch*8); ATTN_STORE16(Ow+(long)row*OP+ch*8,v);} }
  asm volatile("s_waitcnt lgkmcnt(0)\n\ts_barrier":::"memory");
  #undef DMA_K
  #undef DMA_V
  #undef CMASK
  #undef START
  #undef RESC
  #undef ROT
}
constexpr int ATTN_LDS_BYTES=LDS_BYTES;
__device__ __forceinline__ void ret_state(long rowbase,int nt,const bf16*__restrict__ K,int KP,const bf16*__restrict__ V,int VP,char*shm,const int WAVE_S){
  int lane=lane_id_(); asm volatile("":"+v"(lane)); const int r32=lane&31,hi=lane>>5; const int wid=WAVE_S;
  const bf16*Kh=K+rowbase*KP,*Vh=V+rowbase*VP;
  const unsigned lds0=(unsigned)(uintptr_t)shm;
  const unsigned koff=(unsigned)(((16*(wid&3)+(lane>>2))*KP+(wid>>2)*32+(lane&3)*8)*2);
  const unsigned voff=(unsigned)(((16*(wid&3)+(lane>>2))*VP+(wid>>2)*32+(lane&3)*8)*2);
  const unsigned kdst=lds0+wid*1024, vdst=lds0+8192+wid*1024;
  #define RS_DMA(t,slot) do{ glds16s(uptr((const char*)(Kh+(long)(t)*KVBLK*KP)),koff,(unsigned)__builtin_amdgcn_readfirstlane(kdst+(slot))); \
                             glds16s(uptr((const char*)(Vh+(long)(t)*KVBLK*VP)),voff,(unsigned)__builtin_amdgcn_readfirstlane(vdst+(slot))); }while(0)
  const lds_cptr shm3=(lds_cptr)shm;
  const int frag=((lane>>4)&1)*32+(lane&3)*8+(4*hi+((lane&15)>>2))*64;
  const int eb=wid&1, db=(wid>>1)&1, kh=wid>>2;
  f32x16 acc=f32x16{};
  { int s=0; for(int t=0;t<5&&t<nt;++t){ RS_DMA(t,s); s+=RS_SLOTB; } }
  int sl=0, sl_free=5*RS_SLOTB;
  for(int t=0;t<nt;++t){
    const int after=(nt-1-t)<4?(nt-1-t):4;
    if(after==4)WAIT_BAR(8); else if(after==3)WAIT_BAR(6); else if(after==2)WAIT_BAR(4); else if(after==1)WAIT_BAR(2); else WAIT_BAR(0);
    if(t+5<nt)RS_DMA(t+5,sl_free);
    const lds_cptr kp=shm3+sl+frag, vp=shm3+sl+8192+frag;
    #pragma unroll
    for(int k2=0;k2<2;++k2){ const int ks=2*kh+k2;
      const s16x4 alo=vtr(vp+eb*4096+ks*1024), ahi=vtr(vp+eb*4096+ks*1024+512), blo=vtr(kp+db*4096+ks*1024), bhi=vtr(kp+db*4096+ks*1024+512);
      const bf16x8 af=(bf16x8){alo[0],alo[1],alo[2],alo[3],ahi[0],ahi[1],ahi[2],ahi[3]}, bf=(bf16x8){blo[0],blo[1],blo[2],blo[3],bhi[0],bhi[1],bhi[2],bhi[3]};
      acc=__builtin_amdgcn_mfma_f32_32x32x16_bf16(af,bf,acc,0,0,0); }
    sl_free=sl; sl=(sl==(RS_NSLOT-1)*RS_SLOTB)?0:sl+RS_SLOTB;
  }
  #undef RS_DMA
  __attribute__((address_space(3))) float*part=(__attribute__((address_space(3))) float*)((__attribute__((address_space(3))) char*)shm+LDS_RTS)+(wid&3)*1024;
  if(kh==1){ _Pragma("unroll") for(int r=0;r<16;++r)part[r*64+lane]=acc[r]; }
  asm volatile("s_waitcnt lgkmcnt(0)\n\ts_barrier":::"memory");
  if(kh==0){ __attribute__((address_space(3))) unsigned short*rt=(__attribute__((address_space(3))) unsigned short*)((__attribute__((address_space(3))) char*)shm+LDS_RT);
    _Pragma("unroll") for(int r=0;r<16;++r){ const float v=acc[r]+part[r*64+lane]; rt[(32*eb+crow(r,hi))*64+32*db+r32]=(unsigned short)(cvtpk_s(v,0.f)&0xffffu); } }
  asm volatile("s_waitcnt lgkmcnt(0)\n\ts_barrier":::"memory");
}
constexpr int A2_K=0, A2_V=3*8192, A2_WS=A2_V+3*16384, A2_OST=A2_WS+NW*64*4, A2_BYTES=A2_OST+NW*4096;
template<int THRL> __device__ __forceinline__ void attn_unit2(long rowbase,int qb,const bf16*Q,int QP,const bf16*__restrict__ K,int KP,const bf16*__restrict__ V,int VP,bf16*O,int OP,char*shm,const int WAVE_S){
  int lane=lane_id_(); asm volatile("":"+v"(lane)); const int r32=lane&31,hi=lane>>5; const int wid=WAVE_S;
  const int q0=qb*QB;
  const bf16*Qw=Q+(rowbase+q0+wid*QBLK)*QP;
  const bf16*Kh=K+rowbase*KP,*Vh=V+rowbase*VP;
  const unsigned lds0=(unsigned)(uintptr_t)shm;
  float*wsf=(float*)(shm+A2_WS)+wid*64;
  const unsigned koff=(unsigned)((lane*KP+wid*8)*2);
  const unsigned voff=(unsigned)(((16*(wid&3)+(lane>>2))*VP+(wid>>2)*32+(lane&3)*8)*2);
  const unsigned kdst=lds0+A2_K+wid*1024, vdst=lds0+A2_V+wid*1024;
  #define DMA_K(t,slot) glds16s(uptr((const char*)(Kh+(long)(t)*KVBLK*KP)),koff,(unsigned)__builtin_amdgcn_readfirstlane(kdst+(slot)))
  #define DMA_V(t,slot) do{ glds16s(uptr((const char*)(Vh+(long)(t)*KVBLK*VP)),voff,(unsigned)__builtin_amdgcn_readfirstlane(vdst+2*(slot))); \
                            glds16s(uptr((const char*)(Vh+(long)(t)*KVBLK*VP)+128),voff,(unsigned)__builtin_amdgcn_readfirstlane(vdst+2*(slot)+8192)); }while(0)
  const char*Kbase=shm+A2_K; bf16x8 kf[8];
  const lds_cptr shm3=(lds_cptr)shm; const lds_cptr kp0=shm3+A2_K+hi*1024+r32*16; const lds_cptr vp0=shm3+A2_V+((lane>>4)&1)*32+(lane&3)*8+(4*hi+((lane&15)>>2))*64;
  const int NT=(q0+QB)/KVBLK;
  DMA_K(0,0);DMA_V(0,0);DMA_K(1,SLOTB);
  bf16x8 qr[4];
  #pragma unroll
  for(int d0=0;d0<4;++d0)qr[d0]=*reinterpret_cast<const bf16x8*>(&Qw[(long)r32*QP+d0*16+hi*8]);
  float mhat=0.f,l_reg=0.f;f32x16 o[4];o[0]=f32x16{};o[1]=f32x16{};o[2]=f32x16{};o[3]=f32x16{};
  const int qrel=wid*QBLK+r32;
  #define CMASK(P0,P1,t) do{int jb_=(t)-(NT-4); if(jb_>=0)cmask<false>(P0,P1,jb_,qrel,hi);}while(0)
  bool resc=false;
  #define RESC() do{ if(resc){ asm volatile("s_waitcnt lgkmcnt(0)":::"memory"); \
      _Pragma("unroll") for(int d_=0;d_<4;++d_) _Pragma("unroll") for(int r=0;r<16;++r)o[d_][r]*=wsf[crow(r,hi)]; } }while(0)
  f32x16 pA0,pA1,pB0,pB1;
  int sl_prev=0,sl_cur=0,sl_next=SLOTB;
  #define ROT() do{sl_prev=sl_cur;sl_cur=sl_next;sl_next=(sl_next==(NSLOT-1)*SLOTB)?0:sl_next+SLOTB;}while(0)
  DMA_K(2,2*SLOTB);
  WAIT_BAR(4);
  qkt(pA0,pA1,Kbase,qr,f32x16{},r32,hi);asm volatile("s_nop 15\n\ts_nop 7":"+v"(pA0),"+v"(pA1));CMASK(pA0,pA1,0);
  { const float rm=rowmax(pA0,pA1); mhat=rm;
    _Pragma("unroll") for(int r=0;r<16;++r){pA0[r]=__builtin_amdgcn_exp2f(pA0[r]-mhat);pA1[r]=__builtin_amdgcn_exp2f(pA1[r]-mhat);} }
  WAIT_BAR(0);
  DMA_K(3,0);DMA_V(1,SLOTB);
  ROT();
  kload8(kf,kp0+sl_cur);
  WAIT_BAR(3);
  s16x4 fa_lo,fa_hi,fb_lo,fb_hi,fc_lo,fc_hi,fd_lo,fd_hi; u32x4 pw0,pw1,pw2,pw3;
  #define PKW(P,B) cvtpk_s(P[B],P[B+1])
  #define PAF(k) __builtin_bit_cast(bf16x8,pw##k)
  #define PIN(x) asm volatile("":"+v"(x))
  #define MX3(a,b,c) __builtin_fmaxf(__builtin_fmaxf((a),(b)),(c))
  #define VOFF(i) ((((i)&3)>>1)*8192+((i)&1)*4096+((i)>>2)*1024)
  #define VRDX(X,i) do{ X##_lo=vtr(vp_+VOFF(i)); X##_hi=vtr(vp_+VOFF(i)+512); }while(0)
  #define VFRX(X) (bf16x8){X##_lo[0],X##_lo[1],X##_lo[2],X##_lo[3],X##_hi[0],X##_hi[1],X##_hi[2],X##_hi[3]}
  #define GAPA(MF,A0,A1,A2,A3,W0,W1,PW) do{ MF; sacc+=A0; sacc+=A1; sacc+=A2; sacc+=A3; PIN(sacc); W0; W1; PIN(PW); SBAR(); }while(0)
  #define EX(v) __builtin_amdgcn_exp2f(v)
  #define GAPB(MF,X,B) do{ MF; X[B]=EX(X[B]-mhat); X[B+1]=EX(X[B+1]-mhat); PIN(X); SBAR(); }while(0)
  #define KRD(G,j) do{ if(G){ kload2(kf,kp0+sl_next,j); SBAR(); } }while(0)
  #define PVM(i,X) o[(i)&3]=__builtin_amdgcn_mfma_f32_32x32x16_bf16(PAF_((i)>>2),VFRX(X),o[(i)&3],0,0,0)
  #define PAF_(k) ((k)==0?PAF(0):(k)==1?PAF(1):(k)==2?PAF(2):PAF(3))
  #define STEP(C0,C1,P0,P1,t,GK,GV,GL) do{ SBAR(); \
    const lds_cptr vp_=vp0+2*sl_prev; \
    float sacc=(P0[0]+P0[1]); \
    GAPA(C0=__builtin_amdgcn_mfma_f32_32x32x16_bf16(kf[0],qr[0],f32x16{},0,0,0), P0[2],P0[3],P0[4],P0[5],     pw0[0]=PKW(P0,0), pw0[1]=PKW(P0,2), pw0); \
    GAPA(C1=__builtin_amdgcn_mfma_f32_32x32x16_bf16(kf[1],qr[0],f32x16{},0,0,0), P0[6],P0[7],P0[8],P0[9],     pw0[2]=PKW(P0,4), pw0[3]=PKW(P0,6), pw0); \
    GAPA(C0=__builtin_amdgcn_mfma_f32_32x32x16_bf16(kf[2],qr[1],C0,0,0,0),   P0[10],P0[11],P0[12],P0[13], pw1[0]=PKW(P0,8), pw1[1]=PKW(P0,10), pw1); \
    GAPA(C1=__builtin_amdgcn_mfma_f32_32x32x16_bf16(kf[3],qr[1],C1,0,0,0),   P0[14],P0[15],P1[0],P1[1],   pw1[2]=PKW(P0,12),pw1[3]=PKW(P0,14), pw1); \
    GAPA(C0=__builtin_amdgcn_mfma_f32_32x32x16_bf16(kf[4],qr[2],C0,0,0,0),   P1[2],P1[3],P1[4],P1[5],     pw2[0]=PKW(P1,0), pw2[1]=PKW(P1,2), pw2); \
    VRDX(fa,0); SBAR(); GAPA(C1=__builtin_amdgcn_mfma_f32_32x32x16_bf16(kf[5],qr[2],C1,0,0,0),   P1[6],P1[7],P1[8],P1[9],     pw2[2]=PKW(P1,4), pw2[3]=PKW(P1,6), pw2); \
    VRDX(fb,1); SBAR(); GAPA(C0=__builtin_amdgcn_mfma_f32_32x32x16_bf16(kf[6],qr[3],C0,0,0,0),   P1[10],P1[11],P1[12],P1[13], pw3[0]=PKW(P1,8), pw3[1]=PKW(P1,10), pw3); \
    VRDX(fc,2); SBAR(); GAPA(C1=__builtin_amdgcn_mfma_f32_32x32x16_bf16(kf[7],qr[3],C1,0,0,0),   P1[14],P1[15],0.f,0.f,       pw3[2]=PKW(P1,12),pw3[3]=PKW(P1,14), pw3); \
    l_reg+=sacc; \
    if(GK){DMA_K((t)+3,sl_cur);} if(GV){DMA_V((t)+1,sl_next);} \
    CMASK(C0,C1,t); \
    resc=false; { float a=MX3(C0[0],C0[1],C1[0]),b=MX3(C0[2],C0[3],C1[1]); a=MX3(a,C1[2],C1[3]); \
      _Pragma("unroll") for(int r=4;r<16;r+=4){a=MX3(a,C0[r],C0[r+1]);b=MX3(b,C0[r+2],C0[r+3]);a=MX3(a,C1[r],C1[r+1]);b=MX3(b,C1[r+2],C1[r+3]);} \
      float rm=__builtin_fmaxf(a,b); { auto rr=__builtin_amdgcn_permlane32_swap(__float_as_uint(rm),__float_as_uint(rm),false,false); rm=__builtin_fmaxf(__uint_as_float(rr[0]),__uint_as_float(rr[1])); } \
      rm-=mhat; \
      if(__builtin_expect(__any(rm>(float)THRL),0)){ const float dl=__builtin_fmaxf(rm,0.f); mhat+=dl; \
        const float f=__builtin_amdgcn_exp2f(-dl); l_reg*=f; if(hi==0)wsf[r32]=f; resc=true; } } \
    SBAR(); \
    VRDX(fd,3);  SBAR(); GAPB(PVM(0,fa),  C0,0); \
    VRDX(fa,4);  SBAR(); GAPB(PVM(1,fb),  C0,2); \
    VRDX(fb,5);  SBAR(); GAPB(PVM(2,fc),  C0,4); \
    VRDX(fc,6);  SBAR(); KRD(GL,0); GAPB(PVM(3,fd),  C0,6); \
    VRDX(fd,7);  SBAR(); KRD(GL,1); GAPB(PVM(4,fa),  C0,8); \
    VRDX(fa,8);  SBAR(); KRD(GL,2); GAPB(PVM(5,fb),  C0,10); \
    VRDX(fb,9);  SBAR(); KRD(GL,3); GAPB(PVM(6,fc),  C0,12); \
    VRDX(fc,10); SBAR(); GAPB(PVM(7,fd),  C0,14); \
    VRDX(fd,11); SBAR(); GAPB(PVM(8,fa),  C1,0); \
    VRDX(fa,12); SBAR(); GAPB(PVM(9,fb),  C1,2); \
    VRDX(fb,13); SBAR(); GAPB(PVM(10,fc), C1,4); \
    VRDX(fc,14); SBAR(); GAPB(PVM(11,fd), C1,6); \
    VRDX(fd,15); SBAR(); GAPB(PVM(12,fa), C1,8); \
    GAPB(PVM(13,fb), C1,10); \
    GAPB(PVM(14,fc), C1,12); \
    GAPB(PVM(15,fd), C1,14); \
    }while(0)
  int t=1;
  #undef CMASK
  #define CMASK(P0,P1,t) do{}while(0)
  for(;t+5<NT;t+=2){
    STEP(pB0,pB1,pA0,pA1,t,true,true,true);     WAIT_BAR(3); RESC(); ROT();
    STEP(pA0,pA1,pB0,pB1,t+1,true,true,true);   WAIT_BAR(3); RESC(); ROT();
  }
  #undef CMASK
  #define CMASK(P0,P1,t) do{int jb_=(t)-(NT-4); if(jb_>=0)cmask<false>(P0,P1,jb_,qrel,hi);}while(0)
  #define ENDW(tt) do{ if((tt)+3<NT){WAIT_BAR(3);} else if((tt)+2<NT){WAIT_BAR(2);} else {WAIT_BAR(0);} }while(0)
  for(;t+1<NT;t+=2){
    STEP(pB0,pB1,pA0,pA1,t,(t+3<NT),(t+1<NT),(t+1<NT));       ENDW(t);   RESC(); ROT();
    STEP(pA0,pA1,pB0,pB1,t+1,(t+4<NT),(t+2<NT),(t+2<NT));     ENDW(t+1); RESC(); ROT();
  }
  STEP(pB0,pB1,pA0,pA1,NT-1,false,false,false); RESC();
  { float sacc=pB0[0]+pB0[1]; _Pragma("unroll") for(int r=2;r<16;++r)sacc+=pB0[r]; _Pragma("unroll") for(int r=0;r<16;++r)sacc+=pB1[r]; l_reg+=sacc;
    pw0=(u32x4){PKW(pB0,0),PKW(pB0,2),PKW(pB0,4),PKW(pB0,6)};pw1=(u32x4){PKW(pB0,8),PKW(pB0,10),PKW(pB0,12),PKW(pB0,14)};pw2=(u32x4){PKW(pB1,0),PKW(pB1,2),PKW(pB1,4),PKW(pB1,6)};pw3=(u32x4){PKW(pB1,8),PKW(pB1,10),PKW(pB1,12),PKW(pB1,14)};
    SBAR(); const lds_cptr vp_=vp0+2*sl_cur;
    #pragma unroll
    for(int e4=0;e4<4;++e4){ s16x4 lo[4],hh[4];
      #pragma unroll
      for(int ks=0;ks<4;++ks){ lo[ks]=vtr(vp_+VOFF(4*ks+e4)); hh[ks]=vtr(vp_+VOFF(4*ks+e4)+512); }
      #define PK(k) (bf16x8){lo[k][0],lo[k][1],lo[k][2],lo[k][3],hh[k][0],hh[k][1],hh[k][2],hh[k][3]}
      o[e4]=__builtin_amdgcn_mfma_f32_32x32x16_bf16(PAF(0),PK(0),o[e4],0,0,0);
      o[e4]=__builtin_amdgcn_mfma_f32_32x32x16_bf16(PAF(1),PK(1),o[e4],0,0,0);
      o[e4]=__builtin_amdgcn_mfma_f32_32x32x16_bf16(PAF(2),PK(2),o[e4],0,0,0);
      o[e4]=__builtin_amdgcn_mfma_f32_32x32x16_bf16(PAF(3),PK(3),o[e4],0,0,0);
      #undef PK
    } }
  #undef PKW
  #undef PAF
  #undef PAF_
  #undef PVM
  #undef PIN
  #undef MX3
  #undef VOFF
  #undef VRDX
  #undef VFRX
  #undef GAPA
  #undef GAPB
  #undef EX
  #undef KRD
  #undef STEP
  #undef ENDW
  {auto rr=__builtin_amdgcn_permlane32_swap(__float_as_uint(l_reg),__float_as_uint(l_reg),false,false);l_reg=__uint_as_float(rr[0])+__uint_as_float(rr[1]);}
  if(hi==0)wsf[32+r32]=l_reg;asm volatile("s_waitcnt lgkmcnt(0)":::"memory");
  float rli[16];
  #pragma unroll
  for(int r=0;r<16;++r)rli[r]=__builtin_amdgcn_rcpf(wsf[32+crow(r,hi)]);
  bf16*Ow=O+(rowbase+q0+wid*QBLK)*OP;
  { bf16*stg=(bf16*)(shm+A2_OST)+wid*2048;
    int lane_e=lane; asm volatile("":"+v"(lane_e));
    #pragma unroll
    for(int hh=0;hh<2;++hh){
      #pragma unroll
      for(int r=0;r<16;++r){const int orow=crow(r,hi);
        #pragma unroll
        for(int d0=0;d0<2;++d0)stg[orow*64+d0*32+r32]=__float2bfloat16(o[2*hh+d0][r]*rli[r]);}
      asm volatile("s_waitcnt lgkmcnt(0)":::"memory");
      #pragma unroll
      for(int i=0;i<4;++i){const int row=i*8+(lane_e>>3),ch=lane_e&7; const u32x4 v=*(const u32x4*)(stg+row*64+ch*8); ATTN_STORE16(Ow+(long)row*OP+hh*64+ch*8,v);}
      asm volatile("s_waitcnt lgkmcnt(0)":::"memory");
    } }
  asm volatile("s_waitcnt lgkmcnt(0)\n\ts_barrier":::"memory");
  #undef DMA_K
  #undef DMA_V
  #undef CMASK
  #undef RESC
  #undef ROT
}
#undef SBAR
#undef WAIT_BAR
}

#define GAS __attribute__((address_space(1)))
#define LAS __attribute__((address_space(3)))
typedef unsigned v4u __attribute__((ext_vector_type(4)));
typedef float f32x4 __attribute__((ext_vector_type(4)));
typedef short bf16x8 __attribute__((ext_vector_type(8)));
typedef GAS unsigned gu32;
typedef GAS unsigned long long gu64;
#define RLX_AGENT __ATOMIC_RELAXED, __HIP_MEMORY_SCOPE_AGENT
#define LDS_WAIT() asm volatile("s_waitcnt lgkmcnt(0)" ::: "memory")
#define VM_WAIT() asm volatile("s_waitcnt vmcnt(0)" ::: "memory")
__device__ __forceinline__ unsigned long long rt() { return __builtin_amdgcn_s_memrealtime(); }

#define XB_TMO      128
#define XB_XCNT(j)  (256  + 64 * (j))
#define XB_XSUB(j)  (1280 + 64 * (j))
#define XB_XGEN(j)  (2304 + 64 * (j))
#define XB_TOP      3328
#define XB_TOPGEN   3392
#define XCD_BAR_WORDS 3456
#define XB_SPIN_CAP (1u << 18)

__device__ __forceinline__ unsigned xb_ld(unsigned* p)              { return __hip_atomic_load(p, __ATOMIC_RELAXED, __HIP_MEMORY_SCOPE_AGENT); }
__device__ __forceinline__ unsigned xb_add(unsigned* p, unsigned v) { return __hip_atomic_fetch_add(p, v, __ATOMIC_RELAXED, __HIP_MEMORY_SCOPE_AGENT); }
__device__ __forceinline__ unsigned xb_xcc_id() { return (unsigned)__builtin_amdgcn_s_getreg((3 << 11) | 20) & 0xFu; }
#define XB_SPIN(cond, bar) do { unsigned _sp = 0; while (cond) { __builtin_amdgcn_s_sleep(1); \
    if ((++_sp & 255u) == 0u) { if (xb_ld(&(bar)[XB_TMO])) break; if (_sp > XB_SPIN_CAP) { atomicAdd(&(bar)[XB_TMO], 1u); break; } } } } while (0)

struct XcdBarrier {
    unsigned* bar; unsigned x;
    volatile LAS unsigned* st;
};

__device__ __forceinline__ XcdBarrier xcd_barrier_post(unsigned* bar, volatile LAS unsigned* st, const bool first) {
    XcdBarrier b; b.bar = bar; b.x = xb_xcc_id(); b.st = st;
    if (first) (void)xb_add(&bar[XB_XCNT(b.x)], 1u);
    return b;
}
__device__ __forceinline__ void xcd_barrier_complete(unsigned* bar, unsigned x, unsigned& nloc, unsigned& nx) {
    const unsigned G = gridDim.x * gridDim.y * gridDim.z;
    unsigned sum, cnt, mine, sp = 0u;
    for (;;) {
        sum = 0u; cnt = 0u; mine = 0u;
#pragma unroll
        for (unsigned j = 0; j < 16; ++j) { const unsigned c = xb_ld(&bar[XB_XCNT(j)]); sum += c; cnt += (c > 0u) ? 1u : 0u; mine = (j == x) ? c : mine; }
        if (sum == G) break;
        __builtin_amdgcn_s_sleep(1);
        if ((++sp & 255u) == 0u) { if (xb_ld(&bar[XB_TMO])) break; if (sp > XB_SPIN_CAP) { atomicAdd(&bar[XB_TMO], 1u); break; } }
    }
    nloc = mine > 0u ? mine : 1u; nx = cnt > 0u ? cnt : 1u;
}

__device__ __forceinline__ void xcd_barrier(const XcdBarrier& b, const bool first) {
    asm volatile("s_waitcnt vmcnt(0)" ::: "memory");
    __syncthreads();
    if (first) {
        unsigned* bar = b.bar;
        __builtin_amdgcn_s_waitcnt(0);
        unsigned nloc = b.st[0], nx = b.st[1];
        if (nloc == 0u) { xcd_barrier_complete(bar, b.x, nloc, nx); b.st[0] = nloc; b.st[1] = nx; }
        const unsigned old = xb_add(&bar[XB_XSUB(b.x)], 1u);
        const unsigned gen = old / nloc;
        if (old + 1u == (gen + 1u) * nloc) {
            __builtin_amdgcn_fence(__ATOMIC_RELEASE, "agent");
            asm volatile("s_waitcnt vmcnt(0)" ::: "memory");
            const unsigned og = xb_add(&bar[XB_TOP], 1u);
            const unsigned tg = og / nx;
            if (og + 1u == (tg + 1u) * nx) xb_add(&bar[XB_TOPGEN], 1u);
            else XB_SPIN(xb_ld(&bar[XB_TOPGEN]) == tg, bar);
            __builtin_amdgcn_fence(__ATOMIC_ACQUIRE, "agent");
            xb_add(&bar[XB_XGEN(b.x)], 1u);
            asm volatile("s_waitcnt vmcnt(0)" ::: "memory");
        } else {
            XB_SPIN(xb_ld(&bar[XB_XGEN(b.x)]) == gen, bar);
            __builtin_amdgcn_fence(__ATOMIC_ACQUIRE, "agent");
            asm volatile("s_waitcnt vmcnt(0)" ::: "memory");
        }
    }
    __syncthreads();
}

constexpr int NWAVES = 8;
constexpr int RING_OFF = 0, RING_BYTES = 131072;
constexpr int LDSCTL_OFF = RING_BYTES, MISC_OFF = LDSCTL_OFF + 320;
constexpr int LDS_BYTES = 147456;
constexpr int CW_BAR = 0;
#ifndef MK_N_LAUNCHES
#define MK_N_LAUNCHES 1
#endif
constexpr size_t CTL_ZERO_BYTES = (MK_N_LAUNCHES == 1 ? 16 : 256) * 1024;
constexpr int N_PHASES = 10;
#ifndef PROBE_DOUBLEK
#define PROBE_DOUBLEK 0
#endif
#ifndef PROBE_PHASE
#define PROBE_PHASE -1
#endif
constexpr int PROBE_AMP = 8;
#ifndef PROBE_REPS
#define PROBE_REPS 1,1,1,1,1,1,1,1,1,1
#endif
constexpr int PHASE_REP[N_PHASES] = {PROBE_REPS};

__device__ __forceinline__ void xcd_barrier_arrive(const XcdBarrier& b, const bool first) {
    asm volatile("s_waitcnt vmcnt(0)" ::: "memory");
    __syncthreads();
    if (first) {
        unsigned* bar = b.bar;
        __builtin_amdgcn_s_waitcnt(0);
        unsigned nloc = b.st[0], nx = b.st[1];
        if (nloc == 0u) { xcd_barrier_complete(bar, b.x, nloc, nx); b.st[0] = nloc; b.st[1] = nx; }
        const unsigned old = xb_add(&bar[XB_XSUB(b.x)], 1u);
        const unsigned gen = old / nloc;
        unsigned role = 0u, tg = 0u;
        if (old + 1u == (gen + 1u) * nloc) {
            __builtin_amdgcn_fence(__ATOMIC_RELEASE, "agent");
            asm volatile("s_waitcnt vmcnt(0)" ::: "memory");
            const unsigned og = xb_add(&bar[XB_TOP], 1u);
            tg = og / nx;
            if (og + 1u == (tg + 1u) * nx) { xb_add(&bar[XB_TOPGEN], 1u); role = 2u; } else role = 1u;
        }
        b.st[2] = gen; b.st[3] = role; b.st[4] = tg;
    }
}
__device__ __forceinline__ void xcd_barrier_wait(const XcdBarrier& b, const bool first) {
    if (first) {
        unsigned* bar = b.bar;
        const unsigned gen = b.st[2], role = b.st[3], tg = b.st[4];
        if (role != 0u) {
            if (role == 1u) XB_SPIN(xb_ld(&bar[XB_TOPGEN]) == tg, bar);
            __builtin_amdgcn_fence(__ATOMIC_ACQUIRE, "agent");
            xb_add(&bar[XB_XGEN(b.x)], 1u);
            asm volatile("s_waitcnt vmcnt(0)" ::: "memory");
        } else {
            XB_SPIN(xb_ld(&bar[XB_XGEN(b.x)]) == gen, bar);
            __builtin_amdgcn_fence(__ATOMIC_ACQUIRE, "agent");
            asm volatile("s_waitcnt vmcnt(0)" ::: "memory");
        }
    }
    __syncthreads();
}
__device__ __forceinline__ const void* karg(unsigned off) {
    asm volatile("" : "+s"(off));
    return *(const void* const __attribute__((address_space(4)))*)((const char __attribute__((address_space(4)))*)__builtin_amdgcn_kernarg_segment_ptr() + off);
}
struct MArgs { const void* in[20]; float* out; unsigned char* ws; int ph_lo, ph_hi, li, pad; };

__global__ void __launch_bounds__(NWAVES * 64, 2) mega_fwd(MArgs args) {
    extern __shared__ __attribute__((aligned(16))) unsigned char lds[];
    LAS unsigned char* L = (LAS unsigned char*)lds;
    const int WAVE_S = __builtin_amdgcn_readfirstlane((int)(threadIdx.x >> 6));
#define TID() (WAVE_S * 64 + lane_id_())
#define FIRST() (WAVE_S == 0 && lane_id_() == 0)
    const int G = gridDim.x, bx = blockIdx.x, vcu = (G % 8 == 0) ? (bx % 8) * (G / 8) + bx / 8 : bx;
    for (int u = (int)threadIdx.x; u < (LDS_BYTES - LDSCTL_OFF) / 4; u += NWAVES * 64) ((LAS unsigned*)(L + LDSCTL_OFF))[u] = 0u;
    __syncthreads();
    unsigned* ctl = (unsigned*)(args.ws + WS_CTL);
    XcdBarrier bar = xcd_barrier_post(ctl + CW_BAR + args.li * XCD_BAR_WORDS, (volatile LAS unsigned*)(L + MISC_OFF) + 8, FIRST());
    const int lo = args.ph_lo, hi = args.ph_hi;
    unsigned long long t_last = PROBE_PHASE >= 0 ? __builtin_amdgcn_s_memrealtime() : 0ull, t_a = 0ull, t_b = 0ull;
#define IN(k) (lo <= (k) && (k) < hi)
#define ARRIVE(k) do { if (IN(k) && IN((k) + 1)) xcd_barrier_arrive(bar, FIRST()); } while (0)
#define WAITB(k) do { if (PROBE_PHASE == (k)) { t_a = t_last; } if (IN(k) && IN((k) + 1)) xcd_barrier_wait(bar, FIRST()); if (PROBE_PHASE >= 0) { t_last = __builtin_amdgcn_s_memrealtime(); if (PROBE_PHASE == (k)) t_b = t_last; } } while (0)
#define SEAM(k) do { ARRIVE(k); WAITB(k); } while (0)
#define CONVPTRS() ConvPtrs cv{INF(6), INF(14), INF(15), INF(16), INF(18), INF(19), WSB(WS_WIN), WSB(WS_WA), WSB(WS_WB), WSB(WS_WOUT), WSB(WS_WGU), WSB(WS_WDN)}

#define INF(k) ((const float*)karg(8 * (k)))
#define OUTP() ((float*)karg(160))
#define WSB(off) ((bf16_t*)((unsigned char*)karg(168) + (off)))
#define WSF(off) ((float*)((unsigned char*)karg(168) + (off)))

    if (IN(0)) for (int rep_ = 0; rep_ < PHASE_REP[0]; ++rep_) gemv8_phase<true, false>(TID(), vcu, G, INF(1), DM, INF(3), MODW, INF(4), WSF(WS_MOD), MODW, (float*)lds);
    ARRIVE(0);
    if (IN(0)) { CONVPTRS(); convert_phase(TID(), vcu, G, cv, (float*)lds, CV_S0, CV_S1); trig_phase(TID(), vcu, G, (const int*)karg(16), WSF(WS_TA), WSF(WS_TR)); __syncthreads(); }
    WAITB(0);
    if (IN(1)) for (int rep_ = 0; rep_ < PHASE_REP[1]; ++rep_) { const float* mod = WSF(WS_MOD); xn_phase(TID(), vcu, G, INF(0), INF(5), mod + 1 * DM, mod + 0 * DM, WSB(WS_XN)); }
    ARRIVE(1);
    if (IN(1)) { CONVPTRS(); convert_phase(TID(), vcu, G, cv, (float*)lds, CV_S1, CV_S2); __syncthreads(); }
    WAITB(1);
    if (IN(2)) for (int rep_ = 0; rep_ < PHASE_REP[2]; ++rep_) {
        pg8::Gemm g{WSB(WS_XN), WSB(WS_WIN), M, INW, DM}; pg8::StaticOrder S; S.init(M, INW, G, bx);
        pg8::EpiRows<InProjEpi> E{{WSB(WS_DQ), WSB(WS_DK), WSB(WS_DV), WSB(WS_RQ), WSB(WS_RK), WSB(WS_RV), WSB(WS_RG), WSB(WS_GA), WSB(WS_GB), INF(7), INF(8), WSF(WS_TA), WSF(WS_TR)}};
        pg8::gemm_phase<pg8::EpiRows<InProjEpi>, pg8::StaticOrder, true, true>(L + RING_OFF, g, S, E, WAVE_S);
    }
    ARRIVE(2);
    if (IN(2)) { const float* mod = WSF(WS_MOD); gemv8_phase<false, true>(TID(), vcu, G, mod + 3 * DM, MODW, INF(18), 2 * DFF, nullptr, WSF(WS_CVEC), 2 * DFF, (float*)lds); }
    WAITB(2);
    if (IN(3)) for (int rep_ = 0; rep_ < PHASE_REP[3]; ++rep_) {
        char* shm = (char*)lds + RING_OFF;
        typedef attn_body::bf16 abf;
        const int xb = vcu >> 5, lc = vcu & 31;
        for (int i = 0; i < 2; ++i) {
            if (i < 1) {
                const int s4 = lc & 3, u = lc >> 2, b = xb, h = u >> 1;
                for (int k = 0; k < 2; ++k)
                    attn_body::attn_unit2<8>((long)b * SEQ, k == 0 ? 7 - s4 : s4, (const abf*)(WSB(WS_DQ) + u * 64), 512, (const abf*)(WSB(WS_DK) + u * 64), 512, (const abf*)(WSB(WS_DV) + h * 128), 512,
                                             (abf*)(WSB(WS_AO) + u * 128), 1024, shm, WAVE_S);
            } else {
                const int s4 = lc & 3, half = (lc >> 2) & 1, h = lc >> 3, b = xb;
                for (int k = 0; k < 2; ++k) {
                    const int qb = k == 0 ? 7 - s4 : s4; const long row0 = (long)b * SEQ;
                    if (qb > 0) attn_body::ret_state(row0, 4 * qb, (const abf*)(WSB(WS_RK) + h * 64), 256, (const abf*)(WSB(WS_RV) + h * 128 + half * 64), 512, shm, WAVE_S);
                    attn_body::attn_unit<8, true>(row0 + 256 * qb, 0, (const abf*)(WSB(WS_RQ) + h * 64), 256, (const abf*)(WSB(WS_RK) + h * 64), 256, (const abf*)(WSB(WS_RV) + h * 128 + half * 64), 512,
                                                  (abf*)(WSB(WS_RETO) + h * 128 + half * 64), 512, shm, qb > 0, WAVE_S);
                }
            }
        }
    }
    ARRIVE(3);
    if (IN(3)) { CONVPTRS(); convert_phase(TID(), vcu, G, cv, (float*)lds, CV_S2, CV_S2 + CV_GU / 3); __syncthreads(); }
    WAITB(3);
    if (IN(4)) for (int rep_ = 0; rep_ < PHASE_REP[4]; ++rep_) combine_phase(TID(), vcu, G, WSB(WS_AO), WSB(WS_RETO), WSB(WS_RG), WSB(WS_OA), INF(9), INF(10), INF(11), INF(12), INF(13));
    ARRIVE(4);
    if (IN(4)) { CONVPTRS(); convert_phase(TID(), vcu, G, cv, (float*)lds, CV_S2 + CV_GU / 3, CV_S2 + 2 * (CV_GU / 3)); __syncthreads(); }
    WAITB(4);
    if (IN(5)) for (int rep_ = 0; rep_ < PHASE_REP[5]; ++rep_) {
        pg8::Gemm g{WSB(WS_OA), WSB(WS_WA), M, DM, 512, WSB(WS_OB), WSB(WS_WB)}; pg8::PairOrder S; S.init(M, DM, G, bx); pg8::BranchTileEpi E{WSB(WS_GA), WSB(WS_GB), WSB(WS_Y)};
        pg8::gemm_phase<pg8::BranchTileEpi, pg8::PairOrder, true, true>(L + RING_OFF, g, S, E, WAVE_S);
    }
    ARRIVE(5);
    if (IN(5)) { CONVPTRS(); convert_phase(TID(), vcu, G, cv, (float*)lds, CV_S2 + 2 * (CV_GU / 3), CV_S3); __syncthreads(); }
    WAITB(5);
    if (IN(6)) for (int rep_ = 0; rep_ < PHASE_REP[6]; ++rep_) {
        pg8::Gemm g{WSB(WS_Y), WSB(WS_WOUT), M, DM, DM}; pg8::StaticOrder S; S.init(M, DM, G, bx); pg8::EpiOutFused E{{INF(0), WSB(WS_X1B), WSF(WS_MOD), INF(17), WSB(WS_XN), WSF(WS_ROWSS)}};
        pg8::gemm_phase<pg8::EpiOutFused, pg8::StaticOrder, false, true>(L + RING_OFF, g, S, E, WAVE_S);
    }
    SEAM(6);
    if (IN(8)) for (int rep_ = 0; rep_ < PHASE_REP[8]; ++rep_) {
        pg8::Gemm g{WSB(WS_XN), WSB(WS_WGU), M, 2 * DFF, DM}; pg8::StaticOrder S; S.init(M, 2 * DFF, G, bx); pg8::EpiRows<GateUpEpi> E{{WSB(WS_ACT), WSF(WS_ROWSS), WSF(WS_CVEC)}};
        pg8::gemm_phase<pg8::EpiRows<GateUpEpi>, pg8::StaticOrder, true, true>(L + RING_OFF, g, S, E, WAVE_S);
    }
    if (IN(8) && G == 256 && bx >= 128) { CONVPTRS(); convert_phase(TID(), bx - 128, 128, cv, (float*)lds, CV_S3, CV_S4); __syncthreads(); }
    else if (IN(8) && G != 256) { CONVPTRS(); convert_phase(TID(), vcu, G, cv, (float*)lds, CV_S3, CV_S4); __syncthreads(); }
    SEAM(8);
    if (IN(9)) for (int rep_ = 0; rep_ < PHASE_REP[9]; ++rep_) {
        float* out = OUTP();
        pg8::Gemm g{WSB(WS_ACT), WSB(WS_WDN), M, DM, DFF};
#if PROBE_DOUBLEK
        pg8::DoubleKOrder S; S.init(M, DM, G, bx); pg8::EpiRowsDK<ResidEpi> E{{WSB(WS_X1B), out, WSF(WS_MOD) + 5 * DM}};
        pg8::gemm_phase<pg8::EpiRowsDK<ResidEpi>, pg8::DoubleKOrder, false, true>(L + RING_OFF, g, S, E, WAVE_S);
#else
        pg8::StaticOrder S; S.init(M, DM, G, bx); pg8::EpiRows<ResidEpi> E{{WSB(WS_X1B), out, WSF(WS_MOD) + 5 * DM}};
        pg8::gemm_phase<pg8::EpiRows<ResidEpi>, pg8::StaticOrder, true, true>(L + RING_OFF, g, S, E, WAVE_S);
#endif
    }
#undef INF
#undef OUTP
#undef WSB
#undef WSF
    SEAM(9);
    if (PROBE_PHASE >= 0 && blockIdx.x == 0 && WAVE_S == 0) { const unsigned long long tgt = __builtin_amdgcn_s_memrealtime() + (unsigned long long)PROBE_AMP * (t_b - t_a); while (__builtin_amdgcn_s_memrealtime() < tgt) __builtin_amdgcn_s_sleep(8); }
#undef IN
#undef SEAM
#undef ARRIVE
#undef WAITB
#undef CONVPTRS
#undef TID
#undef FIRST
}

#ifndef MK_N_LAUNCHES
#define MK_N_LAUNCHES 1
#endif
extern "C" void kernel_launch(void* const* d_in, const int* in_sizes, int n_in, void* d_out, int out_size, void* d_ws, size_t ws_size, hipStream_t stream) {
    static int grid = 0;
    if (grid == 0) {
        if (n_in != 20 || in_sizes[0] != M * DM || out_size != M * DM || ws_size < WS_END) { fprintf(stderr, "kernel_launch: unexpected shapes (n_in %d, ws %zu)\n", n_in, ws_size); grid = -1; return; }
        int dev = 0, cus = 0, per_cu = 0;
        if (hipGetDevice(&dev) != hipSuccess || hipDeviceGetAttribute(&cus, hipDeviceAttributeMultiprocessorCount, dev) != hipSuccess) { grid = -1; return; }
        if (hipFuncSetAttribute((const void*)mega_fwd, hipFuncAttributeMaxDynamicSharedMemorySize, LDS_BYTES) != hipSuccess) { fprintf(stderr, "kernel_launch: hipFuncSetAttribute failed\n"); grid = -1; return; }
        if (hipOccupancyMaxActiveBlocksPerMultiprocessor(&per_cu, (const void*)mega_fwd, NWAVES * 64, LDS_BYTES) != hipSuccess || per_cu < 1) { fprintf(stderr, "kernel_launch: occupancy query says %d\n", per_cu); per_cu = 1; }
        (void)hipGetLastError();
        if (cus != 256) { fprintf(stderr, "kernel_launch: built for a 256-CU device (got %d)\n", cus); grid = -1; return; }
        grid = cus;
    }
    if (grid < 0) return;
    (void)hipMemsetAsync((char*)d_ws + WS_CTL, 0, CTL_ZERO_BYTES, stream);
    MArgs a{};
    for (int i = 0; i < 20; ++i) a.in[i] = d_in[i];
    a.out = (float*)d_out; a.ws = (unsigned char*)d_ws;
    if (MK_N_LAUNCHES == 1) { a.ph_lo = 0; a.ph_hi = N_PHASES; a.li = 0; hipLaunchKernelGGL(mega_fwd, dim3(grid), dim3(NWAVES * 64), LDS_BYTES, stream, a); }
    else for (int p = 0; p < N_PHASES; ++p) { a.ph_lo = p; a.ph_hi = p + 1; a.li = p; hipLaunchKernelGGL(mega_fwd, dim3(grid), dim3(NWAVES * 64), LDS_BYTES, stream, a); }
}
```

```cpp
#include <hip/hip_runtime.h>
#include <cstdint>
#include <cstdio>
#include <hip/hip_bf16.h>
#include <cmath>

typedef unsigned short bf16_t;
typedef short bf16x8 __attribute__((ext_vector_type(8)));
typedef float f32x4 __attribute__((ext_vector_type(4)));
typedef unsigned u32x2 __attribute__((ext_vector_type(2)));
typedef unsigned u32x4 __attribute__((ext_vector_type(4)));

constexpr int BATCH = 8, SEQ = 2048, DM = 1024, M = BATCH * SEQ, INW = 5120, DFF = 2816, MODW = 6 * DM;
constexpr float EPS = 1e-6f;
constexpr float C2 = 0.125f * 1.4426950408889634f;

constexpr size_t MiB = 1u << 20;
constexpr size_t WS_CTL = 0, WS_MOD = 16 * 1024, WS_CVEC = WS_MOD + 8 * 6144 * 4, WS_ZERO_BYTES = WS_CVEC + 8 * 5632 * 4,     WS_TA = 2 * MiB, WS_TR = 3 * MiB, WS_ROWSS = 7 * MiB;
constexpr size_t WS_WIN = 8 * MiB, WS_WA = 18 * MiB, WS_WB = 19 * MiB, WS_WOUT = 20 * MiB, WS_WGU = 22 * MiB, WS_WDN = 33 * MiB;
constexpr size_t WS_XN = 40 * MiB;
constexpr size_t WS_DQ = 72 * MiB, WS_DK = 88 * MiB, WS_DV = 104 * MiB, WS_RQ = 120 * MiB, WS_RK = 128 * MiB, WS_RV = 136 * MiB,
                 WS_RG = 152 * MiB, WS_GA = 168 * MiB, WS_GB = 200 * MiB, WS_RETO = 232 * MiB, WS_X1B = 208 * MiB;
constexpr size_t WS_AO = WS_XN, WS_OA = WS_DQ, WS_OB = WS_RG, WS_Y = WS_DK, WS_ACT = 120 * MiB, WS_END = 256 * MiB;

__device__ __forceinline__ int lane_id_() { return (int)__builtin_amdgcn_mbcnt_hi(~0u, __builtin_amdgcn_mbcnt_lo(~0u, 0u)); }
__device__ __forceinline__ unsigned f2bf(float f) { unsigned u = __float_as_uint(f); return (u + 0x7fffu + ((u >> 16) & 1u)) >> 16; }
typedef float f32x2_t_ __attribute__((ext_vector_type(2))); typedef __bf16 bf16x2_t_ __attribute__((ext_vector_type(2)));
__device__ __forceinline__ unsigned pk2(float lo, float hi) { f32x2_t_ v = {lo, hi}; bf16x2_t_ b = __builtin_convertvector(v, bf16x2_t_); return __builtin_bit_cast(unsigned, b); }
__device__ __forceinline__ float bf2f(unsigned h) { return __uint_as_float(h << 16); }
__device__ __forceinline__ float bflo(unsigned w) { return __uint_as_float(w << 16); }
__device__ __forceinline__ float bfhi(unsigned w) { return __uint_as_float(w & 0xffff0000u); }
__device__ __forceinline__ u32x2 pack4(f32x4 v) { u32x2 r; r.x = pk2(v[0], v[1]); r.y = pk2(v[2], v[3]); return r; }
__device__ __forceinline__ float wave_sum(float v) {
#pragma unroll
    for (int o = 1; o < 64; o <<= 1) v += __shfl_xor(v, o);
    return v;
}
__device__ __forceinline__ float silu_f(float x) { return x * __builtin_amdgcn_rcpf(1.f + __builtin_amdgcn_exp2f(-1.4426950408889634f * x)); }
__device__ __forceinline__ float sigm_f(float x) { return __builtin_amdgcn_rcpf(1.f + __builtin_amdgcn_exp2f(-1.4426950408889634f * x)); }

__constant__ double c_invf_da[8] = {1.0, 0.19392274474868576, 0.03760603093086393, 0.007292664737217109, 0.001414213562373095, 0.0002742481756762073, 5.318295896944988e-05, 1.031338537721246e-05};
__constant__ double c_invf_ret[32] = {1.0, 0.7498942093324559, 0.5623413251903491, 0.4216965034285822, 0.31622776601683794, 0.23713737056616552, 0.1778279410038923, 0.1333521432163324, 0.1, 0.07498942093324558, 0.05623413251903491, 0.042169650342858224, 0.03162277660168379, 0.023713737056616554, 0.01778279410038923, 0.01333521432163324, 0.01, 0.007498942093324558, 0.005623413251903491, 0.004216965034285823, 0.0031622776601683794, 0.0023713737056616554, 0.0017782794100389228, 0.001333521432163324, 0.001, 0.0007498942093324559, 0.0005623413251903491, 0.00042169650342858224, 0.00031622776601683794, 0.00023713737056616554, 0.00017782794100389227, 0.0001333521432163324};
__device__ __forceinline__ float log2gamma(int h) { return h == 0 ? -0.04580368961312479f : h == 1 ? -0.02272007650008353f : h == 2 ? -0.011315313227834146f : -0.005646563141142063f; }

template <bool SILU, bool GUMAP>
__device__ __forceinline__ void gemv8_phase(int tid, int wg, int G, const float* vec, int vpitch, const float* W, int N, const float* bias, float* out, int opitch, float* lds) {
    const int wave = tid >> 6, lane = tid & 63, r8 = lane >> 3, c4 = lane & 7;
    f32x4 w[16];
    if (wg < N / 32) { const float* wp = W + (size_t)(wave * 128 + r8) * N + wg * 32 + c4 * 4;
#pragma unroll
        for (int i = 0; i < 16; ++i) w[i] = *(const f32x4*)(wp + (size_t)(8 * i) * N); }
    for (int i = tid; i < BATCH * DM; i += 512) { const float v = vec[(i >> 10) * vpitch + (i & 1023)]; lds[i] = SILU ? silu_f(v) : v; }
    __syncthreads();
    float* red = lds + BATCH * DM;
    for (int cg = wg; cg < N / 32; cg += G) {
        const int e0 = cg * 32;
        f32x4 acc[8];
#pragma unroll
        for (int b = 0; b < 8; ++b) acc[b] = (f32x4){0.f, 0.f, 0.f, 0.f};
        if (cg != wg) { const float* wp = W + (size_t)(wave * 128 + r8) * N + e0 + c4 * 4;
#pragma unroll
            for (int i = 0; i < 16; ++i) w[i] = *(const f32x4*)(wp + (size_t)(8 * i) * N); }
#pragma unroll
        for (int i = 0; i < 16; ++i) {
            const int d = wave * 128 + 8 * i + r8;
#pragma unroll
            for (int b = 0; b < 8; ++b) acc[b] += w[i] * lds[b * DM + d];
        }
#pragma unroll
        for (int b = 0; b < 8; ++b)
#pragma unroll
            for (int e = 0; e < 4; ++e) { float v = acc[b][e]; v += __shfl_xor(v, 8); v += __shfl_xor(v, 16); v += __shfl_xor(v, 32); acc[b][e] = v; }
        if (r8 == 0) {
#pragma unroll
            for (int b = 0; b < 8; ++b) *(f32x4*)(red + (wave * 8 + b) * 32 + c4 * 4) = acc[b];
        }
        __syncthreads();
        if (tid < 256) {
            const int b = tid >> 5, c2 = tid & 31, e = e0 + c2;
            float s = bias ? bias[e] : 0.f;
#pragma unroll
            for (int w2 = 0; w2 < 8; ++w2) s += red[(w2 * 8 + b) * 32 + c2];
            int oi = e;
            if (GUMAP) { const int bj = e / DFF, r = e % DFF; oi = (r >> 7) * 256 + bj * 128 + (r & 127); }
            out[b * opitch + oi] = s;
        }
        __syncthreads();
    }
}

template <bool SILU, bool GUMAP>
__device__ __forceinline__ void gemv4_phase(int tid, int wg, int G, const float* vec, int vpitch, const float* W, int N, const float* bias, float* out, int opitch, float* lds) {
    const int wave = tid >> 6, lane = tid & 63, half = lane >> 5, c16 = lane & 31;
    __attribute__((address_space(3))) float* tab = (__attribute__((address_space(3))) float*)lds;
    __attribute__((address_space(3))) float* red = tab + 8 * 256;
    for (int task = wg; task < N / 32; task += G) {
        const int cq = task >> 2, rq = task & 3, e0 = cq * 128, d0 = rq * 256;
        f32x4 w[16];
        const float* wp = W + (size_t)(d0 + 32 * wave + half) * N + e0 + 4 * c16;
#pragma unroll
        for (int i = 0; i < 16; ++i) w[i] = *(const f32x4*)(wp + (size_t)(2 * i) * N);
        for (int i = tid; i < 8 * 256; i += 512) { const float v = vec[(i >> 8) * vpitch + d0 + (i & 255)]; tab[i] = SILU ? silu_f(v) : v; }
        __syncthreads();
        f32x4 acc[8];
#pragma unroll
        for (int b = 0; b < 8; ++b) acc[b] = (f32x4){0.f, 0.f, 0.f, 0.f};
#pragma unroll
        for (int i = 0; i < 16; ++i)
#pragma unroll
            for (int b = 0; b < 8; ++b) acc[b] += w[i] * tab[b * 256 + 32 * wave + 2 * i + half];
#pragma unroll
        for (int b = 0; b < 8; ++b)
#pragma unroll
            for (int e = 0; e < 4; ++e) acc[b][e] += __shfl_xor(acc[b][e], 32);
        if (half == 0) {
#pragma unroll
            for (int b = 0; b < 8; ++b) *(__attribute__((address_space(3))) f32x4*)(red + (wave * 8 + b) * 128 + 4 * c16) = acc[b];
        }
        __syncthreads();
#pragma unroll
        for (int j = 0; j < 2; ++j) { const int o = tid + 512 * j, b = o >> 7, col = o & 127, e = e0 + col;
            float s = (rq == 0 && bias) ? bias[e] : 0.f;
#pragma unroll
            for (int w2 = 0; w2 < 8; ++w2) s += red[(w2 * 8 + b) * 128 + col];
            int oi = e;
            if (GUMAP) { const int bj = e / DFF, r = e % DFF; oi = (r >> 7) * 256 + bj * 128 + (r & 127); }
            (void)__hip_atomic_fetch_add(out + b * opitch + oi, s, __ATOMIC_RELAXED, __HIP_MEMORY_SCOPE_AGENT); }
        __syncthreads();
    }
}

__device__ __forceinline__ int slot2col(int map, int slot) {
    if (map == 1) { const int pn = slot >> 8, bj = (slot >> 7) & 1, wc = (slot >> 5) & 3, r = slot & 31; return (pn << 8) + (wc << 6) + (bj << 5) + r; }
    if (map == 2) { const int pn = slot >> 8, bj = (slot >> 7) & 1, j = slot & 127; return bj * DFF + pn * 128 + j; }
    return slot;
}
__device__ __forceinline__ void convert_item(const float* W, int K, int N, bf16_t* Wt, int map, float* scr, int item, int lane) {
    const int nblk = N / 32, kb = item / nblk, nb = item % nblk, k0 = 64 * kb, s0 = 32 * nb, c0 = slot2col(map, s0);
    { const int r8 = lane >> 3, c4 = lane & 7;
      f32x4 v[8];
#pragma unroll
      for (int i = 0; i < 8; ++i) v[i] = *(const f32x4*)(W + (size_t)(k0 + 8 * i + r8) * N + c0 + 4 * c4);
#pragma unroll
      for (int i = 0; i < 8; ++i) { float* d = scr + (8 * i + r8) * 33 + 4 * c4; d[0] = v[i][0]; d[1] = v[i][1]; d[2] = v[i][2]; d[3] = v[i][3]; } }
    __builtin_amdgcn_s_waitcnt(0xc07f); __builtin_amdgcn_wave_barrier();
    const int c = lane & 7;
#pragma unroll
    for (int j = 0; j < 4; ++j) { const int n = (lane >> 3) + 8 * j; const float* s = scr + (8 * c) * 33 + n;
        u32x4 o; o.x = pk2(s[0 * 33], s[1 * 33]); o.y = pk2(s[2 * 33], s[3 * 33]); o.z = pk2(s[4 * 33], s[5 * 33]); o.w = pk2(s[6 * 33], s[7 * 33]);
        *(u32x4*)(Wt + (size_t)(s0 + n) * K + k0 + 8 * c) = o; }
    __builtin_amdgcn_s_waitcnt(0xc07f); __builtin_amdgcn_wave_barrier();
}
struct ConvPtrs { const float *w_in, *wa, *wb, *wout, *wgu, *wdn; bf16_t *w_in_t, *wa_t, *wb_t, *wout_t, *wgu_t, *wdn_t; };
constexpr int CV_IN = (DM / 64) * (INW / 32), CV_A = (512 / 64) * (DM / 32), CV_O = (DM / 64) * (DM / 32), CV_GU = (DM / 64) * (2 * DFF / 32), CV_DN = (DFF / 64) * (DM / 32);
constexpr int CV_S0 = 0, CV_S1 = CV_IN, CV_S2 = CV_IN + 2 * CV_A + CV_O, CV_S3 = CV_S2 + CV_GU, CV_S4 = CV_S3 + CV_DN;
__device__ __forceinline__ void convert_phase(int tid, int wg, int G, const ConvPtrs& P, float* lds, int it0, int it1) {
    const int wave = tid >> 6, lane = tid & 63;
    float* scr = lds + wave * (64 * 33);
    const int gw = wg * 8 + wave, NGW = G * 8;
    constexpr int I_IN = CV_IN, I_A = CV_A, I_O = CV_O, I_GU = CV_GU;
    for (int it = it0 + gw; it < it1; it += NGW) {
        int r = it;
        if (r < I_IN) { convert_item(P.w_in, DM, INW, P.w_in_t, 1, scr, r, lane); continue; } r -= I_IN;
        if (r < I_A) { convert_item(P.wa, 512, DM, P.wa_t, 0, scr, r, lane); continue; } r -= I_A;
        if (r < I_A) { convert_item(P.wb, 512, DM, P.wb_t, 0, scr, r, lane); continue; } r -= I_A;
        if (r < I_O) { convert_item(P.wout, DM, DM, P.wout_t, 0, scr, r, lane); continue; } r -= I_O;
        if (r < I_GU) { convert_item(P.wgu, DM, 2 * DFF, P.wgu_t, 2, scr, r, lane); continue; } r -= I_GU;
        convert_item(P.wdn, DFF, DM, P.wdn_t, 0, scr, r, lane);
    }
}

__device__ __forceinline__ void trig_phase(int tid, int wg, int G, const int* positions, float* TA, float* TR) {
    const int gt = wg * 512 + tid, NT = G * 512;
    for (int it = gt; it < M * 40; it += NT) {
        const int row = it / 40, i = it % 40;
        const double p = (double)positions[row];
        const double a = p * (i < 8 ? c_invf_da[i] : c_invf_ret[i - 8]);
        double rev = a * 0.15915494309189535;
        rev -= __builtin_rint(rev);
        const float sn = __builtin_amdgcn_sinf((float)rev), cs = __builtin_amdgcn_cosf((float)rev);
        if (i < 8) { TA[row * 16 + i] = cs; TA[row * 16 + 8 + i] = sn; }
        else { TR[row * 64 + (i - 8)] = cs; TR[row * 64 + 32 + (i - 8)] = sn; }
    }
}

__device__ __forceinline__ void xn_phase(int tid, int wg, int G, const float* x, const float* g, const float* sc, const float* sh, bf16_t* XN) {
    const int wave = tid >> 6, lane = tid & 63;
    for (int r0 = (wg * 8 + wave) * 8; r0 < M; r0 += G * 64) {
        const int b = r0 / SEQ;
        f32x4 a[4], s0[4];
#pragma unroll
        for (int j = 0; j < 4; ++j) { const int col = 4 * lane + 256 * j; a[j] = *(const f32x4*)(g + col) * (*(const f32x4*)(sc + b * MODW + col) + 1.f); s0[j] = *(const f32x4*)(sh + b * MODW + col); }
#pragma unroll
        for (int h = 0; h < 2; ++h) {
            f32x4 v[4][4];
#pragma unroll
            for (int r = 0; r < 4; ++r)
#pragma unroll
                for (int j = 0; j < 4; ++j) v[r][j] = ((const f32x4*)(x + (size_t)(r0 + 4 * h + r) * DM))[lane + 64 * j];
            __builtin_amdgcn_sched_barrier(0);
#pragma unroll
            for (int r = 0; r < 4; ++r) {
                float ss = 0.f;
#pragma unroll
                for (int j = 0; j < 4; ++j) ss += (v[r][j][0] * v[r][j][0] + v[r][j][1] * v[r][j][1]) + (v[r][j][2] * v[r][j][2] + v[r][j][3] * v[r][j][3]);
                const float rstd = rsqrtf(wave_sum(ss) * (1.f / DM) + EPS);
                u32x2* o = (u32x2*)(XN + (size_t)(r0 + 4 * h + r) * DM) + lane;
#pragma unroll
                for (int j = 0; j < 4; ++j) o[64 * j] = pack4(v[r][j] * rstd * a[j] + s0[j]);
            }
        }
    }
}

__device__ __forceinline__ void combine_phase(int tid, int wg, int G, const bf16_t* AO, const bf16_t* RETO, bf16_t* RG_OB, bf16_t* OA,
                                              const float* lq1, const float* lk1, const float* lq2, const float* lk2, const float* subln_g) {
    const int wave = tid >> 6, lane = tid & 63;
    const float lam = __expf(wave_sum(lq1[lane] * lk1[lane])) - __expf(wave_sum(lq2[lane] * lk2[lane])) + 0.2f;
    const int h = lane >> 4, d0 = (lane & 15) * 8;
    float gsub[8];
#pragma unroll
    for (int e = 0; e < 8; ++e) gsub[e] = subln_g[d0 + e] * 0.8f;
    for (int row = wg * 64 + wave * 8; row < M; row += G * 64) for (int rj = 0; rj < 8; ++rj, ++row) {
        {
            const u32x4 a = *(const u32x4*)(AO + (size_t)row * 1024 + (2 * h) * 128 + d0), b = *(const u32x4*)(AO + (size_t)row * 1024 + (2 * h + 1) * 128 + d0);
            float d[8]; float ss = 0.f;
#pragma unroll
            for (int e = 0; e < 4; ++e) { d[2 * e] = bflo(a[e]) - lam * bflo(b[e]); d[2 * e + 1] = bfhi(a[e]) - lam * bfhi(b[e]); }
#pragma unroll
            for (int e = 0; e < 8; ++e) ss += d[e] * d[e];
            ss += __shfl_xor(ss, 1); ss += __shfl_xor(ss, 2); ss += __shfl_xor(ss, 4); ss += __shfl_xor(ss, 8);
            const float rstd = rsqrtf(ss * (1.f / 128.f) + EPS);
            u32x4 o;
#pragma unroll
            for (int e = 0; e < 4; ++e) o[e] = pk2(d[2 * e] * rstd * gsub[2 * e], d[2 * e + 1] * rstd * gsub[2 * e + 1]);
            *(u32x4*)(OA + (size_t)row * 512 + h * 128 + d0) = o;
        }
        {
            const u32x4 a = *(const u32x4*)(RETO + (size_t)row * 512 + h * 128 + d0), gt = *(const u32x4*)(RG_OB + (size_t)row * 512 + h * 128 + d0);
            float d[8]; float ss = 0.f;
#pragma unroll
            for (int e = 0; e < 4; ++e) { d[2 * e] = bflo(a[e]); d[2 * e + 1] = bfhi(a[e]); }
#pragma unroll
            for (int e = 0; e < 8; ++e) ss += d[e] * d[e];
            ss += __shfl_xor(ss, 1); ss += __shfl_xor(ss, 2); ss += __shfl_xor(ss, 4); ss += __shfl_xor(ss, 8);
            const float rstd = rsqrtf(ss * (1.f / 128.f) + EPS);
            u32x4 o;
#pragma unroll
            for (int e = 0; e < 4; ++e) o[e] = pk2(d[2 * e] * rstd * bflo(gt[e]), d[2 * e + 1] * rstd * bfhi(gt[e]));
            *(u32x4*)(RG_OB + (size_t)row * 512 + h * 128 + d0) = o;
        }
    }
}

__device__ __forceinline__ u32x4 pack8(f32x4 a, f32x4 b) { u32x4 r; r.x = pk2(a[0], a[1]); r.y = pk2(a[2], a[3]); r.z = pk2(b[0], b[1]); r.w = pk2(b[2], b[3]); return r; }
#define SLOT8(pn, wc, fq, g) (256 * (pn) + 128 * ((g) >> 1) + 32 * (wc) + 8 * (fq) + 4 * ((g) & 1))
struct InProjEpi {
    static constexpr int BATCH = 2;
    struct Tile { f32x4 gn[4]; };
    struct Pre { f32x4 t[4]; };
    bf16_t *DQ, *DK, *DV, *RQ, *RK, *RV, *RG, *GA, *GB; const float *qg, *kg, *TA, *TR;
    __device__ __forceinline__ Tile tile_pre(int b, int pn, int wc, int fq) const {
        Tile T;
        if (pn < 4) { const float* gn = pn < 2 ? qg : kg;
#pragma unroll
            for (int g = 0; g < 4; ++g) T.gn[g] = *(const f32x4*)(gn + 32 * (g >> 1) + 8 * fq + 4 * (g & 1)); }
        return T;
    }
    __device__ __forceinline__ Pre row_pre(int row, int b, int pn, int wc, int fq) const {
        Pre P;
        if (pn < 4) {
#pragma unroll
            for (int i = 0; i < 4; ++i) P.t[i] = *(const f32x4*)(TA + (size_t)row * 16 + 4 * i); }
        else if (pn == 6 || pn == 7) {
#pragma unroll
            for (int n = 0; n < 2; ++n) { P.t[n] = *(const f32x4*)(TR + (size_t)row * 64 + 8 * fq + 4 * n); P.t[2 + n] = *(const f32x4*)(TR + (size_t)row * 64 + 32 + 8 * fq + 4 * n); } }
        return P;
    }
    __device__ __forceinline__ void operator()(const f32x4 (&v)[4], const Pre& P, const Tile& T, int row, int b, int pn, int wc, int fq) const {
        f32x4 o[4]; bf16_t* dst;
        if (pn < 4) {
            const bool isq = pn < 2;
            float ss = 0.f;
#pragma unroll
            for (int g = 0; g < 4; ++g) ss += (v[g][0] * v[g][0] + v[g][1] * v[g][1]) + (v[g][2] * v[g][2] + v[g][3] * v[g][3]);
            ss += __shfl_xor(ss, 16); ss += __shfl_xor(ss, 32);
            const float rstd = rsqrtf(ss * (1.f / 64.f) + EPS) * (isq ? C2 : 1.f);
#pragma unroll
            for (int g = 0; g < 4; ++g) o[g] = v[g] * rstd * T.gn[g];
#pragma unroll
            for (int n = 0; n < 2; ++n) {
                f32x4 other;
#pragma unroll
                for (int r = 0; r < 4; ++r) other[r] = __shfl_xor(o[n][r], 16);
                const f32x4 rot = (fq == 0) ? (o[n] * P.t[n] - other * P.t[2 + n]) : (o[n] * P.t[n] + other * P.t[2 + n]);
                o[n] = (fq < 2) ? rot : o[n];
            }
            dst = (isq ? DQ : DK) + (size_t)row * 512 + ((pn & 1) * 4 + wc) * 64;
        } else if (pn == 6 || pn == 7) {
            const bool isq = pn == 6;
#pragma unroll
            for (int n = 0; n < 2; ++n) { o[n] = v[n] * P.t[n] - v[2 + n] * P.t[2 + n]; o[2 + n] = v[2 + n] * P.t[n] + v[n] * P.t[2 + n]; }
            const float t = (float)(row & (SEQ - 1)), lg = log2gamma(wc);
            const float s = isq ? exp2f(t * lg) : exp2f(-t * lg) * 0.125f;
#pragma unroll
            for (int g = 0; g < 4; ++g) o[g] = o[g] * s;
            dst = (isq ? RQ : RK) + (size_t)row * 256 + wc * 64;
        } else if (pn < 6) {
#pragma unroll
            for (int g = 0; g < 4; ++g) o[g] = v[g];
            dst = DV + (size_t)row * 512 + (pn - 4) * 256 + wc * 64;
        } else if (pn < 10) {
#pragma unroll
            for (int g = 0; g < 4; ++g) o[g] = v[g];
            dst = RV + (size_t)row * 512 + (pn - 8) * 256 + wc * 64;
        } else if (pn < 12) {
#pragma unroll
            for (int g = 0; g < 4; ++g)
#pragma unroll
                for (int r = 0; r < 4; ++r) o[g][r] = silu_f(v[g][r]);
            dst = RG + (size_t)row * 512 + (pn - 10) * 256 + wc * 64;
        } else {
#pragma unroll
            for (int g = 0; g < 4; ++g)
#pragma unroll
                for (int r = 0; r < 4; ++r) o[g][r] = sigm_f(v[g][r]);
            dst = (pn < 16 ? GA + (size_t)row * 1024 + (pn - 12) * 256 : GB + (size_t)row * 1024 + (pn - 16) * 256) + wc * 64;
        }
#pragma unroll
        for (int bj = 0; bj < 2; ++bj) *(u32x4*)(dst + 32 * bj + 8 * fq) = pack8(o[2 * bj], o[2 * bj + 1]);
    }
};
struct OutEpi {
    static constexpr int BATCH = 4;
    struct Tile { f32x4 g1[4], a2[4]; };
    struct Pre { f32x4 x[4]; };
    const float* x; bf16_t* X1B; const float* mod; const float* g2n; bf16_t* XM; float* rowss;
    __device__ __forceinline__ Tile tile_pre(int b, int pn, int wc, int fq) const {
        Tile T;
#pragma unroll
        for (int g = 0; g < 4; ++g) { const int col = SLOT8(pn, wc, fq, g);
            T.g1[g] = *(const f32x4*)(mod + b * MODW + 2 * DM + col); T.a2[g] = *(const f32x4*)(g2n + col) * (*(const f32x4*)(mod + b * MODW + 4 * DM + col) + 1.f); }
        return T;
    }
    __device__ __forceinline__ Pre row_pre(int row, int b, int pn, int wc, int fq) const {
        Pre P;
#pragma unroll
        for (int g = 0; g < 4; ++g) P.x[g] = *(const f32x4*)(x + (size_t)row * DM + SLOT8(pn, wc, fq, g));
        return P;
    }
    __device__ __forceinline__ float operator()(const f32x4 (&v)[4], const Pre& P, const Tile& T, int row, int b, int pn, int wc, int fq) const {
        float ss = 0.f; f32x4 xm[4], x1[4];
#pragma unroll
        for (int g = 0; g < 4; ++g) {
            x1[g] = P.x[g] + T.g1[g] * v[g];
            ss += (x1[g][0] * x1[g][0] + x1[g][1] * x1[g][1]) + (x1[g][2] * x1[g][2] + x1[g][3] * x1[g][3]);
            xm[g] = x1[g] * T.a2[g];
        }
#pragma unroll
        for (int bj = 0; bj < 2; ++bj) { *(u32x4*)(X1B + (size_t)row * DM + SLOT8(pn, wc, fq, 2 * bj)) = pack8(x1[2 * bj], x1[2 * bj + 1]);
                                         *(u32x4*)(XM + (size_t)row * DM + SLOT8(pn, wc, fq, 2 * bj)) = pack8(xm[2 * bj], xm[2 * bj + 1]); }
        ss += __shfl_xor(ss, 16); ss += __shfl_xor(ss, 32);
        return ss;
    }
};
struct ResidEpi {
    static constexpr int BATCH = 8;
    struct Tile { f32x4 gg[4]; };
    struct Pre { u32x4 bs[2]; };
    const bf16_t* base; float* out; const float* gvec;
    __device__ __forceinline__ Tile tile_pre(int b, int pn, int wc, int fq) const {
        Tile T;
#pragma unroll
        for (int g = 0; g < 4; ++g) T.gg[g] = *(const f32x4*)(gvec + b * MODW + SLOT8(pn, wc, fq, g));
        return T;
    }
    __device__ __forceinline__ Pre row_pre(int row, int b, int pn, int wc, int fq) const {
        Pre P;
#pragma unroll
        for (int bj = 0; bj < 2; ++bj) P.bs[bj] = *(const u32x4*)(base + (size_t)row * DM + SLOT8(pn, wc, fq, 2 * bj));
        return P;
    }
    __device__ __forceinline__ void operator()(const f32x4 (&v)[4], const Pre& P, const Tile& T, int row, int b, int pn, int wc, int fq) const {
#pragma unroll
        for (int g = 0; g < 4; ++g) { const unsigned w0 = P.bs[g >> 1][2 * (g & 1)], w1 = P.bs[g >> 1][2 * (g & 1) + 1];
            const f32x4 bs = {bflo(w0), bfhi(w0), bflo(w1), bfhi(w1)};
            *(f32x4*)(out + (size_t)row * DM + SLOT8(pn, wc, fq, g)) = bs + T.gg[g] * v[g]; }
    }
};
struct GateUpEpi {
    static constexpr int BATCH = 4;
    struct Tile { f32x4 cg[2], cu[2]; };
    struct Pre { f32x4 s4; };
    bf16_t* ACT; const float* rowss; const float* cvec;
    __device__ __forceinline__ Tile tile_pre(int b, int pn, int wc, int fq) const {
        Tile T;
#pragma unroll
        for (int n = 0; n < 2; ++n) { const int slot = 256 * pn + 32 * wc + 8 * fq + 4 * n; T.cg[n] = *(const f32x4*)(cvec + b * (2 * DFF) + slot); T.cu[n] = *(const f32x4*)(cvec + b * (2 * DFF) + slot + 128); }
        return T;
    }
    __device__ __forceinline__ Pre row_pre(int row, int b, int pn, int wc, int fq) const { Pre P; P.s4 = *(const f32x4*)(rowss + (size_t)row * 4); return P; }
    __device__ __forceinline__ void operator()(const f32x4 (&v)[4], const Pre& P, const Tile& T, int row, int b, int pn, int wc, int fq) const {
        const float rstd = rsqrtf(((P.s4[0] + P.s4[1]) + (P.s4[2] + P.s4[3])) * (1.f / DM) + EPS);
        f32x4 y[2];
#pragma unroll
        for (int n = 0; n < 2; ++n) {
            const f32x4 gt = v[n] * rstd + T.cg[n], up = v[2 + n] * rstd + T.cu[n];
#pragma unroll
            for (int r = 0; r < 4; ++r) y[n][r] = silu_f(gt[r]) * up[r];
        }
        *(u32x4*)(ACT + (size_t)row * DFF + 128 * pn + 32 * wc + 8 * fq) = pack8(y[0], y[1]);
    }
};

namespace pg8 {
#define PG8_LAS __attribute__((address_space(3)))
typedef unsigned short bf16_t;
typedef short bf16x8 __attribute__((ext_vector_type(8)));
typedef float f32x4 __attribute__((ext_vector_type(4)));
typedef unsigned u32x4 __attribute__((ext_vector_type(4)));
constexpr int BM = 256, BK = 64, HALF = 128, HTB = HALF * BK * 2  , STAGE_BYTES = 8 * HTB, NXCD = 8, WGM = 4;

__host__ __device__ __forceinline__ int lds_byte(int r, int c) { const int st = (r >> 4) * 2 + (c >> 5), rr = r & 15, cc = c & 31, ob = rr * 64 + cc * 2; return st * 1024 + (ob ^ (((ob >> 9) & 1) << 5)); }
__host__ __device__ __forceinline__ void stage_rc(int b, int& R, int& C) { const int st = b / 1024, sb = b % 1024, swz = sb ^ (((sb >> 9) & 1) << 5); R = (st >> 1) * 16 + swz / 64; C = (st & 1) * 32 + (swz % 64) / 2; }
__host__ __device__ __forceinline__ int perm32(int rho) { const int n = rho >> 4, i = rho & 15; return 8 * (i >> 2) + 4 * n + (i & 3); }

struct Unit { int pm, pn, sel, half; };
struct Gemm { const bf16_t* A; const bf16_t* Bt; int M, N, K; const bf16_t* A2; const bf16_t* Bt2; };

struct StaticOrder {
    int nM, nN, nwg, G, c;
    __host__ __device__ void init(int M, int N, int G_, int c_) { nM = M / BM; nN = N / BM; nwg = nM * nN; G = G_; c = c_; }
    __host__ __device__ bool next(int i, Unit& u) const {
        const long L = (long)i * G + c; if (L >= nwg) return false;
        int wgid = (int)L; { const int q = nwg / NXCD, r = nwg % NXCD, xcd = wgid % NXCD, off = wgid / NXCD; wgid = (xcd < r ? xcd * (q + 1) : r * (q + 1) + (xcd - r) * q) + off; }
        const int nig = WGM * nN, gid = wgid / nig, fm = gid * WGM, gsz = (nM - fm) < WGM ? (nM - fm) : WGM;
        u.pm = fm + ((wgid % nig) % gsz); u.pn = (wgid % nig) / gsz; u.sel = 0; u.half = 0; return true;
    }
    __device__ __forceinline__ void a_ready(const Unit&) const {}
    __device__ __forceinline__ void done(const Unit&) const {}
};

template <class Epi, class Sched, bool ALIGN_EPI = false, bool SP2 = false>
__device__ __forceinline__ void gemm_phase(PG8_LAS unsigned char* lds, const Gemm g, const Sched& S, const Epi& E, const int WAVE_S) {
    const int wid = WAVE_S, lane = lane_id_(), tid = wid * 64 + lane, wr = wid >> 2, wc = wid & 3, fr = lane & 15, fq = lane >> 4;
    const int K = g.K, nt = K / BK;
    unsigned voffA[2], voffB[2];
#pragma unroll
    for (int i = 0; i < 2; ++i) { int R, C; stage_rc(tid * 16 + i * 8192, R, C); const int Rb = Epi::PERM ? ((R & ~31) + perm32(R & 31)) : R;
        voffA[i] = (unsigned)(R * K + C) * 2u; voffB[i] = (unsigned)(Rb * K + C) * 2u; }
    const size_t kstep = (size_t)(BK * 2);
    const size_t hstep = (size_t)HALF * K * 2;
    const size_t tstep = 2 * hstep;
    const unsigned ldsw = (unsigned)wid * 1024u;
    const int aoff = lds_byte(wr * 64 + fr, fq * 8), boff = lds_byte(wc * 32 + fr, fq * 8);
#define PG8_SA(b, h) (((b) * 2 + (h)) * HTB)
#define PG8_SB(b, h) ((4 + (b) * 2 + (h)) * HTB)
#define PG8_STAGE(bufoff, gbase, voff) do { _Pragma("unroll") for (int _i = 0; _i < 2; ++_i) \
        __builtin_amdgcn_global_load_lds((const unsigned*)((const char*)(gbase) + (voff)[_i]), (PG8_LAS unsigned*)(lds + (bufoff) + ldsw + _i * 8192), 16, 0, 0); } while (0)
#define PG8_LDA(dst, b, h) do { _Pragma("unroll") for (int m = 0; m < 4; ++m) _Pragma("unroll") for (int k = 0; k < 2; ++k) dst[m][k] = *(const PG8_LAS bf16x8*)(lds + PG8_SA(b, h) + aoff + m * 2048 + k * 1024); } while (0)
#define PG8_LDB(dst, b, h) do { _Pragma("unroll") for (int n = 0; n < 2; ++n) _Pragma("unroll") for (int k = 0; k < 2; ++k) dst[n][k] = *(const PG8_LAS bf16x8*)(lds + PG8_SB(b, h) + boff + n * 2048 + k * 1024); } while (0)
#define PG8_MMA(ai, bj, At, Bt) do { __builtin_amdgcn_s_setprio(1); _Pragma("unroll") for (int m = 0; m < 4; ++m) _Pragma("unroll") for (int n = 0; n < 2; ++n) _Pragma("unroll") for (int k = 0; k < 2; ++k) \
        acc[ai][bj][m][n] = __builtin_amdgcn_mfma_f32_16x16x32_bf16(Bt[n][k], At[m][k], acc[ai][bj][m][n], 0, 0, 0); __builtin_amdgcn_s_setprio(0); } while (0)
#define PG8_WAIT_V(n) asm volatile("s_waitcnt vmcnt(" #n ")" ::: "memory")
#define PG8_WAIT_L(n) asm volatile("s_waitcnt lgkmcnt(" #n ")" ::: "memory")
#define PG8_BAR __builtin_amdgcn_s_barrier()
#define PG8_SCHED __builtin_amdgcn_sched_barrier(0)
    Unit cur, nxt; int ui = 0;
    if (!S.next(0, cur)) return;
    f32x4 acc[2][2][4][2];
#pragma unroll
    for (int a = 0; a < 2; ++a)
#pragma unroll
        for (int b = 0; b < 2; ++b)
#pragma unroll
            for (int m = 0; m < 4; ++m)
#pragma unroll
                for (int n = 0; n < 2; ++n) acc[a][b][m][n] = (f32x4){0.f, 0.f, 0.f, 0.f};
    bf16x8 At[4][2], B0[2][2], B1[2][2];
    const char* cA = (const char*)(cur.sel ? g.A2 : g.A) + (size_t)cur.pm * tstep + (cur.half == 2 ? hstep : (size_t)0); const char* cB = (const char*)(cur.sel ? g.Bt2 : g.Bt) + (size_t)cur.pn * tstep;
    S.a_ready(cur);
    if constexpr (SP2) {
        PG8_STAGE(PG8_SB(0, 0), cB, voffB); PG8_STAGE(PG8_SB(0, 1), cB + hstep, voffB); PG8_STAGE(PG8_SA(0, 0), cA, voffA); PG8_STAGE(PG8_SA(0, 1), cA + hstep, voffA);
        if (wr == 1) PG8_BAR;
        PG8_WAIT_V(2); PG8_BAR;
        PG8_STAGE(PG8_SB(1, 0), cB + kstep, voffB); PG8_STAGE(PG8_SA(1, 0), cA + kstep, voffA); PG8_STAGE(PG8_SB(1, 1), cB + hstep + kstep, voffB);
        PG8_WAIT_V(6); PG8_BAR;
    } else {
        PG8_STAGE(PG8_SB(0, 0), cB, voffB); PG8_STAGE(PG8_SA(0, 0), cA, voffA); PG8_STAGE(PG8_SB(0, 1), cB + hstep, voffB); PG8_STAGE(PG8_SA(0, 1), cA + hstep, voffA);
        if (wr == 1) PG8_BAR;
        PG8_WAIT_V(4); PG8_BAR;
        PG8_STAGE(PG8_SB(1, 0), cB + kstep, voffB); PG8_STAGE(PG8_SA(1, 0), cA + kstep, voffA); PG8_STAGE(PG8_SB(1, 1), cB + hstep + kstep, voffB);
        PG8_WAIT_V(6); PG8_BAR;
    }
    for (;;) {
        const bool has_next = S.next(ui + 1, nxt);
        const char* nA = has_next ? (const char*)(nxt.sel ? g.A2 : g.A) + (size_t)nxt.pm * tstep + (nxt.half == 2 ? hstep : (size_t)0) : cA; const char* nB = has_next ? (const char*)(nxt.sel ? g.Bt2 : g.Bt) + (size_t)nxt.pn * tstep : cB;
        for (int t = 0; t < nt; t += 2) {
            const bool last = (t == nt - 2);
            const char* a1 = cA + (size_t)(t + 1) * kstep;
            const char* a2 = last ? nA : cA + (size_t)(t + 2) * kstep; const char* b2 = last ? nB : cB + (size_t)(t + 2) * kstep;
            const char* a3 = a2 + kstep; const char* b3 = b2 + kstep;
            if (last && has_next) S.a_ready(nxt);
            if constexpr (SP2) {
            PG8_LDB(B0, 0, 0); PG8_LDB(B1, 0, 1); PG8_SCHED; PG8_LDA(At, 0, 0); PG8_STAGE(PG8_SA(1, 1), a1 + hstep, voffA);
            PG8_WAIT_V(8); PG8_WAIT_L(0); PG8_BAR; PG8_MMA(0, 0, At, B0); PG8_MMA(0, 1, At, B1); PG8_BAR; PG8_SCHED;
            PG8_LDA(At, 0, 1); PG8_STAGE(PG8_SB(0, 0), b2, voffB); PG8_STAGE(PG8_SB(0, 1), b2 + hstep, voffB); PG8_STAGE(PG8_SA(0, 0), a2, voffA);
            PG8_WAIT_V(8); PG8_WAIT_L(0); PG8_BAR; PG8_MMA(1, 0, At, B0); PG8_MMA(1, 1, At, B1); PG8_BAR; PG8_SCHED;
            PG8_LDB(B0, 1, 0); PG8_LDB(B1, 1, 1); PG8_SCHED; PG8_LDA(At, 1, 0); PG8_STAGE(PG8_SA(0, 1), a2 + hstep, voffA);
            PG8_WAIT_V(8); PG8_WAIT_L(0); PG8_BAR; PG8_MMA(0, 0, At, B0); PG8_MMA(0, 1, At, B1); PG8_BAR; PG8_SCHED;
            PG8_LDA(At, 1, 1); PG8_STAGE(PG8_SB(1, 0), b3, voffB); PG8_STAGE(PG8_SB(1, 1), b3 + hstep, voffB); PG8_STAGE(PG8_SA(1, 0), a3, voffA);
            PG8_WAIT_V(8); PG8_WAIT_L(0); PG8_BAR; PG8_MMA(1, 0, At, B0); PG8_MMA(1, 1, At, B1); PG8_BAR; PG8_SCHED;
            } else {
            PG8_LDB(B0, 0, 0); PG8_SCHED; PG8_LDA(At, 0, 0); PG8_STAGE(PG8_SA(1, 1), a1 + hstep, voffA);
            PG8_WAIT_L(8); PG8_BAR; PG8_WAIT_L(0); PG8_MMA(0, 0, At, B0); PG8_BAR; PG8_SCHED;
            PG8_LDB(B1, 0, 1); PG8_STAGE(PG8_SB(0, 0), b2, voffB);
            PG8_BAR; PG8_WAIT_L(0); PG8_MMA(0, 1, At, B1); PG8_BAR;
            PG8_LDA(At, 0, 1); PG8_STAGE(PG8_SA(0, 0), a2, voffA);
            PG8_BAR; PG8_WAIT_L(0); PG8_MMA(1, 0, At, B0); PG8_BAR; PG8_SCHED;
            PG8_STAGE(PG8_SB(0, 1), b2 + hstep, voffB);
            PG8_WAIT_V(6); PG8_BAR; PG8_MMA(1, 1, At, B1); PG8_BAR;
            PG8_LDB(B0, 1, 0); PG8_SCHED; PG8_LDA(At, 1, 0); PG8_STAGE(PG8_SA(0, 1), a2 + hstep, voffA);
            PG8_WAIT_L(8); PG8_BAR; PG8_WAIT_L(0); PG8_MMA(0, 0, At, B0); PG8_BAR; PG8_SCHED;
            PG8_LDB(B1, 1, 1); PG8_STAGE(PG8_SB(1, 0), b3, voffB);
            PG8_BAR; PG8_WAIT_L(0); PG8_MMA(0, 1, At, B1); PG8_BAR;
            PG8_LDA(At, 1, 1); PG8_STAGE(PG8_SA(1, 0), a3, voffA);
            PG8_BAR; PG8_WAIT_L(0); PG8_MMA(1, 0, At, B0); PG8_BAR; PG8_SCHED;
            PG8_STAGE(PG8_SB(1, 1), b3 + hstep, voffB);
            PG8_WAIT_V(6); PG8_BAR; PG8_MMA(1, 1, At, B1); PG8_BAR;
            }
        }
        if constexpr (ALIGN_EPI) { if (wr == 0) PG8_BAR; }
        if constexpr (!Epi::AFTER_DRAIN) { E(acc, cur, wr, wc, fr, fq); S.done(cur); }
        if (!has_next) break;
        if (Epi::zero_after(cur))
#pragma unroll
        for (int a = 0; a < 2; ++a)
#pragma unroll
            for (int b = 0; b < 2; ++b)
#pragma unroll
                for (int m = 0; m < 4; ++m)
#pragma unroll
                    for (int n = 0; n < 2; ++n) acc[a][b][m][n] = (f32x4){0.f, 0.f, 0.f, 0.f};
        cur = nxt; cA = nA; cB = nB; ++ui;
        if constexpr (ALIGN_EPI) { if (wr == 1) PG8_BAR; }
    }
    PG8_WAIT_V(0);
    if constexpr (!ALIGN_EPI) { if (wr == 0) PG8_BAR; }
    PG8_BAR;
    if constexpr (Epi::AFTER_DRAIN) { E.fused(acc, cur, wr, wc, fr, fq, lds, wid, lane); S.done(cur); }
#undef PG8_SA
#undef PG8_SB
#undef PG8_STAGE
#undef PG8_LDA
#undef PG8_LDB
#undef PG8_MMA
#undef PG8_WAIT_V
#undef PG8_WAIT_L
#undef PG8_BAR
#undef PG8_SCHED
}
}

namespace pg8 {
template <class RowEpi> struct EpiRows {
    static constexpr bool PERM = true, AFTER_DRAIN = false;
    RowEpi R;
    static __device__ __forceinline__ bool zero_after(const Unit&) { return true; }
    __device__ __forceinline__ void operator()(const f32x4 (&acc)[2][2][4][2], const Unit& u, int wr, int wc, int fr, int fq) const {
        const int b = u.pm >> 3, row0 = u.pm * BM + wr * 64 + fr + (u.half == 2 ? HALF : 0);
        const typename RowEpi::Tile T = R.tile_pre(b, u.pn, wc, fq);
        constexpr int NB = RowEpi::BATCH;
#pragma unroll
        for (int g0 = 0; g0 < 8; g0 += NB) {
            if (u.half && g0 >= 4) break;
            typename RowEpi::Pre P[NB];
#pragma unroll
            for (int j = 0; j < NB; ++j) P[j] = R.row_pre(row0 + ((g0 + j) >> 2) * HALF + ((g0 + j) & 3) * 16, b, u.pn, wc, fq);
            __builtin_amdgcn_sched_barrier(0);
#pragma unroll
            for (int j = 0; j < NB; ++j) { const int ai = (g0 + j) >> 2, m = (g0 + j) & 3;
                const f32x4 v[4] = {acc[ai][0][m][0], acc[ai][0][m][1], acc[ai][1][m][0], acc[ai][1][m][1]};
                R(v, P[j], T, row0 + ai * HALF + m * 16, b, u.pn, wc, fq); }
        }
    }
};
struct EpiOutFused {
    static constexpr bool PERM = true, AFTER_DRAIN = true;
    OutEpi R;
    static __device__ __forceinline__ bool zero_after(const Unit&) { return true; }
    __device__ __forceinline__ void operator()(const f32x4 (&)[2][2][4][2], const Unit&, int, int, int, int) const {}
    __device__ __forceinline__ void fused(f32x4 (&acc)[2][2][4][2], const Unit& u, int wr, int wc, int fr, int fq, PG8_LAS unsigned char* lds, int wid, int lane) const {
        PG8_LAS float* sred = (PG8_LAS float*)lds;
        const int b = u.pm >> 3;
        const OutEpi::Tile T = R.tile_pre(b, u.pn, wc, fq);
        constexpr int NB = OutEpi::BATCH;
#pragma unroll
        for (int g0 = 0; g0 < 8; g0 += NB) {
            OutEpi::Pre P[NB];
#pragma unroll
            for (int j = 0; j < NB; ++j) P[j] = R.row_pre(u.pm * BM + ((g0 + j) >> 2) * HALF + wr * 64 + ((g0 + j) & 3) * 16 + fr, b, u.pn, wc, fq);
            __builtin_amdgcn_sched_barrier(0);
#pragma unroll
            for (int j = 0; j < NB; ++j) { const int ai = (g0 + j) >> 2, m = (g0 + j) & 3;
                const f32x4 v[4] = {acc[ai][0][m][0], acc[ai][0][m][1], acc[ai][1][m][0], acc[ai][1][m][1]};
                const int rl = ai * HALF + wr * 64 + m * 16 + fr;
                const float ss = R(v, P[j], T, u.pm * BM + rl, b, u.pn, wc, fq);
                if (fq == 0) sred[rl * 4 + wc] = ss; }
        }
        asm volatile("s_waitcnt lgkmcnt(0)" ::: "memory"); __builtin_amdgcn_s_barrier(); asm volatile("" ::: "memory");
        const int t = wid * 64 + lane;
        if (t < 256) { const f32x4 p = *(const PG8_LAS f32x4*)(sred + t * 4); R.rowss[(size_t)(u.pm * BM + t) * 4 + u.pn] = (p[0] + p[1]) + (p[2] + p[3]); }
    }
};
struct DoubleKOrder : StaticOrder {
    __host__ __device__ bool next(int i, Unit& u) const { const bool ok = StaticOrder::next(i >> 1, u); u.half = i & 1; return ok; }
};
template <class RowEpi> struct EpiRowsDK {
    static constexpr bool PERM = true, AFTER_DRAIN = false;
    RowEpi R;
    static __device__ __forceinline__ bool zero_after(const Unit& u) { return u.half == 1; }
    __device__ __forceinline__ void operator()(f32x4 (&acc)[2][2][4][2], const Unit& u, int wr, int wc, int fr, int fq) const {
        if (u.half == 0) return;
#pragma unroll
        for (int a = 0; a < 2; ++a)
#pragma unroll
            for (int b = 0; b < 2; ++b)
#pragma unroll
                for (int m = 0; m < 4; ++m)
#pragma unroll
                    for (int n = 0; n < 2; ++n) acc[a][b][m][n] = acc[a][b][m][n] * 0.5f;
        Unit v = u; v.half = 0; EpiRows<RowEpi> E{R}; E(acc, v, wr, wc, fr, fq);
    }
};
struct PairOrder : StaticOrder {
    __host__ __device__ bool next(int i, Unit& u) const { const bool ok = StaticOrder::next(i >> 1, u); u.sel = i & 1; return ok; }
};
struct BranchTileEpi {
    static constexpr bool PERM = true, AFTER_DRAIN = false;
    const bf16_t *GA, *GB; bf16_t* Y;
    static __device__ __forceinline__ bool zero_after(const Unit& u) { return u.sel == 1; }
    __device__ __forceinline__ void operator()(f32x4 (&acc)[2][2][4][2], const Unit& u, int wr, int wc, int fr, int fq) const {
        const size_t off0 = (size_t)(u.pm * BM + wr * 64 + fr) * 1024 + u.pn * BM + wc * 32 + 8 * fq;
#pragma unroll
        for (int g0 = 0; g0 < 8; g0 += 4) {
            u32x4 gb[4][2], ga[4][2];
#pragma unroll
            for (int j = 0; j < 4; ++j)
#pragma unroll
                for (int bj = 0; bj < 2; ++bj) { const size_t off = off0 + (size_t)(((g0 + j) >> 2) * HALF + ((g0 + j) & 3) * 16) * 1024 + bj * HALF;
                    gb[j][bj] = *(const u32x4*)(GB + off); if (u.sel == 0) ga[j][bj] = *(const u32x4*)(GA + off); }
            __builtin_amdgcn_sched_barrier(0);
#pragma unroll
            for (int j = 0; j < 4; ++j) { const int ai = (g0 + j) >> 2, m = (g0 + j) & 3;
#pragma unroll
                for (int bj = 0; bj < 2; ++bj) {
                    f32x4 sb[2];
#pragma unroll
                    for (int n = 0; n < 2; ++n) { sb[n][0] = fmaxf(bflo(gb[j][bj][2 * n]), 1e-30f); sb[n][1] = fmaxf(bfhi(gb[j][bj][2 * n]), 1e-30f); sb[n][2] = fmaxf(bflo(gb[j][bj][2 * n + 1]), 1e-30f); sb[n][3] = fmaxf(bfhi(gb[j][bj][2 * n + 1]), 1e-30f); }
                    if (u.sel == 0) {
#pragma unroll
                        for (int n = 0; n < 2; ++n) { f32x4 r; r[0] = bflo(ga[j][bj][2 * n]) * __builtin_amdgcn_rcpf(sb[n][0]); r[1] = bfhi(ga[j][bj][2 * n]) * __builtin_amdgcn_rcpf(sb[n][1]);
                            r[2] = bflo(ga[j][bj][2 * n + 1]) * __builtin_amdgcn_rcpf(sb[n][2]); r[3] = bfhi(ga[j][bj][2 * n + 1]) * __builtin_amdgcn_rcpf(sb[n][3]);
                            acc[ai][bj][m][n] = acc[ai][bj][m][n] * r; }
                    } else {
                        *(u32x4*)(Y + off0 + (size_t)(ai * HALF + m * 16) * 1024 + bj * HALF) = pack8(acc[ai][bj][m][0] * sb[0], acc[ai][bj][m][1] * sb[1]);
                    }
                }
            }
        }
    }
};
}

namespace attn_body {
using bf16=__hip_bfloat16;
using bf16x8=__attribute__((ext_vector_type(8)))short;
using s16x4=__attribute__((ext_vector_type(4)))short;
using f32x16=__attribute__((ext_vector_type(16)))float;
using u32x4=__attribute__((ext_vector_type(4)))unsigned;
constexpr int SEQ=2048,D=64;
constexpr int NW=8,QBLK=32,QB=QBLK*NW,KVBLK=64,NQB=SEQ/QB;
constexpr int ATTN_UNIT_ROWS=QB;
__device__ __forceinline__ int crow(int r,int hi){return (r&3)+8*(r>>2)+4*hi;}
#define SBAR() __builtin_amdgcn_sched_barrier(0)
template<bool LIN> __device__ __forceinline__ void cmask(f32x16&p0,f32x16&p1,int jb,int qrel,int hi){
  const float NEG=LIN?0.f:-INFINITY; int kb=64*jb+4*hi;
  #pragma unroll
  for(int r=0;r<16;++r){int kv=kb+(r&3)+8*(r>>2); if(kv>qrel)p0[r]=NEG; if(kv+32>qrel)p1[r]=NEG;}
}

constexpr int NSLOT=3, SLOTB=8192;
constexpr int LDS_RT=98304, LDS_RTS=106496, RS_NSLOT=6, RS_SLOTB=16384;
constexpr int LDS_K=0, LDS_V=NSLOT*SLOTB, LDS_WS=2*NSLOT*SLOTB, LDS_OST=LDS_WS+NW*64*4, LDS_BYTES=LDS_OST+NW*4096;
constexpr float C2=0.125f*1.4426950408889634f;
__device__ __forceinline__ void glds16s(const void*sbase,unsigned voff,unsigned lds_dst){unsigned keep;
  asm volatile("s_mov_b32 %0, m0\n\ts_mov_b32 m0, %3\n\ts_nop 4\n\tglobal_load_lds_dwordx4 %1, %2\n\ts_mov_b32 m0, %0":"=&s"(keep):"v"(voff),"s"(sbase),"s"(lds_dst):"memory");}
__device__ __forceinline__ const char* uptr(const char*p){const unsigned long long a=(unsigned long long)p;const unsigned lo=__builtin_amdgcn_readfirstlane((unsigned)a),hi=__builtin_amdgcn_readfirstlane((unsigned)(a>>32));return (const char*)(((unsigned long long)hi<<32)|lo);}
__device__ __forceinline__ void glds16(const void*gsrc,unsigned lds_dst){unsigned keep;
  asm volatile("s_mov_b32 %0, m0\n\ts_mov_b32 m0, %2\n\ts_nop 0\n\tglobal_load_lds_dwordx4 %1, off\n\ts_mov_b32 m0, %0":"=&s"(keep):"v"(gsrc),"s"(lds_dst):"memory");}
__device__ __forceinline__ float max3f(float a,float b,float c){float r;asm("v_max3_f32 %0, %1, %2, %3":"=v"(r):"v"(a),"v"(b),"v"(c));return r;}
__device__ __forceinline__ float max2f(float a,float b){float r;asm("v_max_f32_e32 %0, %1, %2":"=v"(r):"v"(a),"v"(b));return r;}
__device__ __forceinline__ float fadd_s(float a,float b){float r;asm("v_add_f32_e32 %0, %1, %2":"=v"(r):"v"(a),"v"(b));return r;}
__device__ __forceinline__ float fsub_s(float a,float b){float r;asm("v_sub_f32_e32 %0, %1, %2":"=v"(r):"v"(a),"v"(b));return r;}
typedef float f32x2_t __attribute__((ext_vector_type(2))); typedef __bf16 bf16x2_t __attribute__((ext_vector_type(2)));
__device__ __forceinline__ unsigned cvtpk_s(float lo,float hi){f32x2_t v={lo,hi};bf16x2_t b=__builtin_convertvector(v,bf16x2_t);return __builtin_bit_cast(unsigned,b);}
#define WAIT_BAR(N) asm volatile("s_waitcnt vmcnt(" #N ") lgkmcnt(0)\n\ts_barrier":::"memory")

__device__ __forceinline__ void qkt(f32x16&p0,f32x16&p1,const char*Kslot,const bf16x8*qr,const f32x16&negm,int r32,int hi){
  const char*kb=Kslot+hi*1024+r32*16;
  #pragma unroll
  for(int d0=0;d0<4;++d0){
    const bf16x8 b0=*reinterpret_cast<const bf16x8*>(kb+d0*2048);
    const bf16x8 b1=*reinterpret_cast<const bf16x8*>(kb+d0*2048+512);
    if(d0==0){p0=__builtin_amdgcn_mfma_f32_32x32x16_bf16(b0,qr[0],negm,0,0,0);p1=__builtin_amdgcn_mfma_f32_32x32x16_bf16(b1,qr[0],negm,0,0,0);}
    else{p0=__builtin_amdgcn_mfma_f32_32x32x16_bf16(b0,qr[d0],p0,0,0,0);p1=__builtin_amdgcn_mfma_f32_32x32x16_bf16(b1,qr[d0],p1,0,0,0);}}
}
typedef __attribute__((address_space(3))) const char* lds_cptr;
typedef short v4i16_t __attribute__((ext_vector_type(4)));
__device__ __forceinline__ void kload8(bf16x8*kf,lds_cptr kp){
  kf[0]=*(const __attribute__((address_space(3))) bf16x8*)(kp);      kf[1]=*(const __attribute__((address_space(3))) bf16x8*)(kp+512);
  kf[2]=*(const __attribute__((address_space(3))) bf16x8*)(kp+2048); kf[3]=*(const __attribute__((address_space(3))) bf16x8*)(kp+2560);
  kf[4]=*(const __attribute__((address_space(3))) bf16x8*)(kp+4096); kf[5]=*(const __attribute__((address_space(3))) bf16x8*)(kp+4608);
  kf[6]=*(const __attribute__((address_space(3))) bf16x8*)(kp+6144); kf[7]=*(const __attribute__((address_space(3))) bf16x8*)(kp+6656);
}
__device__ __forceinline__ void kload2(bf16x8*kf,lds_cptr kp,int j){ kf[2*j]=*(const __attribute__((address_space(3))) bf16x8*)(kp+j*2048); kf[2*j+1]=*(const __attribute__((address_space(3))) bf16x8*)(kp+j*2048+512); }
__device__ __forceinline__ s16x4 vtr(lds_cptr p){ return __builtin_bit_cast(s16x4,__builtin_amdgcn_ds_read_tr16_b64_v4i16((__attribute__((address_space(3))) v4i16_t*)p)); }
__device__ __forceinline__ float rowmax(const f32x16&p0,const f32x16&p1){
  float a=max3f(p0[0],p0[1],p1[0]),b=max3f(p0[2],p0[3],p1[1]);a=max3f(a,p1[2],p1[3]);
  #pragma unroll
  for(int r=4;r<16;r+=4){a=max3f(a,p0[r],p0[r+1]);b=max3f(b,p0[r+2],p0[r+3]);a=max3f(a,p1[r],p1[r+1]);b=max3f(b,p1[r+2],p1[r+3]);}
  const float m=max2f(a,b);
  auto rr=__builtin_amdgcn_permlane32_swap(__float_as_uint(m),__float_as_uint(m),false,false);
  return max2f(__uint_as_float(rr[0]),__uint_as_float(rr[1]));
}
__device__ __forceinline__ void pv(f32x16*o,int vb,bf16x8 pa0,bf16x8 pa1,bf16x8 pa2,bf16x8 pa3){
  #pragma unroll
  for(int d0=0;d0<2;++d0){s16x4 lo[4],hi[4];
    #pragma unroll
    for(int ks=0;ks<4;++ks){
      asm volatile("ds_read_b64_tr_b16 %0,%1 offset:%c2":"=&v"(lo[ks]):"v"(vb),"i"(d0*4096+ks*1024):"memory");
      asm volatile("ds_read_b64_tr_b16 %0,%1 offset:%c2":"=&v"(hi[ks]):"v"(vb),"i"(d0*4096+ks*1024+512):"memory");}
    asm volatile("s_waitcnt lgkmcnt(0)":::"memory");SBAR();
    #define PK(k) (bf16x8){lo[k][0],lo[k][1],lo[k][2],lo[k][3],hi[k][0],hi[k][1],hi[k][2],hi[k][3]}
    o[d0]=__builtin_amdgcn_mfma_f32_32x32x16_bf16(pa0,PK(0),o[d0],0,0,0);
    o[d0]=__builtin_amdgcn_mfma_f32_32x32x16_bf16(pa1,PK(1),o[d0],0,0,0);
    o[d0]=__builtin_amdgcn_mfma_f32_32x32x16_bf16(pa2,PK(2),o[d0],0,0,0);
    o[d0]=__builtin_amdgcn_mfma_f32_32x32x16_bf16(pa3,PK(3),o[d0],0,0,0);
    #undef PK
  }
}

#ifndef ATTN_STORE16
#define ATTN_STORE16(p,v) (*(u32x4*)(p)=(v))
#endif
template<int THRL,bool LIN> __device__ __forceinline__ void attn_unit(long rowbase,int qb,const bf16*Q,int QP,const bf16*__restrict__ K,int KP,const bf16*__restrict__ V,int VP,bf16*O,int OP,char*shm,const bool xr,const int WAVE_S){
  int lane=lane_id_(); asm volatile("":"+v"(lane)); const int r32=lane&31,hi=lane>>5; const int wid=WAVE_S;
  const int q0=qb*QB;
  const bf16*Qw=Q+(rowbase+q0+wid*QBLK)*QP;
  const bf16*Kh=K+rowbase*KP,*Vh=V+rowbase*VP;
  const unsigned lds0=(unsigned)(uintptr_t)shm;
  float*wsf=(float*)(shm+LDS_WS)+wid*64;
  const unsigned koff=(unsigned)((lane*KP+wid*8)*2);
  const unsigned voff=(unsigned)(((16*(wid&3)+(lane>>2))*VP+(wid>>2)*32+(lane&3)*8)*2);
  const unsigned kdst=lds0+LDS_K+wid*1024, vdst=lds0+LDS_V+wid*1024;
  #define DMA_K(t,slot) glds16s(uptr((const char*)(Kh+(long)(t)*KVBLK*KP)),koff,(unsigned)__builtin_amdgcn_readfirstlane(kdst+(slot)))
  #define DMA_V(t,slot) glds16s(uptr((const char*)(Vh+(long)(t)*KVBLK*VP)),voff,(unsigned)__builtin_amdgcn_readfirstlane(vdst+(slot)))
  const int vb0=(int)(lds0+LDS_V)+((lane>>4)&1)*32+(lane&3)*8+(4*hi+((lane&15)>>2))*64;
  const char*Kbase=shm+LDS_K; bf16x8 kf[8];
  const lds_cptr shm3=(lds_cptr)shm; const lds_cptr kp0=shm3+LDS_K+hi*1024+r32*16; const lds_cptr vp0=shm3+LDS_V+((lane>>4)&1)*32+(lane&3)*8+(4*hi+((lane&15)>>2))*64;
  const int NT=(q0+QB)/KVBLK;
  DMA_K(0,0);DMA_V(0,0);DMA_K(1,SLOTB);
  bf16x8 qr[4];
  #pragma unroll
  for(int d0=0;d0<4;++d0)qr[d0]=*reinterpret_cast<const bf16x8*>(&Qw[(long)r32*QP+d0*16+hi*8]);
  float mhat=0.f,l_reg=0.f;f32x16 o[2];o[0]=f32x16{};o[1]=f32x16{};f32x16 negm;
  if constexpr(LIN){ if(xr){ const lds_cptr rt=(lds_cptr)shm+LDS_RT;
    _Pragma("unroll") for(int e2=0;e2<2;++e2) _Pragma("unroll") for(int d0=0;d0<4;++d0){ const bf16x8 rf=*(const __attribute__((address_space(3))) bf16x8*)(rt+((32*e2+r32)*64+16*d0+8*hi)*2);
      o[e2]=__builtin_amdgcn_mfma_f32_32x32x16_bf16(qr[d0],rf,o[e2],0,0,0);} } }
  #define NEGM (LIN?f32x16{}:negm)
  const int qrel=wid*QBLK+r32;
  #define CMASK(P0,P1,t) do{int jb_=(t)-(NT-4); if(jb_>=0)cmask<LIN>(P0,P1,jb_,qrel,hi);}while(0)
  bool resc=false;
  #define START(P0,P1) do{ if constexpr(!LIN){ const float rm=rowmax(P0,P1); resc=false; \
    { const float dl=rm; mhat=fadd_s(mhat,dl); \
      _Pragma("unroll") for(int r=0;r<16;++r){P0[r]=fsub_s(P0[r],dl);P1[r]=fsub_s(P1[r],dl);} \
      _Pragma("unroll") for(int r=0;r<16;++r)negm[r]=-mhat; asm volatile("":"+v"(negm)); } \
    _Pragma("unroll") for(int r=0;r<16;++r)P0[r]=__builtin_amdgcn_exp2f(P0[r]); } }while(0)
  #define RESC() do{ if(resc){ asm volatile("s_waitcnt lgkmcnt(0)":::"memory"); \
      _Pragma("unroll") for(int d_=0;d_<2;++d_) _Pragma("unroll") for(int r=0;r<16;++r)o[d_][r]*=wsf[crow(r,hi)]; } }while(0)
  f32x16 pA0,pA1,pB0,pB1;
  int sl_prev=0,sl_cur=0,sl_next=SLOTB;
  #define ROT() do{sl_prev=sl_cur;sl_cur=sl_next;sl_next=(sl_next==(NSLOT-1)*SLOTB)?0:sl_next+SLOTB;}while(0)
  DMA_K(2,2*SLOTB);
  WAIT_BAR(3);
  qkt(pA0,pA1,Kbase,qr,f32x16{},r32,hi);asm volatile("s_nop 15\n\ts_nop 7":"+v"(pA0),"+v"(pA1));CMASK(pA0,pA1,0);
  START(pA0,pA1);
  if constexpr(!LIN){ _Pragma("unroll") for(int r=0;r<16;++r)pA1[r]=__builtin_amdgcn_exp2f(pA1[r]); }
  WAIT_BAR(0);
  DMA_K(3,0);DMA_V(1,SLOTB);
  ROT();
  kload8(kf,kp0+sl_cur);
  WAIT_BAR(2);
  s16x4 vlo[8],vhi[8]; u32x4 pw0,pw1,pw2,pw3;
  #define PKW(P,B) cvtpk_s(P[B],P[B+1])
  #define PAF(k) __builtin_bit_cast(bf16x8,pw##k)
  #define VFR(i) (bf16x8){vlo[i][0],vlo[i][1],vlo[i][2],vlo[i][3],vhi[i][0],vhi[i][1],vhi[i][2],vhi[i][3]}
  #define PIN(x) asm volatile("":"+v"(x))
  #define MX3(a,b,c) __builtin_fmaxf(__builtin_fmaxf((a),(b)),(c))
  #define GAPA(MF,A0,A1,A2,A3,W0,W1,PW) do{ MF; if constexpr(!LIN){ sacc+=A0; sacc+=A1; sacc+=A2; sacc+=A3; PIN(sacc); } W0; W1; PIN(PW); SBAR(); }while(0)
  #define EX(v) __builtin_amdgcn_exp2f(v)
  #define GAPB(MF,X,B) do{ MF; if constexpr(!LIN){ X[B]=EX(X[B]); X[B+1]=EX(X[B+1]); X[B+2]=EX(X[B+2]); X[B+3]=EX(X[B+3]); PIN(X); } SBAR(); }while(0)
  #define VRD(i) do{ vlo[i]=vtr(vp_+(((i)>>2)*4096+((i)&3)*1024)); vhi[i]=vtr(vp_+(((i)>>2)*4096+((i)&3)*1024+512)); }while(0)
  #define KRD(G,j) do{ if(G){ kload2(kf,kp0+sl_next,j); SBAR(); } }while(0)
  #define STEP(C0,C1,P0,P1,t,GK,GV,GL) do{ SBAR(); \
    const lds_cptr vp_=vp0+sl_prev; \
    VRD(0); SBAR(); float sacc=(P0[0]+P0[1]); \
    GAPA(C0=__builtin_amdgcn_mfma_f32_32x32x16_bf16(kf[0],qr[0],NEGM,0,0,0), P0[2],P0[3],P0[4],P0[5],     pw0[0]=PKW(P0,0), pw0[1]=PKW(P0,2), pw0); \
    VRD(4); SBAR(); GAPA(C1=__builtin_amdgcn_mfma_f32_32x32x16_bf16(kf[1],qr[0],NEGM,0,0,0), P0[6],P0[7],P0[8],P0[9],     pw0[2]=PKW(P0,4), pw0[3]=PKW(P0,6), pw0); \
    VRD(1); SBAR(); GAPA(C0=__builtin_amdgcn_mfma_f32_32x32x16_bf16(kf[2],qr[1],C0,0,0,0),   P0[10],P0[11],P0[12],P0[13], pw1[0]=PKW(P0,8), pw1[1]=PKW(P0,10), pw1); \
    VRD(5); SBAR(); GAPA(C1=__builtin_amdgcn_mfma_f32_32x32x16_bf16(kf[3],qr[1],C1,0,0,0),   P0[14],P0[15],P1[0],P1[1],   pw1[2]=PKW(P0,12),pw1[3]=PKW(P0,14), pw1); \
    VRD(2); SBAR(); GAPA(C0=__builtin_amdgcn_mfma_f32_32x32x16_bf16(kf[4],qr[2],C0,0,0,0),   P1[2],P1[3],P1[4],P1[5],     pw2[0]=PKW(P1,0), pw2[1]=PKW(P1,2), pw2); \
    VRD(6); SBAR(); GAPA(C1=__builtin_amdgcn_mfma_f32_32x32x16_bf16(kf[5],qr[2],C1,0,0,0),   P1[6],P1[7],P1[8],P1[9],     pw2[2]=PKW(P1,4), pw2[3]=PKW(P1,6), pw2); \
    VRD(3); SBAR(); GAPA(C0=__builtin_amdgcn_mfma_f32_32x32x16_bf16(kf[6],qr[3],C0,0,0,0),   P1[10],P1[11],P1[12],P1[13], pw3[0]=PKW(P1,8), pw3[1]=PKW(P1,10), pw3); \
    VRD(7); SBAR(); GAPA(C1=__builtin_amdgcn_mfma_f32_32x32x16_bf16(kf[7],qr[3],C1,0,0,0),   P1[14],P1[15],0.f,0.f,       pw3[2]=PKW(P1,12),pw3[3]=PKW(P1,14), pw3); \
    l_reg+=sacc; \
    if(GK){DMA_K((t)+3,sl_cur);} if(GV){DMA_V((t)+1,sl_next);} \
    CMASK(C0,C1,t); \
    resc=false; if constexpr(!LIN){ float a=MX3(C0[0],C0[1],C1[0]),b=MX3(C0[2],C0[3],C1[1]); a=MX3(a,C1[2],C1[3]); \
      _Pragma("unroll") for(int r=4;r<16;r+=4){a=MX3(a,C0[r],C0[r+1]);b=MX3(b,C0[r+2],C0[r+3]);a=MX3(a,C1[r],C1[r+1]);b=MX3(b,C1[r+2],C1[r+3]);} \
      float rm=__builtin_fmaxf(a,b); { auto rr=__builtin_amdgcn_permlane32_swap(__float_as_uint(rm),__float_as_uint(rm),false,false); rm=__builtin_fmaxf(__uint_as_float(rr[0]),__uint_as_float(rr[1])); } \
      if(__builtin_expect(__any(rm>(float)THRL),0)){ const float dl=__builtin_fmaxf(rm,0.f); mhat+=dl; \
        _Pragma("unroll") for(int r=0;r<16;++r){C0[r]-=dl;C1[r]-=dl;} \
        _Pragma("unroll") for(int r=0;r<16;++r)negm[r]=-mhat; asm volatile("":"+v"(negm)); \
        const float f=__builtin_amdgcn_exp2f(-dl); l_reg*=f; if(hi==0)wsf[r32]=f; resc=true; } } \
    SBAR(); \
    GAPB(o[0]=__builtin_amdgcn_mfma_f32_32x32x16_bf16(PAF(0),VFR(0),o[0],0,0,0), C0,0); \
    GAPB(o[1]=__builtin_amdgcn_mfma_f32_32x32x16_bf16(PAF(0),VFR(4),o[1],0,0,0), C0,4); \
    KRD(GL,0); GAPB(o[0]=__builtin_amdgcn_mfma_f32_32x32x16_bf16(PAF(1),VFR(1),o[0],0,0,0), C0,8); \
    KRD(GL,1); GAPB(o[1]=__builtin_amdgcn_mfma_f32_32x32x16_bf16(PAF(1),VFR(5),o[1],0,0,0), C0,12); \
    KRD(GL,2); GAPB(o[0]=__builtin_amdgcn_mfma_f32_32x32x16_bf16(PAF(2),VFR(2),o[0],0,0,0), C1,0); \
    KRD(GL,3); GAPB(o[1]=__builtin_amdgcn_mfma_f32_32x32x16_bf16(PAF(2),VFR(6),o[1],0,0,0), C1,4); \
    GAPB(o[0]=__builtin_amdgcn_mfma_f32_32x32x16_bf16(PAF(3),VFR(3),o[0],0,0,0), C1,8); \
    GAPB(o[1]=__builtin_amdgcn_mfma_f32_32x32x16_bf16(PAF(3),VFR(7),o[1],0,0,0), C1,12); \
    }while(0)
  int t=1;
  #undef CMASK
  #define CMASK(P0,P1,t) do{}while(0)
  for(;t+5<NT;t+=2){
    STEP(pB0,pB1,pA0,pA1,t,true,true,true);     WAIT_BAR(2); RESC(); ROT();
    STEP(pA0,pA1,pB0,pB1,t+1,true,true,true);   WAIT_BAR(2); RESC(); ROT();
  }
  #undef CMASK
  #define CMASK(P0,P1,t) do{int jb_=(t)-(NT-4); if(jb_>=0)cmask<LIN>(P0,P1,jb_,qrel,hi);}while(0)
  #define ENDW(tt) do{ if((tt)+3<NT){WAIT_BAR(2);} else if((tt)+2<NT){WAIT_BAR(1);} else {WAIT_BAR(0);} }while(0)
  for(;t+1<NT;t+=2){
    STEP(pB0,pB1,pA0,pA1,t,(t+3<NT),(t+1<NT),(t+1<NT));       ENDW(t);   RESC(); ROT();
    STEP(pA0,pA1,pB0,pB1,t+1,(t+4<NT),(t+2<NT),(t+2<NT));     ENDW(t+1); RESC(); ROT();
  }
  STEP(pB0,pB1,pA0,pA1,NT-1,false,false,false); RESC();
  { float sacc=pB0[0]+pB0[1]; _Pragma("unroll") for(int r=2;r<16;++r)sacc+=pB0[r]; _Pragma("unroll") for(int r=0;r<16;++r)sacc+=pB1[r]; l_reg+=sacc;
    pw0=(u32x4){PKW(pB0,0),PKW(pB0,2),PKW(pB0,4),PKW(pB0,6)};pw1=(u32x4){PKW(pB0,8),PKW(pB0,10),PKW(pB0,12),PKW(pB0,14)};pw2=(u32x4){PKW(pB1,0),PKW(pB1,2),PKW(pB1,4),PKW(pB1,6)};pw3=(u32x4){PKW(pB1,8),PKW(pB1,10),PKW(pB1,12),PKW(pB1,14)};
    SBAR(); pv(o,vb0+sl_cur,PAF(0),PAF(1),PAF(2),PAF(3)); }
  #undef PKW
  #undef PAF
  #undef VFR
  #undef PIN
  #undef MX3
  #undef GAPA
  #undef GAPB
  #undef EX
  #undef VRD
  #undef KRD
  #undef STEP
  #undef ENDW
  {auto rr=__builtin_amdgcn_permlane32_swap(__float_as_uint(l_reg),__float_as_uint(l_reg),false,false);l_reg=__uint_as_float(rr[0])+__uint_as_float(rr[1]);}
  if(hi==0)wsf[32+r32]=l_reg;asm volatile("s_waitcnt lgkmcnt(0)":::"memory");
  float rli[16];
  #pragma unroll
  for(int r=0;r<16;++r)rli[r]=LIN?1.f:__builtin_amdgcn_rcpf(wsf[32+crow(r,hi)]);
  bf16*Ow=O+(rowbase+q0+wid*QBLK)*OP;
  { bf16*stg=(bf16*)(shm+LDS_OST)+wid*2048;
    #pragma unroll
    for(int r=0;r<16;++r){const int orow=crow(r,hi);
      #pragma unroll
      for(int d0=0;d0<2;++d0)stg[orow*64+d0*32+r32]=__float2bfloat16(o[d0][r]*rli[r]);}
    asm volatile("s_waitcnt lgkmcnt(0)":::"memory");
    int lane_e=lane; asm volatile("":"+v"(lane_e));
    #pragma unroll
    for(int i=0;i<4;++i){const int row=i*8+(lane_e>>3),ch=lane_e&7; const u32x4 v=*(const u32x4*)(stg+row*64+ch*8); ATTN_STORE16(Ow+(long)row*OP+ch*8,v);} }
  asm volatile("s_waitcnt lgkmcnt(0)\n\ts_barrier":::"memory");
  #undef DMA_K
  #undef DMA_V
  #undef CMASK
  #undef START
  #undef RESC
  #undef ROT
}
constexpr int ATTN_LDS_BYTES=LDS_BYTES;
__device__ __forceinline__ void ret_state(long rowbase,int nt,const bf16*__restrict__ K,int KP,const bf16*__restrict__ V,int VP,char*shm,const int WAVE_S){
  int lane=lane_id_(); asm volatile("":"+v"(lane)); const int r32=lane&31,hi=lane>>5; const int wid=WAVE_S;
  const bf16*Kh=K+rowbase*KP,*Vh=V+rowbase*VP;
  const unsigned lds0=(unsigned)(uintptr_t)shm;
  const unsigned koff=(unsigned)(((16*(wid&3)+(lane>>2))*KP+(wid>>2)*32+(lane&3)*8)*2);
  const unsigned voff=(unsigned)(((16*(wid&3)+(lane>>2))*VP+(wid>>2)*32+(lane&3)*8)*2);
  const unsigned kdst=lds0+wid*1024, vdst=lds0+8192+wid*1024;
  #define RS_DMA(t,slot) do{ glds16s(uptr((const char*)(Kh+(long)(t)*KVBLK*KP)),koff,(unsigned)__builtin_amdgcn_readfirstlane(kdst+(slot))); \
                             glds16s(uptr((const char*)(Vh+(long)(t)*KVBLK*VP)),voff,(unsigned)__builtin_amdgcn_readfirstlane(vdst+(slot))); }while(0)
  const lds_cptr shm3=(lds_cptr)shm;
  const int frag=((lane>>4)&1)*32+(lane&3)*8+(4*hi+((lane&15)>>2))*64;
  const int eb=wid&1, db=(wid>>1)&1, kh=wid>>2;
  f32x16 acc=f32x16{};
  { int s=0; for(int t=0;t<5&&t<nt;++t){ RS_DMA(t,s); s+=RS_SLOTB; } }
  int sl=0, sl_free=5*RS_SLOTB;
  for(int t=0;t<nt;++t){
    const int after=(nt-1-t)<4?(nt-1-t):4;
    if(after==4)WAIT_BAR(8); else if(after==3)WAIT_BAR(6); else if(after==2)WAIT_BAR(4); else if(after==1)WAIT_BAR(2); else WAIT_BAR(0);
    if(t+5<nt)RS_DMA(t+5,sl_free);
    const lds_cptr kp=shm3+sl+frag, vp=shm3+sl+8192+frag;
    #pragma unroll
    for(int k2=0;k2<2;++k2){ const int ks=2*kh+k2;
      const s16x4 alo=vtr(vp+eb*4096+ks*1024), ahi=vtr(vp+eb*4096+ks*1024+512), blo=vtr(kp+db*4096+ks*1024), bhi=vtr(kp+db*4096+ks*1024+512);
      const bf16x8 af=(bf16x8){alo[0],alo[1],alo[2],alo[3],ahi[0],ahi[1],ahi[2],ahi[3]}, bf=(bf16x8){blo[0],blo[1],blo[2],blo[3],bhi[0],bhi[1],bhi[2],bhi[3]};
      acc=__builtin_amdgcn_mfma_f32_32x32x16_bf16(af,bf,acc,0,0,0); }
    sl_free=sl; sl=(sl==(RS_NSLOT-1)*RS_SLOTB)?0:sl+RS_SLOTB;
  }
  #undef RS_DMA
  __attribute__((address_space(3))) float*part=(__attribute__((address_space(3))) float*)((__attribute__((address_space(3))) char*)shm+LDS_RTS)+(wid&3)*1024;
  if(kh==1){ _Pragma("unroll") for(int r=0;r<16;++r)part[r*64+lane]=acc[r]; }
  asm volatile("s_waitcnt lgkmcnt(0)\n\ts_barrier":::"memory");
  if(kh==0){ __attribute__((address_space(3))) unsigned short*rt=(__attribute__((address_space(3))) unsigned short*)((__attribute__((address_space(3))) char*)shm+LDS_RT);
    _Pragma("unroll") for(int r=0;r<16;++r){ const float v=acc[r]+part[r*64+lane]; rt[(32*eb+crow(r,hi))*64+32*db+r32]=(unsigned short)(cvtpk_s(v,0.f)&0xffffu); } }
  asm volatile("s_waitcnt lgkmcnt(0)\n\ts_barrier":::"memory");
}
constexpr int A2_K=0, A2_V=3*8192, A2_WS=A2_V+3*16384, A2_OST=A2_WS+NW*64*4, A2_BYTES=A2_OST+NW*4096;
template<int THRL> __device__ __forceinline__ void attn_unit2(long rowbase,int qb,const bf16*Q,int QP,const bf16*__restrict__ K,int KP,const bf16*__restrict__ V,int VP,bf16*O,int OP,char*shm,const int WAVE_S){
  int lane=lane_id_(); asm volatile("":"+v"(lane)); const int r32=lane&31,hi=lane>>5; const int wid=WAVE_S;
  const int q0=qb*QB;
  const bf16*Qw=Q+(rowbase+q0+wid*QBLK)*QP;
  const bf16*Kh=K+rowbase*KP,*Vh=V+rowbase*VP;
  const unsigned lds0=(unsigned)(uintptr_t)shm;
  float*wsf=(float*)(shm+A2_WS)+wid*64;
  const unsigned koff=(unsigned)((lane*KP+wid*8)*2);
  const unsigned voff=(unsigned)(((16*(wid&3)+(lane>>2))*VP+(wid>>2)*32+(lane&3)*8)*2);
  const unsigned kdst=lds0+A2_K+wid*1024, vdst=lds0+A2_V+wid*1024;
  #define DMA_K(t,slot) glds16s(uptr((const char*)(Kh+(long)(t)*KVBLK*KP)),koff,(unsigned)__builtin_amdgcn_readfirstlane(kdst+(slot)))
  #define DMA_V(t,slot) do{ glds16s(uptr((const char*)(Vh+(long)(t)*KVBLK*VP)),voff,(unsigned)__builtin_amdgcn_readfirstlane(vdst+2*(slot))); \
                            glds16s(uptr((const char*)(Vh+(long)(t)*KVBLK*VP)+128),voff,(unsigned)__builtin_amdgcn_readfirstlane(vdst+2*(slot)+8192)); }while(0)
  const char*Kbase=shm+A2_K; bf16x8 kf[8];
  const lds_cptr shm3=(lds_cptr)shm; const lds_cptr kp0=shm3+A2_K+hi*1024+r32*16; const lds_cptr vp0=shm3+A2_V+((lane>>4)&1)*32+(lane&3)*8+(4*hi+((lane&15)>>2))*64;
  const int NT=(q0+QB)/KVBLK;
  DMA_K(0,0);DMA_V(0,0);DMA_K(1,SLOTB);
  bf16x8 qr[4];
  #pragma unroll
  for(int d0=0;d0<4;++d0)qr[d0]=*reinterpret_cast<const bf16x8*>(&Qw[(long)r32*QP+d0*16+hi*8]);
  float mhat=0.f,l_reg=0.f;f32x16 o[4];o[0]=f32x16{};o[1]=f32x16{};o[2]=f32x16{};o[3]=f32x16{};
  const int qrel=wid*QBLK+r32;
  #define CMASK(P0,P1,t) do{int jb_=(t)-(NT-4); if(jb_>=0)cmask<false>(P0,P1,jb_,qrel,hi);}while(0)
  bool resc=false;
  #define RESC() do{ if(resc){ asm volatile("s_waitcnt lgkmcnt(0)":::"memory"); \
      _Pragma("unroll") for(int d_=0;d_<4;++d_) _Pragma("unroll") for(int r=0;r<16;++r)o[d_][r]*=wsf[crow(r,hi)]; } }while(0)
  f32x16 pA0,pA1,pB0,pB1;
  int sl_prev=0,sl_cur=0,sl_next=SLOTB;
  #define ROT() do{sl_prev=sl_cur;sl_cur=sl_next;sl_next=(sl_next==(NSLOT-1)*SLOTB)?0:sl_next+SLOTB;}while(0)
  DMA_K(2,2*SLOTB);
  WAIT_BAR(4);
  qkt(pA0,pA1,Kbase,qr,f32x16{},r32,hi);asm volatile("s_nop 15\n\ts_nop 7":"+v"(pA0),"+v"(pA1));CMASK(pA0,pA1,0);
  { const float rm=rowmax(pA0,pA1); mhat=rm;
    _Pragma("unroll") for(int r=0;r<16;++r){pA0[r]=__builtin_amdgcn_exp2f(pA0[r]-mhat);pA1[r]=__builtin_amdgcn_exp2f(pA1[r]-mhat);} }
  WAIT_BAR(0);
  DMA_K(3,0);DMA_V(1,SLOTB);
  ROT();
  kload8(kf,kp0+sl_cur);
  WAIT_BAR(3);
  s16x4 fa_lo,fa_hi,fb_lo,fb_hi,fc_lo,fc_hi,fd_lo,fd_hi; u32x4 pw0,pw1,pw2,pw3;
  #define PKW(P,B) cvtpk_s(P[B],P[B+1])
  #define PAF(k) __builtin_bit_cast(bf16x8,pw##k)
  #define PIN(x) asm volatile("":"+v"(x))
  #define MX3(a,b,c) __builtin_fmaxf(__builtin_fmaxf((a),(b)),(c))
  #define VOFF(i) ((((i)&3)>>1)*8192+((i)&1)*4096+((i)>>2)*1024)
  #define VRDX(X,i) do{ X##_lo=vtr(vp_+VOFF(i)); X##_hi=vtr(vp_+VOFF(i)+512); }while(0)
  #define VFRX(X) (bf16x8){X##_lo[0],X##_lo[1],X##_lo[2],X##_lo[3],X##_hi[0],X##_hi[1],X##_hi[2],X##_hi[3]}
  #define GAPA(MF,A0,A1,A2,A3,W0,W1,PW) do{ MF; sacc+=A0; sacc+=A1; sacc+=A2; sacc+=A3; PIN(sacc); W0; W1; PIN(PW); SBAR(); }while(0)
  #define EX(v) __builtin_amdgcn_exp2f(v)
  #define GAPB(MF,X,B) do{ MF; X[B]=EX(X[B]-mhat); X[B+1]=EX(X[B+1]-mhat); PIN(X); SBAR(); }while(0)
  #define KRD(G,j) do{ if(G){ kload2(kf,kp0+sl_next,j); SBAR(); } }while(0)
  #define PVM(i,X) o[(i)&3]=__builtin_amdgcn_mfma_f32_32x32x16_bf16(PAF_((i)>>2),VFRX(X),o[(i)&3],0,0,0)
  #define PAF_(k) ((k)==0?PAF(0):(k)==1?PAF(1):(k)==2?PAF(2):PAF(3))
  #define STEP(C0,C1,P0,P1,t,GK,GV,GL) do{ SBAR(); \
    const lds_cptr vp_=vp0+2*sl_prev; \
    float sacc=(P0[0]+P0[1]); \
    GAPA(C0=__builtin_amdgcn_mfma_f32_32x32x16_bf16(kf[0],qr[0],f32x16{},0,0,0), P0[2],P0[3],P0[4],P0[5],     pw0[0]=PKW(P0,0), pw0[1]=PKW(P0,2), pw0); \
    GAPA(C1=__builtin_amdgcn_mfma_f32_32x32x16_bf16(kf[1],qr[0],f32x16{},0,0,0), P0[6],P0[7],P0[8],P0[9],     pw0[2]=PKW(P0,4), pw0[3]=PKW(P0,6), pw0); \
    GAPA(C0=__builtin_amdgcn_mfma_f32_32x32x16_bf16(kf[2],qr[1],C0,0,0,0),   P0[10],P0[11],P0[12],P0[13], pw1[0]=PKW(P0,8), pw1[1]=PKW(P0,10), pw1); \
    GAPA(C1=__builtin_amdgcn_mfma_f32_32x32x16_bf16(kf[3],qr[1],C1,0,0,0),   P0[14],P0[15],P1[0],P1[1],   pw1[2]=PKW(P0,12),pw1[3]=PKW(P0,14), pw1); \
    GAPA(C0=__builtin_amdgcn_mfma_f32_32x32x16_bf16(kf[4],qr[2],C0,0,0,0),   P1[2],P1[3],P1[4],P1[5],     pw2[0]=PKW(P1,0), pw2[1]=PKW(P1,2), pw2); \
    VRDX(fa,0); SBAR(); GAPA(C1=__builtin_amdgcn_mfma_f32_32x32x16_bf16(kf[5],qr[2],C1,0,0,0),   P1[6],P1[7],P1[8],P1[9],     pw2[2]=PKW(P1,4), pw2[3]=PKW(P1,6), pw2); \
    VRDX(fb,1); SBAR(); GAPA(C0=__builtin_amdgcn_mfma_f32_32x32x16_bf16(kf[6],qr[3],C0,0,0,0),   P1[10],P1[11],P1[12],P1[13], pw3[0]=PKW(P1,8), pw3[1]=PKW(P1,10), pw3); \
    VRDX(fc,2); SBAR(); GAPA(C1=__builtin_amdgcn_mfma_f32_32x32x16_bf16(kf[7],qr[3],C1,0,0,0),   P1[14],P1[15],0.f,0.f,       pw3[2]=PKW(P1,12),pw3[3]=PKW(P1,14), pw3); \
    l_reg+=sacc; \
    if(GK){DMA_K((t)+3,sl_cur);} if(GV){DMA_V((t)+1,sl_next);} \
    CMASK(C0,C1,t); \
    resc=false; { float a=MX3(C0[0],C0[1],C1[0]),b=MX3(C0[2],C0[3],C1[1]); a=MX3(a,C1[2],C1[3]); \
      _Pragma("unroll") for(int r=4;r<16;r+=4){a=MX3(a,C0[r],C0[r+1]);b=MX3(b,C0[r+2],C0[r+3]);a=MX3(a,C1[r],C1[r+1]);b=MX3(b,C1[r+2],C1[r+3]);} \
      float rm=__builtin_fmaxf(a,b); { auto rr=__builtin_amdgcn_permlane32_swap(__float_as_uint(rm),__float_as_uint(rm),false,false); rm=__builtin_fmaxf(__uint_as_float(rr[0]),__uint_as_float(rr[1])); } \
      rm-=mhat; \
      if(__builtin_expect(__any(rm>(float)THRL),0)){ const float dl=__builtin_fmaxf(rm,0.f); mhat+=dl; \
        const float f=__builtin_amdgcn_exp2f(-dl); l_reg*=f; if(hi==0)wsf[r32]=f; resc=true; } } \
    SBAR(); \
    VRDX(fd,3);  SBAR(); GAPB(PVM(0,fa),  C0,0); \
    VRDX(fa,4);  SBAR(); GAPB(PVM(1,fb),  C0,2); \
    VRDX(fb,5);  SBAR(); GAPB(PVM(2,fc),  C0,4); \
    VRDX(fc,6);  SBAR(); KRD(GL,0); GAPB(PVM(3,fd),  C0,6); \
    VRDX(fd,7);  SBAR(); KRD(GL,1); GAPB(PVM(4,fa),  C0,8); \
    VRDX(fa,8);  SBAR(); KRD(GL,2); GAPB(PVM(5,fb),  C0,10); \
    VRDX(fb,9);  SBAR(); KRD(GL,3); GAPB(PVM(6,fc),  C0,12); \
    VRDX(fc,10); SBAR(); GAPB(PVM(7,fd),  C0,14); \
    VRDX(fd,11); SBAR(); GAPB(PVM(8,fa),  C1,0); \
    VRDX(fa,12); SBAR(); GAPB(PVM(9,fb),  C1,2); \
    VRDX(fb,13); SBAR(); GAPB(PVM(10,fc), C1,4); \
    VRDX(fc,14); SBAR(); GAPB(PVM(11,fd), C1,6); \
    VRDX(fd,15); SBAR(); GAPB(PVM(12,fa), C1,8); \
    GAPB(PVM(13,fb), C1,10); \
    GAPB(PVM(14,fc), C1,12); \
    GAPB(PVM(15,fd), C1,14); \
    }while(0)
  int t=1;
  #undef CMASK
  #define CMASK(P0,P1,t) do{}while(0)
  for(;t+5<NT;t+=2){
    STEP(pB0,pB1,pA0,pA1,t,true,true,true);     WAIT_BAR(3); RESC(); ROT();
    STEP(pA0,pA1,pB0,pB1,t+1,true,true,true);   WAIT_BAR(3); RESC(); ROT();
  }
  #undef CMASK
  #define CMASK(P0,P1,t) do{int jb_=(t)-(NT-4); if(jb_>=0)cmask<false>(P0,P1,jb_,qrel,hi);}while(0)
  #define ENDW(tt) do{ if((tt)+3<NT){WAIT_BAR(3);} else if((tt)+2<NT){WAIT_BAR(2);} else {WAIT_BAR(0);} }while(0)
  for(;t+1<NT;t+=2){
    STEP(pB0,pB1,pA0,pA1,t,(t+3<NT),(t+1<NT),(t+1<NT));       ENDW(t);   RESC(); ROT();
    STEP(pA0,pA1,pB0,pB1,t+1,(t+4<NT),(t+2<NT),(t+2<NT));     ENDW(t+1); RESC(); ROT();
  }
  STEP(pB0,pB1,pA0,pA1,NT-1,false,false,false); RESC();
  { float sacc=pB0[0]+pB0[1]; _Pragma("unroll") for(int r=2;r<16;++r)sacc+=pB0[r]; _Pragma("unroll") for(int r=0;r<16;++r)sacc+=pB1[r]; l_reg+=sacc;
    pw0=(u32x4){PKW(pB0,0),PKW(pB0,2),PKW(pB0,4),PKW(pB0,6)};pw1=(u32x4){PKW(pB0,8),PKW(pB0,10),PKW(pB0,12),PKW(pB0,14)};pw2=(u32x4){PKW(pB1,0),PKW(pB1,2),PKW(pB1,4),PKW(pB1,6)};pw3=(u32x4){PKW(pB1,8),PKW(pB1,10),PKW(pB1,12),PKW(pB1,14)};
    SBAR(); const lds_cptr vp_=vp0+2*sl_cur;
    #pragma unroll
    for(int e4=0;e4<4;++e4){ s16x4 lo[4],hh[4];
      #pragma unroll
      for(int ks=0;ks<4;++ks){ lo[ks]=vtr(vp_+VOFF(4*ks+e4)); hh[ks]=vtr(vp_+VOFF(4*ks+e4)+512); }
      #define PK(k) (bf16x8){lo[k][0],lo[k][1],lo[k][2],lo[k][3],hh[k][0],hh[k][1],hh[k][2],hh[k][3]}
      o[e4]=__builtin_amdgcn_mfma_f32_32x32x16_bf16(PAF(0),PK(0),o[e4],0,0,0);
      o[e4]=__builtin_amdgcn_mfma_f32_32x32x16_bf16(PAF(1),PK(1),o[e4],0,0,0);
      o[e4]=__builtin_amdgcn_mfma_f32_32x32x16_bf16(PAF(2),PK(2),o[e4],0,0,0);
      o[e4]=__builtin_amdgcn_mfma_f32_32x32x16_bf16(PAF(3),PK(3),o[e4],0,0,0);
      #undef PK
    } }
  #undef PKW
  #undef PAF
  #undef PAF_
  #undef PVM
  #undef PIN
  #undef MX3
  #undef VOFF
  #undef VRDX
  #undef VFRX
  #undef GAPA
  #undef GAPB
  #undef EX
  #undef KRD
  #undef STEP
  #undef ENDW
  {auto rr=__builtin_amdgcn_permlane32_swap(__float_as_uint(l_reg),__float_as_uint(l_reg),false,false);l_reg=__uint_as_float(rr[0])+__uint_as_float(rr[1]);}
  if(hi==0)wsf[32+r32]=l_reg;asm volatile("s_waitcnt lgkmcnt(0)":::"memory");
  float rli[16];
  #pragma unroll
  for(int r=0;r<16;++r)rli[r]=__builtin_amdgcn_rcpf(wsf[32+crow(r,hi)]);
  bf16*Ow=O+(rowbase+q0+wid*QBLK)*OP;
  { bf16*stg=(bf16*)(shm+A2_OST)+wid*2048;
    int lane_e=lane; asm volatile("":"+v"(lane_e));
    #pragma unroll
    for(int hh=0;hh<2;++hh){
      #pragma unroll
      for(int r=0;r<16;++r){const int orow=crow(r,hi);
        #pragma unroll
        for(int d0=0;d0<2;++d0)stg[orow*64+d0*32+r32]=__float2bfloat16(o[2*hh+d0][r]*rli[r]);}
      asm volatile("s_waitcnt lgkmcnt(0)":::"memory");
      #pragma unroll
      for(int i=0;i<4;++i){const int row=i*8+(lane_e>>3),ch=lane_e&7; const u32x4 v=*(const u32x4*)(stg+row*64+ch*8); ATTN_STORE16(Ow+(long)row*OP+hh*64+ch*8,v);}
      asm volatile("s_waitcnt lgkmcnt(0)":::"memory");
    } }
  asm volatile("s_waitcnt lgkmcnt(0)\n\ts_barrier":::"memory");
  #undef DMA_K
  #undef DMA_V
  #undef CMASK
  #undef RESC
  #undef ROT
}
#undef SBAR
#undef WAIT_BAR
}

#define GAS __attribute__((address_space(1)))
#define LAS __attribute__((address_space(3)))
typedef unsigned v4u __attribute__((ext_vector_type(4)));
typedef float f32x4 __attribute__((ext_vector_type(4)));
typedef short bf16x8 __attribute__((ext_vector_type(8)));
typedef GAS unsigned gu32;
typedef GAS unsigned long long gu64;
#define RLX_AGENT __ATOMIC_RELAXED, __HIP_MEMORY_SCOPE_AGENT
#define LDS_WAIT() asm volatile("s_waitcnt lgkmcnt(0)" ::: "memory")
#define VM_WAIT() asm volatile("s_waitcnt vmcnt(0)" ::: "memory")
__device__ __forceinline__ unsigned long long rt() { return __builtin_amdgcn_s_memrealtime(); }

#define XB_TMO      128
#define XB_XCNT(j)  (256  + 64 * (j))
#define XB_XSUB(j)  (1280 + 64 * (j))
#define XB_XGEN(j)  (2304 + 64 * (j))
#define XB_TOP      3328
#define XB_TOPGEN   3392
#define XCD_BAR_WORDS 3456
#define XB_SPIN_CAP (1u << 18)

__device__ __forceinline__ unsigned xb_ld(unsigned* p)              { return __hip_atomic_load(p, __ATOMIC_RELAXED, __HIP_MEMORY_SCOPE_AGENT); }
__device__ __forceinline__ unsigned xb_add(unsigned* p, unsigned v) { return __hip_atomic_fetch_add(p, v, __ATOMIC_RELAXED, __HIP_MEMORY_SCOPE_AGENT); }
__device__ __forceinline__ unsigned xb_xcc_id() { return (unsigned)__builtin_amdgcn_s_getreg((3 << 11) | 20) & 0xFu; }
#define XB_SPIN(cond, bar) do { unsigned _sp = 0; while (cond) { __builtin_amdgcn_s_sleep(1); \
    if ((++_sp & 255u) == 0u) { if (xb_ld(&(bar)[XB_TMO])) break; if (_sp > XB_SPIN_CAP) { atomicAdd(&(bar)[XB_TMO], 1u); break; } } } } while (0)

struct XcdBarrier {
    unsigned* bar; unsigned x;
    volatile LAS unsigned* st;
};

__device__ __forceinline__ XcdBarrier xcd_barrier_post(unsigned* bar, volatile LAS unsigned* st, const bool first) {
    XcdBarrier b; b.bar = bar; b.x = xb_xcc_id(); b.st = st;
    if (first) (void)xb_add(&bar[XB_XCNT(b.x)], 1u);
    return b;
}
__device__ __forceinline__ void xcd_barrier_complete(unsigned* bar, unsigned x, unsigned& nloc, unsigned& nx) {
    const unsigned G = gridDim.x * gridDim.y * gridDim.z;
    unsigned sum, cnt, mine, sp = 0u;
    for (;;) {
        sum = 0u; cnt = 0u; mine = 0u;
#pragma unroll
        for (unsigned j = 0; j < 16; ++j) { const unsigned c = xb_ld(&bar[XB_XCNT(j)]); sum += c; cnt += (c > 0u) ? 1u : 0u; mine = (j == x) ? c : mine; }
        if (sum == G) break;
        __builtin_amdgcn_s_sleep(1);
        if ((++sp & 255u) == 0u) { if (xb_ld(&bar[XB_TMO])) break; if (sp > XB_SPIN_CAP) { atomicAdd(&bar[XB_TMO], 1u); break; } }
    }
    nloc = mine > 0u ? mine : 1u; nx = cnt > 0u ? cnt : 1u;
}

__device__ __forceinline__ void xcd_barrier(const XcdBarrier& b, const bool first) {
    asm volatile("s_waitcnt vmcnt(0)" ::: "memory");
    __syncthreads();
    if (first) {
        unsigned* bar = b.bar;
        __builtin_amdgcn_s_waitcnt(0);
        unsigned nloc = b.st[0], nx = b.st[1];
        if (nloc == 0u) { xcd_barrier_complete(bar, b.x, nloc, nx); b.st[0] = nloc; b.st[1] = nx; }
        const unsigned old = xb_add(&bar[XB_XSUB(b.x)], 1u);
        const unsigned gen = old / nloc;
        if (old + 1u == (gen + 1u) * nloc) {
            __builtin_amdgcn_fence(__ATOMIC_RELEASE, "agent");
            asm volatile("s_waitcnt vmcnt(0)" ::: "memory");
            const unsigned og = xb_add(&bar[XB_TOP], 1u);
            const unsigned tg = og / nx;
            if (og + 1u == (tg + 1u) * nx) xb_add(&bar[XB_TOPGEN], 1u);
            else XB_SPIN(xb_ld(&bar[XB_TOPGEN]) == tg, bar);
            __builtin_amdgcn_fence(__ATOMIC_ACQUIRE, "agent");
            xb_add(&bar[XB_XGEN(b.x)], 1u);
            asm volatile("s_waitcnt vmcnt(0)" ::: "memory");
        } else {
            XB_SPIN(xb_ld(&bar[XB_XGEN(b.x)]) == gen, bar);
            __builtin_amdgcn_fence(__ATOMIC_ACQUIRE, "agent");
            asm volatile("s_waitcnt vmcnt(0)" ::: "memory");
        }
    }
    __syncthreads();
}

constexpr int NWAVES = 8;
constexpr int RING_OFF = 0, RING_BYTES = 131072;
constexpr int LDSCTL_OFF = RING_BYTES, MISC_OFF = LDSCTL_OFF + 320;
constexpr int LDS_BYTES = 147456;
constexpr int CW_BAR = 0;
#ifndef MK_N_LAUNCHES
#define MK_N_LAUNCHES 1
#endif
constexpr size_t CTL_ZERO_BYTES = (MK_N_LAUNCHES == 1 ? 16 : 256) * 1024;
constexpr int N_PHASES = 10;
#ifndef PROBE_DOUBLEK
#define PROBE_DOUBLEK 0
#endif
#ifndef PROBE_PHASE
#define PROBE_PHASE -1
#endif
constexpr int PROBE_AMP = 8;
#ifndef PROBE_REPS
#define PROBE_REPS 1,1,1,1,1,1,1,1,1,1
#endif
constexpr int PHASE_REP[N_PHASES] = {PROBE_REPS};

__device__ __forceinline__ void xcd_barrier_arrive(const XcdBarrier& b, const bool first) {
    asm volatile("s_waitcnt vmcnt(0)" ::: "memory");
    __syncthreads();
    if (first) {
        unsigned* bar = b.bar;
        __builtin_amdgcn_s_waitcnt(0);
        unsigned nloc = b.st[0], nx = b.st[1];
        if (nloc == 0u) { xcd_barrier_complete(bar, b.x, nloc, nx); b.st[0] = nloc; b.st[1] = nx; }
        const unsigned old = xb_add(&bar[XB_XSUB(b.x)], 1u);
        const unsigned gen = old / nloc;
        unsigned role = 0u, tg = 0u;
        if (old + 1u == (gen + 1u) * nloc) {
            __builtin_amdgcn_fence(__ATOMIC_RELEASE, "agent");
            asm volatile("s_waitcnt vmcnt(0)" ::: "memory");
            const unsigned og = xb_add(&bar[XB_TOP], 1u);
            tg = og / nx;
            if (og + 1u == (tg + 1u) * nx) { xb_add(&bar[XB_TOPGEN], 1u); role = 2u; } else role = 1u;
        }
        b.st[2] = gen; b.st[3] = role; b.st[4] = tg;
    }
}
__device__ __forceinline__ void xcd_barrier_wait(const XcdBarrier& b, const bool first) {
    if (first) {
        unsigned* bar = b.bar;
        const unsigned gen = b.st[2], role = b.st[3], tg = b.st[4];
        if (role != 0u) {
            if (role == 1u) XB_SPIN(xb_ld(&bar[XB_TOPGEN]) == tg, bar);
            __builtin_amdgcn_fence(__ATOMIC_ACQUIRE, "agent");
            xb_add(&bar[XB_XGEN(b.x)], 1u);
            asm volatile("s_waitcnt vmcnt(0)" ::: "memory");
        } else {
            XB_SPIN(xb_ld(&bar[XB_XGEN(b.x)]) == gen, bar);
            __builtin_amdgcn_fence(__ATOMIC_ACQUIRE, "agent");
            asm volatile("s_waitcnt vmcnt(0)" ::: "memory");
        }
    }
    __syncthreads();
}
__device__ __forceinline__ const void* karg(unsigned off) {
    asm volatile("" : "+s"(off));
    return *(const void* const __attribute__((address_space(4)))*)((const char __attribute__((address_space(4)))*)__builtin_amdgcn_kernarg_segment_ptr() + off);
}
struct MArgs { const void* in[20]; float* out; unsigned char* ws; int ph_lo, ph_hi, li, pad; };

__global__ void __launch_bounds__(NWAVES * 64, 2) mega_fwd(MArgs args) {
    extern __shared__ __attribute__((aligned(16))) unsigned char lds[];
    LAS unsigned char* L = (LAS unsigned char*)lds;
    const int WAVE_S = __builtin_amdgcn_readfirstlane((int)(threadIdx.x >> 6));
#define TID() (WAVE_S * 64 + lane_id_())
#define FIRST() (WAVE_S == 0 && lane_id_() == 0)
    const int G = gridDim.x, bx = blockIdx.x, vcu = (G % 8 == 0) ? (bx % 8) * (G / 8) + bx / 8 : bx;
    for (int u = (int)threadIdx.x; u < (LDS_BYTES - LDSCTL_OFF) / 4; u += NWAVES * 64) ((LAS unsigned*)(L + LDSCTL_OFF))[u] = 0u;
    __syncthreads();
    unsigned* ctl = (unsigned*)(args.ws + WS_CTL);
    XcdBarrier bar = xcd_barrier_post(ctl + CW_BAR + args.li * XCD_BAR_WORDS, (volatile LAS unsigned*)(L + MISC_OFF) + 8, FIRST());
    const int lo = args.ph_lo, hi = args.ph_hi;
    unsigned long long t_last = PROBE_PHASE >= 0 ? __builtin_amdgcn_s_memrealtime() : 0ull, t_a = 0ull, t_b = 0ull;
#define IN(k) (lo <= (k) && (k) < hi)
#define ARRIVE(k) do { if (IN(k) && IN((k) + 1)) xcd_barrier_arrive(bar, FIRST()); } while (0)
#define WAITB(k) do { if (PROBE_PHASE == (k)) { t_a = t_last; } if (IN(k) && IN((k) + 1)) xcd_barrier_wait(bar, FIRST()); if (PROBE_PHASE >= 0) { t_last = __builtin_amdgcn_s_memrealtime(); if (PROBE_PHASE == (k)) t_b = t_last; } } while (0)
#define SEAM(k) do { ARRIVE(k); WAITB(k); } while (0)
#define CONVPTRS() ConvPtrs cv{INF(6), INF(14), INF(15), INF(16), INF(18), INF(19), WSB(WS_WIN), WSB(WS_WA), WSB(WS_WB), WSB(WS_WOUT), WSB(WS_WGU), WSB(WS_WDN)}

#define INF(k) ((const float*)karg(8 * (k)))
#define OUTP() ((float*)karg(160))
#define WSB(off) ((bf16_t*)((unsigned char*)karg(168) + (off)))
#define WSF(off) ((float*)((unsigned char*)karg(168) + (off)))

    if (IN(0)) gemv4_phase<true, false>(TID(), vcu, G, INF(1), DM, INF(3), MODW, INF(4), WSF(WS_MOD), MODW, (float*)lds);
    ARRIVE(0);
    if (IN(0)) { CONVPTRS(); convert_phase(TID(), vcu, G, cv, (float*)lds, CV_S0, CV_S1); trig_phase(TID(), vcu, G, (const int*)karg(16), WSF(WS_TA), WSF(WS_TR)); __syncthreads(); }
    WAITB(0);
    if (IN(1)) for (int rep_ = 0; rep_ < PHASE_REP[1]; ++rep_) { const float* mod = WSF(WS_MOD); xn_phase(TID(), vcu, G, INF(0), INF(5), mod + 1 * DM, mod + 0 * DM, WSB(WS_XN)); }
    ARRIVE(1);
    if (IN(1)) { CONVPTRS(); convert_phase(TID(), vcu, G, cv, (float*)lds, CV_S1, CV_S2); __syncthreads(); }
    WAITB(1);
    if (IN(2)) for (int rep_ = 0; rep_ < PHASE_REP[2]; ++rep_) {
        pg8::Gemm g{WSB(WS_XN), WSB(WS_WIN), M, INW, DM}; pg8::StaticOrder S; S.init(M, INW, G, bx);
        pg8::EpiRows<InProjEpi> E{{WSB(WS_DQ), WSB(WS_DK), WSB(WS_DV), WSB(WS_RQ), WSB(WS_RK), WSB(WS_RV), WSB(WS_RG), WSB(WS_GA), WSB(WS_GB), INF(7), INF(8), WSF(WS_TA), WSF(WS_TR)}};
        pg8::gemm_phase<pg8::EpiRows<InProjEpi>, pg8::StaticOrder, true, true>(L + RING_OFF, g, S, E, WAVE_S);
    }
    ARRIVE(2);
    if (IN(2)) { const float* mod = WSF(WS_MOD); gemv4_phase<false, true>(TID(), vcu, G, mod + 3 * DM, MODW, INF(18), 2 * DFF, nullptr, WSF(WS_CVEC), 2 * DFF, (float*)lds); }
    WAITB(2);
    if (IN(3)) for (int rep_ = 0; rep_ < PHASE_REP[3]; ++rep_) {
        char* shm = (char*)lds + RING_OFF;
        typedef attn_body::bf16 abf;
        const int xb = vcu >> 5, lc = vcu & 31;
        for (int i = 0; i < 2; ++i) {
            if (i < 1) {
                const int s4 = lc & 3, u = lc >> 2, b = xb, h = u >> 1;
                for (int k = 0; k < 2; ++k)
                    attn_body::attn_unit2<8>((long)b * SEQ, k == 0 ? 7 - s4 : s4, (const abf*)(WSB(WS_DQ) + u * 64), 512, (const abf*)(WSB(WS_DK) + u * 64), 512, (const abf*)(WSB(WS_DV) + h * 128), 512,
                                             (abf*)(WSB(WS_AO) + u * 128), 1024, shm, WAVE_S);
            } else {
                const int s4 = lc & 3, half = (lc >> 2) & 1, h = lc >> 3, b = xb;
                for (int k = 0; k < 2; ++k) {
                    const int qb = k == 0 ? 7 - s4 : s4; const long row0 = (long)b * SEQ;
                    if (qb > 0) attn_body::ret_state(row0, 4 * qb, (const abf*)(WSB(WS_RK) + h * 64), 256, (const abf*)(WSB(WS_RV) + h * 128 + half * 64), 512, shm, WAVE_S);
                    attn_body::attn_unit<8, true>(row0 + 256 * qb, 0, (const abf*)(WSB(WS_RQ) + h * 64), 256, (const abf*)(WSB(WS_RK) + h * 64), 256, (const abf*)(WSB(WS_RV) + h * 128 + half * 64), 512,
                                                  (abf*)(WSB(WS_RETO) + h * 128 + half * 64), 512, shm, qb > 0, WAVE_S);
                }
            }
        }
    }
    ARRIVE(3);
    if (IN(3)) { CONVPTRS(); convert_phase(TID(), vcu, G, cv, (float*)lds, CV_S2, CV_S2 + CV_GU / 3); __syncthreads(); }
    WAITB(3);
    if (IN(4)) for (int rep_ = 0; rep_ < PHASE_REP[4]; ++rep_) combine_phase(TID(), vcu, G, WSB(WS_AO), WSB(WS_RETO), WSB(WS_RG), WSB(WS_OA), INF(9), INF(10), INF(11), INF(12), INF(13));
    ARRIVE(4);
    if (IN(4)) { CONVPTRS(); convert_phase(TID(), vcu, G, cv, (float*)lds, CV_S2 + CV_GU / 3, CV_S2 + 2 * (CV_GU / 3)); __syncthreads(); }
    WAITB(4);
    if (IN(5)) for (int rep_ = 0; rep_ < PHASE_REP[5]; ++rep_) {
        pg8::Gemm g{WSB(WS_OA), WSB(WS_WA), M, DM, 512, WSB(WS_OB), WSB(WS_WB)}; pg8::PairOrder S; S.init(M, DM, G, bx); pg8::BranchTileEpi E{WSB(WS_GA), WSB(WS_GB), WSB(WS_Y)};
        pg8::gemm_phase<pg8::BranchTileEpi, pg8::PairOrder, true, true>(L + RING_OFF, g, S, E, WAVE_S);
    }
    ARRIVE(5);
    if (IN(5)) { CONVPTRS(); convert_phase(TID(), vcu, G, cv, (float*)lds, CV_S2 + 2 * (CV_GU / 3), CV_S3); __syncthreads(); }
    WAITB(5);
    if (IN(6)) for (int rep_ = 0; rep_ < PHASE_REP[6]; ++rep_) {
        pg8::Gemm g{WSB(WS_Y), WSB(WS_WOUT), M, DM, DM}; pg8::StaticOrder S; S.init(M, DM, G, bx); pg8::EpiOutFused E{{INF(0), WSB(WS_X1B), WSF(WS_MOD), INF(17), WSB(WS_XN), WSF(WS_ROWSS)}};
        pg8::gemm_phase<pg8::EpiOutFused, pg8::StaticOrder, false, true>(L + RING_OFF, g, S, E, WAVE_S);
    }
    SEAM(6);
    if (IN(8)) for (int rep_ = 0; rep_ < PHASE_REP[8]; ++rep_) {
        pg8::Gemm g{WSB(WS_XN), WSB(WS_WGU), M, 2 * DFF, DM}; pg8::StaticOrder S; S.init(M, 2 * DFF, G, bx); pg8::EpiRows<GateUpEpi> E{{WSB(WS_ACT), WSF(WS_ROWSS), WSF(WS_CVEC)}};
        pg8::gemm_phase<pg8::EpiRows<GateUpEpi>, pg8::StaticOrder, true, true>(L + RING_OFF, g, S, E, WAVE_S);
    }
    if (IN(8) && G == 256 && bx >= 128) { CONVPTRS(); convert_phase(TID(), bx - 128, 128, cv, (float*)lds, CV_S3, CV_S4); __syncthreads(); }
    else if (IN(8) && G != 256) { CONVPTRS(); convert_phase(TID(), vcu, G, cv, (float*)lds, CV_S3, CV_S4); __syncthreads(); }
    SEAM(8);
    if (IN(9)) for (int rep_ = 0; rep_ < PHASE_REP[9]; ++rep_) {
        float* out = OUTP();
        pg8::Gemm g{WSB(WS_ACT), WSB(WS_WDN), M, DM, DFF};
#if PROBE_DOUBLEK
        pg8::DoubleKOrder S; S.init(M, DM, G, bx); pg8::EpiRowsDK<ResidEpi> E{{WSB(WS_X1B), out, WSF(WS_MOD) + 5 * DM}};
        pg8::gemm_phase<pg8::EpiRowsDK<ResidEpi>, pg8::DoubleKOrder, false, true>(L + RING_OFF, g, S, E, WAVE_S);
#else
        pg8::StaticOrder S; S.init(M, DM, G, bx); pg8::EpiRows<ResidEpi> E{{WSB(WS_X1B), out, WSF(WS_MOD) + 5 * DM}};
        pg8::gemm_phase<pg8::EpiRows<ResidEpi>, pg8::StaticOrder, true, true>(L + RING_OFF, g, S, E, WAVE_S);
#endif
    }
#undef INF
#undef OUTP
#undef WSB
#undef WSF
    SEAM(9);
    if (PROBE_PHASE >= 0 && blockIdx.x == 0 && WAVE_S == 0) { const unsigned long long tgt = __builtin_amdgcn_s_memrealtime() + (unsigned long long)PROBE_AMP * (t_b - t_a); while (__builtin_amdgcn_s_memrealtime() < tgt) __builtin_amdgcn_s_sleep(8); }
#undef IN
#undef SEAM
#undef ARRIVE
#undef WAITB
#undef CONVPTRS
#undef TID
#undef FIRST
}

#ifndef MK_N_LAUNCHES
#define MK_N_LAUNCHES 1
#endif
extern "C" void kernel_launch(void* const* d_in, const int* in_sizes, int n_in, void* d_out, int out_size, void* d_ws, size_t ws_size, hipStream_t stream) {
    static int grid = 0;
    if (grid == 0) {
        if (n_in != 20 || in_sizes[0] != M * DM || out_size != M * DM || ws_size < WS_END) { fprintf(stderr, "kernel_launch: unexpected shapes (n_in %d, ws %zu)\n", n_in, ws_size); grid = -1; return; }
        int dev = 0, cus = 0, per_cu = 0;
        if (hipGetDevice(&dev) != hipSuccess || hipDeviceGetAttribute(&cus, hipDeviceAttributeMultiprocessorCount, dev) != hipSuccess) { grid = -1; return; }
        if (hipFuncSetAttribute((const void*)mega_fwd, hipFuncAttributeMaxDynamicSharedMemorySize, LDS_BYTES) != hipSuccess) { fprintf(stderr, "kernel_launch: hipFuncSetAttribute failed\n"); grid = -1; return; }
        if (hipOccupancyMaxActiveBlocksPerMultiprocessor(&per_cu, (const void*)mega_fwd, NWAVES * 64, LDS_BYTES) != hipSuccess || per_cu < 1) { fprintf(stderr, "kernel_launch: occupancy query says %d\n", per_cu); per_cu = 1; }
        (void)hipGetLastError();
        if (cus != 256) { fprintf(stderr, "kernel_launch: built for a 256-CU device (got %d)\n", cus); grid = -1; return; }
        grid = cus;
    }
    if (grid < 0) return;
    (void)hipMemsetAsync((char*)d_ws + WS_CTL, 0, MK_N_LAUNCHES == 1 ? WS_ZERO_BYTES : CTL_ZERO_BYTES, stream);
    MArgs a{};
    for (int i = 0; i < 20; ++i) a.in[i] = d_in[i];
    a.out = (float*)d_out; a.ws = (unsigned char*)d_ws;
    if (MK_N_LAUNCHES == 1) { a.ph_lo = 0; a.ph_hi = N_PHASES; a.li = 0; hipLaunchKernelGGL(mega_fwd, dim3(grid), dim3(NWAVES * 64), LDS_BYTES, stream, a); }
    else for (int p = 0; p < N_PHASES; ++p) { a.ph_lo = p; a.ph_hi = p + 1; a.li = p; hipLaunchKernelGGL(mega_fwd, dim3(grid), dim3(NWAVES * 64), LDS_BYTES, stream, a); }
}
```

```cpp
#include <hip/hip_runtime.h>
#include <cstdint>
#include <cstdio>
#include <hip/hip_bf16.h>
#include <cmath>

typedef unsigned short bf16_t;
typedef short bf16x8 __attribute__((ext_vector_type(8)));
typedef float f32x4 __attribute__((ext_vector_type(4)));
typedef unsigned u32x2 __attribute__((ext_vector_type(2)));
typedef unsigned u32x4 __attribute__((ext_vector_type(4)));

constexpr int BATCH = 8, SEQ = 2048, DM = 1024, M = BATCH * SEQ, INW = 5120, DFF = 2816, MODW = 6 * DM;
constexpr float EPS = 1e-6f;
constexpr float C2 = 0.125f * 1.4426950408889634f;

constexpr size_t MiB = 1u << 20;
constexpr size_t WS_CTL = 0, WS_MOD = 16 * 1024, WS_CVEC = WS_MOD + 8 * 6144 * 4, WS_ZERO_BYTES = WS_CVEC + 8 * 5632 * 4,     WS_TA = 2 * MiB, WS_TR = 3 * MiB, WS_ROWSS = 7 * MiB;
constexpr size_t WS_WIN = 8 * MiB, WS_WA = 18 * MiB, WS_WB = 19 * MiB, WS_WOUT = 20 * MiB, WS_WGU = 22 * MiB, WS_WDN = 33 * MiB;
constexpr size_t WS_XN = 40 * MiB;
constexpr size_t WS_DQ = 72 * MiB, WS_DK = 88 * MiB, WS_DV = 104 * MiB, WS_RQ = 120 * MiB, WS_RK = 128 * MiB, WS_RV = 136 * MiB,
                 WS_RG = 152 * MiB, WS_GA = 168 * MiB, WS_GB = 200 * MiB, WS_RETO = 232 * MiB, WS_X1B = 208 * MiB;
constexpr size_t WS_AO = WS_XN, WS_OA = WS_DQ, WS_OB = WS_RG, WS_Y = WS_DK, WS_ACT = 120 * MiB, WS_END = 256 * MiB;

__device__ __forceinline__ int lane_id_() { return (int)__builtin_amdgcn_mbcnt_hi(~0u, __builtin_amdgcn_mbcnt_lo(~0u, 0u)); }
__device__ __forceinline__ unsigned f2bf(float f) { unsigned u = __float_as_uint(f); return (u + 0x7fffu + ((u >> 16) & 1u)) >> 16; }
typedef float f32x2_t_ __attribute__((ext_vector_type(2))); typedef __bf16 bf16x2_t_ __attribute__((ext_vector_type(2)));
__device__ __forceinline__ unsigned pk2(float lo, float hi) { f32x2_t_ v = {lo, hi}; bf16x2_t_ b = __builtin_convertvector(v, bf16x2_t_); return __builtin_bit_cast(unsigned, b); }
__device__ __forceinline__ float bf2f(unsigned h) { return __uint_as_float(h << 16); }
__device__ __forceinline__ float bflo(unsigned w) { return __uint_as_float(w << 16); }
__device__ __forceinline__ float bfhi(unsigned w) { return __uint_as_float(w & 0xffff0000u); }
__device__ __forceinline__ u32x2 pack4(f32x4 v) { u32x2 r; r.x = pk2(v[0], v[1]); r.y = pk2(v[2], v[3]); return r; }
__device__ __forceinline__ u32x4 pack8(f32x4 a, f32x4 b) { u32x4 r; r.x = pk2(a[0], a[1]); r.y = pk2(a[2], a[3]); r.z = pk2(b[0], b[1]); r.w = pk2(b[2], b[3]); return r; }
__device__ __forceinline__ float wave_sum(float v) {
#pragma unroll
    for (int o = 1; o < 64; o <<= 1) v += __shfl_xor(v, o);
    return v;
}
__device__ __forceinline__ float silu_f(float x) { return x * __builtin_amdgcn_rcpf(1.f + __builtin_amdgcn_exp2f(-1.4426950408889634f * x)); }
__device__ __forceinline__ float sigm_f(float x) { return __builtin_amdgcn_rcpf(1.f + __builtin_amdgcn_exp2f(-1.4426950408889634f * x)); }

__constant__ double c_invf_da[8] = {1.0, 0.19392274474868576, 0.03760603093086393, 0.007292664737217109, 0.001414213562373095, 0.0002742481756762073, 5.318295896944988e-05, 1.031338537721246e-05};
__constant__ double c_invf_ret[32] = {1.0, 0.7498942093324559, 0.5623413251903491, 0.4216965034285822, 0.31622776601683794, 0.23713737056616552, 0.1778279410038923, 0.1333521432163324, 0.1, 0.07498942093324558, 0.05623413251903491, 0.042169650342858224, 0.03162277660168379, 0.023713737056616554, 0.01778279410038923, 0.01333521432163324, 0.01, 0.007498942093324558, 0.005623413251903491, 0.004216965034285823, 0.0031622776601683794, 0.0023713737056616554, 0.0017782794100389228, 0.001333521432163324, 0.001, 0.0007498942093324559, 0.0005623413251903491, 0.00042169650342858224, 0.00031622776601683794, 0.00023713737056616554, 0.00017782794100389227, 0.0001333521432163324};
__device__ __forceinline__ float log2gamma(int h) { return h == 0 ? -0.04580368961312479f : h == 1 ? -0.02272007650008353f : h == 2 ? -0.011315313227834146f : -0.005646563141142063f; }

template <bool SILU, bool GUMAP>
__device__ __forceinline__ void gemv8_phase(int tid, int wg, int G, const float* vec, int vpitch, const float* W, int N, const float* bias, float* out, int opitch, float* lds) {
    const int wave = tid >> 6, lane = tid & 63, r8 = lane >> 3, c4 = lane & 7;
    f32x4 w[16];
    if (wg < N / 32) { const float* wp = W + (size_t)(wave * 128 + r8) * N + wg * 32 + c4 * 4;
#pragma unroll
        for (int i = 0; i < 16; ++i) w[i] = *(const f32x4*)(wp + (size_t)(8 * i) * N); }
    for (int i = tid; i < BATCH * DM; i += 512) { const float v = vec[(i >> 10) * vpitch + (i & 1023)]; lds[i] = SILU ? silu_f(v) : v; }
    __syncthreads();
    float* red = lds + BATCH * DM;
    for (int cg = wg; cg < N / 32; cg += G) {
        const int e0 = cg * 32;
        f32x4 acc[8];
#pragma unroll
        for (int b = 0; b < 8; ++b) acc[b] = (f32x4){0.f, 0.f, 0.f, 0.f};
        if (cg != wg) { const float* wp = W + (size_t)(wave * 128 + r8) * N + e0 + c4 * 4;
#pragma unroll
            for (int i = 0; i < 16; ++i) w[i] = *(const f32x4*)(wp + (size_t)(8 * i) * N); }
#pragma unroll
        for (int i = 0; i < 16; ++i) {
            const int d = wave * 128 + 8 * i + r8;
#pragma unroll
            for (int b = 0; b < 8; ++b) acc[b] += w[i] * lds[b * DM + d];
        }
#pragma unroll
        for (int b = 0; b < 8; ++b)
#pragma unroll
            for (int e = 0; e < 4; ++e) { float v = acc[b][e]; v += __shfl_xor(v, 8); v += __shfl_xor(v, 16); v += __shfl_xor(v, 32); acc[b][e] = v; }
        if (r8 == 0) {
#pragma unroll
            for (int b = 0; b < 8; ++b) *(f32x4*)(red + (wave * 8 + b) * 32 + c4 * 4) = acc[b];
        }
        __syncthreads();
        if (tid < 256) {
            const int b = tid >> 5, c2 = tid & 31, e = e0 + c2;
            float s = bias ? bias[e] : 0.f;
#pragma unroll
            for (int w2 = 0; w2 < 8; ++w2) s += red[(w2 * 8 + b) * 32 + c2];
            int oi = e;
            if (GUMAP) { const int bj = e / DFF, r = e % DFF; oi = (r >> 7) * 256 + bj * 128 + (r & 127); }
            out[b * opitch + oi] = s;
        }
        __syncthreads();
    }
}

template <bool SILU, bool GUMAP>
__device__ __forceinline__ void gemv4_phase(int tid, int wg, int G, const float* vec, int vpitch, const float* W, int N, const float* bias, float* out, int opitch, float* lds) {
    const int wave = tid >> 6, lane = tid & 63, half = lane >> 5, c16 = lane & 31;
    __attribute__((address_space(3))) float* tab = (__attribute__((address_space(3))) float*)lds;
    __attribute__((address_space(3))) float* red = tab + 8 * 256;
    for (int task = wg; task < N / 32; task += G) {
        const int cq = task >> 2, rq = task & 3, e0 = cq * 128, d0 = rq * 256;
        f32x4 w[16];
        const float* wp = W + (size_t)(d0 + 32 * wave + half) * N + e0 + 4 * c16;
#pragma unroll
        for (int i = 0; i < 16; ++i) w[i] = *(const f32x4*)(wp + (size_t)(2 * i) * N);
        for (int i = tid; i < 8 * 256; i += 512) { const float v = vec[(i >> 8) * vpitch + d0 + (i & 255)]; tab[i] = SILU ? silu_f(v) : v; }
        __syncthreads();
        f32x4 acc[8];
#pragma unroll
        for (int b = 0; b < 8; ++b) acc[b] = (f32x4){0.f, 0.f, 0.f, 0.f};
#pragma unroll
        for (int i = 0; i < 16; ++i)
#pragma unroll
            for (int b = 0; b < 8; ++b) acc[b] += w[i] * tab[b * 256 + 32 * wave + 2 * i + half];
#pragma unroll
        for (int b = 0; b < 8; ++b)
#pragma unroll
            for (int e = 0; e < 4; ++e) acc[b][e] += __shfl_xor(acc[b][e], 32);
        if (half == 0) {
#pragma unroll
            for (int b = 0; b < 8; ++b) *(__attribute__((address_space(3))) f32x4*)(red + (wave * 8 + b) * 128 + 4 * c16) = acc[b];
        }
        __syncthreads();
#pragma unroll
        for (int j = 0; j < 2; ++j) { const int o = tid + 512 * j, b = o >> 7, col = o & 127, e = e0 + col;
            float s = (rq == 0 && bias) ? bias[e] : 0.f;
#pragma unroll
            for (int w2 = 0; w2 < 8; ++w2) s += red[(w2 * 8 + b) * 128 + col];
            int oi = e;
            if (GUMAP) { const int bj = e / DFF, r = e % DFF; oi = (r >> 7) * 256 + bj * 128 + (r & 127); }
            (void)__hip_atomic_fetch_add(out + b * opitch + oi, s, __ATOMIC_RELAXED, __HIP_MEMORY_SCOPE_AGENT); }
        __syncthreads();
    }
}

__device__ __forceinline__ int slot2col(int map, int slot) {
    if (map == 1) { const int pn = slot >> 8, bj = (slot >> 7) & 1, wc = (slot >> 5) & 3, r = slot & 31; return (pn << 8) + (wc << 6) + (bj << 5) + r; }
    if (map == 2) { const int pn = slot >> 8, bj = (slot >> 7) & 1, j = slot & 127; return bj * DFF + pn * 128 + j; }
    return slot;
}
__device__ __forceinline__ void convert_item(const float* W, int K, int N, bf16_t* Wt, int map, float* scr, int item, int lane) {
    const int nblk = N / 32, kb = item / nblk, nb = item % nblk, k0 = 64 * kb, s0 = 32 * nb, c0 = slot2col(map, s0);
    { const int r8 = lane >> 3, c4 = lane & 7;
      f32x4 v[8];
#pragma unroll
      for (int i = 0; i < 8; ++i) v[i] = *(const f32x4*)(W + (size_t)(k0 + 8 * i + r8) * N + c0 + 4 * c4);
#pragma unroll
      for (int i = 0; i < 8; ++i) { float* d = scr + (8 * i + r8) * 33 + 4 * c4; d[0] = v[i][0]; d[1] = v[i][1]; d[2] = v[i][2]; d[3] = v[i][3]; } }
    __builtin_amdgcn_s_waitcnt(0xc07f); __builtin_amdgcn_wave_barrier();
    const int c = lane & 7;
#pragma unroll
    for (int j = 0; j < 4; ++j) { const int n = (lane >> 3) + 8 * j; const float* s = scr + (8 * c) * 33 + n;
        u32x4 o; o.x = pk2(s[0 * 33], s[1 * 33]); o.y = pk2(s[2 * 33], s[3 * 33]); o.z = pk2(s[4 * 33], s[5 * 33]); o.w = pk2(s[6 * 33], s[7 * 33]);
        *(u32x4*)(Wt + (size_t)(s0 + n) * K + k0 + 8 * c) = o; }
    __builtin_amdgcn_s_waitcnt(0xc07f); __builtin_amdgcn_wave_barrier();
}
struct ConvPtrs { const float *w_in, *wa, *wb, *wout, *wgu, *wdn; bf16_t *w_in_t, *wa_t, *wb_t, *wout_t, *wgu_t, *wdn_t; };
constexpr int CV_IN = (DM / 64) * (INW / 32), CV_A = (512 / 64) * (DM / 32), CV_O = (DM / 64) * (DM / 32), CV_GU = (DM / 64) * (2 * DFF / 32), CV_DN = (DFF / 64) * (DM / 32);
constexpr int CV_S0 = 0, CV_S1 = CV_IN, CV_S2 = CV_IN + 2 * CV_A + CV_O, CV_S3 = CV_S2 + CV_GU, CV_S4 = CV_S3 + CV_DN;
__device__ __forceinline__ void convert_phase(int tid, int wg, int G, const ConvPtrs& P, float* lds, int it0, int it1) {
    const int wave = tid >> 6, lane = tid & 63;
    float* scr = lds + wave * (64 * 33);
    const int gw = wg * 8 + wave, NGW = G * 8;
    constexpr int I_IN = CV_IN, I_A = CV_A, I_O = CV_O, I_GU = CV_GU;
    for (int it = it0 + gw; it < it1; it += NGW) {
        int r = it;
        if (r < I_IN) { convert_item(P.w_in, DM, INW, P.w_in_t, 1, scr, r, lane); continue; } r -= I_IN;
        if (r < I_A) { convert_item(P.wa, 512, DM, P.wa_t, 0, scr, r, lane); continue; } r -= I_A;
        if (r < I_A) { convert_item(P.wb, 512, DM, P.wb_t, 0, scr, r, lane); continue; } r -= I_A;
        if (r < I_O) { convert_item(P.wout, DM, DM, P.wout_t, 0, scr, r, lane); continue; } r -= I_O;
        if (r < I_GU) { convert_item(P.wgu, DM, 2 * DFF, P.wgu_t, 2, scr, r, lane); continue; } r -= I_GU;
        convert_item(P.wdn, DFF, DM, P.wdn_t, 0, scr, r, lane);
    }
}

__device__ __forceinline__ void trig_phase(int tid, int wg, int G, const int* positions, float* TA, float* TR) {
    const int gt = wg * 512 + tid, NT = G * 512;
    for (int it = gt; it < M * 40; it += NT) {
        const int row = it / 40, i = it % 40;
        const double p = (double)positions[row];
        const double a = p * (i < 8 ? c_invf_da[i] : c_invf_ret[i - 8]);
        double rev = a * 0.15915494309189535;
        rev -= __builtin_rint(rev);
        const float sn = __builtin_amdgcn_sinf((float)rev), cs = __builtin_amdgcn_cosf((float)rev);
        if (i < 8) { TA[row * 16 + i] = cs; TA[row * 16 + 8 + i] = sn; }
        else { TR[row * 64 + (i - 8)] = cs; TR[row * 64 + 32 + (i - 8)] = sn; }
    }
}

__device__ __forceinline__ void xn_phase(int tid, int wg, int G, const float* x, const float* g, const float* sc, const float* sh, bf16_t* XN) {
    const int wave = tid >> 6, lane = tid & 63;
    for (int r0 = (wg * 8 + wave) * 8; r0 < M; r0 += G * 64) {
        const int b = r0 / SEQ;
        f32x4 a[4], s0[4];
#pragma unroll
        for (int j = 0; j < 4; ++j) { const int col = 8 * lane + 4 * (j & 1) + 512 * (j >> 1); a[j] = *(const f32x4*)(g + col) * (*(const f32x4*)(sc + b * MODW + col) + 1.f); s0[j] = *(const f32x4*)(sh + b * MODW + col); }
#pragma unroll
        for (int h = 0; h < 2; ++h) {
            f32x4 v[4][4];
#pragma unroll
            for (int r = 0; r < 4; ++r)
#pragma unroll
                for (int j = 0; j < 4; ++j) v[r][j] = ((const f32x4*)(x + (size_t)(r0 + 4 * h + r) * DM))[2 * lane + (j & 1) + 128 * (j >> 1)];
            __builtin_amdgcn_sched_barrier(0);
#pragma unroll
            for (int r = 0; r < 4; ++r) {
                float ss = 0.f;
#pragma unroll
                for (int j = 0; j < 4; ++j) ss += (v[r][j][0] * v[r][j][0] + v[r][j][1] * v[r][j][1]) + (v[r][j][2] * v[r][j][2] + v[r][j][3] * v[r][j][3]);
                const float rstd = rsqrtf(wave_sum(ss) * (1.f / DM) + EPS);
                u32x4* o = (u32x4*)(XN + (size_t)(r0 + 4 * h + r) * DM) + lane;
#pragma unroll
                for (int j2 = 0; j2 < 2; ++j2) o[64 * j2] = pack8(v[r][2 * j2] * rstd * a[2 * j2] + s0[2 * j2], v[r][2 * j2 + 1] * rstd * a[2 * j2 + 1] + s0[2 * j2 + 1]);
            }
        }
    }
}

__device__ __forceinline__ void combine_phase(int tid, int wg, int G, const bf16_t* AO, const bf16_t* RETO, bf16_t* RG_OB, bf16_t* OA,
                                              const float* lq1, const float* lk1, const float* lq2, const float* lk2, const float* subln_g) {
    const int wave = tid >> 6, lane = tid & 63;
    const float lam = __expf(wave_sum(lq1[lane] * lk1[lane])) - __expf(wave_sum(lq2[lane] * lk2[lane])) + 0.2f;
    const int h = lane >> 4, d0 = (lane & 15) * 8;
    float gsub[8];
#pragma unroll
    for (int e = 0; e < 8; ++e) gsub[e] = subln_g[d0 + e] * 0.8f;
    for (int row = wg * 64 + wave * 8; row < M; row += G * 64) for (int rj = 0; rj < 8; ++rj, ++row) {
        {
            const u32x4 a = *(const u32x4*)(AO + (size_t)row * 1024 + (2 * h) * 128 + d0), b = *(const u32x4*)(AO + (size_t)row * 1024 + (2 * h + 1) * 128 + d0);
            float d[8]; float ss = 0.f;
#pragma unroll
            for (int e = 0; e < 4; ++e) { d[2 * e] = bflo(a[e]) - lam * bflo(b[e]); d[2 * e + 1] = bfhi(a[e]) - lam * bfhi(b[e]); }
#pragma unroll
            for (int e = 0; e < 8; ++e) ss += d[e] * d[e];
            ss += __shfl_xor(ss, 1); ss += __shfl_xor(ss, 2); ss += __shfl_xor(ss, 4); ss += __shfl_xor(ss, 8);
            const float rstd = rsqrtf(ss * (1.f / 128.f) + EPS);
            u32x4 o;
#pragma unroll
            for (int e = 0; e < 4; ++e) o[e] = pk2(d[2 * e] * rstd * gsub[2 * e], d[2 * e + 1] * rstd * gsub[2 * e + 1]);
            *(u32x4*)(OA + (size_t)row * 512 + h * 128 + d0) = o;
        }
        {
            const u32x4 a = *(const u32x4*)(RETO + (size_t)row * 512 + h * 128 + d0), gt = *(const u32x4*)(RG_OB + (size_t)row * 512 + h * 128 + d0);
            float d[8]; float ss = 0.f;
#pragma unroll
            for (int e = 0; e < 4; ++e) { d[2 * e] = bflo(a[e]); d[2 * e + 1] = bfhi(a[e]); }
#pragma unroll
            for (int e = 0; e < 8; ++e) ss += d[e] * d[e];
            ss += __shfl_xor(ss, 1); ss += __shfl_xor(ss, 2); ss += __shfl_xor(ss, 4); ss += __shfl_xor(ss, 8);
            const float rstd = rsqrtf(ss * (1.f / 128.f) + EPS);
            u32x4 o;
#pragma unroll
            for (int e = 0; e < 4; ++e) o[e] = pk2(d[2 * e] * rstd * bflo(gt[e]), d[2 * e + 1] * rstd * bfhi(gt[e]));
            *(u32x4*)(RG_OB + (size_t)row * 512 + h * 128 + d0) = o;
        }
    }
}

#define SLOT8(pn, wc, fq, g) (256 * (pn) + 128 * ((g) >> 1) + 32 * (wc) + 8 * (fq) + 4 * ((g) & 1))
struct InProjEpi {
    static constexpr int BATCH = 2;
    struct Tile { f32x4 gn[4]; };
    struct Pre { f32x4 t[4]; };
    bf16_t *DQ, *DK, *DV, *RQ, *RK, *RV, *RG, *GA, *GB; const float *qg, *kg, *TA, *TR;
    __device__ __forceinline__ Tile tile_pre(int b, int pn, int wc, int fq) const {
        Tile T;
        if (pn < 4) { const float* gn = pn < 2 ? qg : kg;
#pragma unroll
            for (int g = 0; g < 4; ++g) T.gn[g] = *(const f32x4*)(gn + 32 * (g >> 1) + 8 * fq + 4 * (g & 1)); }
        return T;
    }
    __device__ __forceinline__ Pre row_pre(int row, int b, int pn, int wc, int fq) const {
        Pre P;
        if (pn < 4) {
#pragma unroll
            for (int i = 0; i < 4; ++i) P.t[i] = *(const f32x4*)(TA + (size_t)row * 16 + 4 * i); }
        else if (pn == 6 || pn == 7) {
#pragma unroll
            for (int n = 0; n < 2; ++n) { P.t[n] = *(const f32x4*)(TR + (size_t)row * 64 + 8 * fq + 4 * n); P.t[2 + n] = *(const f32x4*)(TR + (size_t)row * 64 + 32 + 8 * fq + 4 * n); } }
        return P;
    }
    __device__ __forceinline__ void operator()(const f32x4 (&v)[4], const Pre& P, const Tile& T, int row, int b, int pn, int wc, int fq) const {
        f32x4 o[4]; bf16_t* dst;
        if (pn < 4) {
            const bool isq = pn < 2;
            float ss = 0.f;
#pragma unroll
            for (int g = 0; g < 4; ++g) ss += (v[g][0] * v[g][0] + v[g][1] * v[g][1]) + (v[g][2] * v[g][2] + v[g][3] * v[g][3]);
            ss += __shfl_xor(ss, 16); ss += __shfl_xor(ss, 32);
            const float rstd = rsqrtf(ss * (1.f / 64.f) + EPS) * (isq ? C2 : 1.f);
#pragma unroll
            for (int g = 0; g < 4; ++g) o[g] = v[g] * rstd * T.gn[g];
#pragma unroll
            for (int n = 0; n < 2; ++n) {
                f32x4 other;
#pragma unroll
                for (int r = 0; r < 4; ++r) other[r] = __shfl_xor(o[n][r], 16);
                const f32x4 rot = (fq == 0) ? (o[n] * P.t[n] - other * P.t[2 + n]) : (o[n] * P.t[n] + other * P.t[2 + n]);
                o[n] = (fq < 2) ? rot : o[n];
            }
            dst = (isq ? DQ : DK) + (size_t)row * 512 + ((pn & 1) * 4 + wc) * 64;
        } else if (pn == 6 || pn == 7) {
            const bool isq = pn == 6;
#pragma unroll
            for (int n = 0; n < 2; ++n) { o[n] = v[n] * P.t[n] - v[2 + n] * P.t[2 + n]; o[2 + n] = v[2 + n] * P.t[n] + v[n] * P.t[2 + n]; }
            const float t = (float)(row & (SEQ - 1)), lg = log2gamma(wc);
            const float s = isq ? exp2f(t * lg) : exp2f(-t * lg) * 0.125f;
#pragma unroll
            for (int g = 0; g < 4; ++g) o[g] = o[g] * s;
            dst = (isq ? RQ : RK) + (size_t)row * 256 + wc * 64;
        } else if (pn < 6) {
#pragma unroll
            for (int g = 0; g < 4; ++g) o[g] = v[g];
            dst = DV + (size_t)row * 512 + (pn - 4) * 256 + wc * 64;
        } else if (pn < 10) {
#pragma unroll
            for (int g = 0; g < 4; ++g) o[g] = v[g];
            dst = RV + (size_t)row * 512 + (pn - 8) * 256 + wc * 64;
        } else if (pn < 12) {
#pragma unroll
            for (int g = 0; g < 4; ++g)
#pragma unroll
                for (int r = 0; r < 4; ++r) o[g][r] = silu_f(v[g][r]);
            dst = RG + (size_t)row * 512 + (pn - 10) * 256 + wc * 64;
        } else {
#pragma unroll
            for (int g = 0; g < 4; ++g)
#pragma unroll
                for (int r = 0; r < 4; ++r) o[g][r] = sigm_f(v[g][r]);
            dst = (pn < 16 ? GA + (size_t)row * 1024 + (pn - 12) * 256 : GB + (size_t)row * 1024 + (pn - 16) * 256) + wc * 64;
        }
#pragma unroll
        for (int bj = 0; bj < 2; ++bj) *(u32x4*)(dst + 32 * bj + 8 * fq) = pack8(o[2 * bj], o[2 * bj + 1]);
    }
};
struct OutEpi {
    static constexpr int BATCH = 4;
    struct Tile { f32x4 g1[4], a2[4]; };
    struct Pre { f32x4 x[4]; };
    const float* x; bf16_t* X1B; const float* mod; const float* g2n; bf16_t* XM; float* rowss;
    __device__ __forceinline__ Tile tile_pre(int b, int pn, int wc, int fq) const {
        Tile T;
#pragma unroll
        for (int g = 0; g < 4; ++g) { const int col = SLOT8(pn, wc, fq, g);
            T.g1[g] = *(const f32x4*)(mod + b * MODW + 2 * DM + col); T.a2[g] = *(const f32x4*)(g2n + col) * (*(const f32x4*)(mod + b * MODW + 4 * DM + col) + 1.f); }
        return T;
    }
    __device__ __forceinline__ Pre row_pre(int row, int b, int pn, int wc, int fq) const {
        Pre P;
#pragma unroll
        for (int g = 0; g < 4; ++g) P.x[g] = *(const f32x4*)(x + (size_t)row * DM + SLOT8(pn, wc, fq, g));
        return P;
    }
    __device__ __forceinline__ float operator()(const f32x4 (&v)[4], const Pre& P, const Tile& T, int row, int b, int pn, int wc, int fq) const {
        float ss = 0.f; f32x4 xm[4], x1[4];
#pragma unroll
        for (int g = 0; g < 4; ++g) {
            x1[g] = P.x[g] + T.g1[g] * v[g];
            ss += (x1[g][0] * x1[g][0] + x1[g][1] * x1[g][1]) + (x1[g][2] * x1[g][2] + x1[g][3] * x1[g][3]);
            xm[g] = x1[g] * T.a2[g];
        }
#pragma unroll
        for (int bj = 0; bj < 2; ++bj) { *(u32x4*)(X1B + (size_t)row * DM + SLOT8(pn, wc, fq, 2 * bj)) = pack8(x1[2 * bj], x1[2 * bj + 1]);
                                         *(u32x4*)(XM + (size_t)row * DM + SLOT8(pn, wc, fq, 2 * bj)) = pack8(xm[2 * bj], xm[2 * bj + 1]); }
        ss += __shfl_xor(ss, 16); ss += __shfl_xor(ss, 32);
        return ss;
    }
};
struct ResidEpi {
    static constexpr int BATCH = 8;
    struct Tile { f32x4 gg[4]; };
    struct Pre { u32x4 bs[2]; };
    const bf16_t* base; float* out; const float* gvec;
    __device__ __forceinline__ Tile tile_pre(int b, int pn, int wc, int fq) const {
        Tile T;
#pragma unroll
        for (int g = 0; g < 4; ++g) T.gg[g] = *(const f32x4*)(gvec + b * MODW + SLOT8(pn, wc, fq, g));
        return T;
    }
    __device__ __forceinline__ Pre row_pre(int row, int b, int pn, int wc, int fq) const {
        Pre P;
#pragma unroll
        for (int bj = 0; bj < 2; ++bj) P.bs[bj] = *(const u32x4*)(base + (size_t)row * DM + SLOT8(pn, wc, fq, 2 * bj));
        return P;
    }
    __device__ __forceinline__ void operator()(const f32x4 (&v)[4], const Pre& P, const Tile& T, int row, int b, int pn, int wc, int fq) const {
#pragma unroll
        for (int g = 0; g < 4; ++g) { const unsigned w0 = P.bs[g >> 1][2 * (g & 1)], w1 = P.bs[g >> 1][2 * (g & 1) + 1];
            const f32x4 bs = {bflo(w0), bfhi(w0), bflo(w1), bfhi(w1)};
            *(f32x4*)(out + (size_t)row * DM + SLOT8(pn, wc, fq, g)) = bs + T.gg[g] * v[g]; }
    }
};
struct GateUpEpi {
    static constexpr int BATCH = 4;
    struct Tile { f32x4 cg[2], cu[2]; };
    struct Pre { f32x4 s4; };
    bf16_t* ACT; const float* rowss; const float* cvec;
    __device__ __forceinline__ Tile tile_pre(int b, int pn, int wc, int fq) const {
        Tile T;
#pragma unroll
        for (int n = 0; n < 2; ++n) { const int slot = 256 * pn + 32 * wc + 8 * fq + 4 * n; T.cg[n] = *(const f32x4*)(cvec + b * (2 * DFF) + slot); T.cu[n] = *(const f32x4*)(cvec + b * (2 * DFF) + slot + 128); }
        return T;
    }
    __device__ __forceinline__ Pre row_pre(int row, int b, int pn, int wc, int fq) const { Pre P; P.s4 = *(const f32x4*)(rowss + (size_t)row * 4); return P; }
    __device__ __forceinline__ void operator()(const f32x4 (&v)[4], const Pre& P, const Tile& T, int row, int b, int pn, int wc, int fq) const {
        const float rstd = rsqrtf(((P.s4[0] + P.s4[1]) + (P.s4[2] + P.s4[3])) * (1.f / DM) + EPS);
        f32x4 y[2];
#pragma unroll
        for (int n = 0; n < 2; ++n) {
            const f32x4 gt = v[n] * rstd + T.cg[n], up = v[2 + n] * rstd + T.cu[n];
#pragma unroll
            for (int r = 0; r < 4; ++r) y[n][r] = silu_f(gt[r]) * up[r];
        }
        *(u32x4*)(ACT + (size_t)row * DFF + 128 * pn + 32 * wc + 8 * fq) = pack8(y[0], y[1]);
    }
};

namespace pg8 {
#define PG8_LAS __attribute__((address_space(3)))
typedef unsigned short bf16_t;
typedef short bf16x8 __attribute__((ext_vector_type(8)));
typedef float f32x4 __attribute__((ext_vector_type(4)));
typedef unsigned u32x4 __attribute__((ext_vector_type(4)));
constexpr int BM = 256, BK = 64, HALF = 128, HTB = HALF * BK * 2  , STAGE_BYTES = 8 * HTB, NXCD = 8, WGM = 4;

__host__ __device__ __forceinline__ int lds_byte(int r, int c) { const int st = (r >> 4) * 2 + (c >> 5), rr = r & 15, cc = c & 31, ob = rr * 64 + cc * 2; return st * 1024 + (ob ^ (((ob >> 9) & 1) << 5)); }
__host__ __device__ __forceinline__ void stage_rc(int b, int& R, int& C) { const int st = b / 1024, sb = b % 1024, swz = sb ^ (((sb >> 9) & 1) << 5); R = (st >> 1) * 16 + swz / 64; C = (st & 1) * 32 + (swz % 64) / 2; }
__host__ __device__ __forceinline__ int perm32(int rho) { const int n = rho >> 4, i = rho & 15; return 8 * (i >> 2) + 4 * n + (i & 3); }

struct Unit { int pm, pn, sel, half; };
struct Gemm { const bf16_t* A; const bf16_t* Bt; int M, N, K; const bf16_t* A2; const bf16_t* Bt2; };

struct StaticOrder {
    int nM, nN, nwg, G, c;
    __host__ __device__ void init(int M, int N, int G_, int c_) { nM = M / BM; nN = N / BM; nwg = nM * nN; G = G_; c = c_; }
    __host__ __device__ bool next(int i, Unit& u) const {
        const long L = (long)i * G + c; if (L >= nwg) return false;
        int wgid = (int)L; { const int q = nwg / NXCD, r = nwg % NXCD, xcd = wgid % NXCD, off = wgid / NXCD; wgid = (xcd < r ? xcd * (q + 1) : r * (q + 1) + (xcd - r) * q) + off; }
        const int nig = WGM * nN, gid = wgid / nig, fm = gid * WGM, gsz = (nM - fm) < WGM ? (nM - fm) : WGM;
        u.pm = fm + ((wgid % nig) % gsz); u.pn = (wgid % nig) / gsz; u.sel = 0; u.half = 0; return true;
    }
    __device__ __forceinline__ void a_ready(const Unit&) const {}
    __device__ __forceinline__ void done(const Unit&) const {}
};

template <class Epi, class Sched, bool ALIGN_EPI = false, bool SP2 = false>
__device__ __forceinline__ void gemm_phase(PG8_LAS unsigned char* lds, const Gemm g, const Sched& S, const Epi& E, const int WAVE_S) {
    const int wid = WAVE_S, lane = lane_id_(), tid = wid * 64 + lane, wr = wid >> 2, wc = wid & 3, fr = lane & 15, fq = lane >> 4;
    const int K = g.K, nt = K / BK;
    unsigned voffA[2], voffB[2];
#pragma unroll
    for (int i = 0; i < 2; ++i) { int R, C; stage_rc(tid * 16 + i * 8192, R, C); const int Rb = Epi::PERM ? ((R & ~31) + perm32(R & 31)) : R;
        voffA[i] = (unsigned)(R * K + C) * 2u; voffB[i] = (unsigned)(Rb * K + C) * 2u; }
    const size_t kstep = (size_t)(BK * 2);
    const size_t hstep = (size_t)HALF * K * 2;
    const size_t tstep = 2 * hstep;
    const unsigned ldsw = (unsigned)wid * 1024u;
    const int aoff = lds_byte(wr * 64 + fr, fq * 8), boff = lds_byte(wc * 32 + fr, fq * 8);
#define PG8_SA(b, h) (((b) * 2 + (h)) * HTB)
#define PG8_SB(b, h) ((4 + (b) * 2 + (h)) * HTB)
#define PG8_STAGE(bufoff, gbase, voff) do { _Pragma("unroll") for (int _i = 0; _i < 2; ++_i) \
        __builtin_amdgcn_global_load_lds((const unsigned*)((const char*)(gbase) + (voff)[_i]), (PG8_LAS unsigned*)(lds + (bufoff) + ldsw + _i * 8192), 16, 0, 0); } while (0)
#define PG8_LDA(dst, b, h) do { _Pragma("unroll") for (int m = 0; m < 4; ++m) _Pragma("unroll") for (int k = 0; k < 2; ++k) dst[m][k] = *(const PG8_LAS bf16x8*)(lds + PG8_SA(b, h) + aoff + m * 2048 + k * 1024); } while (0)
#define PG8_LDB(dst, b, h) do { _Pragma("unroll") for (int n = 0; n < 2; ++n) _Pragma("unroll") for (int k = 0; k < 2; ++k) dst[n][k] = *(const PG8_LAS bf16x8*)(lds + PG8_SB(b, h) + boff + n * 2048 + k * 1024); } while (0)
#define PG8_MMA(ai, bj, At, Bt) do { __builtin_amdgcn_s_setprio(1); _Pragma("unroll") for (int m = 0; m < 4; ++m) _Pragma("unroll") for (int n = 0; n < 2; ++n) _Pragma("unroll") for (int k = 0; k < 2; ++k) \
        acc[ai][bj][m][n] = __builtin_amdgcn_mfma_f32_16x16x32_bf16(Bt[n][k], At[m][k], acc[ai][bj][m][n], 0, 0, 0); __builtin_amdgcn_s_setprio(0); } while (0)
#define PG8_WAIT_V(n) asm volatile("s_waitcnt vmcnt(" #n ")" ::: "memory")
#define PG8_WAIT_L(n) asm volatile("s_waitcnt lgkmcnt(" #n ")" ::: "memory")
#define PG8_BAR __builtin_amdgcn_s_barrier()
#define PG8_SCHED __builtin_amdgcn_sched_barrier(0)
    Unit cur, nxt; int ui = 0;
    if (!S.next(0, cur)) return;
    f32x4 acc[2][2][4][2];
#pragma unroll
    for (int a = 0; a < 2; ++a)
#pragma unroll
        for (int b = 0; b < 2; ++b)
#pragma unroll
            for (int m = 0; m < 4; ++m)
#pragma unroll
                for (int n = 0; n < 2; ++n) acc[a][b][m][n] = (f32x4){0.f, 0.f, 0.f, 0.f};
    bf16x8 At[4][2], B0[2][2], B1[2][2];
    const char* cA = (const char*)(cur.sel ? g.A2 : g.A) + (size_t)cur.pm * tstep + (cur.half == 2 ? hstep : (size_t)0); const char* cB = (const char*)(cur.sel ? g.Bt2 : g.Bt) + (size_t)cur.pn * tstep;
    S.a_ready(cur);
    if constexpr (SP2) {
        PG8_STAGE(PG8_SB(0, 0), cB, voffB); PG8_STAGE(PG8_SB(0, 1), cB + hstep, voffB); PG8_STAGE(PG8_SA(0, 0), cA, voffA); PG8_STAGE(PG8_SA(0, 1), cA + hstep, voffA);
        if (wr == 1) PG8_BAR;
        PG8_WAIT_V(2); PG8_BAR;
        PG8_STAGE(PG8_SB(1, 0), cB + kstep, voffB); PG8_STAGE(PG8_SA(1, 0), cA + kstep, voffA); PG8_STAGE(PG8_SB(1, 1), cB + hstep + kstep, voffB);
        PG8_WAIT_V(6); PG8_BAR;
    } else {
        PG8_STAGE(PG8_SB(0, 0), cB, voffB); PG8_STAGE(PG8_SA(0, 0), cA, voffA); PG8_STAGE(PG8_SB(0, 1), cB + hstep, voffB); PG8_STAGE(PG8_SA(0, 1), cA + hstep, voffA);
        if (wr == 1) PG8_BAR;
        PG8_WAIT_V(4); PG8_BAR;
        PG8_STAGE(PG8_SB(1, 0), cB + kstep, voffB); PG8_STAGE(PG8_SA(1, 0), cA + kstep, voffA); PG8_STAGE(PG8_SB(1, 1), cB + hstep + kstep, voffB);
        PG8_WAIT_V(6); PG8_BAR;
    }
    for (;;) {
        const bool has_next = S.next(ui + 1, nxt);
        const char* nA = has_next ? (const char*)(nxt.sel ? g.A2 : g.A) + (size_t)nxt.pm * tstep + (nxt.half == 2 ? hstep : (size_t)0) : cA; const char* nB = has_next ? (const char*)(nxt.sel ? g.Bt2 : g.Bt) + (size_t)nxt.pn * tstep : cB;
        for (int t = 0; t < nt; t += 2) {
            const bool last = (t == nt - 2);
            const char* a1 = cA + (size_t)(t + 1) * kstep;
            const char* a2 = last ? nA : cA + (size_t)(t + 2) * kstep; const char* b2 = last ? nB : cB + (size_t)(t + 2) * kstep;
            const char* a3 = a2 + kstep; const char* b3 = b2 + kstep;
            if (last && has_next) S.a_ready(nxt);
            if constexpr (SP2) {
            PG8_LDB(B0, 0, 0); PG8_LDB(B1, 0, 1); PG8_SCHED; PG8_LDA(At, 0, 0); PG8_STAGE(PG8_SA(1, 1), a1 + hstep, voffA);
            PG8_WAIT_V(8); PG8_WAIT_L(0); PG8_BAR; PG8_MMA(0, 0, At, B0); PG8_MMA(0, 1, At, B1); PG8_BAR; PG8_SCHED;
            PG8_LDA(At, 0, 1); PG8_STAGE(PG8_SB(0, 0), b2, voffB); PG8_STAGE(PG8_SB(0, 1), b2 + hstep, voffB); PG8_STAGE(PG8_SA(0, 0), a2, voffA);
            PG8_WAIT_V(8); PG8_WAIT_L(0); PG8_BAR; PG8_MMA(1, 0, At, B0); PG8_MMA(1, 1, At, B1); PG8_BAR; PG8_SCHED;
            PG8_LDB(B0, 1, 0); PG8_LDB(B1, 1, 1); PG8_SCHED; PG8_LDA(At, 1, 0); PG8_STAGE(PG8_SA(0, 1), a2 + hstep, voffA);
            PG8_WAIT_V(8); PG8_WAIT_L(0); PG8_BAR; PG8_MMA(0, 0, At, B0); PG8_MMA(0, 1, At, B1); PG8_BAR; PG8_SCHED;
            PG8_LDA(At, 1, 1); PG8_STAGE(PG8_SB(1, 0), b3, voffB); PG8_STAGE(PG8_SB(1, 1), b3 + hstep, voffB); PG8_STAGE(PG8_SA(1, 0), a3, voffA);
            PG8_WAIT_V(8); PG8_WAIT_L(0); PG8_BAR; PG8_MMA(1, 0, At, B0); PG8_MMA(1, 1, At, B1); PG8_BAR; PG8_SCHED;
            } else {
            PG8_LDB(B0, 0, 0); PG8_SCHED; PG8_LDA(At, 0, 0); PG8_STAGE(PG8_SA(1, 1), a1 + hstep, voffA);
            PG8_WAIT_L(8); PG8_BAR; PG8_WAIT_L(0); PG8_MMA(0, 0, At, B0); PG8_BAR; PG8_SCHED;
            PG8_LDB(B1, 0, 1); PG8_STAGE(PG8_SB(0, 0), b2, voffB);
            PG8_BAR; PG8_WAIT_L(0); PG8_MMA(0, 1, At, B1); PG8_BAR;
            PG8_LDA(At, 0, 1); PG8_STAGE(PG8_SA(0, 0), a2, voffA);
            PG8_BAR; PG8_WAIT_L(0); PG8_MMA(1, 0, At, B0); PG8_BAR; PG8_SCHED;
            PG8_STAGE(PG8_SB(0, 1), b2 + hstep, voffB);
            PG8_WAIT_V(6); PG8_BAR; PG8_MMA(1, 1, At, B1); PG8_BAR;
            PG8_LDB(B0, 1, 0); PG8_SCHED; PG8_LDA(At, 1, 0); PG8_STAGE(PG8_SA(0, 1), a2 + hstep, voffA);
            PG8_WAIT_L(8); PG8_BAR; PG8_WAIT_L(0); PG8_MMA(0, 0, At, B0); PG8_BAR; PG8_SCHED;
            PG8_LDB(B1, 1, 1); PG8_STAGE(PG8_SB(1, 0), b3, voffB);
            PG8_BAR; PG8_WAIT_L(0); PG8_MMA(0, 1, At, B1); PG8_BAR;
            PG8_LDA(At, 1, 1); PG8_STAGE(PG8_SA(1, 0), a3, voffA);
            PG8_BAR; PG8_WAIT_L(0); PG8_MMA(1, 0, At, B0); PG8_BAR; PG8_SCHED;
            PG8_STAGE(PG8_SB(1, 1), b3 + hstep, voffB);
            PG8_WAIT_V(6); PG8_BAR; PG8_MMA(1, 1, At, B1); PG8_BAR;
            }
        }
        if constexpr (ALIGN_EPI) { if (wr == 0) PG8_BAR; }
        if constexpr (!Epi::AFTER_DRAIN) { E(acc, cur, wr, wc, fr, fq); S.done(cur); }
        if (!has_next) break;
        if (Epi::zero_after(cur))
#pragma unroll
        for (int a = 0; a < 2; ++a)
#pragma unroll
            for (int b = 0; b < 2; ++b)
#pragma unroll
                for (int m = 0; m < 4; ++m)
#pragma unroll
                    for (int n = 0; n < 2; ++n) acc[a][b][m][n] = (f32x4){0.f, 0.f, 0.f, 0.f};
        cur = nxt; cA = nA; cB = nB; ++ui;
        if constexpr (ALIGN_EPI) { if (wr == 1) PG8_BAR; }
    }
    PG8_WAIT_V(0);
    if constexpr (!ALIGN_EPI) { if (wr == 0) PG8_BAR; }
    PG8_BAR;
    if constexpr (Epi::AFTER_DRAIN) { E.fused(acc, cur, wr, wc, fr, fq, lds, wid, lane); S.done(cur); }
#undef PG8_SA
#undef PG8_SB
#undef PG8_STAGE
#undef PG8_LDA
#undef PG8_LDB
#undef PG8_MMA
#undef PG8_WAIT_V
#undef PG8_WAIT_L
#undef PG8_BAR
#undef PG8_SCHED
}
}

namespace pg8 {
template <class RowEpi> struct EpiRows {
    static constexpr bool PERM = true, AFTER_DRAIN = false;
    RowEpi R;
    static __device__ __forceinline__ bool zero_after(const Unit&) { return true; }
    __device__ __forceinline__ void operator()(const f32x4 (&acc)[2][2][4][2], const Unit& u, int wr, int wc, int fr, int fq) const {
        const int b = u.pm >> 3, row0 = u.pm * BM + wr * 64 + fr + (u.half == 2 ? HALF : 0);
        const typename RowEpi::Tile T = R.tile_pre(b, u.pn, wc, fq);
        constexpr int NB = RowEpi::BATCH;
#pragma unroll
        for (int g0 = 0; g0 < 8; g0 += NB) {
            if (u.half && g0 >= 4) break;
            typename RowEpi::Pre P[NB];
#pragma unroll
            for (int j = 0; j < NB; ++j) P[j] = R.row_pre(row0 + ((g0 + j) >> 2) * HALF + ((g0 + j) & 3) * 16, b, u.pn, wc, fq);
            __builtin_amdgcn_sched_barrier(0);
#pragma unroll
            for (int j = 0; j < NB; ++j) { const int ai = (g0 + j) >> 2, m = (g0 + j) & 3;
                const f32x4 v[4] = {acc[ai][0][m][0], acc[ai][0][m][1], acc[ai][1][m][0], acc[ai][1][m][1]};
                R(v, P[j], T, row0 + ai * HALF + m * 16, b, u.pn, wc, fq); }
        }
    }
};
struct EpiOutFused {
    static constexpr bool PERM = true, AFTER_DRAIN = true;
    OutEpi R;
    static __device__ __forceinline__ bool zero_after(const Unit&) { return true; }
    __device__ __forceinline__ void operator()(const f32x4 (&)[2][2][4][2], const Unit&, int, int, int, int) const {}
    __device__ __forceinline__ void fused(f32x4 (&acc)[2][2][4][2], const Unit& u, int wr, int wc, int fr, int fq, PG8_LAS unsigned char* lds, int wid, int lane) const {
        PG8_LAS float* sred = (PG8_LAS float*)lds;
        const int b = u.pm >> 3;
        const OutEpi::Tile T = R.tile_pre(b, u.pn, wc, fq);
        constexpr int NB = OutEpi::BATCH;
#pragma unroll
        for (int g0 = 0; g0 < 8; g0 += NB) {
            OutEpi::Pre P[NB];
#pragma unroll
            for (int j = 0; j < NB; ++j) P[j] = R.row_pre(u.pm * BM + ((g0 + j) >> 2) * HALF + wr * 64 + ((g0 + j) & 3) * 16 + fr, b, u.pn, wc, fq);
            __builtin_amdgcn_sched_barrier(0);
#pragma unroll
            for (int j = 0; j < NB; ++j) { const int ai = (g0 + j) >> 2, m = (g0 + j) & 3;
                const f32x4 v[4] = {acc[ai][0][m][0], acc[ai][0][m][1], acc[ai][1][m][0], acc[ai][1][m][1]};
                const int rl = ai * HALF + wr * 64 + m * 16 + fr;
                const float ss = R(v, P[j], T, u.pm * BM + rl, b, u.pn, wc, fq);
                if (fq == 0) sred[rl * 4 + wc] = ss; }
        }
        asm volatile("s_waitcnt lgkmcnt(0)" ::: "memory"); __builtin_amdgcn_s_barrier(); asm volatile("" ::: "memory");
        const int t = wid * 64 + lane;
        if (t < 256) { const f32x4 p = *(const PG8_LAS f32x4*)(sred + t * 4); R.rowss[(size_t)(u.pm * BM + t) * 4 + u.pn] = (p[0] + p[1]) + (p[2] + p[3]); }
    }
};
struct DoubleKOrder : StaticOrder {
    __host__ __device__ bool next(int i, Unit& u) const { const bool ok = StaticOrder::next(i >> 1, u); u.half = i & 1; return ok; }
};
template <class RowEpi> struct EpiRowsDK {
    static constexpr bool PERM = true, AFTER_DRAIN = false;
    RowEpi R;
    static __device__ __forceinline__ bool zero_after(const Unit& u) { return u.half == 1; }
    __device__ __forceinline__ void operator()(f32x4 (&acc)[2][2][4][2], const Unit& u, int wr, int wc, int fr, int fq) const {
        if (u.half == 0) return;
#pragma unroll
        for (int a = 0; a < 2; ++a)
#pragma unroll
            for (int b = 0; b < 2; ++b)
#pragma unroll
                for (int m = 0; m < 4; ++m)
#pragma unroll
                    for (int n = 0; n < 2; ++n) acc[a][b][m][n] = acc[a][b][m][n] * 0.5f;
        Unit v = u; v.half = 0; EpiRows<RowEpi> E{R}; E(acc, v, wr, wc, fr, fq);
    }
};
struct PairOrder : StaticOrder {
    __host__ __device__ bool next(int i, Unit& u) const { const bool ok = StaticOrder::next(i >> 1, u); u.sel = i & 1; return ok; }
};
struct BranchTileEpi {
    static constexpr bool PERM = true, AFTER_DRAIN = false;
    const bf16_t *GA, *GB; bf16_t* Y;
    static __device__ __forceinline__ bool zero_after(const Unit& u) { return u.sel == 1; }
    __device__ __forceinline__ void operator()(f32x4 (&acc)[2][2][4][2], const Unit& u, int wr, int wc, int fr, int fq) const {
        const size_t off0 = (size_t)(u.pm * BM + wr * 64 + fr) * 1024 + u.pn * BM + wc * 32 + 8 * fq;
#pragma unroll
        for (int g0 = 0; g0 < 8; g0 += 4) {
            u32x4 gb[4][2], ga[4][2];
#pragma unroll
            for (int j = 0; j < 4; ++j)
#pragma unroll
                for (int bj = 0; bj < 2; ++bj) { const size_t off = off0 + (size_t)(((g0 + j) >> 2) * HALF + ((g0 + j) & 3) * 16) * 1024 + bj * HALF;
                    gb[j][bj] = *(const u32x4*)(GB + off); if (u.sel == 0) ga[j][bj] = *(const u32x4*)(GA + off); }
            __builtin_amdgcn_sched_barrier(0);
#pragma unroll
            for (int j = 0; j < 4; ++j) { const int ai = (g0 + j) >> 2, m = (g0 + j) & 3;
#pragma unroll
                for (int bj = 0; bj < 2; ++bj) {
                    f32x4 sb[2];
#pragma unroll
                    for (int n = 0; n < 2; ++n) { sb[n][0] = fmaxf(bflo(gb[j][bj][2 * n]), 1e-30f); sb[n][1] = fmaxf(bfhi(gb[j][bj][2 * n]), 1e-30f); sb[n][2] = fmaxf(bflo(gb[j][bj][2 * n + 1]), 1e-30f); sb[n][3] = fmaxf(bfhi(gb[j][bj][2 * n + 1]), 1e-30f); }
                    if (u.sel == 0) {
#pragma unroll
                        for (int n = 0; n < 2; ++n) { f32x4 r; r[0] = bflo(ga[j][bj][2 * n]) * __builtin_amdgcn_rcpf(sb[n][0]); r[1] = bfhi(ga[j][bj][2 * n]) * __builtin_amdgcn_rcpf(sb[n][1]);
                            r[2] = bflo(ga[j][bj][2 * n + 1]) * __builtin_amdgcn_rcpf(sb[n][2]); r[3] = bfhi(ga[j][bj][2 * n + 1]) * __builtin_amdgcn_rcpf(sb[n][3]);
                            acc[ai][bj][m][n] = acc[ai][bj][m][n] * r; }
                    } else {
                        *(u32x4*)(Y + off0 + (size_t)(ai * HALF + m * 16) * 1024 + bj * HALF) = pack8(acc[ai][bj][m][0] * sb[0], acc[ai][bj][m][1] * sb[1]);
                    }
                }
            }
        }
    }
};
}

namespace attn_body {
using bf16=__hip_bfloat16;
using bf16x8=__attribute__((ext_vector_type(8)))short;
using s16x4=__attribute__((ext_vector_type(4)))short;
using f32x16=__attribute__((ext_vector_type(16)))float;
using u32x4=__attribute__((ext_vector_type(4)))unsigned;
constexpr int SEQ=2048,D=64;
constexpr int NW=8,QBLK=32,QB=QBLK*NW,KVBLK=64,NQB=SEQ/QB;
constexpr int ATTN_UNIT_ROWS=QB;
__device__ __forceinline__ int crow(int r,int hi){return (r&3)+8*(r>>2)+4*hi;}
#define SBAR() __builtin_amdgcn_sched_barrier(0)
template<bool LIN> __device__ __forceinline__ void cmask(f32x16&p0,f32x16&p1,int jb,int qrel,int hi){
  const float NEG=LIN?0.f:-INFINITY; int kb=64*jb+4*hi;
  #pragma unroll
  for(int r=0;r<16;++r){int kv=kb+(r&3)+8*(r>>2); if(kv>qrel)p0[r]=NEG; if(kv+32>qrel)p1[r]=NEG;}
}

constexpr int NSLOT=3, SLOTB=8192;
constexpr int LDS_RT=98304, LDS_RTS=106496, RS_NSLOT=6, RS_SLOTB=16384;
constexpr int LDS_K=0, LDS_V=NSLOT*SLOTB, LDS_WS=2*NSLOT*SLOTB, LDS_OST=LDS_WS+NW*64*4, LDS_BYTES=LDS_OST+NW*4096;
constexpr float C2=0.125f*1.4426950408889634f;
__device__ __forceinline__ void glds16s(const void*sbase,unsigned voff,unsigned lds_dst){unsigned keep;
  asm volatile("s_mov_b32 %0, m0\n\ts_mov_b32 m0, %3\n\ts_nop 4\n\tglobal_load_lds_dwordx4 %1, %2\n\ts_mov_b32 m0, %0":"=&s"(keep):"v"(voff),"s"(sbase),"s"(lds_dst):"memory");}
__device__ __forceinline__ const char* uptr(const char*p){const unsigned long long a=(unsigned long long)p;const unsigned lo=__builtin_amdgcn_readfirstlane((unsigned)a),hi=__builtin_amdgcn_readfirstlane((unsigned)(a>>32));return (const char*)(((unsigned long long)hi<<32)|lo);}
__device__ __forceinline__ void glds16(const void*gsrc,unsigned lds_dst){unsigned keep;
  asm volatile("s_mov_b32 %0, m0\n\ts_mov_b32 m0, %2\n\ts_nop 0\n\tglobal_load_lds_dwordx4 %1, off\n\ts_mov_b32 m0, %0":"=&s"(keep):"v"(gsrc),"s"(lds_dst):"memory");}
__device__ __forceinline__ float max3f(float a,float b,float c){float r;asm("v_max3_f32 %0, %1, %2, %3":"=v"(r):"v"(a),"v"(b),"v"(c));return r;}
__device__ __forceinline__ float max2f(float a,float b){float r;asm("v_max_f32_e32 %0, %1, %2":"=v"(r):"v"(a),"v"(b));return r;}
__device__ __forceinline__ float fadd_s(float a,float b){float r;asm("v_add_f32_e32 %0, %1, %2":"=v"(r):"v"(a),"v"(b));return r;}
__device__ __forceinline__ float fsub_s(float a,float b){float r;asm("v_sub_f32_e32 %0, %1, %2":"=v"(r):"v"(a),"v"(b));return r;}
typedef float f32x2_t __attribute__((ext_vector_type(2))); typedef __bf16 bf16x2_t __attribute__((ext_vector_type(2)));
__device__ __forceinline__ unsigned cvtpk_s(float lo,float hi){f32x2_t v={lo,hi};bf16x2_t b=__builtin_convertvector(v,bf16x2_t);return __builtin_bit_cast(unsigned,b);}
#define WAIT_BAR(N) asm volatile("s_waitcnt vmcnt(" #N ") lgkmcnt(0)\n\ts_barrier":::"memory")

__device__ __forceinline__ void qkt(f32x16&p0,f32x16&p1,const char*Kslot,const bf16x8*qr,const f32x16&negm,int r32,int hi){
  const char*kb=Kslot+hi*1024+r32*16;
  #pragma unroll
  for(int d0=0;d0<4;++d0){
    const bf16x8 b0=*reinterpret_cast<const bf16x8*>(kb+d0*2048);
    const bf16x8 b1=*reinterpret_cast<const bf16x8*>(kb+d0*2048+512);
    if(d0==0){p0=__builtin_amdgcn_mfma_f32_32x32x16_bf16(b0,qr[0],negm,0,0,0);p1=__builtin_amdgcn_mfma_f32_32x32x16_bf16(b1,qr[0],negm,0,0,0);}
    else{p0=__builtin_amdgcn_mfma_f32_32x32x16_bf16(b0,qr[d0],p0,0,0,0);p1=__builtin_amdgcn_mfma_f32_32x32x16_bf16(b1,qr[d0],p1,0,0,0);}}
}
typedef __attribute__((address_space(3))) const char* lds_cptr;
typedef short v4i16_t __attribute__((ext_vector_type(4)));
__device__ __forceinline__ void kload8(bf16x8*kf,lds_cptr kp){
  kf[0]=*(const __attribute__((address_space(3))) bf16x8*)(kp);      kf[1]=*(const __attribute__((address_space(3))) bf16x8*)(kp+512);
  kf[2]=*(const __attribute__((address_space(3))) bf16x8*)(kp+2048); kf[3]=*(const __attribute__((address_space(3))) bf16x8*)(kp+2560);
  kf[4]=*(const __attribute__((address_space(3))) bf16x8*)(kp+4096); kf[5]=*(const __attribute__((address_space(3))) bf16x8*)(kp+4608);
  kf[6]=*(const __attribute__((address_space(3))) bf16x8*)(kp+6144); kf[7]=*(const __attribute__((address_space(3))) bf16x8*)(kp+6656);
}
__device__ __forceinline__ void kload2(bf16x8*kf,lds_cptr kp,int j){ kf[2*j]=*(const __attribute__((address_space(3))) bf16x8*)(kp+j*2048); kf[2*j+1]=*(const __attribute__((address_space(3))) bf16x8*)(kp+j*2048+512); }
__device__ __forceinline__ s16x4 vtr(lds_cptr p){ return __builtin_bit_cast(s16x4,__builtin_amdgcn_ds_read_tr16_b64_v4i16((__attribute__((address_space(3))) v4i16_t*)p)); }
__device__ __forceinline__ float rowmax(const f32x16&p0,const f32x16&p1){
  float a=max3f(p0[0],p0[1],p1[0]),b=max3f(p0[2],p0[3],p1[1]);a=max3f(a,p1[2],p1[3]);
  #pragma unroll
  for(int r=4;r<16;r+=4){a=max3f(a,p0[r],p0[r+1]);b=max3f(b,p0[r+2],p0[r+3]);a=max3f(a,p1[r],p1[r+1]);b=max3f(b,p1[r+2],p1[r+3]);}
  const float m=max2f(a,b);
  auto rr=__builtin_amdgcn_permlane32_swap(__float_as_uint(m),__float_as_uint(m),false,false);
  return max2f(__uint_as_float(rr[0]),__uint_as_float(rr[1]));
}
__device__ __forceinline__ void pv(f32x16*o,int vb,bf16x8 pa0,bf16x8 pa1,bf16x8 pa2,bf16x8 pa3){
  #pragma unroll
  for(int d0=0;d0<2;++d0){s16x4 lo[4],hi[4];
    #pragma unroll
    for(int ks=0;ks<4;++ks){
      asm volatile("ds_read_b64_tr_b16 %0,%1 offset:%c2":"=&v"(lo[ks]):"v"(vb),"i"(d0*4096+ks*1024):"memory");
      asm volatile("ds_read_b64_tr_b16 %0,%1 offset:%c2":"=&v"(hi[ks]):"v"(vb),"i"(d0*4096+ks*1024+512):"memory");}
    asm volatile("s_waitcnt lgkmcnt(0)":::"memory");SBAR();
    #define PK(k) (bf16x8){lo[k][0],lo[k][1],lo[k][2],lo[k][3],hi[k][0],hi[k][1],hi[k][2],hi[k][3]}
    o[d0]=__builtin_amdgcn_mfma_f32_32x32x16_bf16(pa0,PK(0),o[d0],0,0,0);
    o[d0]=__builtin_amdgcn_mfma_f32_32x32x16_bf16(pa1,PK(1),o[d0],0,0,0);
    o[d0]=__builtin_amdgcn_mfma_f32_32x32x16_bf16(pa2,PK(2),o[d0],0,0,0);
    o[d0]=__builtin_amdgcn_mfma_f32_32x32x16_bf16(pa3,PK(3),o[d0],0,0,0);
    #undef PK
  }
}

#ifndef ATTN_STORE16
#define ATTN_STORE16(p,v) (*(u32x4*)(p)=(v))
#endif
template<int THRL,bool LIN> __device__ __forceinline__ void attn_unit(long rowbase,int qb,const bf16*Q,int QP,const bf16*__restrict__ K,int KP,const bf16*__restrict__ V,int VP,bf16*O,int OP,char*shm,const bool xr,const int WAVE_S){
  int lane=lane_id_(); asm volatile("":"+v"(lane)); const int r32=lane&31,hi=lane>>5; const int wid=WAVE_S;
  const int q0=qb*QB;
  const bf16*Qw=Q+(rowbase+q0+wid*QBLK)*QP;
  const bf16*Kh=K+rowbase*KP,*Vh=V+rowbase*VP;
  const unsigned lds0=(unsigned)(uintptr_t)shm;
  float*wsf=(float*)(shm+LDS_WS)+wid*64;
  const unsigned koff=(unsigned)((lane*KP+wid*8)*2);
  const unsigned voff=(unsigned)(((16*(wid&3)+(lane>>2))*VP+(wid>>2)*32+(lane&3)*8)*2);
  const unsigned kdst=lds0+LDS_K+wid*1024, vdst=lds0+LDS_V+wid*1024;
  #define DMA_K(t,slot) glds16s(uptr((const char*)(Kh+(long)(t)*KVBLK*KP)),koff,(unsigned)__builtin_amdgcn_readfirstlane(kdst+(slot)))
  #define DMA_V(t,slot) glds16s(uptr((const char*)(Vh+(long)(t)*KVBLK*VP)),voff,(unsigned)__builtin_amdgcn_readfirstlane(vdst+(slot)))
  const int vb0=(int)(lds0+LDS_V)+((lane>>4)&1)*32+(lane&3)*8+(4*hi+((lane&15)>>2))*64;
  const char*Kbase=shm+LDS_K; bf16x8 kf[8];
  const lds_cptr shm3=(lds_cptr)shm; const lds_cptr kp0=shm3+LDS_K+hi*1024+r32*16; const lds_cptr vp0=shm3+LDS_V+((lane>>4)&1)*32+(lane&3)*8+(4*hi+((lane&15)>>2))*64;
  const int NT=(q0+QB)/KVBLK;
  DMA_K(0,0);DMA_V(0,0);DMA_K(1,SLOTB);
  bf16x8 qr[4];
  #pragma unroll
  for(int d0=0;d0<4;++d0)qr[d0]=*reinterpret_cast<const bf16x8*>(&Qw[(long)r32*QP+d0*16+hi*8]);
  float mhat=0.f,l_reg=0.f;f32x16 o[2];o[0]=f32x16{};o[1]=f32x16{};f32x16 negm;
  if constexpr(LIN){ if(xr){ const lds_cptr rt=(lds_cptr)shm+LDS_RT;
    _Pragma("unroll") for(int e2=0;e2<2;++e2) _Pragma("unroll") for(int d0=0;d0<4;++d0){ const bf16x8 rf=*(const __attribute__((address_space(3))) bf16x8*)(rt+((32*e2+r32)*64+16*d0+8*hi)*2);
      o[e2]=__builtin_amdgcn_mfma_f32_32x32x16_bf16(qr[d0],rf,o[e2],0,0,0);} } }
  #define NEGM (LIN?f32x16{}:negm)
  const int qrel=wid*QBLK+r32;
  #define CMASK(P0,P1,t) do{int jb_=(t)-(NT-4); if(jb_>=0)cmask<LIN>(P0,P1,jb_,qrel,hi);}while(0)
  bool resc=false;
  #define START(P0,P1) do{ if constexpr(!LIN){ const float rm=rowmax(P0,P1); resc=false; \
    { const float dl=rm; mhat=fadd_s(mhat,dl); \
      _Pragma("unroll") for(int r=0;r<16;++r){P0[r]=fsub_s(P0[r],dl);P1[r]=fsub_s(P1[r],dl);} \
      _Pragma("unroll") for(int r=0;r<16;++r)negm[r]=-mhat; asm volatile("":"+v"(negm)); } \
    _Pragma("unroll") for(int r=0;r<16;++r)P0[r]=__builtin_amdgcn_exp2f(P0[r]); } }while(0)
  #define RESC() do{ if(resc){ asm volatile("s_waitcnt lgkmcnt(0)":::"memory"); \
      _Pragma("unroll") for(int d_=0;d_<2;++d_) _Pragma("unroll") for(int r=0;r<16;++r)o[d_][r]*=wsf[crow(r,hi)]; } }while(0)
  f32x16 pA0,pA1,pB0,pB1;
  int sl_prev=0,sl_cur=0,sl_next=SLOTB;
  #define ROT() do{sl_prev=sl_cur;sl_cur=sl_next;sl_next=(sl_next==(NSLOT-1)*SLOTB)?0:sl_next+SLOTB;}while(0)
  DMA_K(2,2*SLOTB);
  WAIT_BAR(3);
  qkt(pA0,pA1,Kbase,qr,f32x16{},r32,hi);asm volatile("s_nop 15\n\ts_nop 7":"+v"(pA0),"+v"(pA1));CMASK(pA0,pA1,0);
  START(pA0,pA1);
  if constexpr(!LIN){ _Pragma("unroll") for(int r=0;r<16;++r)pA1[r]=__builtin_amdgcn_exp2f(pA1[r]); }
  WAIT_BAR(0);
  DMA_K(3,0);DMA_V(1,SLOTB);
  ROT();
  kload8(kf,kp0+sl_cur);
  WAIT_BAR(2);
  s16x4 vlo[8],vhi[8]; u32x4 pw0,pw1,pw2,pw3;
  #define PKW(P,B) cvtpk_s(P[B],P[B+1])
  #define PAF(k) __builtin_bit_cast(bf16x8,pw##k)
  #define VFR(i) (bf16x8){vlo[i][0],vlo[i][1],vlo[i][2],vlo[i][3],vhi[i][0],vhi[i][1],vhi[i][2],vhi[i][3]}
  #define PIN(x) asm volatile("":"+v"(x))
  #define MX3(a,b,c) __builtin_fmaxf(__builtin_fmaxf((a),(b)),(c))
  #define GAPA(MF,A0,A1,A2,A3,W0,W1,PW) do{ MF; if constexpr(!LIN){ sacc+=A0; sacc+=A1; sacc+=A2; sacc+=A3; PIN(sacc); } W0; W1; PIN(PW); SBAR(); }while(0)
  #define EX(v) __builtin_amdgcn_exp2f(v)
  #define GAPB(MF,X,B) do{ MF; if constexpr(!LIN){ X[B]=EX(X[B]); X[B+1]=EX(X[B+1]); X[B+2]=EX(X[B+2]); X[B+3]=EX(X[B+3]); PIN(X); } SBAR(); }while(0)
  #define VRD(i) do{ vlo[i]=vtr(vp_+(((i)>>2)*4096+((i)&3)*1024)); vhi[i]=vtr(vp_+(((i)>>2)*4096+((i)&3)*1024+512)); }while(0)
  #define KRD(G,j) do{ if(G){ kload2(kf,kp0+sl_next,j); SBAR(); } }while(0)
  #define STEP(C0,C1,P0,P1,t,GK,GV,GL) do{ SBAR(); \
    const lds_cptr vp_=vp0+sl_prev; \
    VRD(0); SBAR(); float sacc=(P0[0]+P0[1]); \
    GAPA(C0=__builtin_amdgcn_mfma_f32_32x32x16_bf16(kf[0],qr[0],NEGM,0,0,0), P0[2],P0[3],P0[4],P0[5],     pw0[0]=PKW(P0,0), pw0[1]=PKW(P0,2), pw0); \
    VRD(4); SBAR(); GAPA(C1=__builtin_amdgcn_mfma_f32_32x32x16_bf16(kf[1],qr[0],NEGM,0,0,0), P0[6],P0[7],P0[8],P0[9],     pw0[2]=PKW(P0,4), pw0[3]=PKW(P0,6), pw0); \
    VRD(1); SBAR(); GAPA(C0=__builtin_amdgcn_mfma_f32_32x32x16_bf16(kf[2],qr[1],C0,0,0,0),   P0[10],P0[11],P0[12],P0[13], pw1[0]=PKW(P0,8), pw1[1]=PKW(P0,10), pw1); \
    VRD(5); SBAR(); GAPA(C1=__builtin_amdgcn_mfma_f32_32x32x16_bf16(kf[3],qr[1],C1,0,0,0),   P0[14],P0[15],P1[0],P1[1],   pw1[2]=PKW(P0,12),pw1[3]=PKW(P0,14), pw1); \
    VRD(2); SBAR(); GAPA(C0=__builtin_amdgcn_mfma_f32_32x32x16_bf16(kf[4],qr[2],C0,0,0,0),   P1[2],P1[3],P1[4],P1[5],     pw2[0]=PKW(P1,0), pw2[1]=PKW(P1,2), pw2); \
    VRD(6); SBAR(); GAPA(C1=__builtin_amdgcn_mfma_f32_32x32x16_bf16(kf[5],qr[2],C1,0,0,0),   P1[6],P1[7],P1[8],P1[9],     pw2[2]=PKW(P1,4), pw2[3]=PKW(P1,6), pw2); \
    VRD(3); SBAR(); GAPA(C0=__builtin_amdgcn_mfma_f32_32x32x16_bf16(kf[6],qr[3],C0,0,0,0),   P1[10],P1[11],P1[12],P1[13], pw3[0]=PKW(P1,8), pw3[1]=PKW(P1,10), pw3); \
    VRD(7); SBAR(); GAPA(C1=__builtin_amdgcn_mfma_f32_32x32x16_bf16(kf[7],qr[3],C1,0,0,0),   P1[14],P1[15],0.f,0.f,       pw3[2]=PKW(P1,12),pw3[3]=PKW(P1,14), pw3); \
    l_reg+=sacc; \
    if(GK){DMA_K((t)+3,sl_cur);} if(GV){DMA_V((t)+1,sl_next);} \
    CMASK(C0,C1,t); \
    resc=false; if constexpr(!LIN){ float a=MX3(C0[0],C0[1],C1[0]),b=MX3(C0[2],C0[3],C1[1]); a=MX3(a,C1[2],C1[3]); \
      _Pragma("unroll") for(int r=4;r<16;r+=4){a=MX3(a,C0[r],C0[r+1]);b=MX3(b,C0[r+2],C0[r+3]);a=MX3(a,C1[r],C1[r+1]);b=MX3(b,C1[r+2],C1[r+3]);} \
      float rm=__builtin_fmaxf(a,b); { auto rr=__builtin_amdgcn_permlane32_swap(__float_as_uint(rm),__float_as_uint(rm),false,false); rm=__builtin_fmaxf(__uint_as_float(rr[0]),__uint_as_float(rr[1])); } \
      if(__builtin_expect(__any(rm>(float)THRL),0)){ const float dl=__builtin_fmaxf(rm,0.f); mhat+=dl; \
        _Pragma("unroll") for(int r=0;r<16;++r){C0[r]-=dl;C1[r]-=dl;} \
        _Pragma("unroll") for(int r=0;r<16;++r)negm[r]=-mhat; asm volatile("":"+v"(negm)); \
        const float f=__builtin_amdgcn_exp2f(-dl); l_reg*=f; if(hi==0)wsf[r32]=f; resc=true; } } \
    SBAR(); \
    GAPB(o[0]=__builtin_amdgcn_mfma_f32_32x32x16_bf16(PAF(0),VFR(0),o[0],0,0,0), C0,0); \
    GAPB(o[1]=__builtin_amdgcn_mfma_f32_32x32x16_bf16(PAF(0),VFR(4),o[1],0,0,0), C0,4); \
    KRD(GL,0); GAPB(o[0]=__builtin_amdgcn_mfma_f32_32x32x16_bf16(PAF(1),VFR(1),o[0],0,0,0), C0,8); \
    KRD(GL,1); GAPB(o[1]=__builtin_amdgcn_mfma_f32_32x32x16_bf16(PAF(1),VFR(5),o[1],0,0,0), C0,12); \
    KRD(GL,2); GAPB(o[0]=__builtin_amdgcn_mfma_f32_32x32x16_bf16(PAF(2),VFR(2),o[0],0,0,0), C1,0); \
    KRD(GL,3); GAPB(o[1]=__builtin_amdgcn_mfma_f32_32x32x16_bf16(PAF(2),VFR(6),o[1],0,0,0), C1,4); \
    GAPB(o[0]=__builtin_amdgcn_mfma_f32_32x32x16_bf16(PAF(3),VFR(3),o[0],0,0,0), C1,8); \
    GAPB(o[1]=__builtin_amdgcn_mfma_f32_32x32x16_bf16(PAF(3),VFR(7),o[1],0,0,0), C1,12); \
    }while(0)
  int t=1;
  #undef CMASK
  #define CMASK(P0,P1,t) do{}while(0)
  for(;t+5<NT;t+=2){
    STEP(pB0,pB1,pA0,pA1,t,true,true,true);     WAIT_BAR(2); RESC(); ROT();
    STEP(pA0,pA1,pB0,pB1,t+1,true,true,true);   WAIT_BAR(2); RESC(); ROT();
  }
  #undef CMASK
  #define CMASK(P0,P1,t) do{int jb_=(t)-(NT-4); if(jb_>=0)cmask<LIN>(P0,P1,jb_,qrel,hi);}while(0)
  #define ENDW(tt) do{ if((tt)+3<NT){WAIT_BAR(2);} else if((tt)+2<NT){WAIT_BAR(1);} else {WAIT_BAR(0);} }while(0)
  for(;t+1<NT;t+=2){
    STEP(pB0,pB1,pA0,pA1,t,(t+3<NT),(t+1<NT),(t+1<NT));       ENDW(t);   RESC(); ROT();
    STEP(pA0,pA1,pB0,pB1,t+1,(t+4<NT),(t+2<NT),(t+2<NT));     ENDW(t+1); RESC(); ROT();
  }
  STEP(pB0,pB1,pA0,pA1,NT-1,false,false,false); RESC();
  { float sacc=pB0[0]+pB0[1]; _Pragma("unroll") for(int r=2;r<16;++r)sacc+=pB0[r]; _Pragma("unroll") for(int r=0;r<16;++r)sacc+=pB1[r]; l_reg+=sacc;
    pw0=(u32x4){PKW(pB0,0),PKW(pB0,2),PKW(pB0,4),PKW(pB0,6)};pw1=(u32x4){PKW(pB0,8),PKW(pB0,10),PKW(pB0,12),PKW(pB0,14)};pw2=(u32x4){PKW(pB1,0),PKW(pB1,2),PKW(pB1,4),PKW(pB1,6)};pw3=(u32x4){PKW(pB1,8),PKW(pB1,10),PKW(pB1,12),PKW(pB1,14)};
    SBAR(); pv(o,vb0+sl_cur,PAF(0),PAF(1),PAF(2),PAF(3)); }
  #undef PKW
  #undef PAF
  #undef VFR
  #undef PIN
  #undef MX3
  #undef GAPA
  #undef GAPB
  #undef EX
  #undef VRD
  #undef KRD
  #undef STEP
  #undef ENDW
  {auto rr=__builtin_amdgcn_permlane32_swap(__float_as_uint(l_reg),__float_as_uint(l_reg),false,false);l_reg=__uint_as_float(rr[0])+__uint_as_float(rr[1]);}
  if(hi==0)wsf[32+r32]=l_reg;asm volatile("s_waitcnt lgkmcnt(0)":::"memory");
  float rli[16];
  #pragma unroll
  for(int r=0;r<16;++r)rli[r]=LIN?1.f:__builtin_amdgcn_rcpf(wsf[32+crow(r,hi)]);
  bf16*Ow=O+(rowbase+q0+wid*QBLK)*OP;
  { bf16*stg=(bf16*)(shm+LDS_OST)+wid*2048;
    #pragma unroll
    for(int r=0;r<16;++r){const int orow=crow(r,hi);
      #pragma unroll
      for(int d0=0;d0<2;++d0)stg[orow*64+d0*32+r32]=__float2bfloat16(o[d0][r]*rli[r]);}
    asm volatile("s_waitcnt lgkmcnt(0)":::"memory");
    int lane_e=lane; asm volatile("":"+v"(lane_e));
    #pragma unroll
    for(int i=0;i<4;++i){const int row=i*8+(lane_e>>3),ch=lane_e&7; const u32x4 v=*(const u32x4*)(stg+row*64+ch*8); ATTN_STORE16(Ow+(long)row*OP+ch*8,v);} }
  asm volatile("s_waitcnt lgkmcnt(0)\n\ts_barrier":::"memory");
  #undef DMA_K
  #undef DMA_V
  #undef CMASK
  #undef START
  #undef RESC
  #undef ROT
}
constexpr int ATTN_LDS_BYTES=LDS_BYTES;
__device__ __forceinline__ void ret_state(long rowbase,int nt,const bf16*__restrict__ K,int KP,const bf16*__restrict__ V,int VP,char*shm,const int WAVE_S){
  int lane=lane_id_(); asm volatile("":"+v"(lane)); const int r32=lane&31,hi=lane>>5; const int wid=WAVE_S;
  const bf16*Kh=K+rowbase*KP,*Vh=V+rowbase*VP;
  const unsigned lds0=(unsigned)(uintptr_t)shm;
  const unsigned koff=(unsigned)(((16*(wid&3)+(lane>>2))*KP+(wid>>2)*32+(lane&3)*8)*2);
  const unsigned voff=(unsigned)(((16*(wid&3)+(lane>>2))*VP+(wid>>2)*32+(lane&3)*8)*2);
  const unsigned kdst=lds0+wid*1024, vdst=lds0+8192+wid*1024;
  #define RS_DMA(t,slot) do{ glds16s(uptr((const char*)(Kh+(long)(t)*KVBLK*KP)),koff,(unsigned)__builtin_amdgcn_readfirstlane(kdst+(slot))); \
                             glds16s(uptr((const char*)(Vh+(long)(t)*KVBLK*VP)),voff,(unsigned)__builtin_amdgcn_readfirstlane(vdst+(slot))); }while(0)
  const lds_cptr shm3=(lds_cptr)shm;
  const int frag=((lane>>4)&1)*32+(lane&3)*8+(4*hi+((lane&15)>>2))*64;
  const int eb=wid&1, db=(wid>>1)&1, kh=wid>>2;
  f32x16 acc=f32x16{};
  { int s=0; for(int t=0;t<5&&t<nt;++t){ RS_DMA(t,s); s+=RS_SLOTB; } }
  int sl=0, sl_free=5*RS_SLOTB;
  for(int t=0;t<nt;++t){
    const int after=(nt-1-t)<4?(nt-1-t):4;
    if(after==4)WAIT_BAR(8); else if(after==3)WAIT_BAR(6); else if(after==2)WAIT_BAR(4); else if(after==1)WAIT_BAR(2); else WAIT_BAR(0);
    if(t+5<nt)RS_DMA(t+5,sl_free);
    const lds_cptr kp=shm3+sl+frag, vp=shm3+sl+8192+frag;
    #pragma unroll
    for(int k2=0;k2<2;++k2){ const int ks=2*kh+k2;
      const s16x4 alo=vtr(vp+eb*4096+ks*1024), ahi=vtr(vp+eb*4096+ks*1024+512), blo=vtr(kp+db*4096+ks*1024), bhi=vtr(kp+db*4096+ks*1024+512);
      const bf16x8 af=(bf16x8){alo[0],alo[1],alo[2],alo[3],ahi[0],ahi[1],ahi[2],ahi[3]}, bf=(bf16x8){blo[0],blo[1],blo[2],blo[3],bhi[0],bhi[1],bhi[2],bhi[3]};
      acc=__builtin_amdgcn_mfma_f32_32x32x16_bf16(af,bf,acc,0,0,0); }
    sl_free=sl; sl=(sl==(RS_NSLOT-1)*RS_SLOTB)?0:sl+RS_SLOTB;
  }
  #undef RS_DMA
  __attribute__((address_space(3))) float*part=(__attribute__((address_space(3))) float*)((__attribute__((address_space(3))) char*)shm+LDS_RTS)+(wid&3)*1024;
  if(kh==1){ _Pragma("unroll") for(int r=0;r<16;++r)part[r*64+lane]=acc[r]; }
  asm volatile("s_waitcnt lgkmcnt(0)\n\ts_barrier":::"memory");
  if(kh==0){ __attribute__((address_space(3))) unsigned short*rt=(__attribute__((address_space(3))) unsigned short*)((__attribute__((address_space(3))) char*)shm+LDS_RT);
    _Pragma("unroll") for(int r=0;r<16;++r){ const float v=acc[r]+part[r*64+lane]; rt[(32*eb+crow(r,hi))*64+32*db+r32]=(unsigned short)(cvtpk_s(v,0.f)&0xffffu); } }
  asm volatile("s_waitcnt lgkmcnt(0)\n\ts_barrier":::"memory");
}
constexpr int A2_K=0, A2_V=3*8192, A2_WS=A2_V+3*16384, A2_OST=A2_WS+NW*64*4, A2_BYTES=A2_OST+NW*4096;
template<int THRL> __device__ __forceinline__ void attn_unit2(long rowbase,int qb,const bf16*Q,int QP,const bf16*__restrict__ K,int KP,const bf16*__restrict__ V,int VP,bf16*O,int OP,char*shm,const int WAVE_S){
  int lane=lane_id_(); asm volatile("":"+v"(lane)); const int r32=lane&31,hi=lane>>5; const int wid=WAVE_S;
  const int q0=qb*QB;
  const bf16*Qw=Q+(rowbase+q0+wid*QBLK)*QP;
  const bf16*Kh=K+rowbase*KP,*Vh=V+rowbase*VP;
  const unsigned lds0=(unsigned)(uintptr_t)shm;
  float*wsf=(float*)(shm+A2_WS)+wid*64;
  const unsigned koff=(unsigned)((lane*KP+wid*8)*2);
  const unsigned voff=(unsigned)(((16*(wid&3)+(lane>>2))*VP+(wid>>2)*32+(lane&3)*8)*2);
  const unsigned kdst=lds0+A2_K+wid*1024, vdst=lds0+A2_V+wid*1024;
  #define DMA_K(t,slot) glds16s(uptr((const char*)(Kh+(long)(t)*KVBLK*KP)),koff,(unsigned)__builtin_amdgcn_readfirstlane(kdst+(slot)))
  #define DMA_V(t,slot) do{ glds16s(uptr((const char*)(Vh+(long)(t)*KVBLK*VP)),voff,(unsigned)__builtin_amdgcn_readfirstlane(vdst+2*(slot))); \
                            glds16s(uptr((const char*)(Vh+(long)(t)*KVBLK*VP)+128),voff,(unsigned)__builtin_amdgcn_readfirstlane(vdst+2*(slot)+8192)); }while(0)
  const char*Kbase=shm+A2_K; bf16x8 kf[8];
  const lds_cptr shm3=(lds_cptr)shm; const lds_cptr kp0=shm3+A2_K+hi*1024+r32*16; const lds_cptr vp0=shm3+A2_V+((lane>>4)&1)*32+(lane&3)*8+(4*hi+((lane&15)>>2))*64;
  const int NT=(q0+QB)/KVBLK;
  DMA_K(0,0);DMA_V(0,0);DMA_K(1,SLOTB);
  bf16x8 qr[4];
  #pragma unroll
  for(int d0=0;d0<4;++d0)qr[d0]=*reinterpret_cast<const bf16x8*>(&Qw[(long)r32*QP+d0*16+hi*8]);
  float mhat=0.f,l_reg=0.f;f32x16 o[4];o[0]=f32x16{};o[1]=f32x16{};o[2]=f32x16{};o[3]=f32x16{};
  const int qrel=wid*QBLK+r32;
  #define CMASK(P0,P1,t) do{int jb_=(t)-(NT-4); if(jb_>=0)cmask<false>(P0,P1,jb_,qrel,hi);}while(0)
  bool resc=false;
  #define RESC() do{ if(resc){ asm volatile("s_waitcnt lgkmcnt(0)":::"memory"); \
      _Pragma("unroll") for(int d_=0;d_<4;++d_) _Pragma("unroll") for(int r=0;r<16;++r)o[d_][r]*=wsf[crow(r,hi)]; } }while(0)
  f32x16 pA0,pA1,pB0,pB1;
  int sl_prev=0,sl_cur=0,sl_next=SLOTB;
  #define ROT() do{sl_prev=sl_cur;sl_cur=sl_next;sl_next=(sl_next==(NSLOT-1)*SLOTB)?0:sl_next+SLOTB;}while(0)
  DMA_K(2,2*SLOTB);
  WAIT_BAR(4);
  qkt(pA0,pA1,Kbase,qr,f32x16{},r32,hi);asm volatile("s_nop 15\n\ts_nop 7":"+v"(pA0),"+v"(pA1));CMASK(pA0,pA1,0);
  { const float rm=rowmax(pA0,pA1); mhat=rm;
    _Pragma("unroll") for(int r=0;r<16;++r){pA0[r]=__builtin_amdgcn_exp2f(pA0[r]-mhat);pA1[r]=__builtin_amdgcn_exp2f(pA1[r]-mhat);} }
  WAIT_BAR(0);
  DMA_K(3,0);DMA_V(1,SLOTB);
  ROT();
  kload8(kf,kp0+sl_cur);
  WAIT_BAR(3);
  s16x4 fa_lo,fa_hi,fb_lo,fb_hi,fc_lo,fc_hi,fd_lo,fd_hi; u32x4 pw0,pw1,pw2,pw3;
  #define PKW(P,B) cvtpk_s(P[B],P[B+1])
  #define PAF(k) __builtin_bit_cast(bf16x8,pw##k)
  #define PIN(x) asm volatile("":"+v"(x))
  #define MX3(a,b,c) __builtin_fmaxf(__builtin_fmaxf((a),(b)),(c))
  #define VOFF(i) ((((i)&3)>>1)*8192+((i)&1)*4096+((i)>>2)*1024)
  #define VRDX(X,i) do{ X##_lo=vtr(vp_+VOFF(i)); X##_hi=vtr(vp_+VOFF(i)+512); }while(0)
  #define VFRX(X) (bf16x8){X##_lo[0],X##_lo[1],X##_lo[2],X##_lo[3],X##_hi[0],X##_hi[1],X##_hi[2],X##_hi[3]}
  #define GAPA(MF,A0,A1,A2,A3,W0,W1,PW) do{ MF; sacc+=A0; sacc+=A1; sacc+=A2; sacc+=A3; PIN(sacc); W0; W1; PIN(PW); SBAR(); }while(0)
  #define EX(v) __builtin_amdgcn_exp2f(v)
  #define GAPB(MF,X,B) do{ MF; X[B]=EX(X[B]-mhat); X[B+1]=EX(X[B+1]-mhat); PIN(X); SBAR(); }while(0)
  #define KRD(G,j) do{ if(G){ kload2(kf,kp0+sl_next,j); SBAR(); } }while(0)
  #define PVM(i,X) o[(i)&3]=__builtin_amdgcn_mfma_f32_32x32x16_bf16(PAF_((i)>>2),VFRX(X),o[(i)&3],0,0,0)
  #define PAF_(k) ((k)==0?PAF(0):(k)==1?PAF(1):(k)==2?PAF(2):PAF(3))
  #define STEP(C0,C1,P0,P1,t,GK,GV,GL) do{ SBAR(); \
    const lds_cptr vp_=vp0+2*sl_prev; \
    float sacc=(P0[0]+P0[1]); \
    GAPA(C0=__builtin_amdgcn_mfma_f32_32x32x16_bf16(kf[0],qr[0],f32x16{},0,0,0), P0[2],P0[3],P0[4],P0[5],     pw0[0]=PKW(P0,0), pw0[1]=PKW(P0,2), pw0); \
    GAPA(C1=__builtin_amdgcn_mfma_f32_32x32x16_bf16(kf[1],qr[0],f32x16{},0,0,0), P0[6],P0[7],P0[8],P0[9],     pw0[2]=PKW(P0,4), pw0[3]=PKW(P0,6), pw0); \
    GAPA(C0=__builtin_amdgcn_mfma_f32_32x32x16_bf16(kf[2],qr[1],C0,0,0,0),   P0[10],P0[11],P0[12],P0[13], pw1[0]=PKW(P0,8), pw1[1]=PKW(P0,10), pw1); \
    GAPA(C1=__builtin_amdgcn_mfma_f32_32x32x16_bf16(kf[3],qr[1],C1,0,0,0),   P0[14],P0[15],P1[0],P1[1],   pw1[2]=PKW(P0,12),pw1[3]=PKW(P0,14), pw1); \
    GAPA(C0=__builtin_amdgcn_mfma_f32_32x32x16_bf16(kf[4],qr[2],C0,0,0,0),   P1[2],P1[3],P1[4],P1[5],     pw2[0]=PKW(P1,0), pw2[1]=PKW(P1,2), pw2); \
    VRDX(fa,0); SBAR(); GAPA(C1=__builtin_amdgcn_mfma_f32_32x32x16_bf16(kf[5],qr[2],C1,0,0,0),   P1[6],P1[7],P1[8],P1[9],     pw2[2]=PKW(P1,4), pw2[3]=PKW(P1,6), pw2); \
    VRDX(fb,1); SBAR(); GAPA(C0=__builtin_amdgcn_mfma_f32_32x32x16_bf16(kf[6],qr[3],C0,0,0,0),   P1[10],P1[11],P1[12],P1[13], pw3[0]=PKW(P1,8), pw3[1]=PKW(P1,10), pw3); \
    VRDX(fc,2); SBAR(); GAPA(C1=__builtin_amdgcn_mfma_f32_32x32x16_bf16(kf[7],qr[3],C1,0,0,0),   P1[14],P1[15],0.f,0.f,       pw3[2]=PKW(P1,12),pw3[3]=PKW(P1,14), pw3); \
    l_reg+=sacc; \
    if(GK){DMA_K((t)+3,sl_cur);} if(GV){DMA_V((t)+1,sl_next);} \
    CMASK(C0,C1,t); \
    resc=false; { float a=MX3(C0[0],C0[1],C1[0]),b=MX3(C0[2],C0[3],C1[1]); a=MX3(a,C1[2],C1[3]); \
      _Pragma("unroll") for(int r=4;r<16;r+=4){a=MX3(a,C0[r],C0[r+1]);b=MX3(b,C0[r+2],C0[r+3]);a=MX3(a,C1[r],C1[r+1]);b=MX3(b,C1[r+2],C1[r+3]);} \
      float rm=__builtin_fmaxf(a,b); { auto rr=__builtin_amdgcn_permlane32_swap(__float_as_uint(rm),__float_as_uint(rm),false,false); rm=__builtin_fmaxf(__uint_as_float(rr[0]),__uint_as_float(rr[1])); } \
      rm-=mhat; \
      if(__builtin_expect(__any(rm>(float)THRL),0)){ const float dl=__builtin_fmaxf(rm,0.f); mhat+=dl; \
        const float f=__builtin_amdgcn_exp2f(-dl); l_reg*=f; if(hi==0)wsf[r32]=f; resc=true; } } \
    SBAR(); \
    VRDX(fd,3);  SBAR(); GAPB(PVM(0,fa),  C0,0); \
    VRDX(fa,4);  SBAR(); GAPB(PVM(1,fb),  C0,2); \
    VRDX(fb,5);  SBAR(); GAPB(PVM(2,fc),  C0,4); \
    VRDX(fc,6);  SBAR(); KRD(GL,0); GAPB(PVM(3,fd),  C0,6); \
    VRDX(fd,7);  SBAR(); KRD(GL,1); GAPB(PVM(4,fa),  C0,8); \
    VRDX(fa,8);  SBAR(); KRD(GL,2); GAPB(PVM(5,fb),  C0,10); \
    VRDX(fb,9);  SBAR(); KRD(GL,3); GAPB(PVM(6,fc),  C0,12); \
    VRDX(fc,10); SBAR(); GAPB(PVM(7,fd),  C0,14); \
    VRDX(fd,11); SBAR(); GAPB(PVM(8,fa),  C1,0); \
    VRDX(fa,12); SBAR(); GAPB(PVM(9,fb),  C1,2); \
    VRDX(fb,13); SBAR(); GAPB(PVM(10,fc), C1,4); \
    VRDX(fc,14); SBAR(); GAPB(PVM(11,fd), C1,6); \
    VRDX(fd,15); SBAR(); GAPB(PVM(12,fa), C1,8); \
    GAPB(PVM(13,fb), C1,10); \
    GAPB(PVM(14,fc), C1,12); \
    GAPB(PVM(15,fd), C1,14); \
    }while(0)
  int t=1;
  #undef CMASK
  #define CMASK(P0,P1,t) do{}while(0)
  for(;t+5<NT;t+=2){
    STEP(pB0,pB1,pA0,pA1,t,true,true,true);     WAIT_BAR(3); RESC(); ROT();
    STEP(pA0,pA1,pB0,pB1,t+1,true,true,true);   WAIT_BAR(3); RESC(); ROT();
  }
  #undef CMASK
  #define CMASK(P0,P1,t) do{int jb_=(t)-(NT-4); if(jb_>=0)cmask<false>(P0,P1,jb_,qrel,hi);}while(0)
  #define ENDW(tt) do{ if((tt)+3<NT){WAIT_BAR(3);} else if((tt)+2<NT){WAIT_BAR(2);} else {WAIT_BAR(0);} }while(0)
  for(;t+1<NT;t+=2){
    STEP(pB0,pB1,pA0,pA1,t,(t+3<NT),(t+1<NT),(t+1<NT));       ENDW(t);   RESC(); ROT();
    STEP(pA0,pA1,pB0,pB1,t+1,(t+4<NT),(t+2<NT),(t+2<NT));     ENDW(t+1); RESC(); ROT();
  }
  STEP(pB0,pB1,pA0,pA1,NT-1,false,false,false); RESC();
  { float sacc=pB0[0]+pB0[1]; _Pragma("unroll") for(int r=2;r<16;++r)sacc+=pB0[r]; _Pragma("unroll") for(int r=0;r<16;++r)sacc+=pB1[r]; l_reg+=sacc;
    pw0=(u32x4){PKW(pB0,0),PKW(pB0,2),PKW(pB0,4),PKW(pB0,6)};pw1=(u32x4){PKW(pB0,8),PKW(pB0,10),PKW(pB0,12),PKW(pB0,14)};pw2=(u32x4){PKW(pB1,0),PKW(pB1,2),PKW(pB1,4),PKW(pB1,6)};pw3=(u32x4){PKW(pB1,8),PKW(pB1,10),PKW(pB1,12),PKW(pB1,14)};
    SBAR(); const lds_cptr vp_=vp0+2*sl_cur;
    #pragma unroll
    for(int e4=0;e4<4;++e4){ s16x4 lo[4],hh[4];
      #pragma unroll
      for(int ks=0;ks<4;++ks){ lo[ks]=vtr(vp_+VOFF(4*ks+e4)); hh[ks]=vtr(vp_+VOFF(4*ks+e4)+512); }
      #define PK(k) (bf16x8){lo[k][0],lo[k][1],lo[k][2],lo[k][3],hh[k][0],hh[k][1],hh[k][2],hh[k][3]}
      o[e4]=__builtin_amdgcn_mfma_f32_32x32x16_bf16(PAF(0),PK(0),o[e4],0,0,0);
      o[e4]=__builtin_amdgcn_mfma_f32_32x32x16_bf16(PAF(1),PK(1),o[e4],0,0,0);
      o[e4]=__builtin_amdgcn_mfma_f32_32x32x16_bf16(PAF(2),PK(2),o[e4],0,0,0);
      o[e4]=__builtin_amdgcn_mfma_f32_32x32x16_bf16(PAF(3),PK(3),o[e4],0,0,0);
      #undef PK
    } }
  #undef PKW
  #undef PAF
  #undef PAF_
  #undef PVM
  #undef PIN
  #undef MX3
  #undef VOFF
  #undef VRDX
  #undef VFRX
  #undef GAPA
  #undef GAPB
  #undef EX
  #undef KRD
  #undef STEP
  #undef ENDW
  {auto rr=__builtin_amdgcn_permlane32_swap(__float_as_uint(l_reg),__float_as_uint(l_reg),false,false);l_reg=__uint_as_float(rr[0])+__uint_as_float(rr[1]);}
  if(hi==0)wsf[32+r32]=l_reg;asm volatile("s_waitcnt lgkmcnt(0)":::"memory");
  float rli[16];
  #pragma unroll
  for(int r=0;r<16;++r)rli[r]=__builtin_amdgcn_rcpf(wsf[32+crow(r,hi)]);
  bf16*Ow=O+(rowbase+q0+wid*QBLK)*OP;
  { bf16*stg=(bf16*)(shm+A2_OST)+wid*2048;
    int lane_e=lane; asm volatile("":"+v"(lane_e));
    #pragma unroll
    for(int hh=0;hh<2;++hh){
      #pragma unroll
      for(int r=0;r<16;++r){const int orow=crow(r,hi);
        #pragma unroll
        for(int d0=0;d0<2;++d0)stg[orow*64+d0*32+r32]=__float2bfloat16(o[2*hh+d0][r]*rli[r]);}
      asm volatile("s_waitcnt lgkmcnt(0)":::"memory");
      #pragma unroll
      for(int i=0;i<4;++i){const int row=i*8+(lane_e>>3),ch=lane_e&7; const u32x4 v=*(const u32x4*)(stg+row*64+ch*8); ATTN_STORE16(Ow+(long)row*OP+hh*64+ch*8,v);}
      asm volatile("s_waitcnt lgkmcnt(0)":::"memory");
    } }
  asm volatile("s_waitcnt lgkmcnt(0)\n\ts_barrier":::"memory");
  #undef DMA_K
  #undef DMA_V
  #undef CMASK
  #undef RESC
  #undef ROT
}
#undef SBAR
#undef WAIT_BAR
}

#define GAS __attribute__((address_space(1)))
#define LAS __attribute__((address_space(3)))
typedef unsigned v4u __attribute__((ext_vector_type(4)));
typedef float f32x4 __attribute__((ext_vector_type(4)));
typedef short bf16x8 __attribute__((ext_vector_type(8)));
typedef GAS unsigned gu32;
typedef GAS unsigned long long gu64;
#define RLX_AGENT __ATOMIC_RELAXED, __HIP_MEMORY_SCOPE_AGENT
#define LDS_WAIT() asm volatile("s_waitcnt lgkmcnt(0)" ::: "memory")
#define VM_WAIT() asm volatile("s_waitcnt vmcnt(0)" ::: "memory")
__device__ __forceinline__ unsigned long long rt() { return __builtin_amdgcn_s_memrealtime(); }

#define XB_TMO      128
#define XB_XCNT(j)  (256  + 64 * (j))
#define XB_XSUB(j)  (1280 + 64 * (j))
#define XB_XGEN(j)  (2304 + 64 * (j))
#define XB_TOP      3328
#define XB_TOPGEN   3392
#define XCD_BAR_WORDS 3456
#define XB_SPIN_CAP (1u << 18)

__device__ __forceinline__ unsigned xb_ld(unsigned* p)              { return __hip_atomic_load(p, __ATOMIC_RELAXED, __HIP_MEMORY_SCOPE_AGENT); }
__device__ __forceinline__ unsigned xb_add(unsigned* p, unsigned v) { return __hip_atomic_fetch_add(p, v, __ATOMIC_RELAXED, __HIP_MEMORY_SCOPE_AGENT); }
__device__ __forceinline__ unsigned xb_xcc_id() { return (unsigned)__builtin_amdgcn_s_getreg((3 << 11) | 20) & 0xFu; }
#define XB_SPIN(cond, bar) do { unsigned _sp = 0; while (cond) { __builtin_amdgcn_s_sleep(1); \
    if ((++_sp & 255u) == 0u) { if (xb_ld(&(bar)[XB_TMO])) break; if (_sp > XB_SPIN_CAP) { atomicAdd(&(bar)[XB_TMO], 1u); break; } } } } while (0)

struct XcdBarrier {
    unsigned* bar; unsigned x;
    volatile LAS unsigned* st;
};

__device__ __forceinline__ XcdBarrier xcd_barrier_post(unsigned* bar, volatile LAS unsigned* st, const bool first) {
    XcdBarrier b; b.bar = bar; b.x = xb_xcc_id(); b.st = st;
    if (first) (void)xb_add(&bar[XB_XCNT(b.x)], 1u);
    return b;
}
__device__ __forceinline__ void xcd_barrier_complete(unsigned* bar, unsigned x, unsigned& nloc, unsigned& nx) {
    const unsigned G = gridDim.x * gridDim.y * gridDim.z;
    unsigned sum, cnt, mine, sp = 0u;
    for (;;) {
        sum = 0u; cnt = 0u; mine = 0u;
#pragma unroll
        for (unsigned j = 0; j < 16; ++j) { const unsigned c = xb_ld(&bar[XB_XCNT(j)]); sum += c; cnt += (c > 0u) ? 1u : 0u; mine = (j == x) ? c : mine; }
        if (sum == G) break;
        __builtin_amdgcn_s_sleep(1);
        if ((++sp & 255u) == 0u) { if (xb_ld(&bar[XB_TMO])) break; if (sp > XB_SPIN_CAP) { atomicAdd(&bar[XB_TMO], 1u); break; } }
    }
    nloc = mine > 0u ? mine : 1u; nx = cnt > 0u ? cnt : 1u;
}

__device__ __forceinline__ void xcd_barrier(const XcdBarrier& b, const bool first) {
    asm volatile("s_waitcnt vmcnt(0)" ::: "memory");
    __syncthreads();
    if (first) {
        unsigned* bar = b.bar;
        __builtin_amdgcn_s_waitcnt(0);
        unsigned nloc = b.st[0], nx = b.st[1];
        if (nloc == 0u) { xcd_barrier_complete(bar, b.x, nloc, nx); b.st[0] = nloc; b.st[1] = nx; }
        const unsigned old = xb_add(&bar[XB_XSUB(b.x)], 1u);
        const unsigned gen = old / nloc;
        if (old + 1u == (gen + 1u) * nloc) {
            __builtin_amdgcn_fence(__ATOMIC_RELEASE, "agent");
            asm volatile("s_waitcnt vmcnt(0)" ::: "memory");
            const unsigned og = xb_add(&bar[XB_TOP], 1u);
            const unsigned tg = og / nx;
            if (og + 1u == (tg + 1u) * nx) xb_add(&bar[XB_TOPGEN], 1u);
            else XB_SPIN(xb_ld(&bar[XB_TOPGEN]) == tg, bar);
            __builtin_amdgcn_fence(__ATOMIC_ACQUIRE, "agent");
            xb_add(&bar[XB_XGEN(b.x)], 1u);
            asm volatile("s_waitcnt vmcnt(0)" ::: "memory");
        } else {
            XB_SPIN(xb_ld(&bar[XB_XGEN(b.x)]) == gen, bar);
            __builtin_amdgcn_fence(__ATOMIC_ACQUIRE, "agent");
            asm volatile("s_waitcnt vmcnt(0)" ::: "memory");
        }
    }
    __syncthreads();
}

constexpr int NWAVES = 8;
constexpr int RING_OFF = 0, RING_BYTES = 131072;
constexpr int LDSCTL_OFF = RING_BYTES, MISC_OFF = LDSCTL_OFF + 320;
constexpr int LDS_BYTES = 147456;
constexpr int CW_BAR = 0;
#ifndef MK_N_LAUNCHES
#define MK_N_LAUNCHES 1
#endif
constexpr size_t CTL_ZERO_BYTES = (MK_N_LAUNCHES == 1 ? 16 : 256) * 1024;
constexpr int N_PHASES = 10;
#ifndef PROBE_DOUBLEK
#define PROBE_DOUBLEK 0
#endif
#ifndef PROBE_PHASE
#define PROBE_PHASE -1
#endif
constexpr int PROBE_AMP = 8;
#ifndef PROBE_REPS
#define PROBE_REPS 1,1,1,1,1,1,1,1,1,1
#endif
constexpr int PHASE_REP[N_PHASES] = {PROBE_REPS};

__device__ __forceinline__ void xcd_barrier_arrive(const XcdBarrier& b, const bool first) {
    asm volatile("s_waitcnt vmcnt(0)" ::: "memory");
    __syncthreads();
    if (first) {
        unsigned* bar = b.bar;
        __builtin_amdgcn_s_waitcnt(0);
        unsigned nloc = b.st[0], nx = b.st[1];
        if (nloc == 0u) { xcd_barrier_complete(bar, b.x, nloc, nx); b.st[0] = nloc; b.st[1] = nx; }
        const unsigned old = xb_add(&bar[XB_XSUB(b.x)], 1u);
        const unsigned gen = old / nloc;
        unsigned role = 0u, tg = 0u;
        if (old + 1u == (gen + 1u) * nloc) {
            __builtin_amdgcn_fence(__ATOMIC_RELEASE, "agent");
            asm volatile("s_waitcnt vmcnt(0)" ::: "memory");
            const unsigned og = xb_add(&bar[XB_TOP], 1u);
            tg = og / nx;
            if (og + 1u == (tg + 1u) * nx) { xb_add(&bar[XB_TOPGEN], 1u); role = 2u; } else role = 1u;
        }
        b.st[2] = gen; b.st[3] = role; b.st[4] = tg;
    }
}
__device__ __forceinline__ void xcd_barrier_wait(const XcdBarrier& b, const bool first) {
    if (first) {
        unsigned* bar = b.bar;
        const unsigned gen = b.st[2], role = b.st[3], tg = b.st[4];
        if (role != 0u) {
            if (role == 1u) XB_SPIN(xb_ld(&bar[XB_TOPGEN]) == tg, bar);
            __builtin_amdgcn_fence(__ATOMIC_ACQUIRE, "agent");
            xb_add(&bar[XB_XGEN(b.x)], 1u);
            asm volatile("s_waitcnt vmcnt(0)" ::: "memory");
        } else {
            XB_SPIN(xb_ld(&bar[XB_XGEN(b.x)]) == gen, bar);
            __builtin_amdgcn_fence(__ATOMIC_ACQUIRE, "agent");
            asm volatile("s_waitcnt vmcnt(0)" ::: "memory");
        }
    }
    __syncthreads();
}
__device__ __forceinline__ const void* karg(unsigned off) {
    asm volatile("" : "+s"(off));
    return *(const void* const __attribute__((address_space(4)))*)((const char __attribute__((address_space(4)))*)__builtin_amdgcn_kernarg_segment_ptr() + off);
}
struct MArgs { const void* in[20]; float* out; unsigned char* ws; int ph_lo, ph_hi, li, pad; };

__global__ void __launch_bounds__(NWAVES * 64, 2) mega_fwd(MArgs args) {
    extern __shared__ __attribute__((aligned(16))) unsigned char lds[];
    LAS unsigned char* L = (LAS unsigned char*)lds;
    const int WAVE_S = __builtin_amdgcn_readfirstlane((int)(threadIdx.x >> 6));
#define TID() (WAVE_S * 64 + lane_id_())
#define FIRST() (WAVE_S == 0 && lane_id_() == 0)
    const int G = gridDim.x, bx = blockIdx.x, vcu = (G % 8 == 0) ? (bx % 8) * (G / 8) + bx / 8 : bx;
    for (int u = (int)threadIdx.x; u < (LDS_BYTES - LDSCTL_OFF) / 4; u += NWAVES * 64) ((LAS unsigned*)(L + LDSCTL_OFF))[u] = 0u;
    __syncthreads();
    unsigned* ctl = (unsigned*)(args.ws + WS_CTL);
    XcdBarrier bar = xcd_barrier_post(ctl + CW_BAR + args.li * XCD_BAR_WORDS, (volatile LAS unsigned*)(L + MISC_OFF) + 8, FIRST());
    const int lo = args.ph_lo, hi = args.ph_hi;
    unsigned long long t_last = PROBE_PHASE >= 0 ? __builtin_amdgcn_s_memrealtime() : 0ull, t_a = 0ull, t_b = 0ull;
#define IN(k) (lo <= (k) && (k) < hi)
#define ARRIVE(k) do { if (IN(k) && IN((k) + 1)) xcd_barrier_arrive(bar, FIRST()); } while (0)
#define WAITB(k) do { if (PROBE_PHASE == (k)) { t_a = t_last; } if (IN(k) && IN((k) + 1)) xcd_barrier_wait(bar, FIRST()); if (PROBE_PHASE >= 0) { t_last = __builtin_amdgcn_s_memrealtime(); if (PROBE_PHASE == (k)) t_b = t_last; } } while (0)
#define SEAM(k) do { ARRIVE(k); WAITB(k); } while (0)
#define CONVPTRS() ConvPtrs cv{INF(6), INF(14), INF(15), INF(16), INF(18), INF(19), WSB(WS_WIN), WSB(WS_WA), WSB(WS_WB), WSB(WS_WOUT), WSB(WS_WGU), WSB(WS_WDN)}

#define INF(k) ((const float*)karg(8 * (k)))
#define OUTP() ((float*)karg(160))
#define WSB(off) ((bf16_t*)((unsigned char*)karg(168) + (off)))
#define WSF(off) ((float*)((unsigned char*)karg(168) + (off)))

    if (IN(0)) gemv4_phase<true, false>(TID(), vcu, G, INF(1), DM, INF(3), MODW, INF(4), WSF(WS_MOD), MODW, (float*)lds);
    ARRIVE(0);
    if (IN(0)) { CONVPTRS(); convert_phase(TID(), vcu, G, cv, (float*)lds, CV_S0, CV_S1); trig_phase(TID(), vcu, G, (const int*)karg(16), WSF(WS_TA), WSF(WS_TR)); __syncthreads(); }
    WAITB(0);
    if (IN(1)) for (int rep_ = 0; rep_ < PHASE_REP[1]; ++rep_) { const float* mod = WSF(WS_MOD); xn_phase(TID(), vcu, G, INF(0), INF(5), mod + 1 * DM, mod + 0 * DM, WSB(WS_XN)); }
    ARRIVE(1);
    if (IN(1)) { CONVPTRS(); convert_phase(TID(), vcu, G, cv, (float*)lds, CV_S1, CV_S2); __syncthreads(); }
    WAITB(1);
    if (IN(2)) for (int rep_ = 0; rep_ < PHASE_REP[2]; ++rep_) {
        pg8::Gemm g{WSB(WS_XN), WSB(WS_WIN), M, INW, DM}; pg8::StaticOrder S; S.init(M, INW, G, bx);
        pg8::EpiRows<InProjEpi> E{{WSB(WS_DQ), WSB(WS_DK), WSB(WS_DV), WSB(WS_RQ), WSB(WS_RK), WSB(WS_RV), WSB(WS_RG), WSB(WS_GA), WSB(WS_GB), INF(7), INF(8), WSF(WS_TA), WSF(WS_TR)}};
        pg8::gemm_phase<pg8::EpiRows<InProjEpi>, pg8::StaticOrder, true, true>(L + RING_OFF, g, S, E, WAVE_S);
    }
    ARRIVE(2);
    if (IN(2)) { const float* mod = WSF(WS_MOD); gemv4_phase<false, true>(TID(), vcu, G, mod + 3 * DM, MODW, INF(18), 2 * DFF, nullptr, WSF(WS_CVEC), 2 * DFF, (float*)lds); }
    WAITB(2);
    if (IN(3)) for (int rep_ = 0; rep_ < PHASE_REP[3]; ++rep_) {
        char* shm = (char*)lds + RING_OFF;
        typedef attn_body::bf16 abf;
        const int xb = vcu >> 5, lc = vcu & 31;
        for (int i = 0; i < 2; ++i) {
            if (i < 1) {
                const int s4 = lc & 3, u = lc >> 2, b = xb, h = u >> 1;
                for (int k = 0; k < 2; ++k)
                    attn_body::attn_unit2<8>((long)b * SEQ, k == 0 ? 7 - s4 : s4, (const abf*)(WSB(WS_DQ) + u * 64), 512, (const abf*)(WSB(WS_DK) + u * 64), 512, (const abf*)(WSB(WS_DV) + h * 128), 512,
                                             (abf*)(WSB(WS_AO) + u * 128), 1024, shm, WAVE_S);
            } else {
                const int s4 = lc & 3, half = (lc >> 2) & 1, h = lc >> 3, b = xb;
                for (int k = 0; k < 2; ++k) {
                    const int qb = k == 0 ? 7 - s4 : s4; const long row0 = (long)b * SEQ;
                    if (qb > 0) attn_body::ret_state(row0, 4 * qb, (const abf*)(WSB(WS_RK) + h * 64), 256, (const abf*)(WSB(WS_RV) + h * 128 + half * 64), 512, shm, WAVE_S);
                    attn_body::attn_unit<8, true>(row0 + 256 * qb, 0, (const abf*)(WSB(WS_RQ) + h * 64), 256, (const abf*)(WSB(WS_RK) + h * 64), 256, (const abf*)(WSB(WS_RV) + h * 128 + half * 64), 512,
                                                  (abf*)(WSB(WS_RETO) + h * 128 + half * 64), 512, shm, qb > 0, WAVE_S);
                }
            }
        }
    }
    ARRIVE(3);
    if (IN(3)) { CONVPTRS(); convert_phase(TID(), vcu, G, cv, (float*)lds, CV_S2, CV_S2 + CV_GU / 3); __syncthreads(); }
    WAITB(3);
    if (IN(4)) for (int rep_ = 0; rep_ < PHASE_REP[4]; ++rep_) combine_phase(TID(), vcu, G, WSB(WS_AO), WSB(WS_RETO), WSB(WS_RG), WSB(WS_OA), INF(9), INF(10), INF(11), INF(12), INF(13));
    ARRIVE(4);
    if (IN(4)) { CONVPTRS(); convert_phase(TID(), vcu, G, cv, (float*)lds, CV_S2 + CV_GU / 3, CV_S2 + 2 * (CV_GU / 3)); __syncthreads(); }
    WAITB(4);
    if (IN(5)) for (int rep_ = 0; rep_ < PHASE_REP[5]; ++rep_) {
        pg8::Gemm g{WSB(WS_OA), WSB(WS_WA), M, DM, 512, WSB(WS_OB), WSB(WS_WB)}; pg8::PairOrder S; S.init(M, DM, G, bx); pg8::BranchTileEpi E{WSB(WS_GA), WSB(WS_GB), WSB(WS_Y)};
        pg8::gemm_phase<pg8::BranchTileEpi, pg8::PairOrder, true, true>(L + RING_OFF, g, S, E, WAVE_S);
    }
    ARRIVE(5);
    if (IN(5)) { CONVPTRS(); convert_phase(TID(), vcu, G, cv, (float*)lds, CV_S2 + 2 * (CV_GU / 3), CV_S3); __syncthreads(); }
    WAITB(5);
    if (IN(6)) for (int rep_ = 0; rep_ < PHASE_REP[6]; ++rep_) {
        pg8::Gemm g{WSB(WS_Y), WSB(WS_WOUT), M, DM, DM}; pg8::StaticOrder S; S.init(M, DM, G, bx); pg8::EpiOutFused E{{INF(0), WSB(WS_X1B), WSF(WS_MOD), INF(17), WSB(WS_XN), WSF(WS_ROWSS)}};
        pg8::gemm_phase<pg8::EpiOutFused, pg8::StaticOrder, false, true>(L + RING_OFF, g, S, E, WAVE_S);
    }
    SEAM(6);
    if (IN(8)) for (int rep_ = 0; rep_ < PHASE_REP[8]; ++rep_) {
        pg8::Gemm g{WSB(WS_XN), WSB(WS_WGU), M, 2 * DFF, DM}; pg8::StaticOrder S; S.init(M, 2 * DFF, G, bx); pg8::EpiRows<GateUpEpi> E{{WSB(WS_ACT), WSF(WS_ROWSS), WSF(WS_CVEC)}};
        pg8::gemm_phase<pg8::EpiRows<GateUpEpi>, pg8::StaticOrder, true, true>(L + RING_OFF, g, S, E, WAVE_S);
    }
    if (IN(8) && G == 256 && bx >= 128) { CONVPTRS(); convert_phase(TID(), bx - 128, 128, cv, (float*)lds, CV_S3, CV_S4); __syncthreads(); }
    else if (IN(8) && G != 256) { CONVPTRS(); convert_phase(TID(), vcu, G, cv, (float*)lds, CV_S3, CV_S4); __syncthreads(); }
    SEAM(8);
    if (IN(9)) for (int rep_ = 0; rep_ < PHASE_REP[9]; ++rep_) {
        float* out = OUTP();
        pg8::Gemm g{WSB(WS_ACT), WSB(WS_WDN), M, DM, DFF};
#if PROBE_DOUBLEK
        pg8::DoubleKOrder S; S.init(M, DM, G, bx); pg8::EpiRowsDK<ResidEpi> E{{WSB(WS_X1B), out, WSF(WS_MOD) + 5 * DM}};
        pg8::gemm_phase<pg8::EpiRowsDK<ResidEpi>, pg8::DoubleKOrder, false, true>(L + RING_OFF, g, S, E, WAVE_S);
#else
        pg8::StaticOrder S; S.init(M, DM, G, bx); pg8::EpiRows<ResidEpi> E{{WSB(WS_X1B), out, WSF(WS_MOD) + 5 * DM}};
        pg8::gemm_phase<pg8::EpiRows<ResidEpi>, pg8::StaticOrder, true, true>(L + RING_OFF, g, S, E, WAVE_S);
#endif
    }
#undef INF
#undef OUTP
#undef WSB
#undef WSF
    SEAM(9);
    if (PROBE_PHASE >= 0 && blockIdx.x == 0 && WAVE_S == 0) { const unsigned long long tgt = __builtin_amdgcn_s_memrealtime() + (unsigned long long)PROBE_AMP * (t_b - t_a); while (__builtin_amdgcn_s_memrealtime() < tgt) __builtin_amdgcn_s_sleep(8); }
#undef IN
#undef SEAM
#undef ARRIVE
#undef WAITB
#undef CONVPTRS
#undef TID
#undef FIRST
}

#ifndef MK_N_LAUNCHES
#define MK_N_LAUNCHES 1
#endif
extern "C" void kernel_launch(void* const* d_in, const int* in_sizes, int n_in, void* d_out, int out_size, void* d_ws, size_t ws_size, hipStream_t stream) {
    static int grid = 0;
    if (grid == 0) {
        if (n_in != 20 || in_sizes[0] != M * DM || out_size != M * DM || ws_size < WS_END) { fprintf(stderr, "kernel_launch: unexpected shapes (n_in %d, ws %zu)\n", n_in, ws_size); grid = -1; return; }
        int dev = 0, cus = 0, per_cu = 0;
        if (hipGetDevice(&dev) != hipSuccess || hipDeviceGetAttribute(&cus, hipDeviceAttributeMultiprocessorCount, dev) != hipSuccess) { grid = -1; return; }
        if (hipFuncSetAttribute((const void*)mega_fwd, hipFuncAttributeMaxDynamicSharedMemorySize, LDS_BYTES) != hipSuccess) { fprintf(stderr, "kernel_launch: hipFuncSetAttribute failed\n"); grid = -1; return; }
        if (hipOccupancyMaxActiveBlocksPerMultiprocessor(&per_cu, (const void*)mega_fwd, NWAVES * 64, LDS_BYTES) != hipSuccess || per_cu < 1) { fprintf(stderr, "kernel_launch: occupancy query says %d\n", per_cu); per_cu = 1; }
        (void)hipGetLastError();
        if (cus != 256) { fprintf(stderr, "kernel_launch: built for a 256-CU device (got %d)\n", cus); grid = -1; return; }
        grid = cus;
    }
    if (grid < 0) return;
    (void)hipMemsetAsync((char*)d_ws + WS_CTL, 0, MK_N_LAUNCHES == 1 ? WS_ZERO_BYTES : CTL_ZERO_BYTES, stream);
    MArgs a{};
    for (int i = 0; i < 20; ++i) a.in[i] = d_in[i];
    a.out = (float*)d_out; a.ws = (unsigned char*)d_ws;
    if (MK_N_LAUNCHES == 1) { a.ph_lo = 0; a.ph_hi = N_PHASES; a.li = 0; hipLaunchKernelGGL(mega_fwd, dim3(grid), dim3(NWAVES * 64), LDS_BYTES, stream, a); }
    else for (int p = 0; p < N_PHASES; ++p) { a.ph_lo = p; a.ph_hi = p + 1; a.li = p; hipLaunchKernelGGL(mega_fwd, dim3(grid), dim3(NWAVES * 64), LDS_BYTES, stream, a); }
}
```

```cpp
#include <hip/hip_runtime.h>
#include <cstdint>
#include <cstdio>
#include <hip/hip_bf16.h>
#include <cmath>

typedef unsigned short bf16_t;
typedef short bf16x8 __attribute__((ext_vector_type(8)));
typedef float f32x4 __attribute__((ext_vector_type(4)));
typedef unsigned u32x2 __attribute__((ext_vector_type(2)));
typedef unsigned u32x4 __attribute__((ext_vector_type(4)));

constexpr int BATCH = 8, SEQ = 2048, DM = 1024, M = BATCH * SEQ, INW = 5120, DFF = 2816, MODW = 6 * DM;
constexpr float EPS = 1e-6f;
constexpr float C2 = 0.125f * 1.4426950408889634f;

constexpr size_t MiB = 1u << 20;
constexpr size_t WS_CTL = 0, WS_MOD = 16 * 1024, WS_CVEC = WS_MOD + 8 * 6144 * 4, WS_PAIR = WS_CVEC + 8 * 5632 * 4  , WS_ZERO_BYTES = WS_PAIR + 1024,     WS_TA = 2 * MiB, WS_TR = 3 * MiB, WS_ROWSS = 7 * MiB;
constexpr size_t WS_WIN = 8 * MiB, WS_WA = 18 * MiB, WS_WB = 19 * MiB, WS_WOUT = 20 * MiB, WS_WGU = 22 * MiB, WS_WDN = 33 * MiB;
constexpr size_t WS_XN = 40 * MiB;
constexpr size_t WS_DQ = 72 * MiB, WS_DK = 88 * MiB, WS_DV = 104 * MiB, WS_RQ = 120 * MiB, WS_RK = 128 * MiB, WS_RV = 136 * MiB,
                 WS_RG = 152 * MiB, WS_GA = 168 * MiB, WS_GB = 200 * MiB, WS_RETO = 232 * MiB, WS_X1B = 208 * MiB;
constexpr size_t WS_AO = WS_XN, WS_OA = WS_DQ, WS_OB = WS_RG, WS_Y = WS_DK, WS_ACT = 120 * MiB, WS_END = 256 * MiB;

__device__ __forceinline__ int lane_id_() { return (int)__builtin_amdgcn_mbcnt_hi(~0u, __builtin_amdgcn_mbcnt_lo(~0u, 0u)); }
__device__ __forceinline__ unsigned f2bf(float f) { unsigned u = __float_as_uint(f); return (u + 0x7fffu + ((u >> 16) & 1u)) >> 16; }
typedef float f32x2_t_ __attribute__((ext_vector_type(2))); typedef __bf16 bf16x2_t_ __attribute__((ext_vector_type(2)));
__device__ __forceinline__ unsigned pk2(float lo, float hi) { f32x2_t_ v = {lo, hi}; bf16x2_t_ b = __builtin_convertvector(v, bf16x2_t_); return __builtin_bit_cast(unsigned, b); }
__device__ __forceinline__ float bf2f(unsigned h) { return __uint_as_float(h << 16); }
__device__ __forceinline__ float bflo(unsigned w) { return __uint_as_float(w << 16); }
__device__ __forceinline__ float bfhi(unsigned w) { return __uint_as_float(w & 0xffff0000u); }
__device__ __forceinline__ u32x2 pack4(f32x4 v) { u32x2 r; r.x = pk2(v[0], v[1]); r.y = pk2(v[2], v[3]); return r; }
__device__ __forceinline__ u32x4 pack8(f32x4 a, f32x4 b) { u32x4 r; r.x = pk2(a[0], a[1]); r.y = pk2(a[2], a[3]); r.z = pk2(b[0], b[1]); r.w = pk2(b[2], b[3]); return r; }
__device__ __forceinline__ float wave_sum(float v) {
#pragma unroll
    for (int o = 1; o < 64; o <<= 1) v += __shfl_xor(v, o);
    return v;
}
__device__ __forceinline__ float silu_f(float x) { return x * __builtin_amdgcn_rcpf(1.f + __builtin_amdgcn_exp2f(-1.4426950408889634f * x)); }
__device__ __forceinline__ float sigm_f(float x) { return __builtin_amdgcn_rcpf(1.f + __builtin_amdgcn_exp2f(-1.4426950408889634f * x)); }

__constant__ double c_invf_da[8] = {1.0, 0.19392274474868576, 0.03760603093086393, 0.007292664737217109, 0.001414213562373095, 0.0002742481756762073, 5.318295896944988e-05, 1.031338537721246e-05};
__constant__ double c_invf_ret[32] = {1.0, 0.7498942093324559, 0.5623413251903491, 0.4216965034285822, 0.31622776601683794, 0.23713737056616552, 0.1778279410038923, 0.1333521432163324, 0.1, 0.07498942093324558, 0.05623413251903491, 0.042169650342858224, 0.03162277660168379, 0.023713737056616554, 0.01778279410038923, 0.01333521432163324, 0.01, 0.007498942093324558, 0.005623413251903491, 0.004216965034285823, 0.0031622776601683794, 0.0023713737056616554, 0.0017782794100389228, 0.001333521432163324, 0.001, 0.0007498942093324559, 0.0005623413251903491, 0.00042169650342858224, 0.00031622776601683794, 0.00023713737056616554, 0.00017782794100389227, 0.0001333521432163324};
__device__ __forceinline__ float log2gamma(int h) { return h == 0 ? -0.04580368961312479f : h == 1 ? -0.02272007650008353f : h == 2 ? -0.011315313227834146f : -0.005646563141142063f; }

template <bool SILU, bool GUMAP>
__device__ __forceinline__ void gemv8_phase(int tid, int wg, int G, const float* vec, int vpitch, const float* W, int N, const float* bias, float* out, int opitch, float* lds) {
    const int wave = tid >> 6, lane = tid & 63, r8 = lane >> 3, c4 = lane & 7;
    f32x4 w[16];
    if (wg < N / 32) { const float* wp = W + (size_t)(wave * 128 + r8) * N + wg * 32 + c4 * 4;
#pragma unroll
        for (int i = 0; i < 16; ++i) w[i] = *(const f32x4*)(wp + (size_t)(8 * i) * N); }
    for (int i = tid; i < BATCH * DM; i += 512) { const float v = vec[(i >> 10) * vpitch + (i & 1023)]; lds[i] = SILU ? silu_f(v) : v; }
    __syncthreads();
    float* red = lds + BATCH * DM;
    for (int cg = wg; cg < N / 32; cg += G) {
        const int e0 = cg * 32;
        f32x4 acc[8];
#pragma unroll
        for (int b = 0; b < 8; ++b) acc[b] = (f32x4){0.f, 0.f, 0.f, 0.f};
        if (cg != wg) { const float* wp = W + (size_t)(wave * 128 + r8) * N + e0 + c4 * 4;
#pragma unroll
            for (int i = 0; i < 16; ++i) w[i] = *(const f32x4*)(wp + (size_t)(8 * i) * N); }
#pragma unroll
        for (int i = 0; i < 16; ++i) {
            const int d = wave * 128 + 8 * i + r8;
#pragma unroll
            for (int b = 0; b < 8; ++b) acc[b] += w[i] * lds[b * DM + d];
        }
#pragma unroll
        for (int b = 0; b < 8; ++b)
#pragma unroll
            for (int e = 0; e < 4; ++e) { float v = acc[b][e]; v += __shfl_xor(v, 8); v += __shfl_xor(v, 16); v += __shfl_xor(v, 32); acc[b][e] = v; }
        if (r8 == 0) {
#pragma unroll
            for (int b = 0; b < 8; ++b) *(f32x4*)(red + (wave * 8 + b) * 32 + c4 * 4) = acc[b];
        }
        __syncthreads();
        if (tid < 256) {
            const int b = tid >> 5, c2 = tid & 31, e = e0 + c2;
            float s = bias ? bias[e] : 0.f;
#pragma unroll
            for (int w2 = 0; w2 < 8; ++w2) s += red[(w2 * 8 + b) * 32 + c2];
            int oi = e;
            if (GUMAP) { const int bj = e / DFF, r = e % DFF; oi = (r >> 7) * 256 + bj * 128 + (r & 127); s *= bj ? -0.6931471805599453f : -1.4426950408889634f; }
            out[b * opitch + oi] = s;
        }
        __syncthreads();
    }
}

template <bool SILU, bool GUMAP>
__device__ __forceinline__ void gemv4_phase(int tid, int wg, int G, const float* vec, int vpitch, const float* W, int N, const float* bias, float* out, int opitch, float* lds) {
    const int wave = tid >> 6, lane = tid & 63, half = lane >> 5, c16 = lane & 31;
    __attribute__((address_space(3))) float* tab = (__attribute__((address_space(3))) float*)lds;
    __attribute__((address_space(3))) float* red = tab + 8 * 256;
    for (int task = wg; task < N / 32; task += G) {
        const int cq = task >> 2, rq = task & 3, e0 = cq * 128, d0 = rq * 256;
        float tv[4];
#pragma unroll
        for (int i4 = 0; i4 < 4; ++i4) { const int i = tid + 512 * i4; tv[i4] = vec[(i >> 8) * vpitch + d0 + (i & 255)]; }
        f32x4 w[16];
        const float* wp = W + (size_t)(d0 + 32 * wave + half) * N + e0 + 4 * c16;
#pragma unroll
        for (int i = 0; i < 16; ++i) w[i] = *(const f32x4*)(wp + (size_t)(2 * i) * N);
#pragma unroll
        for (int i4 = 0; i4 < 4; ++i4) tab[tid + 512 * i4] = SILU ? silu_f(tv[i4]) : tv[i4];
        asm volatile("s_waitcnt lgkmcnt(0)" ::: "memory"); __builtin_amdgcn_s_barrier(); asm volatile("" ::: "memory");
        f32x4 acc[8];
#pragma unroll
        for (int b = 0; b < 8; ++b) acc[b] = (f32x4){0.f, 0.f, 0.f, 0.f};
#pragma unroll
        for (int i = 0; i < 16; ++i)
#pragma unroll
            for (int b = 0; b < 8; ++b) acc[b] += w[i] * tab[b * 256 + 32 * wave + 2 * i + half];
#pragma unroll
        for (int b = 0; b < 8; ++b)
#pragma unroll
            for (int e = 0; e < 4; ++e) acc[b][e] += __shfl_xor(acc[b][e], 32);
        if (half == 0) {
#pragma unroll
            for (int b = 0; b < 8; ++b) *(__attribute__((address_space(3))) f32x4*)(red + (wave * 8 + b) * 128 + 4 * c16) = acc[b];
        }
        __syncthreads();
#pragma unroll
        for (int j = 0; j < 2; ++j) { const int o = tid + 512 * j, b = o >> 7, col = o & 127, e = e0 + col;
            float s = (rq == 0 && bias) ? bias[e] : 0.f;
#pragma unroll
            for (int w2 = 0; w2 < 8; ++w2) s += red[(w2 * 8 + b) * 128 + col];
            int oi = e;
            if (GUMAP) { const int bj = e / DFF, r = e % DFF; oi = (r >> 7) * 256 + bj * 128 + (r & 127); s *= bj ? -0.6931471805599453f : -1.4426950408889634f; }
            (void)__hip_atomic_fetch_add(out + b * opitch + oi, s, __ATOMIC_RELAXED, __HIP_MEMORY_SCOPE_AGENT); }
        __syncthreads();
    }
}

__device__ __forceinline__ int slot2col(int map, int slot) {
    if (map == 1) { const int pn = slot >> 8, bj = (slot >> 7) & 1, wc = (slot >> 5) & 3, r = slot & 31;
        if (pn >= 12) return (bj ? 4096 : 3072) + 128 * (pn - 12) + 32 * wc + r;
        return (pn << 8) + (wc << 6) + (bj << 5) + r; }
    if (map == 2) { const int pn = slot >> 8, bj = (slot >> 7) & 1, j = slot & 127; return bj * DFF + pn * 128 + j; }
    return slot;
}
struct ConvSel { const float* W; bf16_t* Wt; int K, N, map, item; };
__device__ __forceinline__ void convert_load(const ConvSel& S, int lane, f32x4 (&v)[8]) {
    const int nblk = S.N / 32, kb = S.item / nblk, nb = S.item % nblk, k0 = 64 * kb, c0 = slot2col(S.map, 32 * nb);
    const int r8 = lane >> 3, c4 = lane & 7;
#pragma unroll
    for (int i = 0; i < 8; ++i) v[i] = *(const f32x4*)(S.W + (size_t)(k0 + 8 * i + r8) * S.N + c0 + 4 * c4);
}
__device__ __forceinline__ void convert_store(const ConvSel& S, float* scr, int lane, const f32x4 (&v)[8]) {
    const int nblk = S.N / 32, kb = S.item / nblk, nb = S.item % nblk, k0 = 64 * kb, s0 = 32 * nb;
    const float sc = (S.map == 1 && s0 >= 12 * 256) ? -1.4426950408889634f : S.map == 2 ? (((s0 >> 7) & 1) ? -0.6931471805599453f : -1.4426950408889634f) : 1.f;
    { const int r8 = lane >> 3, c4 = lane & 7;
#pragma unroll
      for (int i = 0; i < 8; ++i) { float* d = scr + (8 * i + r8) * 33 + 4 * c4; d[0] = v[i][0]; d[1] = v[i][1]; d[2] = v[i][2]; d[3] = v[i][3]; } }
    __builtin_amdgcn_s_waitcnt(0xc07f); __builtin_amdgcn_wave_barrier();
    const int c = lane & 7;
#pragma unroll
    for (int j = 0; j < 4; ++j) { const int n = (lane >> 3) + 8 * j; const float* s = scr + (8 * c) * 33 + n;
        u32x4 o; o.x = pk2(s[0 * 33] * sc, s[1 * 33] * sc); o.y = pk2(s[2 * 33] * sc, s[3 * 33] * sc); o.z = pk2(s[4 * 33] * sc, s[5 * 33] * sc); o.w = pk2(s[6 * 33] * sc, s[7 * 33] * sc);
        *(u32x4*)(S.Wt + (size_t)(s0 + n) * S.K + k0 + 8 * c) = o; }
    __builtin_amdgcn_s_waitcnt(0xc07f); __builtin_amdgcn_wave_barrier();
}
struct ConvPtrs { const float *w_in, *wa, *wb, *wout, *wgu, *wdn; bf16_t *w_in_t, *wa_t, *wb_t, *wout_t, *wgu_t, *wdn_t; };
constexpr int CV_IN = (DM / 64) * (INW / 32), CV_A = (512 / 64) * (DM / 32), CV_O = (DM / 64) * (DM / 32), CV_GU = (DM / 64) * (2 * DFF / 32), CV_DN = (DFF / 64) * (DM / 32);
constexpr int CV_S0 = 0, CV_S1 = CV_IN, CV_S2 = CV_IN + 2 * CV_A + CV_O, CV_S3 = CV_S2 + CV_GU, CV_S4 = CV_S3 + CV_DN;
__device__ __forceinline__ ConvSel convert_sel(const ConvPtrs& P, int it) {
    constexpr int I_IN = CV_IN, I_A = CV_A, I_O = CV_O, I_GU = CV_GU;
    int r = it;
    if (r < I_IN) return ConvSel{P.w_in, P.w_in_t, DM, INW, 1, r}; r -= I_IN;
    if (r < I_A) return ConvSel{P.wa, P.wa_t, 512, DM, 0, r}; r -= I_A;
    if (r < I_A) return ConvSel{P.wb, P.wb_t, 512, DM, 0, r}; r -= I_A;
    if (r < I_O) return ConvSel{P.wout, P.wout_t, DM, DM, 0, r}; r -= I_O;
    if (r < I_GU) return ConvSel{P.wgu, P.wgu_t, DM, 2 * DFF, 2, r}; r -= I_GU;
    return ConvSel{P.wdn, P.wdn_t, DFF, DM, 0, r};
}
__device__ __forceinline__ void convert_phase(int tid, int wg, int G, const ConvPtrs& P, float* lds, int it0, int it1) {
    const int wave = tid >> 6, lane = tid & 63;
    float* scr = lds + wave * (64 * 33);
    const int gw = wg * 8 + wave, NGW = G * 8;
    for (int it = it0 + gw; it < it1; it += 2 * NGW) {
        const bool two = it + NGW < it1;
        const ConvSel A = convert_sel(P, it), Bs = convert_sel(P, two ? it + NGW : it);
        f32x4 va[8], vb[8];
        convert_load(A, lane, va);
        if (two) convert_load(Bs, lane, vb);
        convert_store(A, scr, lane, va);
        if (two) convert_store(Bs, scr, lane, vb);
    }
}

__device__ __forceinline__ void trig_phase(int tid, int wg, int G, const int* positions, float* TA, float* TR) {
    const int gt = wg * 512 + tid, NT = G * 512;
    for (int it = gt; it < M * 40; it += NT) {
        const int row = it / 40, i = it % 40;
        const double p = (double)positions[row];
        const double a = p * (i < 8 ? c_invf_da[i] : c_invf_ret[i - 8]);
        double rev = a * 0.15915494309189535;
        rev -= __builtin_rint(rev);
        const float sn = __builtin_amdgcn_sinf((float)rev), cs = __builtin_amdgcn_cosf((float)rev);
        if (i < 8) { TA[row * 16 + i] = cs; TA[row * 16 + 8 + i] = sn; }
        else { TR[row * 64 + (i - 8)] = cs; TR[row * 64 + 32 + (i - 8)] = sn; }
    }
}

__device__ __forceinline__ void xn_phase(int tid, int wg, int G, const float* x, const float* g, const float* sc, const float* sh, bf16_t* XN) {
    const int wave = tid >> 6, lane = tid & 63;
    for (int r0 = (wg * 8 + wave) * 8; r0 < M; r0 += G * 64) {
        const int b = r0 / SEQ;
        f32x4 a[4], s0[4];
#pragma unroll
        for (int j = 0; j < 4; ++j) { const int col = 8 * lane + 4 * (j & 1) + 512 * (j >> 1); a[j] = *(const f32x4*)(g + col) * (*(const f32x4*)(sc + b * MODW + col) + 1.f); s0[j] = *(const f32x4*)(sh + b * MODW + col); }
#pragma unroll
        for (int h = 0; h < 2; ++h) {
            f32x4 v[4][4];
#pragma unroll
            for (int r = 0; r < 4; ++r)
#pragma unroll
                for (int j = 0; j < 4; ++j) v[r][j] = ((const f32x4*)(x + (size_t)(r0 + 4 * h + r) * DM))[2 * lane + (j & 1) + 128 * (j >> 1)];
            __builtin_amdgcn_sched_barrier(0);
#pragma unroll
            for (int r = 0; r < 4; ++r) {
                float ss = 0.f;
#pragma unroll
                for (int j = 0; j < 4; ++j) ss += (v[r][j][0] * v[r][j][0] + v[r][j][1] * v[r][j][1]) + (v[r][j][2] * v[r][j][2] + v[r][j][3] * v[r][j][3]);
                const float rstd = rsqrtf(wave_sum(ss) * (1.f / DM) + EPS);
                u32x4* o = (u32x4*)(XN + (size_t)(r0 + 4 * h + r) * DM) + lane;
#pragma unroll
                for (int j2 = 0; j2 < 2; ++j2) o[64 * j2] = pack8(v[r][2 * j2] * rstd * a[2 * j2] + s0[2 * j2], v[r][2 * j2 + 1] * rstd * a[2 * j2 + 1] + s0[2 * j2 + 1]);
            }
        }
    }
}

__device__ __forceinline__ void xn_load(int tid, int wg, const float* x, f32x4 (&v)[2][4][4]) {
    const int wave = tid >> 6, lane = tid & 63, r0 = (wg * 8 + wave) * 8;
#pragma unroll
    for (int h = 0; h < 2; ++h)
#pragma unroll
        for (int r = 0; r < 4; ++r)
#pragma unroll
            for (int j = 0; j < 4; ++j) v[h][r][j] = ((const f32x4*)(x + (size_t)(r0 + 4 * h + r) * DM))[2 * lane + (j & 1) + 128 * (j >> 1)];
}
__device__ __forceinline__ void xn_finish(int tid, int wg, const f32x4 (&v)[2][4][4], const float* g, const float* sc, const float* sh, bf16_t* XN) {
    const int wave = tid >> 6, lane = tid & 63, r0 = (wg * 8 + wave) * 8, b = r0 / SEQ;
    f32x4 a[4], s0[4];
#pragma unroll
    for (int j = 0; j < 4; ++j) { const int col = 8 * lane + 4 * (j & 1) + 512 * (j >> 1); a[j] = *(const f32x4*)(g + col) * (*(const f32x4*)(sc + b * MODW + col) + 1.f); s0[j] = *(const f32x4*)(sh + b * MODW + col); }
#pragma unroll
    for (int h = 0; h < 2; ++h)
#pragma unroll
        for (int r = 0; r < 4; ++r) {
            float ss = 0.f;
#pragma unroll
            for (int j = 0; j < 4; ++j) ss += (v[h][r][j][0] * v[h][r][j][0] + v[h][r][j][1] * v[h][r][j][1]) + (v[h][r][j][2] * v[h][r][j][2] + v[h][r][j][3] * v[h][r][j][3]);
            const float rstd = rsqrtf(wave_sum(ss) * (1.f / DM) + EPS);
            u32x4* o = (u32x4*)(XN + (size_t)(r0 + 4 * h + r) * DM) + lane;
#pragma unroll
            for (int j2 = 0; j2 < 2; ++j2) o[64 * j2] = pack8(v[h][r][2 * j2] * rstd * a[2 * j2] + s0[2 * j2], v[h][r][2 * j2 + 1] * rstd * a[2 * j2 + 1] + s0[2 * j2 + 1]);
        }
}

__device__ __forceinline__ void combine_phase(int tid, int wg, int G, const bf16_t* AO, const bf16_t* RETO, bf16_t* RG_OB, bf16_t* OA,
                                              const float* lq1, const float* lk1, const float* lq2, const float* lk2, const float* subln_g) {
    const int wave = tid >> 6, lane = tid & 63;
    const float lam = __expf(wave_sum(lq1[lane] * lk1[lane])) - __expf(wave_sum(lq2[lane] * lk2[lane])) + 0.2f;
    const int h = lane >> 4, d0 = (lane & 15) * 8;
    float gsub[8];
#pragma unroll
    for (int e = 0; e < 8; ++e) gsub[e] = subln_g[d0 + e] * 0.8f;
    for (int row = wg * 64 + wave * 8; row < M; row += G * 64) for (int rj = 0; rj < 8; ++rj, ++row) {
        {
            const u32x4 a = *(const u32x4*)(AO + (size_t)row * 1024 + (2 * h) * 128 + d0), b = *(const u32x4*)(AO + (size_t)row * 1024 + (2 * h + 1) * 128 + d0);
            float d[8]; float ss = 0.f;
#pragma unroll
            for (int e = 0; e < 4; ++e) { d[2 * e] = bflo(a[e]) - lam * bflo(b[e]); d[2 * e + 1] = bfhi(a[e]) - lam * bfhi(b[e]); }
#pragma unroll
            for (int e = 0; e < 8; ++e) ss += d[e] * d[e];
            ss += __shfl_xor(ss, 1); ss += __shfl_xor(ss, 2); ss += __shfl_xor(ss, 4); ss += __shfl_xor(ss, 8);
            const float rstd = rsqrtf(ss * (1.f / 128.f) + EPS);
            u32x4 o;
#pragma unroll
            for (int e = 0; e < 4; ++e) o[e] = pk2(d[2 * e] * rstd * gsub[2 * e], d[2 * e + 1] * rstd * gsub[2 * e + 1]);
            *(u32x4*)(OA + (size_t)row * 512 + h * 128 + d0) = o;
        }
        {
            const u32x4 a = *(const u32x4*)(RETO + (size_t)row * 512 + h * 128 + d0), gt = *(const u32x4*)(RG_OB + (size_t)row * 512 + h * 128 + d0);
            float d[8]; float ss = 0.f;
#pragma unroll
            for (int e = 0; e < 4; ++e) { d[2 * e] = bflo(a[e]); d[2 * e + 1] = bfhi(a[e]); }
#pragma unroll
            for (int e = 0; e < 8; ++e) ss += d[e] * d[e];
            ss += __shfl_xor(ss, 1); ss += __shfl_xor(ss, 2); ss += __shfl_xor(ss, 4); ss += __shfl_xor(ss, 8);
            const float rstd = rsqrtf(ss * (1.f / 128.f) + EPS);
            u32x4 o;
#pragma unroll
            for (int e = 0; e < 4; ++e) o[e] = pk2(d[2 * e] * rstd * bflo(gt[e]), d[2 * e + 1] * rstd * bfhi(gt[e]));
            *(u32x4*)(RG_OB + (size_t)row * 512 + h * 128 + d0) = o;
        }
    }
}

__device__ __forceinline__ float da_lambda(int lane, const float* lq1, const float* lk1, const float* lq2, const float* lk2) {
    return __expf(wave_sum(lq1[lane] * lk1[lane])) - __expf(wave_sum(lq2[lane] * lk2[lane])) + 0.2f;
}
__device__ __forceinline__ void combine_da_block(int tid, long R0, int h, float lam, const bf16_t* __restrict__ AO, bf16_t* __restrict__ OA, const float* __restrict__ subln_g) {
    const int wave = tid >> 6, lane = tid & 63, d0 = (lane & 15) * 8;
    float gsub[8];
#pragma unroll
    for (int e = 0; e < 8; ++e) gsub[e] = subln_g[d0 + e] * 0.8f;
    const long rw = R0 + wave * 32 + (lane >> 4);
    u32x4 a[8], b[8];
#pragma unroll
    for (int it = 0; it < 8; ++it) { const bf16_t* pa = AO + (size_t)(rw + 4 * it) * 1024 + (2 * h) * 128 + d0; const bf16_t* pb = pa + 128;
        asm volatile("global_load_dwordx4 %0, %1, off sc0 sc1" : "=&v"(a[it]) : "v"(pa) : "memory"); asm volatile("global_load_dwordx4 %0, %1, off sc0 sc1" : "=&v"(b[it]) : "v"(pb) : "memory"); }
    asm volatile("s_waitcnt vmcnt(0)" : "+v"(a[0]), "+v"(a[1]), "+v"(a[2]), "+v"(a[3]), "+v"(a[4]), "+v"(a[5]), "+v"(a[6]), "+v"(a[7]), "+v"(b[0]), "+v"(b[1]), "+v"(b[2]), "+v"(b[3]), "+v"(b[4]), "+v"(b[5]), "+v"(b[6]), "+v"(b[7]) :: "memory");
#pragma unroll
    for (int it = 0; it < 8; ++it) {
        float d[8]; float ss = 0.f;
#pragma unroll
        for (int e = 0; e < 4; ++e) { d[2 * e] = bflo(a[it][e]) - lam * bflo(b[it][e]); d[2 * e + 1] = bfhi(a[it][e]) - lam * bfhi(b[it][e]); }
#pragma unroll
        for (int e = 0; e < 8; ++e) ss += d[e] * d[e];
        ss += __shfl_xor(ss, 1); ss += __shfl_xor(ss, 2); ss += __shfl_xor(ss, 4); ss += __shfl_xor(ss, 8);
        const float rstd = rsqrtf(ss * (1.f / 128.f) + EPS);
        u32x4 o;
#pragma unroll
        for (int e = 0; e < 4; ++e) o[e] = pk2(d[2 * e] * rstd * gsub[2 * e], d[2 * e + 1] * rstd * gsub[2 * e + 1]);
        *(u32x4*)(OA + (size_t)(rw + 4 * it) * 512 + h * 128 + d0) = o;
    }
}
__device__ __forceinline__ void combine_ret_block(int tid, long R0, int h, const bf16_t* __restrict__ RETO, bf16_t* RG_OB) {
    const int wave = tid >> 6, lane = tid & 63, d0 = (lane & 15) * 8;
    const long rw = R0 + wave * 32 + (lane >> 4);
    u32x4 a[8], gt[8];
#pragma unroll
    for (int it = 0; it < 8; ++it) { a[it] = *(const u32x4*)(RETO + (size_t)(rw + 4 * it) * 512 + h * 128 + d0); gt[it] = *(const u32x4*)(RG_OB + (size_t)(rw + 4 * it) * 512 + h * 128 + d0); }
#pragma unroll
    for (int it = 0; it < 8; ++it) {
        float d[8]; float ss = 0.f;
#pragma unroll
        for (int e = 0; e < 4; ++e) { d[2 * e] = bflo(a[it][e]); d[2 * e + 1] = bfhi(a[it][e]); }
#pragma unroll
        for (int e = 0; e < 8; ++e) ss += d[e] * d[e];
        ss += __shfl_xor(ss, 1); ss += __shfl_xor(ss, 2); ss += __shfl_xor(ss, 4); ss += __shfl_xor(ss, 8);
        const float rstd = rsqrtf(ss * (1.f / 128.f) + EPS);
        u32x4 o;
#pragma unroll
        for (int e = 0; e < 4; ++e) o[e] = pk2(d[2 * e] * rstd * bflo(gt[it][e]), d[2 * e + 1] * rstd * bfhi(gt[it][e]));
        *(u32x4*)(RG_OB + (size_t)(rw + 4 * it) * 512 + h * 128 + d0) = o;
    }
}

#define SLOT8(pn, wc, fq, g) (256 * (pn) + 128 * ((g) >> 1) + 32 * (wc) + 8 * (fq) + 4 * ((g) & 1))
struct InProjEpi {
    static constexpr int BATCH = 2;
    struct Tile { f32x4 gn[4]; };
    struct Pre { f32x4 t[4]; };
    bf16_t *DQ, *DK, *DV, *RQ, *RK, *RV, *RG, *GA, *GB; const float *qg, *kg, *TA, *TR;
    __device__ __forceinline__ Tile tile_pre(int b, int pn, int wc, int fq) const {
        Tile T;
        if (pn < 4) { const float* gn = pn < 2 ? qg : kg;
#pragma unroll
            for (int g = 0; g < 4; ++g) T.gn[g] = *(const f32x4*)(gn + 32 * (g >> 1) + 8 * fq + 4 * (g & 1)); }
        return T;
    }
    __device__ __forceinline__ Pre row_pre(int row, int b, int pn, int wc, int fq) const {
        Pre P;
        if (pn < 4) {
#pragma unroll
            for (int i = 0; i < 4; ++i) P.t[i] = *(const f32x4*)(TA + (size_t)row * 16 + 4 * i); }
        else if (pn == 6 || pn == 7) {
#pragma unroll
            for (int n = 0; n < 2; ++n) { P.t[n] = *(const f32x4*)(TR + (size_t)row * 64 + 8 * fq + 4 * n); P.t[2 + n] = *(const f32x4*)(TR + (size_t)row * 64 + 32 + 8 * fq + 4 * n); } }
        return P;
    }
    __device__ __forceinline__ void operator()(const f32x4 (&v)[4], const Pre& P, const Tile& T, int row, int b, int pn, int wc, int fq) const {
        f32x4 o[4]; bf16_t* dst;
        if (pn < 4) {
            const bool isq = pn < 2;
            float ss = 0.f;
#pragma unroll
            for (int g = 0; g < 4; ++g) ss += (v[g][0] * v[g][0] + v[g][1] * v[g][1]) + (v[g][2] * v[g][2] + v[g][3] * v[g][3]);
            ss += __shfl_xor(ss, 16); ss += __shfl_xor(ss, 32);
            const float rstd = rsqrtf(ss * (1.f / 64.f) + EPS) * (isq ? C2 : 1.f);
#pragma unroll
            for (int g = 0; g < 4; ++g) o[g] = v[g] * rstd * T.gn[g];
#pragma unroll
            for (int n = 0; n < 2; ++n) {
                f32x4 other;
#pragma unroll
                for (int r = 0; r < 4; ++r) other[r] = __shfl_xor(o[n][r], 16);
                const f32x4 rot = (fq == 0) ? (o[n] * P.t[n] - other * P.t[2 + n]) : (o[n] * P.t[n] + other * P.t[2 + n]);
                o[n] = (fq < 2) ? rot : o[n];
            }
            dst = (isq ? DQ : DK) + (size_t)row * 512 + ((pn & 1) * 4 + wc) * 64;
        } else if (pn == 6 || pn == 7) {
            const bool isq = pn == 6;
#pragma unroll
            for (int n = 0; n < 2; ++n) { o[n] = v[n] * P.t[n] - v[2 + n] * P.t[2 + n]; o[2 + n] = v[2 + n] * P.t[n] + v[n] * P.t[2 + n]; }
            const float t = (float)(row & (SEQ - 1)), lg = log2gamma(wc);
            const float s = isq ? exp2f(t * lg) : exp2f(-t * lg) * 0.125f;
#pragma unroll
            for (int g = 0; g < 4; ++g) o[g] = o[g] * s;
            dst = (isq ? RQ : RK) + (size_t)row * 256 + wc * 64;
        } else if (pn < 6) {
#pragma unroll
            for (int g = 0; g < 4; ++g) o[g] = v[g];
            dst = DV + (size_t)row * 512 + (pn - 4) * 256 + wc * 64;
        } else if (pn < 10) {
#pragma unroll
            for (int g = 0; g < 4; ++g) o[g] = v[g];
            dst = RV + (size_t)row * 512 + (pn - 8) * 256 + wc * 64;
        } else if (pn < 12) {
#pragma unroll
            for (int g = 0; g < 4; ++g)
#pragma unroll
                for (int r = 0; r < 4; ++r) o[g][r] = silu_f(v[g][r]);
            dst = RG + (size_t)row * 512 + (pn - 10) * 256 + wc * 64;
        } else {
            f32x4 rr[2], sb[2];
#pragma unroll
            for (int n = 0; n < 2; ++n)
#pragma unroll
                for (int r = 0; r < 4; ++r) { const float da = 1.f + __builtin_amdgcn_exp2f(v[n][r]), db = fminf(1.f + __builtin_amdgcn_exp2f(v[2 + n][r]), 1e30f);
                    rr[n][r] = db * __builtin_amdgcn_rcpf(da); sb[n][r] = __builtin_amdgcn_rcpf(db); }
            const size_t off = (size_t)row * 1024 + 128 * (pn - 12) + 32 * wc + 8 * fq;
            *(u32x4*)(GA + off) = pack8(rr[0], rr[1]); *(u32x4*)(GB + off) = pack8(sb[0], sb[1]);
            return;
        }
#pragma unroll
        for (int bj = 0; bj < 2; ++bj) *(u32x4*)(dst + 32 * bj + 8 * fq) = pack8(o[2 * bj], o[2 * bj + 1]);
    }
};
constexpr float A2_MIN = 1e-20f;
struct OutEpi {
    static constexpr int BATCH = 4;
    struct Tile { f32x4 g1[4], a2[4]; bool small; };
    struct Pre { f32x4 x[4]; };
    const float* x; bf16_t* X1B; const float* mod; const float* g2n; bf16_t* XM; float* rowss;
    __device__ __forceinline__ Tile tile_pre(int b, int pn, int wc, int fq) const {
        Tile T;
#pragma unroll
        for (int g = 0; g < 4; ++g) { const int col = SLOT8(pn, wc, fq, g);
            T.g1[g] = *(const f32x4*)(mod + b * MODW + 2 * DM + col); T.a2[g] = *(const f32x4*)(g2n + col) * (*(const f32x4*)(mod + b * MODW + 4 * DM + col) + 1.f); }
        T.small = false;
#pragma unroll
        for (int g = 0; g < 4; ++g)
#pragma unroll
            for (int r = 0; r < 4; ++r) T.small = T.small || !(__builtin_fabsf(T.a2[g][r]) >= A2_MIN);
        return T;
    }
    __device__ __forceinline__ Pre row_pre(int row, int b, int pn, int wc, int fq) const {
        Pre P;
#pragma unroll
        for (int g = 0; g < 4; ++g) P.x[g] = *(const f32x4*)(x + (size_t)row * DM + SLOT8(pn, wc, fq, g));
        return P;
    }
    __device__ __forceinline__ float operator()(const f32x4 (&v)[4], const Pre& P, const Tile& T, int row, int b, int pn, int wc, int fq) const {
        float ss = 0.f; f32x4 xm[4], x1[4];
#pragma unroll
        for (int g = 0; g < 4; ++g) {
            x1[g] = P.x[g] + T.g1[g] * v[g];
            ss += (x1[g][0] * x1[g][0] + x1[g][1] * x1[g][1]) + (x1[g][2] * x1[g][2] + x1[g][3] * x1[g][3]);
            xm[g] = x1[g] * T.a2[g];
        }
#pragma unroll
        for (int bj = 0; bj < 2; ++bj) *(u32x4*)(XM + (size_t)row * DM + SLOT8(pn, wc, fq, 2 * bj)) = pack8(xm[2 * bj], xm[2 * bj + 1]);
        if (T.small) {
#pragma unroll
            for (int bj = 0; bj < 2; ++bj) *(u32x4*)(X1B + (size_t)row * DM + SLOT8(pn, wc, fq, 2 * bj)) = pack8(x1[2 * bj], x1[2 * bj + 1]);
        }
        ss += __shfl_xor(ss, 16); ss += __shfl_xor(ss, 32);
        return ss;
    }
};
struct ResidEpi {
    static constexpr int BATCH = 4;
    struct Tile { f32x4 gg[4], ia[4]; unsigned small; };
    struct Pre { u32x4 bs[2]; };
    const bf16_t* base; float* out; const float* gvec; const float* sc2; const float* g2n; const bf16_t* X1B;
    __device__ __forceinline__ Tile tile_pre(int b, int pn, int wc, int fq) const {
        Tile T; T.small = 0u;
#pragma unroll
        for (int g = 0; g < 4; ++g) { const int col = SLOT8(pn, wc, fq, g);
            T.gg[g] = *(const f32x4*)(gvec + b * MODW + col);
            const f32x4 a2 = *(const f32x4*)(g2n + col) * (*(const f32x4*)(sc2 + b * MODW + col) + 1.f);
#pragma unroll
            for (int r = 0; r < 4; ++r) { const bool sm = !(__builtin_fabsf(a2[r]) >= A2_MIN); T.ia[g][r] = sm ? 0.f : __builtin_amdgcn_rcpf(a2[r]); T.small |= sm ? (1u << (4 * g + r)) : 0u; } }
        return T;
    }
    __device__ __forceinline__ Pre row_pre(int row, int b, int pn, int wc, int fq) const {
        Pre P;
#pragma unroll
        for (int bj = 0; bj < 2; ++bj) P.bs[bj] = *(const u32x4*)(base + (size_t)row * DM + SLOT8(pn, wc, fq, 2 * bj));
        return P;
    }
    __device__ __forceinline__ void operator()(const f32x4 (&v)[4], const Pre& P, const Tile& T, int row, int b, int pn, int wc, int fq) const {
        f32x4 bs[4];
#pragma unroll
        for (int g = 0; g < 4; ++g) { const unsigned w0 = P.bs[g >> 1][2 * (g & 1)], w1 = P.bs[g >> 1][2 * (g & 1) + 1];
            bs[g] = (f32x4){bflo(w0), bfhi(w0), bflo(w1), bfhi(w1)} * T.ia[g]; }
        if (T.small != 0u) {
#pragma unroll
            for (int bj = 0; bj < 2; ++bj) { const u32x4 xb = *(const u32x4*)(X1B + (size_t)row * DM + SLOT8(pn, wc, fq, 2 * bj));
#pragma unroll
                for (int e = 0; e < 8; ++e) { const int g = 2 * bj + (e >> 2), r = e & 3; const float xv = (e & 1) ? bfhi(xb[e >> 1]) : bflo(xb[e >> 1]);
                    bs[g][r] = ((T.small >> (4 * g + r)) & 1u) ? xv : bs[g][r]; } }
        }
#pragma unroll
        for (int g = 0; g < 4; ++g) *(f32x4*)(out + (size_t)row * DM + SLOT8(pn, wc, fq, g)) = bs[g] + T.gg[g] * v[g];
    }
};
struct GateUpEpi {
    static constexpr int BATCH = 8;
    struct Tile { f32x4 cg[2], cu[2]; };
    struct Pre { f32x4 s4; };
    bf16_t* ACT; const float* rowss; const float* cvec;
    __device__ __forceinline__ Tile tile_pre(int b, int pn, int wc, int fq) const {
        Tile T;
#pragma unroll
        for (int n = 0; n < 2; ++n) { const int slot = 256 * pn + 32 * wc + 8 * fq + 4 * n; T.cg[n] = *(const f32x4*)(cvec + b * (2 * DFF) + slot); T.cu[n] = *(const f32x4*)(cvec + b * (2 * DFF) + slot + 128); }
        return T;
    }
    __device__ __forceinline__ Pre row_pre(int row, int b, int pn, int wc, int fq) const { Pre P; P.s4 = *(const f32x4*)(rowss + (size_t)row * 4); return P; }
    __device__ __forceinline__ void operator()(const f32x4 (&v)[4], const Pre& P, const Tile& T, int row, int b, int pn, int wc, int fq) const {
        const float rstd = rsqrtf(((P.s4[0] + P.s4[1]) + (P.s4[2] + P.s4[3])) * (1.f / DM) + EPS);
        f32x4 y[2];
#pragma unroll
        for (int n = 0; n < 2; ++n) {
            const f32x4 gt = v[n] * rstd + T.cg[n], up = v[2 + n] * rstd + T.cu[n];
#pragma unroll
            for (int r = 0; r < 4; ++r) y[n][r] = gt[r] * up[r] * __builtin_amdgcn_rcpf(1.f + __builtin_amdgcn_exp2f(gt[r]));
        }
        *(u32x4*)(ACT + (size_t)row * DFF + 128 * pn + 32 * wc + 8 * fq) = pack8(y[0], y[1]);
    }
};

namespace pg8 {
#define PG8_LAS __attribute__((address_space(3)))
typedef unsigned short bf16_t;
typedef short bf16x8 __attribute__((ext_vector_type(8)));
typedef float f32x4 __attribute__((ext_vector_type(4)));
typedef unsigned u32x4 __attribute__((ext_vector_type(4)));
constexpr int BM = 256, BK = 64, HALF = 128, HTB = HALF * BK * 2  , STAGE_BYTES = 8 * HTB, NXCD = 8, WGM = 4;

__host__ __device__ __forceinline__ int lds_byte(int r, int c) { const int st = (r >> 4) * 2 + (c >> 5), rr = r & 15, cc = c & 31, ob = rr * 64 + cc * 2; return st * 1024 + (ob ^ (((ob >> 9) & 1) << 5)); }
__host__ __device__ __forceinline__ void stage_rc(int b, int& R, int& C) { const int st = b / 1024, sb = b % 1024, swz = sb ^ (((sb >> 9) & 1) << 5); R = (st >> 1) * 16 + swz / 64; C = (st & 1) * 32 + (swz % 64) / 2; }
__host__ __device__ __forceinline__ int perm32(int rho) { const int n = rho >> 4, i = rho & 15; return 8 * (i >> 2) + 4 * n + (i & 3); }

struct Unit { int pm, pn, sel, half; };
struct Gemm { const bf16_t* A; const bf16_t* Bt; int M, N, K; const bf16_t* A2; const bf16_t* Bt2; };

struct StaticOrder {
    static constexpr bool ROWHALF = false;
    int nM, nN, nwg, G, c;
    __host__ __device__ void init(int M, int N, int G_, int c_) { nM = M / BM; nN = N / BM; nwg = nM * nN; G = G_; c = c_; }
    __host__ __device__ bool next(int i, Unit& u) const {
        const long L = (long)i * G + c; if (L >= nwg) return false;
        int wgid = (int)L; { const int q = nwg / NXCD, r = nwg % NXCD, xcd = wgid % NXCD, off = wgid / NXCD; wgid = (xcd < r ? xcd * (q + 1) : r * (q + 1) + (xcd - r) * q) + off; }
        const int nig = WGM * nN, gid = wgid / nig, fm = gid * WGM, gsz = (nM - fm) < WGM ? (nM - fm) : WGM;
        u.pm = fm + ((wgid % nig) % gsz); u.pn = (wgid % nig) / gsz; u.sel = 0; u.half = 0; return true;
    }
    __device__ __forceinline__ void a_ready(const Unit&) const {}
    __device__ __forceinline__ void done(const Unit&) const {}
};

template <class Epi, class Sched, bool ALIGN_EPI = false, bool SP2 = false>
__device__ __forceinline__ void gemm_phase(PG8_LAS unsigned char* lds, const Gemm g, const Sched& S, const Epi& E, const int WAVE_S) {
    const int wid = WAVE_S, lane = lane_id_(), tid = wid * 64 + lane, wr = wid >> 2, wc = wid & 3, fr = lane & 15, fq = lane >> 4;
    const int K = g.K, nt = K / BK;
    unsigned voffA[2], voffB[2];
#pragma unroll
    for (int i = 0; i < 2; ++i) { int R, C; stage_rc(tid * 16 + i * 8192, R, C); const int Rb = Epi::PERM ? ((R & ~31) + perm32(R & 31)) : R;
        voffA[i] = (unsigned)(R * K + C) * 2u; voffB[i] = (unsigned)(Rb * K + C) * 2u; }
    const size_t kstep = (size_t)(BK * 2);
    const size_t hstep = (size_t)HALF * K * 2;
    const size_t tstep = 2 * hstep;
    const unsigned ldsw = (unsigned)wid * 1024u;
    const int aoff = lds_byte(wr * 64 + fr, fq * 8), boff = lds_byte(wc * 32 + fr, fq * 8);
#define PG8_SA(b, h) (((b) * 2 + (h)) * HTB)
#define PG8_SB(b, h) ((4 + (b) * 2 + (h)) * HTB)
#define PG8_STAGE(bufoff, gbase, voff) do { _Pragma("unroll") for (int _i = 0; _i < 2; ++_i) \
        __builtin_amdgcn_global_load_lds((const unsigned*)((const char*)(gbase) + (voff)[_i]), (PG8_LAS unsigned*)(lds + (bufoff) + ldsw + _i * 8192), 16, 0, 0); } while (0)
#define PG8_LDA(dst, b, h) do { _Pragma("unroll") for (int m = 0; m < 4; ++m) _Pragma("unroll") for (int k = 0; k < 2; ++k) dst[m][k] = *(const PG8_LAS bf16x8*)(lds + PG8_SA(b, h) + aoff + m * 2048 + k * 1024); } while (0)
#define PG8_LDB(dst, b, h) do { _Pragma("unroll") for (int n = 0; n < 2; ++n) _Pragma("unroll") for (int k = 0; k < 2; ++k) dst[n][k] = *(const PG8_LAS bf16x8*)(lds + PG8_SB(b, h) + boff + n * 2048 + k * 1024); } while (0)
#define PG8_MMA(ai, bj, At, Bt) do { __builtin_amdgcn_s_setprio(1); _Pragma("unroll") for (int m = 0; m < 4; ++m) _Pragma("unroll") for (int n = 0; n < 2; ++n) _Pragma("unroll") for (int k = 0; k < 2; ++k) \
        acc[ai][bj][m][n] = __builtin_amdgcn_mfma_f32_16x16x32_bf16(Bt[n][k], At[m][k], acc[ai][bj][m][n], 0, 0, 0); __builtin_amdgcn_s_setprio(0); } while (0)
#define PG8_WAIT_V(n) asm volatile("s_waitcnt vmcnt(" #n ")" ::: "memory")
#define PG8_WAIT_L(n) asm volatile("s_waitcnt lgkmcnt(" #n ")" ::: "memory")
#define PG8_BAR __builtin_amdgcn_s_barrier()
#define PG8_SCHED __builtin_amdgcn_sched_barrier(0)
    Unit cur, nxt; int ui = 0;
    if (!S.next(0, cur)) return;
    f32x4 acc[2][2][4][2];
#pragma unroll
    for (int a = 0; a < 2; ++a)
#pragma unroll
        for (int b = 0; b < 2; ++b)
#pragma unroll
            for (int m = 0; m < 4; ++m)
#pragma unroll
                for (int n = 0; n < 2; ++n) acc[a][b][m][n] = (f32x4){0.f, 0.f, 0.f, 0.f};
    bf16x8 At[4][2], B0[2][2], B1[2][2];
    const char* cA = (const char*)(cur.sel ? g.A2 : g.A) + (size_t)cur.pm * tstep + (cur.half == 2 ? hstep : (size_t)0); const char* cB = (const char*)(cur.sel ? g.Bt2 : g.Bt) + (size_t)cur.pn * tstep;
    S.a_ready(cur);
    if constexpr (SP2) {
        PG8_STAGE(PG8_SB(0, 0), cB, voffB); PG8_STAGE(PG8_SB(0, 1), cB + hstep, voffB); PG8_STAGE(PG8_SA(0, 0), cA, voffA); PG8_STAGE(PG8_SA(0, 1), cA + hstep, voffA);
        if (wr == 1) PG8_BAR;
        PG8_WAIT_V(2); PG8_BAR;
        PG8_STAGE(PG8_SB(1, 0), cB + kstep, voffB); PG8_STAGE(PG8_SA(1, 0), cA + kstep, voffA); PG8_STAGE(PG8_SB(1, 1), cB + hstep + kstep, voffB);
        PG8_WAIT_V(6); PG8_BAR;
    } else {
        PG8_STAGE(PG8_SB(0, 0), cB, voffB); PG8_STAGE(PG8_SA(0, 0), cA, voffA); PG8_STAGE(PG8_SB(0, 1), cB + hstep, voffB); PG8_STAGE(PG8_SA(0, 1), cA + hstep, voffA);
        if (wr == 1) PG8_BAR;
        PG8_WAIT_V(4); PG8_BAR;
        PG8_STAGE(PG8_SB(1, 0), cB + kstep, voffB); PG8_STAGE(PG8_SA(1, 0), cA + kstep, voffA); PG8_STAGE(PG8_SB(1, 1), cB + hstep + kstep, voffB);
        PG8_WAIT_V(6); PG8_BAR;
    }
    for (;;) {
        if constexpr (Sched::ROWHALF) { if (cur.half != 0) break; }
        const bool has_next = S.next(ui + 1, nxt);
        const char* nA = has_next ? (const char*)(nxt.sel ? g.A2 : g.A) + (size_t)nxt.pm * tstep + (nxt.half == 2 ? hstep : (size_t)0) : cA; const char* nB = has_next ? (const char*)(nxt.sel ? g.Bt2 : g.Bt) + (size_t)nxt.pn * tstep : cB;
        for (int t = 0; t < nt; t += 2) {
            const bool last = (t == nt - 2);
            const char* a1 = cA + (size_t)(t + 1) * kstep;
            const char* a2 = last ? nA : cA + (size_t)(t + 2) * kstep; const char* b2 = last ? nB : cB + (size_t)(t + 2) * kstep;
            const char* a3 = a2 + kstep; const char* b3 = b2 + kstep;
            if (last && has_next) S.a_ready(nxt);
            if constexpr (SP2) {
            PG8_LDB(B0, 0, 0); PG8_LDB(B1, 0, 1); PG8_SCHED; PG8_LDA(At, 0, 0); PG8_STAGE(PG8_SA(1, 1), a1 + hstep, voffA);
            PG8_WAIT_V(8); PG8_WAIT_L(0); PG8_BAR; PG8_MMA(0, 0, At, B0); PG8_MMA(0, 1, At, B1); PG8_BAR; PG8_SCHED;
            PG8_LDA(At, 0, 1); PG8_STAGE(PG8_SB(0, 0), b2, voffB); PG8_STAGE(PG8_SB(0, 1), b2 + hstep, voffB); PG8_STAGE(PG8_SA(0, 0), a2, voffA);
            PG8_WAIT_V(8); PG8_WAIT_L(0); PG8_BAR; PG8_MMA(1, 0, At, B0); PG8_MMA(1, 1, At, B1); PG8_BAR; PG8_SCHED;
            PG8_LDB(B0, 1, 0); PG8_LDB(B1, 1, 1); PG8_SCHED; PG8_LDA(At, 1, 0); PG8_STAGE(PG8_SA(0, 1), a2 + hstep, voffA);
            PG8_WAIT_V(8); PG8_WAIT_L(0); PG8_BAR; PG8_MMA(0, 0, At, B0); PG8_MMA(0, 1, At, B1); PG8_BAR; PG8_SCHED;
            PG8_LDA(At, 1, 1); PG8_STAGE(PG8_SB(1, 0), b3, voffB); PG8_STAGE(PG8_SB(1, 1), b3 + hstep, voffB); PG8_STAGE(PG8_SA(1, 0), a3, voffA);
            PG8_WAIT_V(8); PG8_WAIT_L(0); PG8_BAR; PG8_MMA(1, 0, At, B0); PG8_MMA(1, 1, At, B1); PG8_BAR; PG8_SCHED;
            } else {
            PG8_LDB(B0, 0, 0); PG8_SCHED; PG8_LDA(At, 0, 0); PG8_STAGE(PG8_SA(1, 1), a1 + hstep, voffA);
            PG8_WAIT_L(8); PG8_BAR; PG8_WAIT_L(0); PG8_MMA(0, 0, At, B0); PG8_BAR; PG8_SCHED;
            PG8_LDB(B1, 0, 1); PG8_STAGE(PG8_SB(0, 0), b2, voffB);
            PG8_BAR; PG8_WAIT_L(0); PG8_MMA(0, 1, At, B1); PG8_BAR;
            PG8_LDA(At, 0, 1); PG8_STAGE(PG8_SA(0, 0), a2, voffA);
            PG8_BAR; PG8_WAIT_L(0); PG8_MMA(1, 0, At, B0); PG8_BAR; PG8_SCHED;
            PG8_STAGE(PG8_SB(0, 1), b2 + hstep, voffB);
            PG8_WAIT_V(6); PG8_BAR; PG8_MMA(1, 1, At, B1); PG8_BAR;
            PG8_LDB(B0, 1, 0); PG8_SCHED; PG8_LDA(At, 1, 0); PG8_STAGE(PG8_SA(0, 1), a2 + hstep, voffA);
            PG8_WAIT_L(8); PG8_BAR; PG8_WAIT_L(0); PG8_MMA(0, 0, At, B0); PG8_BAR; PG8_SCHED;
            PG8_LDB(B1, 1, 1); PG8_STAGE(PG8_SB(1, 0), b3, voffB);
            PG8_BAR; PG8_WAIT_L(0); PG8_MMA(0, 1, At, B1); PG8_BAR;
            PG8_LDA(At, 1, 1); PG8_STAGE(PG8_SA(1, 0), a3, voffA);
            PG8_BAR; PG8_WAIT_L(0); PG8_MMA(1, 0, At, B0); PG8_BAR; PG8_SCHED;
            PG8_STAGE(PG8_SB(1, 1), b3 + hstep, voffB);
            PG8_WAIT_V(6); PG8_BAR; PG8_MMA(1, 1, At, B1); PG8_BAR;
            }
        }
        if constexpr (ALIGN_EPI) { if (wr == 0) PG8_BAR; }
        if constexpr (!Epi::AFTER_DRAIN) { E(acc, cur, wr, wc, fr, fq); S.done(cur); }
        if (!has_next) break;
        if (Epi::zero_after(cur))
#pragma unroll
        for (int a = 0; a < 2; ++a)
#pragma unroll
            for (int b = 0; b < 2; ++b)
#pragma unroll
                for (int m = 0; m < 4; ++m)
#pragma unroll
                    for (int n = 0; n < 2; ++n) acc[a][b][m][n] = (f32x4){0.f, 0.f, 0.f, 0.f};
        cur = nxt; cA = nA; cB = nB; ++ui;
        if constexpr (ALIGN_EPI) { if (wr == 1) PG8_BAR; }
    }
    if constexpr (Sched::ROWHALF && SP2 && ALIGN_EPI) { if (cur.half != 0) {
        for (int t = 0; t < nt; t += 2) {
            const bool last = (t == nt - 2);
            const char* a2 = last ? cA : cA + (size_t)(t + 2) * kstep; const char* b2 = last ? cB : cB + (size_t)(t + 2) * kstep;
            const char* a3 = a2 + kstep; const char* b3 = b2 + kstep;
            PG8_LDB(B0, 0, 0); PG8_LDB(B1, 0, 1); PG8_SCHED; PG8_LDA(At, 0, 0);
            PG8_WAIT_V(6); PG8_WAIT_L(0); PG8_BAR; PG8_MMA(0, 0, At, B0); PG8_MMA(0, 1, At, B1); PG8_BAR; PG8_SCHED;
            PG8_STAGE(PG8_SB(0, 0), b2, voffB); PG8_STAGE(PG8_SB(0, 1), b2 + hstep, voffB); PG8_STAGE(PG8_SA(0, 0), a2, voffA);
            PG8_WAIT_V(6); PG8_BAR; PG8_BAR; PG8_SCHED;
            PG8_LDB(B0, 1, 0); PG8_LDB(B1, 1, 1); PG8_SCHED; PG8_LDA(At, 1, 0);
            PG8_WAIT_V(6); PG8_WAIT_L(0); PG8_BAR; PG8_MMA(0, 0, At, B0); PG8_MMA(0, 1, At, B1); PG8_BAR; PG8_SCHED;
            PG8_STAGE(PG8_SB(1, 0), b3, voffB); PG8_STAGE(PG8_SB(1, 1), b3 + hstep, voffB); PG8_STAGE(PG8_SA(1, 0), a3, voffA);
            PG8_WAIT_V(6); PG8_BAR; PG8_BAR;
        }
        if (wr == 0) PG8_BAR;
        E(acc, cur, wr, wc, fr, fq); S.done(cur);
    } }
    PG8_WAIT_V(0);
    if constexpr (!ALIGN_EPI) { if (wr == 0) PG8_BAR; }
    PG8_BAR;
    if constexpr (Epi::AFTER_DRAIN) { E.fused(acc, cur, wr, wc, fr, fq, lds, wid, lane); S.done(cur); }
#undef PG8_SA
#undef PG8_SB
#undef PG8_STAGE
#undef PG8_LDA
#undef PG8_LDB
#undef PG8_MMA
#undef PG8_WAIT_V
#undef PG8_WAIT_L
#undef PG8_BAR
#undef PG8_SCHED
}
}

namespace pg8 {
template <class RowEpi> struct EpiRows {
    static constexpr bool PERM = true, AFTER_DRAIN = false;
    RowEpi R;
    static __device__ __forceinline__ bool zero_after(const Unit&) { return true; }
    __device__ __forceinline__ void operator()(const f32x4 (&acc)[2][2][4][2], const Unit& u, int wr, int wc, int fr, int fq) const {
        const int b = u.pm >> 3, row0 = u.pm * BM + wr * 64 + fr + (u.half == 2 ? HALF : 0);
        const typename RowEpi::Tile T = R.tile_pre(b, u.pn, wc, fq);
        constexpr int NB = RowEpi::BATCH;
#pragma unroll
        for (int g0 = 0; g0 < 8; g0 += NB) {
            if (u.half && g0 >= 4) break;
            typename RowEpi::Pre P[NB];
#pragma unroll
            for (int j = 0; j < NB; ++j) if (!(u.half && g0 + j >= 4)) P[j] = R.row_pre(row0 + ((g0 + j) >> 2) * HALF + ((g0 + j) & 3) * 16, b, u.pn, wc, fq);
            __builtin_amdgcn_sched_barrier(0);
#pragma unroll
            for (int j = 0; j < NB; ++j) { const int ai = (g0 + j) >> 2, m = (g0 + j) & 3;
                if (u.half && g0 + j >= 4) continue;
                const f32x4 v[4] = {acc[ai][0][m][0], acc[ai][0][m][1], acc[ai][1][m][0], acc[ai][1][m][1]};
                R(v, P[j], T, row0 + ai * HALF + m * 16, b, u.pn, wc, fq); }
        }
    }
};
struct EpiOutFused {
    static constexpr bool PERM = true, AFTER_DRAIN = true;
    OutEpi R;
    static __device__ __forceinline__ bool zero_after(const Unit&) { return true; }
    __device__ __forceinline__ void operator()(const f32x4 (&)[2][2][4][2], const Unit&, int, int, int, int) const {}
    __device__ __forceinline__ void fused(f32x4 (&acc)[2][2][4][2], const Unit& u, int wr, int wc, int fr, int fq, PG8_LAS unsigned char* lds, int wid, int lane) const {
        PG8_LAS float* sred = (PG8_LAS float*)lds;
        const int b = u.pm >> 3;
        const OutEpi::Tile T = R.tile_pre(b, u.pn, wc, fq);
        constexpr int NB = OutEpi::BATCH;
#pragma unroll
        for (int g0 = 0; g0 < 8; g0 += NB) {
            OutEpi::Pre P[NB];
#pragma unroll
            for (int j = 0; j < NB; ++j) P[j] = R.row_pre(u.pm * BM + ((g0 + j) >> 2) * HALF + wr * 64 + ((g0 + j) & 3) * 16 + fr, b, u.pn, wc, fq);
            __builtin_amdgcn_sched_barrier(0);
#pragma unroll
            for (int j = 0; j < NB; ++j) { const int ai = (g0 + j) >> 2, m = (g0 + j) & 3;
                const f32x4 v[4] = {acc[ai][0][m][0], acc[ai][0][m][1], acc[ai][1][m][0], acc[ai][1][m][1]};
                const int rl = ai * HALF + wr * 64 + m * 16 + fr;
                const float ss = R(v, P[j], T, u.pm * BM + rl, b, u.pn, wc, fq);
                if (fq == 0) sred[rl * 4 + wc] = ss; }
        }
        asm volatile("s_waitcnt lgkmcnt(0)" ::: "memory"); __builtin_amdgcn_s_barrier(); asm volatile("" ::: "memory");
        const int t = wid * 64 + lane;
        if (t < 256) { const f32x4 p = *(const PG8_LAS f32x4*)(sred + t * 4); R.rowss[(size_t)(u.pm * BM + t) * 4 + u.pn] = (p[0] + p[1]) + (p[2] + p[3]); }
    }
};
struct DoubleKOrder : StaticOrder {
    __host__ __device__ bool next(int i, Unit& u) const { const bool ok = StaticOrder::next(i >> 1, u); u.half = i & 1; return ok; }
};
template <class RowEpi> struct EpiRowsDK {
    static constexpr bool PERM = true, AFTER_DRAIN = false;
    RowEpi R;
    static __device__ __forceinline__ bool zero_after(const Unit& u) { return u.half == 1; }
    __device__ __forceinline__ void operator()(f32x4 (&acc)[2][2][4][2], const Unit& u, int wr, int wc, int fr, int fq) const {
        if (u.half == 0) return;
#pragma unroll
        for (int a = 0; a < 2; ++a)
#pragma unroll
            for (int b = 0; b < 2; ++b)
#pragma unroll
                for (int m = 0; m < 4; ++m)
#pragma unroll
                    for (int n = 0; n < 2; ++n) acc[a][b][m][n] = acc[a][b][m][n] * 0.5f;
        Unit v = u; v.half = 0; EpiRows<RowEpi> E{R}; E(acc, v, wr, wc, fr, fq);
    }
};
struct TailHalfOrder : StaticOrder {
    static constexpr bool ROWHALF = true;
    __host__ __device__ bool next(int i, Unit& u) const {
        const int full = nwg / G, rem = nwg - full * G;
        if (rem * 2 != G || i < full) return StaticOrder::next(i, u);
        if (i > full) return false;
        StaticOrder t = *this; t.c = c < rem ? c : c - rem; const bool ok = t.next(full, u); u.half = c < rem ? 1 : 2; return ok;
    }
};
struct PairOrder : StaticOrder {
    __host__ __device__ bool next(int i, Unit& u) const { const bool ok = StaticOrder::next(i >> 1, u); u.sel = i & 1; return ok; }
};
struct BranchTileEpi {
    static constexpr bool PERM = true, AFTER_DRAIN = false;
    const bf16_t *GA, *GB; bf16_t* Y;
    static __device__ __forceinline__ bool zero_after(const Unit& u) { return u.sel == 1; }
    __device__ __forceinline__ void operator()(f32x4 (&acc)[2][2][4][2], const Unit& u, int wr, int wc, int fr, int fq) const {
        const size_t off0 = (size_t)(u.pm * BM + wr * 64 + fr) * 1024 + u.pn * BM + wc * 32 + 8 * fq;
        const bf16_t* S = u.sel == 0 ? GA : GB;
        u32x4 s[8][2];
#pragma unroll
        for (int g = 0; g < 8; ++g)
#pragma unroll
            for (int bj = 0; bj < 2; ++bj) s[g][bj] = *(const u32x4*)(S + off0 + (size_t)((g >> 2) * HALF + (g & 3) * 16) * 1024 + bj * HALF);
        __builtin_amdgcn_sched_barrier(0);
#pragma unroll
        for (int g = 0; g < 8; ++g) { const int ai = g >> 2, m = g & 3;
#pragma unroll
            for (int bj = 0; bj < 2; ++bj) {
                f32x4 f[2];
#pragma unroll
                for (int n = 0; n < 2; ++n) { f[n][0] = bflo(s[g][bj][2 * n]); f[n][1] = bfhi(s[g][bj][2 * n]); f[n][2] = bflo(s[g][bj][2 * n + 1]); f[n][3] = bfhi(s[g][bj][2 * n + 1]); }
                if (u.sel == 0) { acc[ai][bj][m][0] = acc[ai][bj][m][0] * f[0]; acc[ai][bj][m][1] = acc[ai][bj][m][1] * f[1]; }
                else *(u32x4*)(Y + off0 + (size_t)(ai * HALF + m * 16) * 1024 + bj * HALF) = pack8(acc[ai][bj][m][0] * f[0], acc[ai][bj][m][1] * f[1]);
            }
        }
    }
};
}

namespace attn_body {
using bf16=__hip_bfloat16;
using bf16x8=__attribute__((ext_vector_type(8)))short;
using s16x4=__attribute__((ext_vector_type(4)))short;
using f32x16=__attribute__((ext_vector_type(16)))float;
using u32x4=__attribute__((ext_vector_type(4)))unsigned;
constexpr int SEQ=2048,D=64;
constexpr int NW=8,QBLK=32,QB=QBLK*NW,KVBLK=64,NQB=SEQ/QB;
constexpr int ATTN_UNIT_ROWS=QB;
__device__ __forceinline__ int crow(int r,int hi){return (r&3)+8*(r>>2)+4*hi;}
#define SBAR() __builtin_amdgcn_sched_barrier(0)
template<bool LIN> __device__ __forceinline__ void cmask(f32x16&p0,f32x16&p1,int jb,int qrel,int hi){
  const float NEG=LIN?0.f:-INFINITY; int kb=64*jb+4*hi;
  #pragma unroll
  for(int r=0;r<16;++r){int kv=kb+(r&3)+8*(r>>2); if(kv>qrel)p0[r]=NEG; if(kv+32>qrel)p1[r]=NEG;}
}

constexpr int NSLOT=3, SLOTB=8192;
constexpr int LDS_RT=98304, LDS_RTS=106496, RS_NSLOT=6, RS_SLOTB=16384;
constexpr int LDS_K=0, LDS_V=NSLOT*SLOTB, LDS_WS=2*NSLOT*SLOTB, LDS_OST=LDS_WS+NW*64*4, LDS_BYTES=LDS_OST+NW*4096;
constexpr float C2=0.125f*1.4426950408889634f;
__device__ __forceinline__ void glds16s(const void*sbase,unsigned voff,unsigned lds_dst){unsigned keep;
  asm volatile("s_mov_b32 %0, m0\n\ts_mov_b32 m0, %3\n\ts_nop 4\n\tglobal_load_lds_dwordx4 %1, %2\n\ts_mov_b32 m0, %0":"=&s"(keep):"v"(voff),"s"(sbase),"s"(lds_dst):"memory");}
__device__ __forceinline__ const char* uptr(const char*p){const unsigned long long a=(unsigned long long)p;const unsigned lo=__builtin_amdgcn_readfirstlane((unsigned)a),hi=__builtin_amdgcn_readfirstlane((unsigned)(a>>32));return (const char*)(((unsigned long long)hi<<32)|lo);}
__device__ __forceinline__ void glds16(const void*gsrc,unsigned lds_dst){unsigned keep;
  asm volatile("s_mov_b32 %0, m0\n\ts_mov_b32 m0, %2\n\ts_nop 0\n\tglobal_load_lds_dwordx4 %1, off\n\ts_mov_b32 m0, %0":"=&s"(keep):"v"(gsrc),"s"(lds_dst):"memory");}
__device__ __forceinline__ float max3f(float a,float b,float c){float r;asm("v_max3_f32 %0, %1, %2, %3":"=v"(r):"v"(a),"v"(b),"v"(c));return r;}
__device__ __forceinline__ float max2f(float a,float b){float r;asm("v_max_f32_e32 %0, %1, %2":"=v"(r):"v"(a),"v"(b));return r;}
__device__ __forceinline__ float fadd_s(float a,float b){float r;asm("v_add_f32_e32 %0, %1, %2":"=v"(r):"v"(a),"v"(b));return r;}
__device__ __forceinline__ float fsub_s(float a,float b){float r;asm("v_sub_f32_e32 %0, %1, %2":"=v"(r):"v"(a),"v"(b));return r;}
typedef float f32x2_t __attribute__((ext_vector_type(2))); typedef __bf16 bf16x2_t __attribute__((ext_vector_type(2)));
__device__ __forceinline__ unsigned cvtpk_s(float lo,float hi){f32x2_t v={lo,hi};bf16x2_t b=__builtin_convertvector(v,bf16x2_t);return __builtin_bit_cast(unsigned,b);}
#define WAIT_BAR(N) asm volatile("s_waitcnt vmcnt(" #N ") lgkmcnt(0)\n\ts_barrier":::"memory")

__device__ __forceinline__ void qkt(f32x16&p0,f32x16&p1,const char*Kslot,const bf16x8*qr,const f32x16&negm,int r32,int hi){
  const char*kb=Kslot+hi*1024+r32*16;
  #pragma unroll
  for(int d0=0;d0<4;++d0){
    const bf16x8 b0=*reinterpret_cast<const bf16x8*>(kb+d0*2048);
    const bf16x8 b1=*reinterpret_cast<const bf16x8*>(kb+d0*2048+512);
    if(d0==0){p0=__builtin_amdgcn_mfma_f32_32x32x16_bf16(b0,qr[0],negm,0,0,0);p1=__builtin_amdgcn_mfma_f32_32x32x16_bf16(b1,qr[0],negm,0,0,0);}
    else{p0=__builtin_amdgcn_mfma_f32_32x32x16_bf16(b0,qr[d0],p0,0,0,0);p1=__builtin_amdgcn_mfma_f32_32x32x16_bf16(b1,qr[d0],p1,0,0,0);}}
}
typedef __attribute__((address_space(3))) const char* lds_cptr;
typedef short v4i16_t __attribute__((ext_vector_type(4)));
__device__ __forceinline__ void kload8(bf16x8*kf,lds_cptr kp){
  kf[0]=*(const __attribute__((address_space(3))) bf16x8*)(kp);      kf[1]=*(const __attribute__((address_space(3))) bf16x8*)(kp+512);
  kf[2]=*(const __attribute__((address_space(3))) bf16x8*)(kp+2048); kf[3]=*(const __attribute__((address_space(3))) bf16x8*)(kp+2560);
  kf[4]=*(const __attribute__((address_space(3))) bf16x8*)(kp+4096); kf[5]=*(const __attribute__((address_space(3))) bf16x8*)(kp+4608);
  kf[6]=*(const __attribute__((address_space(3))) bf16x8*)(kp+6144); kf[7]=*(const __attribute__((address_space(3))) bf16x8*)(kp+6656);
}
__device__ __forceinline__ void kload2(bf16x8*kf,lds_cptr kp,int j){ kf[2*j]=*(const __attribute__((address_space(3))) bf16x8*)(kp+j*2048); kf[2*j+1]=*(const __attribute__((address_space(3))) bf16x8*)(kp+j*2048+512); }
__device__ __forceinline__ s16x4 vtr(lds_cptr p){ return __builtin_bit_cast(s16x4,__builtin_amdgcn_ds_read_tr16_b64_v4i16((__attribute__((address_space(3))) v4i16_t*)p)); }
__device__ __forceinline__ float rowmax(const f32x16&p0,const f32x16&p1){
  float a=max3f(p0[0],p0[1],p1[0]),b=max3f(p0[2],p0[3],p1[1]);a=max3f(a,p1[2],p1[3]);
  #pragma unroll
  for(int r=4;r<16;r+=4){a=max3f(a,p0[r],p0[r+1]);b=max3f(b,p0[r+2],p0[r+3]);a=max3f(a,p1[r],p1[r+1]);b=max3f(b,p1[r+2],p1[r+3]);}
  const float m=max2f(a,b);
  auto rr=__builtin_amdgcn_permlane32_swap(__float_as_uint(m),__float_as_uint(m),false,false);
  return max2f(__uint_as_float(rr[0]),__uint_as_float(rr[1]));
}
__device__ __forceinline__ void pv(f32x16*o,int vb,bf16x8 pa0,bf16x8 pa1,bf16x8 pa2,bf16x8 pa3){
  #pragma unroll
  for(int d0=0;d0<2;++d0){s16x4 lo[4],hi[4];
    #pragma unroll
    for(int ks=0;ks<4;++ks){
      asm volatile("ds_read_b64_tr_b16 %0,%1 offset:%c2":"=&v"(lo[ks]):"v"(vb),"i"(d0*4096+ks*1024):"memory");
      asm volatile("ds_read_b64_tr_b16 %0,%1 offset:%c2":"=&v"(hi[ks]):"v"(vb),"i"(d0*4096+ks*1024+512):"memory");}
    asm volatile("s_waitcnt lgkmcnt(0)":::"memory");SBAR();
    #define PK(k) (bf16x8){lo[k][0],lo[k][1],lo[k][2],lo[k][3],hi[k][0],hi[k][1],hi[k][2],hi[k][3]}
    o[d0]=__builtin_amdgcn_mfma_f32_32x32x16_bf16(pa0,PK(0),o[d0],0,0,0);
    o[d0]=__builtin_amdgcn_mfma_f32_32x32x16_bf16(pa1,PK(1),o[d0],0,0,0);
    o[d0]=__builtin_amdgcn_mfma_f32_32x32x16_bf16(pa2,PK(2),o[d0],0,0,0);
    o[d0]=__builtin_amdgcn_mfma_f32_32x32x16_bf16(pa3,PK(3),o[d0],0,0,0);
    #undef PK
  }
}

#ifndef ATTN_STORE16
#define ATTN_STORE16(p,v) (*(u32x4*)(p)=(v))
#endif
template<int THRL,bool LIN> __device__ __forceinline__ void attn_unit(long rowbase,int qb,const bf16*Q,int QP,const bf16*__restrict__ K,int KP,const bf16*__restrict__ V,int VP,bf16*O,int OP,char*shm,const bool xr,const int WAVE_S){
  int lane=lane_id_(); asm volatile("":"+v"(lane)); const int r32=lane&31,hi=lane>>5; const int wid=WAVE_S;
  const int q0=qb*QB;
  const bf16*Qw=Q+(rowbase+q0+wid*QBLK)*QP;
  const bf16*Kh=K+rowbase*KP,*Vh=V+rowbase*VP;
  const unsigned lds0=(unsigned)(uintptr_t)shm;
  float*wsf=(float*)(shm+LDS_WS)+wid*64;
  const unsigned koff=(unsigned)((lane*KP+wid*8)*2);
  const unsigned voff=(unsigned)(((16*(wid&3)+(lane>>2))*VP+(wid>>2)*32+(lane&3)*8)*2);
  const unsigned kdst=lds0+LDS_K+wid*1024, vdst=lds0+LDS_V+wid*1024;
  #define DMA_K(t,slot) glds16s(uptr((const char*)(Kh+(long)(t)*KVBLK*KP)),koff,(unsigned)__builtin_amdgcn_readfirstlane(kdst+(slot)))
  #define DMA_V(t,slot) glds16s(uptr((const char*)(Vh+(long)(t)*KVBLK*VP)),voff,(unsigned)__builtin_amdgcn_readfirstlane(vdst+(slot)))
  const int vb0=(int)(lds0+LDS_V)+((lane>>4)&1)*32+(lane&3)*8+(4*hi+((lane&15)>>2))*64;
  const char*Kbase=shm+LDS_K; bf16x8 kf[8];
  const lds_cptr shm3=(lds_cptr)shm; const lds_cptr kp0=shm3+LDS_K+hi*1024+r32*16; const lds_cptr vp0=shm3+LDS_V+((lane>>4)&1)*32+(lane&3)*8+(4*hi+((lane&15)>>2))*64;
  const int NT=(q0+QB)/KVBLK;
  DMA_K(0,0);DMA_V(0,0);DMA_K(1,SLOTB);
  bf16x8 qr[4];
  #pragma unroll
  for(int d0=0;d0<4;++d0)qr[d0]=*reinterpret_cast<const bf16x8*>(&Qw[(long)r32*QP+d0*16+hi*8]);
  float mhat=0.f,l_reg=0.f;f32x16 o[2];o[0]=f32x16{};o[1]=f32x16{};f32x16 negm;
  if constexpr(LIN){ if(xr){ const lds_cptr rt=(lds_cptr)shm+LDS_RT;
    _Pragma("unroll") for(int e2=0;e2<2;++e2) _Pragma("unroll") for(int d0=0;d0<4;++d0){ const bf16x8 rf=*(const __attribute__((address_space(3))) bf16x8*)(rt+((32*e2+r32)*64+16*d0+8*hi)*2);
      o[e2]=__builtin_amdgcn_mfma_f32_32x32x16_bf16(qr[d0],rf,o[e2],0,0,0);} } }
  #define NEGM (LIN?f32x16{}:negm)
  const int qrel=wid*QBLK+r32;
  #define CMASK(P0,P1,t) do{int jb_=(t)-(NT-4); if(jb_>=0)cmask<LIN>(P0,P1,jb_,qrel,hi);}while(0)
  bool resc=false;
  #define START(P0,P1) do{ if constexpr(!LIN){ const float rm=rowmax(P0,P1); resc=false; \
    { const float dl=rm; mhat=fadd_s(mhat,dl); \
      _Pragma("unroll") for(int r=0;r<16;++r){P0[r]=fsub_s(P0[r],dl);P1[r]=fsub_s(P1[r],dl);} \
      _Pragma("unroll") for(int r=0;r<16;++r)negm[r]=-mhat; asm volatile("":"+v"(negm)); } \
    _Pragma("unroll") for(int r=0;r<16;++r)P0[r]=__builtin_amdgcn_exp2f(P0[r]); } }while(0)
  #define RESC() do{ if(resc){ asm volatile("s_waitcnt lgkmcnt(0)":::"memory"); \
      _Pragma("unroll") for(int d_=0;d_<2;++d_) _Pragma("unroll") for(int r=0;r<16;++r)o[d_][r]*=wsf[crow(r,hi)]; } }while(0)
  f32x16 pA0,pA1,pB0,pB1;
  int sl_prev=0,sl_cur=0,sl_next=SLOTB;
  #define ROT() do{sl_prev=sl_cur;sl_cur=sl_next;sl_next=(sl_next==(NSLOT-1)*SLOTB)?0:sl_next+SLOTB;}while(0)
  DMA_K(2,2*SLOTB);
  WAIT_BAR(3);
  qkt(pA0,pA1,Kbase,qr,f32x16{},r32,hi);asm volatile("s_nop 15\n\ts_nop 7":"+v"(pA0),"+v"(pA1));CMASK(pA0,pA1,0);
  START(pA0,pA1);
  if constexpr(!LIN){ _Pragma("unroll") for(int r=0;r<16;++r)pA1[r]=__builtin_amdgcn_exp2f(pA1[r]); }
  WAIT_BAR(0);
  DMA_K(3,0);DMA_V(1,SLOTB);
  ROT();
  kload8(kf,kp0+sl_cur);
  WAIT_BAR(2);
  s16x4 vlo[8],vhi[8]; u32x4 pw0,pw1,pw2,pw3;
  #define PKW(P,B) cvtpk_s(P[B],P[B+1])
  #define PAF(k) __builtin_bit_cast(bf16x8,pw##k)
  #define VFR(i) (bf16x8){vlo[i][0],vlo[i][1],vlo[i][2],vlo[i][3],vhi[i][0],vhi[i][1],vhi[i][2],vhi[i][3]}
  #define PIN(x) asm volatile("":"+v"(x))
  #define MX3(a,b,c) __builtin_fmaxf(__builtin_fmaxf((a),(b)),(c))
  #define GAPA(MF,A0,A1,A2,A3,W0,W1,PW) do{ MF; if constexpr(!LIN){ sacc+=A0; sacc+=A1; sacc+=A2; sacc+=A3; PIN(sacc); } W0; W1; PIN(PW); SBAR(); }while(0)
  #define EX(v) __builtin_amdgcn_exp2f(v)
  #define GAPB(MF,X,B) do{ MF; if constexpr(!LIN){ X[B]=EX(X[B]); X[B+1]=EX(X[B+1]); X[B+2]=EX(X[B+2]); X[B+3]=EX(X[B+3]); PIN(X); } SBAR(); }while(0)
  #define VRD(i) do{ vlo[i]=vtr(vp_+(((i)>>2)*4096+((i)&3)*1024)); vhi[i]=vtr(vp_+(((i)>>2)*4096+((i)&3)*1024+512)); }while(0)
  #define KRD(G,j) do{ if(G){ kload2(kf,kp0+sl_next,j); SBAR(); } }while(0)
  #define STEP(C0,C1,P0,P1,t,GK,GV,GL) do{ SBAR(); \
    const lds_cptr vp_=vp0+sl_prev; \
    VRD(0); SBAR(); float sacc=(P0[0]+P0[1]); \
    GAPA(C0=__builtin_amdgcn_mfma_f32_32x32x16_bf16(kf[0],qr[0],NEGM,0,0,0), P0[2],P0[3],P0[4],P0[5],     pw0[0]=PKW(P0,0), pw0[1]=PKW(P0,2), pw0); \
    VRD(4); SBAR(); GAPA(C1=__builtin_amdgcn_mfma_f32_32x32x16_bf16(kf[1],qr[0],NEGM,0,0,0), P0[6],P0[7],P0[8],P0[9],     pw0[2]=PKW(P0,4), pw0[3]=PKW(P0,6), pw0); \
    VRD(1); SBAR(); GAPA(C0=__builtin_amdgcn_mfma_f32_32x32x16_bf16(kf[2],qr[1],C0,0,0,0),   P0[10],P0[11],P0[12],P0[13], pw1[0]=PKW(P0,8), pw1[1]=PKW(P0,10), pw1); \
    VRD(5); SBAR(); GAPA(C1=__builtin_amdgcn_mfma_f32_32x32x16_bf16(kf[3],qr[1],C1,0,0,0),   P0[14],P0[15],P1[0],P1[1],   pw1[2]=PKW(P0,12),pw1[3]=PKW(P0,14), pw1); \
    VRD(2); SBAR(); GAPA(C0=__builtin_amdgcn_mfma_f32_32x32x16_bf16(kf[4],qr[2],C0,0,0,0),   P1[2],P1[3],P1[4],P1[5],     pw2[0]=PKW(P1,0), pw2[1]=PKW(P1,2), pw2); \
    VRD(6); SBAR(); GAPA(C1=__builtin_amdgcn_mfma_f32_32x32x16_bf16(kf[5],qr[2],C1,0,0,0),   P1[6],P1[7],P1[8],P1[9],     pw2[2]=PKW(P1,4), pw2[3]=PKW(P1,6), pw2); \
    VRD(3); SBAR(); GAPA(C0=__builtin_amdgcn_mfma_f32_32x32x16_bf16(kf[6],qr[3],C0,0,0,0),   P1[10],P1[11],P1[12],P1[13], pw3[0]=PKW(P1,8), pw3[1]=PKW(P1,10), pw3); \
    VRD(7); SBAR(); GAPA(C1=__builtin_amdgcn_mfma_f32_32x32x16_bf16(kf[7],qr[3],C1,0,0,0),   P1[14],P1[15],0.f,0.f,       pw3[2]=PKW(P1,12),pw3[3]=PKW(P1,14), pw3); \
    l_reg+=sacc; \
    if(GK){DMA_K((t)+3,sl_cur);} if(GV){DMA_V((t)+1,sl_next);} \
    CMASK(C0,C1,t); \
    resc=false; if constexpr(!LIN){ float a=MX3(C0[0],C0[1],C1[0]),b=MX3(C0[2],C0[3],C1[1]); a=MX3(a,C1[2],C1[3]); \
      _Pragma("unroll") for(int r=4;r<16;r+=4){a=MX3(a,C0[r],C0[r+1]);b=MX3(b,C0[r+2],C0[r+3]);a=MX3(a,C1[r],C1[r+1]);b=MX3(b,C1[r+2],C1[r+3]);} \
      float rm=__builtin_fmaxf(a,b); { auto rr=__builtin_amdgcn_permlane32_swap(__float_as_uint(rm),__float_as_uint(rm),false,false); rm=__builtin_fmaxf(__uint_as_float(rr[0]),__uint_as_float(rr[1])); } \
      if(__builtin_expect(__any(rm>(float)THRL),0)){ const float dl=__builtin_fmaxf(rm,0.f); mhat+=dl; \
        _Pragma("unroll") for(int r=0;r<16;++r){C0[r]-=dl;C1[r]-=dl;} \
        _Pragma("unroll") for(int r=0;r<16;++r)negm[r]=-mhat; asm volatile("":"+v"(negm)); \
        const float f=__builtin_amdgcn_exp2f(-dl); l_reg*=f; if(hi==0)wsf[r32]=f; resc=true; } } \
    SBAR(); \
    GAPB(o[0]=__builtin_amdgcn_mfma_f32_32x32x16_bf16(PAF(0),VFR(0),o[0],0,0,0), C0,0); \
    GAPB(o[1]=__builtin_amdgcn_mfma_f32_32x32x16_bf16(PAF(0),VFR(4),o[1],0,0,0), C0,4); \
    KRD(GL,0); GAPB(o[0]=__builtin_amdgcn_mfma_f32_32x32x16_bf16(PAF(1),VFR(1),o[0],0,0,0), C0,8); \
    KRD(GL,1); GAPB(o[1]=__builtin_amdgcn_mfma_f32_32x32x16_bf16(PAF(1),VFR(5),o[1],0,0,0), C0,12); \
    KRD(GL,2); GAPB(o[0]=__builtin_amdgcn_mfma_f32_32x32x16_bf16(PAF(2),VFR(2),o[0],0,0,0), C1,0); \
    KRD(GL,3); GAPB(o[1]=__builtin_amdgcn_mfma_f32_32x32x16_bf16(PAF(2),VFR(6),o[1],0,0,0), C1,4); \
    GAPB(o[0]=__builtin_amdgcn_mfma_f32_32x32x16_bf16(PAF(3),VFR(3),o[0],0,0,0), C1,8); \
    GAPB(o[1]=__builtin_amdgcn_mfma_f32_32x32x16_bf16(PAF(3),VFR(7),o[1],0,0,0), C1,12); \
    }while(0)
  int t=1;
  #undef CMASK
  #define CMASK(P0,P1,t) do{}while(0)
  for(;t+5<NT;t+=2){
    STEP(pB0,pB1,pA0,pA1,t,true,true,true);     WAIT_BAR(2); RESC(); ROT();
    STEP(pA0,pA1,pB0,pB1,t+1,true,true,true);   WAIT_BAR(2); RESC(); ROT();
  }
  #undef CMASK
  #define CMASK(P0,P1,t) do{int jb_=(t)-(NT-4); if(jb_>=0)cmask<LIN>(P0,P1,jb_,qrel,hi);}while(0)
  #define ENDW(tt) do{ if((tt)+3<NT){WAIT_BAR(2);} else if((tt)+2<NT){WAIT_BAR(1);} else {WAIT_BAR(0);} }while(0)
  for(;t+1<NT;t+=2){
    STEP(pB0,pB1,pA0,pA1,t,(t+3<NT),(t+1<NT),(t+1<NT));       ENDW(t);   RESC(); ROT();
    STEP(pA0,pA1,pB0,pB1,t+1,(t+4<NT),(t+2<NT),(t+2<NT));     ENDW(t+1); RESC(); ROT();
  }
  STEP(pB0,pB1,pA0,pA1,NT-1,false,false,false); RESC();
  { float sacc=pB0[0]+pB0[1]; _Pragma("unroll") for(int r=2;r<16;++r)sacc+=pB0[r]; _Pragma("unroll") for(int r=0;r<16;++r)sacc+=pB1[r]; l_reg+=sacc;
    pw0=(u32x4){PKW(pB0,0),PKW(pB0,2),PKW(pB0,4),PKW(pB0,6)};pw1=(u32x4){PKW(pB0,8),PKW(pB0,10),PKW(pB0,12),PKW(pB0,14)};pw2=(u32x4){PKW(pB1,0),PKW(pB1,2),PKW(pB1,4),PKW(pB1,6)};pw3=(u32x4){PKW(pB1,8),PKW(pB1,10),PKW(pB1,12),PKW(pB1,14)};
    SBAR(); pv(o,vb0+sl_cur,PAF(0),PAF(1),PAF(2),PAF(3)); }
  #undef PKW
  #undef PAF
  #undef VFR
  #undef PIN
  #undef MX3
  #undef GAPA
  #undef GAPB
  #undef EX
  #undef VRD
  #undef KRD
  #undef STEP
  #undef ENDW
  {auto rr=__builtin_amdgcn_permlane32_swap(__float_as_uint(l_reg),__float_as_uint(l_reg),false,false);l_reg=__uint_as_float(rr[0])+__uint_as_float(rr[1]);}
  if(hi==0)wsf[32+r32]=l_reg;asm volatile("s_waitcnt lgkmcnt(0)":::"memory");
  float rli[16];
  #pragma unroll
  for(int r=0;r<16;++r)rli[r]=LIN?1.f:__builtin_amdgcn_rcpf(wsf[32+crow(r,hi)]);
  bf16*Ow=O+(rowbase+q0+wid*QBLK)*OP;
  { bf16*stg=(bf16*)(shm+LDS_OST)+wid*2048;
    #pragma unroll
    for(int r=0;r<16;++r){const int orow=crow(r,hi);
      #pragma unroll
      for(int d0=0;d0<2;++d0)stg[orow*64+d0*32+r32]=__float2bfloat16(o[d0][r]*rli[r]);}
    asm volatile("s_waitcnt lgkmcnt(0)":::"memory");
    int lane_e=lane; asm volatile("":"+v"(lane_e));
    #pragma unroll
    for(int i=0;i<4;++i){const int row=i*8+(lane_e>>3),ch=lane_e&7; const u32x4 v=*(const u32x4*)(stg+row*64+ch*8); ATTN_STORE16(Ow+(long)row*OP+ch*8,v);} }
  asm volatile("s_waitcnt lgkmcnt(0)\n\ts_barrier":::"memory");
  #undef DMA_K
  #undef DMA_V
  #undef CMASK
  #undef START
  #undef RESC
  #undef ROT
}
constexpr int ATTN_LDS_BYTES=LDS_BYTES;
__device__ __forceinline__ void ret_state(long rowbase,int nt,const bf16*__restrict__ K,int KP,const bf16*__restrict__ V,int VP,char*shm,const int WAVE_S){
  int lane=lane_id_(); asm volatile("":"+v"(lane)); const int r32=lane&31,hi=lane>>5; const int wid=WAVE_S;
  const bf16*Kh=K+rowbase*KP,*Vh=V+rowbase*VP;
  const unsigned lds0=(unsigned)(uintptr_t)shm;
  const unsigned koff=(unsigned)(((16*(wid&3)+(lane>>2))*KP+(wid>>2)*32+(lane&3)*8)*2);
  const unsigned voff=(unsigned)(((16*(wid&3)+(lane>>2))*VP+(wid>>2)*32+(lane&3)*8)*2);
  const unsigned kdst=lds0+wid*1024, vdst=lds0+8192+wid*1024;
  #define RS_DMA(t,slot) do{ glds16s(uptr((const char*)(Kh+(long)(t)*KVBLK*KP)),koff,(unsigned)__builtin_amdgcn_readfirstlane(kdst+(slot))); \
                             glds16s(uptr((const char*)(Vh+(long)(t)*KVBLK*VP)),voff,(unsigned)__builtin_amdgcn_readfirstlane(vdst+(slot))); }while(0)
  const lds_cptr shm3=(lds_cptr)shm;
  const int frag=((lane>>4)&1)*32+(lane&3)*8+(4*hi+((lane&15)>>2))*64;
  const int eb=wid&1, db=(wid>>1)&1, kh=wid>>2;
  f32x16 acc=f32x16{};
  { int s=0; for(int t=0;t<5&&t<nt;++t){ RS_DMA(t,s); s+=RS_SLOTB; } }
  int sl=0, sl_free=5*RS_SLOTB;
  for(int t=0;t<nt;++t){
    const int after=(nt-1-t)<4?(nt-1-t):4;
    if(after==4)WAIT_BAR(8); else if(after==3)WAIT_BAR(6); else if(after==2)WAIT_BAR(4); else if(after==1)WAIT_BAR(2); else WAIT_BAR(0);
    if(t+5<nt)RS_DMA(t+5,sl_free);
    const lds_cptr kp=shm3+sl+frag, vp=shm3+sl+8192+frag;
    #pragma unroll
    for(int k2=0;k2<2;++k2){ const int ks=2*kh+k2;
      const s16x4 alo=vtr(vp+eb*4096+ks*1024), ahi=vtr(vp+eb*4096+ks*1024+512), blo=vtr(kp+db*4096+ks*1024), bhi=vtr(kp+db*4096+ks*1024+512);
      const bf16x8 af=(bf16x8){alo[0],alo[1],alo[2],alo[3],ahi[0],ahi[1],ahi[2],ahi[3]}, bf=(bf16x8){blo[0],blo[1],blo[2],blo[3],bhi[0],bhi[1],bhi[2],bhi[3]};
      acc=__builtin_amdgcn_mfma_f32_32x32x16_bf16(af,bf,acc,0,0,0); }
    sl_free=sl; sl=(sl==(RS_NSLOT-1)*RS_SLOTB)?0:sl+RS_SLOTB;
  }
  #undef RS_DMA
  __attribute__((address_space(3))) float*part=(__attribute__((address_space(3))) float*)((__attribute__((address_space(3))) char*)shm+LDS_RTS)+(wid&3)*1024;
  if(kh==1){ _Pragma("unroll") for(int r=0;r<16;++r)part[r*64+lane]=acc[r]; }
  asm volatile("s_waitcnt lgkmcnt(0)\n\ts_barrier":::"memory");
  if(kh==0){ __attribute__((address_space(3))) unsigned short*rt=(__attribute__((address_space(3))) unsigned short*)((__attribute__((address_space(3))) char*)shm+LDS_RT);
    _Pragma("unroll") for(int r=0;r<16;++r){ const float v=acc[r]+part[r*64+lane]; rt[(32*eb+crow(r,hi))*64+32*db+r32]=(unsigned short)(cvtpk_s(v,0.f)&0xffffu); } }
  asm volatile("s_waitcnt lgkmcnt(0)\n\ts_barrier":::"memory");
}
constexpr int A2_K=0, A2_V=3*8192, A2_WS=A2_V+3*16384, A2_OST=A2_WS+NW*64*4, A2_BYTES=A2_OST+NW*4096;
constexpr int LDS_RT2=98304;
template<int THRL,bool LIN,bool GATE=false> __device__ __forceinline__ void attn_unit2(long rowbase,int qb,const bf16*Q,int QP,const bf16*__restrict__ K,int KP,const bf16*__restrict__ V,int VP,bf16*O,int OP,char*shm,const bool xr,const int WAVE_S,const bf16*G=nullptr){
  int lane=lane_id_(); asm volatile("":"+v"(lane)); const int r32=lane&31,hi=lane>>5; const int wid=WAVE_S;
  const int q0=qb*QB;
  const bf16*Qw=Q+(rowbase+q0+wid*QBLK)*QP;
  const bf16*Kh=K+rowbase*KP,*Vh=V+rowbase*VP;
  const unsigned lds0=(unsigned)(uintptr_t)shm;
  float*wsf=(float*)(shm+A2_WS)+wid*64;
  const unsigned koff=(unsigned)((lane*KP+wid*8)*2);
  const unsigned voff=(unsigned)(((16*(wid&3)+(lane>>2))*VP+(wid>>2)*32+(lane&3)*8)*2);
  const unsigned kdst=lds0+A2_K+wid*1024, vdst=lds0+A2_V+wid*1024;
  #define DMA_K(t,slot) glds16s(uptr((const char*)(Kh+(long)(t)*KVBLK*KP)),koff,(unsigned)__builtin_amdgcn_readfirstlane(kdst+(slot)))
  #define DMA_V(t,slot) do{ glds16s(uptr((const char*)(Vh+(long)(t)*KVBLK*VP)),voff,(unsigned)__builtin_amdgcn_readfirstlane(vdst+2*(slot))); \
                            glds16s(uptr((const char*)(Vh+(long)(t)*KVBLK*VP)+128),voff,(unsigned)__builtin_amdgcn_readfirstlane(vdst+2*(slot)+8192)); }while(0)
  const char*Kbase=shm+A2_K; bf16x8 kf[8];
  const lds_cptr shm3=(lds_cptr)shm; const lds_cptr kp0=shm3+A2_K+hi*1024+r32*16; const lds_cptr vp0=shm3+A2_V+((lane>>4)&1)*32+(lane&3)*8+(4*hi+((lane&15)>>2))*64;
  const int NT=(q0+QB)/KVBLK;
  DMA_K(0,0);DMA_V(0,0);DMA_K(1,SLOTB);
  bf16x8 qr[4];
  #pragma unroll
  for(int d0=0;d0<4;++d0)qr[d0]=*reinterpret_cast<const bf16x8*>(&Qw[(long)r32*QP+d0*16+hi*8]);
  float mhat=0.f,l_reg=0.f;f32x16 o[4];o[0]=f32x16{};o[1]=f32x16{};o[2]=f32x16{};o[3]=f32x16{};
  if constexpr(LIN){ if(xr){ const lds_cptr rt=(lds_cptr)shm+LDS_RT2;
    _Pragma("unroll") for(int e2=0;e2<4;++e2) _Pragma("unroll") for(int d0=0;d0<4;++d0){ const bf16x8 rf=*(const __attribute__((address_space(3))) bf16x8*)(rt+((32*e2+r32)*64+16*d0+8*hi)*2);
      o[e2]=__builtin_amdgcn_mfma_f32_32x32x16_bf16(qr[d0],rf,o[e2],0,0,0);} } }
  const int qrel=wid*QBLK+r32;
  #define CMASK(P0,P1,t) do{int jb_=(t)-(NT-4); if(jb_>=0)cmask<LIN>(P0,P1,jb_,qrel,hi);}while(0)
  bool resc=false;
  #define RESC() do{ if(resc){ asm volatile("s_waitcnt lgkmcnt(0)":::"memory"); \
      _Pragma("unroll") for(int d_=0;d_<4;++d_) _Pragma("unroll") for(int r=0;r<16;++r)o[d_][r]*=wsf[crow(r,hi)]; } }while(0)
  f32x16 pA0,pA1,pB0,pB1;
  int sl_prev=0,sl_cur=0,sl_next=SLOTB;
  #define ROT() do{sl_prev=sl_cur;sl_cur=sl_next;sl_next=(sl_next==(NSLOT-1)*SLOTB)?0:sl_next+SLOTB;}while(0)
  DMA_K(2,2*SLOTB);
  WAIT_BAR(4);
  qkt(pA0,pA1,Kbase,qr,f32x16{},r32,hi);asm volatile("s_nop 15\n\ts_nop 7":"+v"(pA0),"+v"(pA1));CMASK(pA0,pA1,0);
  if constexpr(!LIN){ const float rm=rowmax(pA0,pA1); mhat=rm;
    _Pragma("unroll") for(int r=0;r<16;++r){pA0[r]=__builtin_amdgcn_exp2f(pA0[r]-mhat);pA1[r]=__builtin_amdgcn_exp2f(pA1[r]-mhat);} }
  WAIT_BAR(0);
  DMA_K(3,0);DMA_V(1,SLOTB);
  ROT();
  kload8(kf,kp0+sl_cur);
  WAIT_BAR(3);
  s16x4 fa_lo,fa_hi,fb_lo,fb_hi,fc_lo,fc_hi,fd_lo,fd_hi; u32x4 pw0,pw1,pw2,pw3;
  #define PKW(P,B) cvtpk_s(P[B],P[B+1])
  #define PAF(k) __builtin_bit_cast(bf16x8,pw##k)
  #define PIN(x) asm volatile("":"+v"(x))
  #define MX3(a,b,c) __builtin_fmaxf(__builtin_fmaxf((a),(b)),(c))
  #define VOFF(i) ((((i)&3)>>1)*8192+((i)&1)*4096+((i)>>2)*1024)
  #define VRDX(X,i) do{ X##_lo=vtr(vp_+VOFF(i)); X##_hi=vtr(vp_+VOFF(i)+512); }while(0)
  #define VFRX(X) (bf16x8){X##_lo[0],X##_lo[1],X##_lo[2],X##_lo[3],X##_hi[0],X##_hi[1],X##_hi[2],X##_hi[3]}
  #define GAPA(MF,A0,A1,A2,A3,W0,W1,PW) do{ MF; if constexpr(!LIN){ sacc+=A0; sacc+=A1; sacc+=A2; sacc+=A3; PIN(sacc); } W0; W1; PIN(PW); SBAR(); }while(0)
  #define EX(v) __builtin_amdgcn_exp2f(v)
  #define GAPB(MF,X,B) do{ MF; if constexpr(!LIN){ X[B]=EX(X[B]-mhat); X[B+1]=EX(X[B+1]-mhat); PIN(X); } SBAR(); }while(0)
  #define KRD(G,j) do{ if(G){ kload2(kf,kp0+sl_next,j); SBAR(); } }while(0)
  #define PVM(i,X) o[(i)&3]=__builtin_amdgcn_mfma_f32_32x32x16_bf16(PAF_((i)>>2),VFRX(X),o[(i)&3],0,0,0)
  #define PAF_(k) ((k)==0?PAF(0):(k)==1?PAF(1):(k)==2?PAF(2):PAF(3))
  #define STEP(C0,C1,P0,P1,t,GK,GV,GL) do{ SBAR(); \
    const lds_cptr vp_=vp0+2*sl_prev; \
    float sacc=(P0[0]+P0[1]); \
    GAPA(C0=__builtin_amdgcn_mfma_f32_32x32x16_bf16(kf[0],qr[0],f32x16{},0,0,0), P0[2],P0[3],P0[4],P0[5],     pw0[0]=PKW(P0,0), pw0[1]=PKW(P0,2), pw0); \
    GAPA(C1=__builtin_amdgcn_mfma_f32_32x32x16_bf16(kf[1],qr[0],f32x16{},0,0,0), P0[6],P0[7],P0[8],P0[9],     pw0[2]=PKW(P0,4), pw0[3]=PKW(P0,6), pw0); \
    GAPA(C0=__builtin_amdgcn_mfma_f32_32x32x16_bf16(kf[2],qr[1],C0,0,0,0),   P0[10],P0[11],P0[12],P0[13], pw1[0]=PKW(P0,8), pw1[1]=PKW(P0,10), pw1); \
    GAPA(C1=__builtin_amdgcn_mfma_f32_32x32x16_bf16(kf[3],qr[1],C1,0,0,0),   P0[14],P0[15],P1[0],P1[1],   pw1[2]=PKW(P0,12),pw1[3]=PKW(P0,14), pw1); \
    GAPA(C0=__builtin_amdgcn_mfma_f32_32x32x16_bf16(kf[4],qr[2],C0,0,0,0),   P1[2],P1[3],P1[4],P1[5],     pw2[0]=PKW(P1,0), pw2[1]=PKW(P1,2), pw2); \
    VRDX(fa,0); SBAR(); GAPA(C1=__builtin_amdgcn_mfma_f32_32x32x16_bf16(kf[5],qr[2],C1,0,0,0),   P1[6],P1[7],P1[8],P1[9],     pw2[2]=PKW(P1,4), pw2[3]=PKW(P1,6), pw2); \
    VRDX(fb,1); SBAR(); GAPA(C0=__builtin_amdgcn_mfma_f32_32x32x16_bf16(kf[6],qr[3],C0,0,0,0),   P1[10],P1[11],P1[12],P1[13], pw3[0]=PKW(P1,8), pw3[1]=PKW(P1,10), pw3); \
    VRDX(fc,2); SBAR(); GAPA(C1=__builtin_amdgcn_mfma_f32_32x32x16_bf16(kf[7],qr[3],C1,0,0,0),   P1[14],P1[15],0.f,0.f,       pw3[2]=PKW(P1,12),pw3[3]=PKW(P1,14), pw3); \
    l_reg+=sacc; \
    if(GK){DMA_K((t)+3,sl_cur);} if(GV){DMA_V((t)+1,sl_next);} \
    CMASK(C0,C1,t); \
    resc=false; if constexpr(!LIN){ float a=MX3(C0[0],C0[1],C1[0]),b=MX3(C0[2],C0[3],C1[1]); a=MX3(a,C1[2],C1[3]); \
      _Pragma("unroll") for(int r=4;r<16;r+=4){a=MX3(a,C0[r],C0[r+1]);b=MX3(b,C0[r+2],C0[r+3]);a=MX3(a,C1[r],C1[r+1]);b=MX3(b,C1[r+2],C1[r+3]);} \
      float rm=__builtin_fmaxf(a,b); { auto rr=__builtin_amdgcn_permlane32_swap(__float_as_uint(rm),__float_as_uint(rm),false,false); rm=__builtin_fmaxf(__uint_as_float(rr[0]),__uint_as_float(rr[1])); } \
      rm-=mhat; \
      if(__builtin_expect(__any(rm>(float)THRL),0)){ const float dl=__builtin_fmaxf(rm,0.f); mhat+=dl; \
        const float f=__builtin_amdgcn_exp2f(-dl); l_reg*=f; if(hi==0)wsf[r32]=f; resc=true; } } \
    SBAR(); \
    VRDX(fd,3);  SBAR(); GAPB(PVM(0,fa),  C0,0); \
    VRDX(fa,4);  SBAR(); GAPB(PVM(1,fb),  C0,2); \
    VRDX(fb,5);  SBAR(); GAPB(PVM(2,fc),  C0,4); \
    VRDX(fc,6);  SBAR(); KRD(GL,0); GAPB(PVM(3,fd),  C0,6); \
    VRDX(fd,7);  SBAR(); KRD(GL,1); GAPB(PVM(4,fa),  C0,8); \
    VRDX(fa,8);  SBAR(); KRD(GL,2); GAPB(PVM(5,fb),  C0,10); \
    VRDX(fb,9);  SBAR(); KRD(GL,3); GAPB(PVM(6,fc),  C0,12); \
    VRDX(fc,10); SBAR(); GAPB(PVM(7,fd),  C0,14); \
    VRDX(fd,11); SBAR(); GAPB(PVM(8,fa),  C1,0); \
    VRDX(fa,12); SBAR(); GAPB(PVM(9,fb),  C1,2); \
    VRDX(fb,13); SBAR(); GAPB(PVM(10,fc), C1,4); \
    VRDX(fc,14); SBAR(); GAPB(PVM(11,fd), C1,6); \
    VRDX(fd,15); SBAR(); GAPB(PVM(12,fa), C1,8); \
    GAPB(PVM(13,fb), C1,10); \
    GAPB(PVM(14,fc), C1,12); \
    GAPB(PVM(15,fd), C1,14); \
    }while(0)
  int t=1;
  #undef CMASK
  #define CMASK(P0,P1,t) do{}while(0)
  for(;t+5<NT;t+=2){
    STEP(pB0,pB1,pA0,pA1,t,true,true,true);     WAIT_BAR(3); RESC(); ROT();
    STEP(pA0,pA1,pB0,pB1,t+1,true,true,true);   WAIT_BAR(3); RESC(); ROT();
  }
  #undef CMASK
  #define CMASK(P0,P1,t) do{int jb_=(t)-(NT-4); if(jb_>=0)cmask<LIN>(P0,P1,jb_,qrel,hi);}while(0)
  #define ENDW(tt) do{ if((tt)+3<NT){WAIT_BAR(3);} else if((tt)+2<NT){WAIT_BAR(2);} else {WAIT_BAR(0);} }while(0)
  for(;t+1<NT;t+=2){
    STEP(pB0,pB1,pA0,pA1,t,(t+3<NT),(t+1<NT),(t+1<NT));       ENDW(t);   RESC(); ROT();
    STEP(pA0,pA1,pB0,pB1,t+1,(t+4<NT),(t+2<NT),(t+2<NT));     ENDW(t+1); RESC(); ROT();
  }
  STEP(pB0,pB1,pA0,pA1,NT-1,false,false,false); RESC();
  { float sacc=pB0[0]+pB0[1]; _Pragma("unroll") for(int r=2;r<16;++r)sacc+=pB0[r]; _Pragma("unroll") for(int r=0;r<16;++r)sacc+=pB1[r]; l_reg+=sacc;
    pw0=(u32x4){PKW(pB0,0),PKW(pB0,2),PKW(pB0,4),PKW(pB0,6)};pw1=(u32x4){PKW(pB0,8),PKW(pB0,10),PKW(pB0,12),PKW(pB0,14)};pw2=(u32x4){PKW(pB1,0),PKW(pB1,2),PKW(pB1,4),PKW(pB1,6)};pw3=(u32x4){PKW(pB1,8),PKW(pB1,10),PKW(pB1,12),PKW(pB1,14)};
    SBAR(); const lds_cptr vp_=vp0+2*sl_cur;
    #pragma unroll
    for(int e4=0;e4<4;++e4){ s16x4 lo[4],hh[4];
      #pragma unroll
      for(int ks=0;ks<4;++ks){ lo[ks]=vtr(vp_+VOFF(4*ks+e4)); hh[ks]=vtr(vp_+VOFF(4*ks+e4)+512); }
      #define PK(k) (bf16x8){lo[k][0],lo[k][1],lo[k][2],lo[k][3],hh[k][0],hh[k][1],hh[k][2],hh[k][3]}
      o[e4]=__builtin_amdgcn_mfma_f32_32x32x16_bf16(PAF(0),PK(0),o[e4],0,0,0);
      o[e4]=__builtin_amdgcn_mfma_f32_32x32x16_bf16(PAF(1),PK(1),o[e4],0,0,0);
      o[e4]=__builtin_amdgcn_mfma_f32_32x32x16_bf16(PAF(2),PK(2),o[e4],0,0,0);
      o[e4]=__builtin_amdgcn_mfma_f32_32x32x16_bf16(PAF(3),PK(3),o[e4],0,0,0);
      #undef PK
    } }
  #undef PKW
  #undef PAF
  #undef PAF_
  #undef PVM
  #undef PIN
  #undef MX3
  #undef VOFF
  #undef VRDX
  #undef VFRX
  #undef GAPA
  #undef GAPB
  #undef EX
  #undef KRD
  #undef STEP
  #undef ENDW
  {auto rr=__builtin_amdgcn_permlane32_swap(__float_as_uint(l_reg),__float_as_uint(l_reg),false,false);l_reg=__uint_as_float(rr[0])+__uint_as_float(rr[1]);}
  if(hi==0)wsf[32+r32]=l_reg;asm volatile("s_waitcnt lgkmcnt(0)":::"memory");
  float rli[16];
  #pragma unroll
  for(int r=0;r<16;++r)rli[r]=LIN?1.f:__builtin_amdgcn_rcpf(wsf[32+crow(r,hi)]);
  bf16*Ow=O+(rowbase+q0+wid*QBLK)*OP;
  { bf16*stg=(bf16*)(shm+A2_OST)+wid*2048;
    int lane_e=lane; asm volatile("":"+v"(lane_e));
    u32x4 gv[2][4];
    if constexpr(GATE){
      const bf16*Gw=G+(rowbase+q0+wid*QBLK)*OP;
      #pragma unroll
      for(int hh=0;hh<2;++hh){
        #pragma unroll
        for(int i=0;i<4;++i){const int row=i*8+(lane_e>>3),ch=lane_e&7; gv[hh][i]=*(const u32x4*)(Gw+(long)row*OP+hh*64+ch*8);} }
      #pragma unroll
      for(int r=0;r<16;++r){ float p=(o[0][r]*o[0][r]+o[1][r]*o[1][r])+(o[2][r]*o[2][r]+o[3][r]*o[3][r]);
        p+=__shfl_xor(p,1);p+=__shfl_xor(p,2);p+=__shfl_xor(p,4);p+=__shfl_xor(p,8);p+=__shfl_xor(p,16);
        rli[r]=rsqrtf(p*(1.f/128.f)+EPS); }
    }
    #pragma unroll
    for(int hh=0;hh<2;++hh){
      #pragma unroll
      for(int r=0;r<16;++r){const int orow=crow(r,hi);
        #pragma unroll
        for(int d0=0;d0<2;++d0)stg[orow*64+d0*32+r32]=__float2bfloat16(o[2*hh+d0][r]*rli[r]);}
      asm volatile("s_waitcnt lgkmcnt(0)":::"memory");
      #pragma unroll
      for(int i=0;i<4;++i){const int row=i*8+(lane_e>>3),ch=lane_e&7; u32x4 v=*(const u32x4*)(stg+row*64+ch*8);
        if constexpr(GATE){
          #pragma unroll
          for(int e=0;e<4;++e)v[e]=pk2(bflo(v[e])*bflo(gv[hh][i][e]),bfhi(v[e])*bfhi(gv[hh][i][e])); }
        { const bf16*sp=Ow+(long)row*OP+hh*64+ch*8; asm volatile("global_store_dwordx4 %0, %1, off sc0 sc1\n\ts_nop 1"::"v"(sp),"v"(v):"memory"); } }
      asm volatile("s_waitcnt lgkmcnt(0)":::"memory");
    } }
  asm volatile("s_waitcnt lgkmcnt(0)\n\ts_barrier":::"memory");
  #undef DMA_K
  #undef DMA_V
  #undef CMASK
  #undef RESC
  #undef ROT
}

constexpr int RS2_NSLOT=4, RS2_SLOTB=24576;
__device__ __forceinline__ void ret_state2(long rowbase,int nt,const bf16*__restrict__ K,int KP,const bf16*__restrict__ V,int VP,char*shm,const int WAVE_S){
  int lane=lane_id_(); asm volatile("":"+v"(lane)); const int r32=lane&31,hi=lane>>5; const int wid=WAVE_S;
  const bf16*Kh=K+rowbase*KP,*Vh=V+rowbase*VP;
  const unsigned lds0=(unsigned)(uintptr_t)shm;
  const unsigned koff=(unsigned)(((16*(wid&3)+(lane>>2))*KP+(wid>>2)*32+(lane&3)*8)*2);
  const unsigned voff=(unsigned)(((16*(wid&3)+(lane>>2))*VP+(wid>>2)*32+(lane&3)*8)*2);
  const unsigned dst0=lds0+wid*1024;
  #define RS_DMA(t,slot) do{ glds16s(uptr((const char*)(Kh+(long)(t)*KVBLK*KP)),koff,(unsigned)__builtin_amdgcn_readfirstlane(dst0+(slot))); \
                             glds16s(uptr((const char*)(Vh+(long)(t)*KVBLK*VP)),voff,(unsigned)__builtin_amdgcn_readfirstlane(dst0+(slot)+8192)); \
                             glds16s(uptr((const char*)(Vh+(long)(t)*KVBLK*VP)+128),voff,(unsigned)__builtin_amdgcn_readfirstlane(dst0+(slot)+16384)); }while(0)
  const lds_cptr shm3=(lds_cptr)shm;
  const int frag=((lane>>4)&1)*32+(lane&3)*8+(4*hi+((lane&15)>>2))*64;
  const int eb=wid&3, db=wid>>2;
  f32x16 acc=f32x16{};
  { int s=0; for(int t=0;t<3&&t<nt;++t){ RS_DMA(t,s); s+=RS2_SLOTB; } }
  int sl=0, sl_free=3*RS2_SLOTB;
  for(int t=0;t<nt;++t){
    const int after=(nt-1-t)<2?(nt-1-t):2;
    if(after==2)WAIT_BAR(6); else if(after==1)WAIT_BAR(3); else WAIT_BAR(0);
    if(t+3<nt)RS_DMA(t+3,sl_free);
    const lds_cptr kp=shm3+sl+db*4096+frag, vp=shm3+sl+8192+(eb>>1)*8192+(eb&1)*4096+frag;
    #pragma unroll
    for(int ks=0;ks<4;++ks){
      const s16x4 alo=vtr(vp+ks*1024), ahi=vtr(vp+ks*1024+512), blo=vtr(kp+ks*1024), bhi=vtr(kp+ks*1024+512);
      const bf16x8 af=(bf16x8){alo[0],alo[1],alo[2],alo[3],ahi[0],ahi[1],ahi[2],ahi[3]}, bf=(bf16x8){blo[0],blo[1],blo[2],blo[3],bhi[0],bhi[1],bhi[2],bhi[3]};
      acc=__builtin_amdgcn_mfma_f32_32x32x16_bf16(af,bf,acc,0,0,0); }
    sl_free=sl; sl=(sl==(RS2_NSLOT-1)*RS2_SLOTB)?0:sl+RS2_SLOTB;
  }
  #undef RS_DMA
  asm volatile("s_waitcnt lgkmcnt(0)\n\ts_barrier":::"memory");
  { __attribute__((address_space(3))) unsigned short*rt=(__attribute__((address_space(3))) unsigned short*)((__attribute__((address_space(3))) char*)shm+LDS_RT2);
    _Pragma("unroll") for(int r=0;r<16;++r) rt[(32*eb+crow(r,hi))*64+32*db+r32]=(unsigned short)(cvtpk_s(acc[r],0.f)&0xffffu); }
  asm volatile("s_waitcnt lgkmcnt(0)\n\ts_barrier":::"memory");
}
#undef SBAR
#undef WAIT_BAR
}

#define GAS __attribute__((address_space(1)))
#define LAS __attribute__((address_space(3)))
typedef unsigned v4u __attribute__((ext_vector_type(4)));
typedef float f32x4 __attribute__((ext_vector_type(4)));
typedef short bf16x8 __attribute__((ext_vector_type(8)));
typedef GAS unsigned gu32;
typedef GAS unsigned long long gu64;
#define RLX_AGENT __ATOMIC_RELAXED, __HIP_MEMORY_SCOPE_AGENT
#define LDS_WAIT() asm volatile("s_waitcnt lgkmcnt(0)" ::: "memory")
#define VM_WAIT() asm volatile("s_waitcnt vmcnt(0)" ::: "memory")
__device__ __forceinline__ unsigned long long rt() { return __builtin_amdgcn_s_memrealtime(); }

#define XB_TMO      128
#define XB_XCNT(j)  (256  + 64 * (j))
#define XB_XSUB(j)  (1280 + 64 * (j))
#define XB_XGEN(j)  (2304 + 64 * (j))
#define XB_TOP      3328
#define XB_TOPGEN   3392
#define XCD_BAR_WORDS 3456
#define XB_SPIN_CAP (1u << 18)

__device__ __forceinline__ unsigned xb_ld(unsigned* p)              { return __hip_atomic_load(p, __ATOMIC_RELAXED, __HIP_MEMORY_SCOPE_AGENT); }
__device__ __forceinline__ unsigned xb_add(unsigned* p, unsigned v) { return __hip_atomic_fetch_add(p, v, __ATOMIC_RELAXED, __HIP_MEMORY_SCOPE_AGENT); }
__device__ __forceinline__ unsigned xb_xcc_id() { return (unsigned)__builtin_amdgcn_s_getreg((3 << 11) | 20) & 0xFu; }
#define XB_SPIN(cond, bar) do { unsigned _sp = 0; while (cond) { __builtin_amdgcn_s_sleep(1); \
    if ((++_sp & 255u) == 0u) { if (xb_ld(&(bar)[XB_TMO])) break; if (_sp > XB_SPIN_CAP) { atomicAdd(&(bar)[XB_TMO], 1u); break; } } } } while (0)

struct XcdBarrier {
    unsigned* bar; unsigned x;
    volatile LAS unsigned* st;
};

__device__ __forceinline__ XcdBarrier xcd_barrier_post(unsigned* bar, volatile LAS unsigned* st, const bool first) {
    XcdBarrier b; b.bar = bar; b.x = xb_xcc_id(); b.st = st;
    if (first) (void)xb_add(&bar[XB_XCNT(b.x)], 1u);
    return b;
}
__device__ __forceinline__ void xcd_barrier_complete(unsigned* bar, unsigned x, unsigned& nloc, unsigned& nx) {
    const unsigned G = gridDim.x * gridDim.y * gridDim.z;
    unsigned sum, cnt, mine, sp = 0u;
    for (;;) {
        sum = 0u; cnt = 0u; mine = 0u;
#pragma unroll
        for (unsigned j = 0; j < 16; ++j) { const unsigned c = xb_ld(&bar[XB_XCNT(j)]); sum += c; cnt += (c > 0u) ? 1u : 0u; mine = (j == x) ? c : mine; }
        if (sum == G) break;
        __builtin_amdgcn_s_sleep(1);
        if ((++sp & 255u) == 0u) { if (xb_ld(&bar[XB_TMO])) break; if (sp > XB_SPIN_CAP) { atomicAdd(&bar[XB_TMO], 1u); break; } }
    }
    nloc = mine > 0u ? mine : 1u; nx = cnt > 0u ? cnt : 1u;
}

__device__ __forceinline__ void xcd_barrier(const XcdBarrier& b, const bool first) {
    asm volatile("s_waitcnt vmcnt(0)" ::: "memory");
    __syncthreads();
    if (first) {
        unsigned* bar = b.bar;
        __builtin_amdgcn_s_waitcnt(0);
        unsigned nloc = b.st[0], nx = b.st[1];
        if (nloc == 0u) { xcd_barrier_complete(bar, b.x, nloc, nx); b.st[0] = nloc; b.st[1] = nx; }
        const unsigned old = xb_add(&bar[XB_XSUB(b.x)], 1u);
        const unsigned gen = old / nloc;
        if (old + 1u == (gen + 1u) * nloc) {
            __builtin_amdgcn_fence(__ATOMIC_RELEASE, "agent");
            asm volatile("s_waitcnt vmcnt(0)" ::: "memory");
            const unsigned og = xb_add(&bar[XB_TOP], 1u);
            const unsigned tg = og / nx;
            if (og + 1u == (tg + 1u) * nx) xb_add(&bar[XB_TOPGEN], 1u);
            else XB_SPIN(xb_ld(&bar[XB_TOPGEN]) == tg, bar);
            __builtin_amdgcn_fence(__ATOMIC_ACQUIRE, "agent");
            xb_add(&bar[XB_XGEN(b.x)], 1u);
            asm volatile("s_waitcnt vmcnt(0)" ::: "memory");
        } else {
            XB_SPIN(xb_ld(&bar[XB_XGEN(b.x)]) == gen, bar);
            __builtin_amdgcn_fence(__ATOMIC_ACQUIRE, "agent");
            asm volatile("s_waitcnt vmcnt(0)" ::: "memory");
        }
    }
    __syncthreads();
}

constexpr int NWAVES = 8;
constexpr int RING_OFF = 0, RING_BYTES = 131072;
constexpr int LDSCTL_OFF = RING_BYTES, MISC_OFF = LDSCTL_OFF + 320;
constexpr int LDS_BYTES = 147456;
constexpr int CW_BAR = 0;
#ifndef MK_N_LAUNCHES
#define MK_N_LAUNCHES 1
#endif
constexpr size_t CTL_ZERO_BYTES = (MK_N_LAUNCHES == 1 ? 16 : 256) * 1024;
constexpr int N_PHASES = 10;
#ifndef PROBE_DOUBLEK
#define PROBE_DOUBLEK 0
#endif
#ifndef PROBE_PHASE
#define PROBE_PHASE -1
#endif
constexpr int PROBE_AMP = 8;
#ifndef PROBE_REPS
#define PROBE_REPS 1,1,1,1,1,1,1,1,1,1
#endif
constexpr int PHASE_REP[N_PHASES] = {PROBE_REPS};

__device__ __forceinline__ void xcd_barrier_arrive(const XcdBarrier& b, const bool first) {
    asm volatile("s_waitcnt vmcnt(0)" ::: "memory");
    __syncthreads();
    if (first) {
        unsigned* bar = b.bar;
        __builtin_amdgcn_s_waitcnt(0);
        unsigned nloc = b.st[0], nx = b.st[1];
        if (nloc == 0u) { xcd_barrier_complete(bar, b.x, nloc, nx); b.st[0] = nloc; b.st[1] = nx; }
        const unsigned old = xb_add(&bar[XB_XSUB(b.x)], 1u);
        const unsigned gen = old / nloc;
        unsigned role = 0u, tg = 0u;
        if (old + 1u == (gen + 1u) * nloc) {
            __builtin_amdgcn_fence(__ATOMIC_RELEASE, "agent");
            asm volatile("s_waitcnt vmcnt(0)" ::: "memory");
            (void)xb_add(&bar[XB_TOP], 1u);
            tg = gen; role = 1u;
        }
        b.st[2] = gen; b.st[3] = role; b.st[4] = tg;
    }
}
__device__ __forceinline__ void xcd_barrier_wait(const XcdBarrier& b, const bool first) {
    if (first) {
        unsigned* bar = b.bar;
        const unsigned gen = b.st[2], role = b.st[3], tg = b.st[4];
        if (role != 0u) {
            { const unsigned need = (tg + 1u) * b.st[1]; XB_SPIN(xb_ld(&bar[XB_TOP]) < need, bar); }
            __builtin_amdgcn_fence(__ATOMIC_ACQUIRE, "agent");
            asm volatile("s_waitcnt vmcnt(0)" ::: "memory");
        } else {
            { const unsigned need = (gen + 1u) * b.st[1]; XB_SPIN(xb_ld(&bar[XB_TOP]) < need, bar); }
            __builtin_amdgcn_fence(__ATOMIC_ACQUIRE, "agent");
            asm volatile("s_waitcnt vmcnt(0)" ::: "memory");
        }
    }
    __syncthreads();
}
__device__ __forceinline__ const void* karg(unsigned off) {
    asm volatile("" : "+s"(off));
    return *(const void* const __attribute__((address_space(4)))*)((const char __attribute__((address_space(4)))*)__builtin_amdgcn_kernarg_segment_ptr() + off);
}
struct MArgs { const void* in[20]; float* out; unsigned char* ws; int ph_lo, ph_hi, li, pad; };

__global__ void __launch_bounds__(NWAVES * 64, 2) mega_fwd(MArgs args) {
    extern __shared__ __attribute__((aligned(16))) unsigned char lds[];
    LAS unsigned char* L = (LAS unsigned char*)lds;
    const int WAVE_S = __builtin_amdgcn_readfirstlane((int)(threadIdx.x >> 6));
#define TID() (WAVE_S * 64 + lane_id_())
#define FIRST() (WAVE_S == 0 && lane_id_() == 0)
    const int G = gridDim.x, bx = blockIdx.x, vcu = (G % 8 == 0) ? (bx % 8) * (G / 8) + bx / 8 : bx;
    for (int u = (int)threadIdx.x; u < (LDS_BYTES - LDSCTL_OFF) / 4; u += NWAVES * 64) ((LAS unsigned*)(L + LDSCTL_OFF))[u] = 0u;
    __syncthreads();
    unsigned* ctl = (unsigned*)(args.ws + WS_CTL);
    XcdBarrier bar = xcd_barrier_post(ctl + CW_BAR + args.li * XCD_BAR_WORDS, (volatile LAS unsigned*)(L + MISC_OFF) + 8, FIRST());
    const int lo = args.ph_lo, hi = args.ph_hi;
    unsigned long long t_last = PROBE_PHASE >= 0 ? __builtin_amdgcn_s_memrealtime() : 0ull, t_a = 0ull, t_b = 0ull;
#define IN(k) (lo <= (k) && (k) < hi)
#define ARRIVE(k) do { if (IN(k) && IN((k) + 1)) xcd_barrier_arrive(bar, FIRST()); } while (0)
#define WAITB(k) do { if (PROBE_PHASE == (k)) { t_a = t_last; } if (IN(k) && IN((k) + 1)) xcd_barrier_wait(bar, FIRST()); if (PROBE_PHASE >= 0) { t_last = __builtin_amdgcn_s_memrealtime(); if (PROBE_PHASE == (k)) t_b = t_last; } } while (0)
#define SEAM(k) do { ARRIVE(k); WAITB(k); } while (0)
#define CONVPTRS() ConvPtrs cv{INF(6), INF(14), INF(15), INF(16), INF(18), INF(19), WSB(WS_WIN), WSB(WS_WA), WSB(WS_WB), WSB(WS_WOUT), WSB(WS_WGU), WSB(WS_WDN)}

#define INF(k) ((const float*)karg(8 * (k)))
#define OUTP() ((float*)karg(160))
#define WSB(off) ((bf16_t*)((unsigned char*)karg(168) + (off)))
#define WSF(off) ((float*)((unsigned char*)karg(168) + (off)))

    if (IN(0)) gemv4_phase<true, false>(TID(), vcu, G, INF(1), DM, INF(3), MODW, INF(4), WSF(WS_MOD), MODW, (float*)lds);
    ARRIVE(0);
    if (IN(0)) { CONVPTRS(); convert_phase(TID(), vcu, G, cv, (float*)lds, CV_S0, CV_S1); trig_phase(TID(), vcu, G, (const int*)karg(16), WSF(WS_TA), WSF(WS_TR)); __syncthreads(); }
    if (IN(0) && IN(1) && G * 64 == M) {
        f32x4 xv[2][4][4];
        xn_load(TID(), vcu, INF(0), xv);
        WAITB(0);
        const float* mod = WSF(WS_MOD); xn_finish(TID(), vcu, xv, INF(5), mod + 1 * DM, mod + 0 * DM, WSB(WS_XN));
    } else {
        WAITB(0);
        if (IN(1)) { const float* mod = WSF(WS_MOD); xn_phase(TID(), vcu, G, INF(0), INF(5), mod + 1 * DM, mod + 0 * DM, WSB(WS_XN)); }
    }
    ARRIVE(1);
    if (IN(1)) { CONVPTRS(); convert_phase(TID(), vcu, G, cv, (float*)lds, CV_S1, CV_S2); __syncthreads(); }
    WAITB(1);
    if (IN(2)) for (int rep_ = 0; rep_ < PHASE_REP[2]; ++rep_) {
        pg8::Gemm g{WSB(WS_XN), WSB(WS_WIN), M, INW, DM}; pg8::StaticOrder S; S.init(M, INW, G, bx);
        pg8::EpiRows<InProjEpi> E{{WSB(WS_DQ), WSB(WS_DK), WSB(WS_DV), WSB(WS_RQ), WSB(WS_RK), WSB(WS_RV), WSB(WS_RG), WSB(WS_GA), WSB(WS_GB), INF(7), INF(8), WSF(WS_TA), WSF(WS_TR)}};
        pg8::gemm_phase<pg8::EpiRows<InProjEpi>, pg8::StaticOrder, true, true>(L + RING_OFF, g, S, E, WAVE_S);
    }
    ARRIVE(2);
    if (IN(2)) { const float* mod = WSF(WS_MOD); gemv4_phase<false, true>(TID(), vcu, G, mod + 3 * DM, MODW, INF(18), 2 * DFF, nullptr, WSF(WS_CVEC), 2 * DFF, (float*)lds); }
    WAITB(2);
    if (IN(3)) for (int rep_ = 0; rep_ < PHASE_REP[3]; ++rep_) {
        char* shm = (char*)lds + RING_OFF;
        typedef attn_body::bf16 abf;
        const int xb = vcu >> 5, lc = vcu & 31;
        for (int i = 0; i < 2; ++i) {
            if (i < 1) {
                const int hq = lc >> 3, q = lc & 7, b = xb;
                for (int k = 0; k < 2; ++k) {
                    const int qb = k == 0 ? ((0x974f77u >> (3 * q)) & 7) : ((0x4430d1u >> (3 * q)) & 7), u = 4 * (k == 0 ? ((0xe8u >> q) & 1) : ((0xf0u >> q) & 1)) + hq, h = u >> 1;
                    attn_body::attn_unit2<8, false>((long)b * SEQ, qb, (const abf*)(WSB(WS_DQ) + u * 64), 512, (const abf*)(WSB(WS_DK) + u * 64), 512, (const abf*)(WSB(WS_DV) + h * 128), 512,
                                                    (abf*)(WSB(WS_AO) + u * 128), 1024, shm, false, WAVE_S);
                }
                asm volatile("s_waitcnt vmcnt(0)" ::: "memory"); __syncthreads();
                if (FIRST()) (void)__hip_atomic_fetch_add((unsigned*)WSF(WS_PAIR) + (b * 2 + (hq >> 1)) * 8 + q, 1u, __ATOMIC_RELAXED, __HIP_MEMORY_SCOPE_AGENT);
            } else {
                const int h = lc >> 3, qb = lc & 7, b = xb; const long row0 = (long)b * SEQ;
                if (qb > 0) attn_body::ret_state2(row0, 4 * qb, (const abf*)(WSB(WS_RK) + h * 64), 256, (const abf*)(WSB(WS_RV) + h * 128), 512, shm, WAVE_S);
                attn_body::attn_unit2<8, true, true>(row0 + 256 * qb, 0, (const abf*)(WSB(WS_RQ) + h * 64), 256, (const abf*)(WSB(WS_RK) + h * 64), 256, (const abf*)(WSB(WS_RV) + h * 128), 512,
                                                     (abf*)(WSB(WS_RG) + h * 128), 512, shm, qb > 0, WAVE_S, (const abf*)(WSB(WS_RG) + h * 128));
            }
        }
        {
            const int hq = lc >> 3, q = lc & 7, b = xb, k = hq & 1;
            const int qb = k == 0 ? ((0x974f77u >> (3 * q)) & 7) : ((0x4430d1u >> (3 * q)) & 7), h = (4 * (k == 0 ? ((0xe8u >> q) & 1) : ((0xf0u >> q) & 1)) + hq) >> 1;
            if (FIRST()) { unsigned* pc = (unsigned*)WSF(WS_PAIR) + (b * 2 + (hq >> 1)) * 8 + q; unsigned sp = 0; while (__hip_atomic_load(pc, __ATOMIC_RELAXED, __HIP_MEMORY_SCOPE_AGENT) < 2u && ++sp < (1u << 22)) __builtin_amdgcn_s_sleep(1); }
            __syncthreads();
            const float lam = da_lambda(lane_id_(), INF(9), INF(10), INF(11), INF(12));
            combine_da_block(TID(), (long)b * SEQ + 256 * qb, h, lam, WSB(WS_AO), (bf16_t*)OUTP(), INF(13));
        }
    }
    ARRIVE(3);
    if (IN(3)) { CONVPTRS(); convert_phase(TID(), vcu, G, cv, (float*)lds, CV_S2, CV_S2 + 2 * (CV_GU / 3)); __syncthreads(); }
    WAITB(3);
    if (IN(5)) for (int rep_ = 0; rep_ < PHASE_REP[5]; ++rep_) {
        pg8::Gemm g{(const bf16_t*)OUTP(), WSB(WS_WA), M, DM, 512, WSB(WS_OB), WSB(WS_WB)}; pg8::PairOrder S; S.init(M, DM, G, bx); pg8::BranchTileEpi E{WSB(WS_GA), WSB(WS_GB), WSB(WS_Y)};
        pg8::gemm_phase<pg8::BranchTileEpi, pg8::PairOrder, true, true>(L + RING_OFF, g, S, E, WAVE_S);
    }
    ARRIVE(5);
    if (IN(5)) { CONVPTRS(); convert_phase(TID(), vcu, G, cv, (float*)lds, CV_S2 + 2 * (CV_GU / 3), CV_S3); __syncthreads(); }
    WAITB(5);
    if (IN(6)) for (int rep_ = 0; rep_ < PHASE_REP[6]; ++rep_) {
        pg8::Gemm g{WSB(WS_Y), WSB(WS_WOUT), M, DM, DM}; pg8::StaticOrder S; S.init(M, DM, G, bx); pg8::EpiOutFused E{{INF(0), WSB(WS_X1B), WSF(WS_MOD), INF(17), WSB(WS_XN), WSF(WS_ROWSS)}};
        pg8::gemm_phase<pg8::EpiOutFused, pg8::StaticOrder, false, true>(L + RING_OFF, g, S, E, WAVE_S);
    }
    ARRIVE(6);
    if (IN(6)) { CONVPTRS(); convert_phase(TID(), vcu, G, cv, (float*)lds, CV_S3, CV_S4); __syncthreads(); }
    WAITB(6);
    if (IN(8)) for (int rep_ = 0; rep_ < PHASE_REP[8]; ++rep_) {
        pg8::Gemm g{WSB(WS_XN), WSB(WS_WGU), M, 2 * DFF, DM}; pg8::TailHalfOrder S; S.init(M, 2 * DFF, G, bx); pg8::EpiRows<GateUpEpi> E{{WSB(WS_ACT), WSF(WS_ROWSS), WSF(WS_CVEC)}};
        pg8::gemm_phase<pg8::EpiRows<GateUpEpi>, pg8::TailHalfOrder, true, true>(L + RING_OFF, g, S, E, WAVE_S);
    }
    SEAM(8);
    if (IN(9)) for (int rep_ = 0; rep_ < PHASE_REP[9]; ++rep_) {
        float* out = OUTP();
        pg8::Gemm g{WSB(WS_ACT), WSB(WS_WDN), M, DM, DFF};
#if PROBE_DOUBLEK
        pg8::DoubleKOrder S; S.init(M, DM, G, bx); pg8::EpiRowsDK<ResidEpi> E{{WSB(WS_XN), out, WSF(WS_MOD) + 5 * DM, WSF(WS_MOD) + 4 * DM, INF(17), WSB(WS_X1B)}};
        pg8::gemm_phase<pg8::EpiRowsDK<ResidEpi>, pg8::DoubleKOrder, false, true>(L + RING_OFF, g, S, E, WAVE_S);
#else
        pg8::StaticOrder S; S.init(M, DM, G, bx); pg8::EpiRows<ResidEpi> E{{WSB(WS_XN), out, WSF(WS_MOD) + 5 * DM, WSF(WS_MOD) + 4 * DM, INF(17), WSB(WS_X1B)}};
        pg8::gemm_phase<pg8::EpiRows<ResidEpi>, pg8::StaticOrder, true, true>(L + RING_OFF, g, S, E, WAVE_S);
#endif
    }
#undef INF
#undef OUTP
#undef WSB
#undef WSF
    SEAM(9);
    if (PROBE_PHASE >= 0 && blockIdx.x == 0 && WAVE_S == 0) { const unsigned long long tgt = __builtin_amdgcn_s_memrealtime() + (unsigned long long)PROBE_AMP * (t_b - t_a); while (__builtin_amdgcn_s_memrealtime() < tgt) __builtin_amdgcn_s_sleep(8); }
#undef IN
#undef SEAM
#undef ARRIVE
#undef WAITB
#undef CONVPTRS
#undef TID
#undef FIRST
}

#ifndef MK_N_LAUNCHES
#define MK_N_LAUNCHES 1
#endif
extern "C" void kernel_launch(void* const* d_in, const int* in_sizes, int n_in, void* d_out, int out_size, void* d_ws, size_t ws_size, hipStream_t stream) {
    static int grid = 0;
    if (grid == 0) {
        if (n_in != 20 || in_sizes[0] != M * DM || out_size != M * DM || ws_size < WS_END) { fprintf(stderr, "kernel_launch: unexpected shapes (n_in %d, ws %zu)\n", n_in, ws_size); grid = -1; return; }
        int dev = 0, cus = 0, per_cu = 0;
        if (hipGetDevice(&dev) != hipSuccess || hipDeviceGetAttribute(&cus, hipDeviceAttributeMultiprocessorCount, dev) != hipSuccess) { grid = -1; return; }
        if (hipFuncSetAttribute((const void*)mega_fwd, hipFuncAttributeMaxDynamicSharedMemorySize, LDS_BYTES) != hipSuccess) { fprintf(stderr, "kernel_launch: hipFuncSetAttribute failed\n"); grid = -1; return; }
        if (hipOccupancyMaxActiveBlocksPerMultiprocessor(&per_cu, (const void*)mega_fwd, NWAVES * 64, LDS_BYTES) != hipSuccess || per_cu < 1) { fprintf(stderr, "kernel_launch: occupancy query says %d\n", per_cu); per_cu = 1; }
        (void)hipGetLastError();
        if (cus != 256) { fprintf(stderr, "kernel_launch: built for a 256-CU device (got %d)\n", cus); grid = -1; return; }
        grid = cus;
    }
    if (grid < 0) return;
    (void)hipMemsetAsync((char*)d_ws + WS_CTL, 0, MK_N_LAUNCHES == 1 ? WS_ZERO_BYTES : CTL_ZERO_BYTES, stream);
    MArgs a{};
    for (int i = 0; i < 20; ++i) a.in[i] = d_in[i];
    a.out = (float*)d_out; a.ws = (unsigned char*)d_ws;
    if (MK_N_LAUNCHES == 1) { a.ph_lo = 0; a.ph_hi = N_PHASES; a.li = 0; hipLaunchKernelGGL(mega_fwd, dim3(grid), dim3(NWAVES * 64), LDS_BYTES, stream, a); }
    else for (int p = 0; p < N_PHASES; ++p) { a.ph_lo = p; a.ph_hi = p + 1; a.li = p; hipLaunchKernelGGL(mega_fwd, dim3(grid), dim3(NWAVES * 64), LDS_BYTES, stream, a); }
}
```
